# Optimizing an MI355X kernel written in HIP

```python
import jax, jax.numpy as jnp
from jax import lax
import numpy as np

D_MODEL = 1024
BATCH = 4
SEQ = 4096
DEPTH = 4
DEC_BATCH = 16
DEC_SEQ = 2048
PAST_LEN = 128

PLE_DIM = 256
N_EVEN = (DEPTH + 1) // 2
N_ODD = DEPTH // 2
EPS = 1e-6
A_HEADS = 4
A_HD = 128
A_W = A_HEADS * A_HD
B_GROUPS = ((128, 1), (512, 4), (2048, 16))
N_B_GROUPS = 3
B_HEADS = 4
B_HD = 128
B_W = B_HEADS * B_HD
B_BLOCK = 64
ALIBI_MAX_EXP = 8.0
EV_IN = 5 * A_W + N_B_GROUPS * 3 * B_W
EV_OUT = A_W + B_W
C_HEADS = 4
C_KD = D_MODEL // 2
C_VD = D_MODEL
C_HDK = C_KD // C_HEADS
C_HDV = C_VD // C_HEADS
C_RANK = 16
GATE_NORMALIZER = 16.0
OD_IN = 2 * C_KD + 2 * C_VD + 2 * C_RANK
CHUNK = 64
SUB = 16
LOG_DECAY_MIN = -30.0
NEG_INF = -1e30
D_FF = 2816
CONV_W = 3

kernel_name = 'hybrid_bidir_hgrn2_dilattn_gla_encoder'


def _rmsnorm(x, g):
    x32 = x.astype(jnp.float32)
    y = x32 * lax.rsqrt(jnp.mean(x32 * x32, axis=-1, keepdims=True) + EPS)
    return y.astype(x.dtype) * g


def _head_rmsnorm(o, g):
    y = o * lax.rsqrt(jnp.mean(o * o, axis=-1, keepdims=True) + EPS)
    return y.reshape(o.shape[0], o.shape[1], -1) * g


def _chunk_gla(q, k, v, g):
    bsz, T, H, dk = q.shape
    dv = v.shape[-1]
    nc, ns = T // CHUNK, CHUNK // SUB
    f32 = jnp.float32

    def to_chunks(t):
        return t.astype(f32).reshape(bsz, nc, CHUNK, H, t.shape[-1]).transpose(1, 0, 3, 2, 4)

    g = jnp.maximum(g.astype(f32), LOG_DECAY_MIN)
    xs = (to_chunks(q), to_chunks(k), to_chunks(v), to_chunks(g))
    tri = jnp.tril(jnp.ones((SUB, SUB), dtype=bool))
    lower = jnp.tril(jnp.ones((ns, ns), dtype=bool), -1)

    def step(S, inp):
        qc, kc, vc, gc = inp
        b = jnp.cumsum(gc, axis=2)
        b_last = b[:, :, -1]
        o = jnp.einsum('bhcd,bhde->bhce', qc * jnp.exp(b), S)
        qs = qc.reshape(bsz, H, ns, SUB, dk)
        ks = kc.reshape(bsz, H, ns, SUB, dk)
        vs = vc.reshape(bsz, H, ns, SUB, dv)
        bs = b.reshape(bsz, H, ns, SUB, dk)
        r = bs[:, :, :, -1]
        q_off = qs[:, :, :, None] * jnp.exp(jnp.minimum(bs[:, :, :, None] - r[:, :, None, :, None, :], 0.0))
        k_off = ks * jnp.exp(r[:, :, :, None, :] - bs)
        a_off = jnp.where(lower[:, :, None, None],
                          jnp.einsum('bhijtd,bhjsd->bhijts', q_off, k_off), 0.0)
        w = jnp.where(tri[:, :, None],
                      jnp.exp(jnp.minimum(bs[:, :, :, :, None] - bs[:, :, :, None], 0.0)), 0.0)
        a_diag = jnp.einsum('bhitd,bhisd,bhitsd->bhits', qs, ks, w)
        o_intra = (jnp.einsum('bhijts,bhjse->bhite', a_off, vs)
                   + jnp.einsum('bhits,bhise->bhite', a_diag, vs))
        o = o + o_intra.reshape(bsz, H, CHUNK, dv)
        S = (jnp.exp(b_last)[..., None] * S
             + jnp.einsum('bhcd,bhce->bhde', kc * jnp.exp(b_last[:, :, None] - b), vc))
        return S, o

    S0 = jnp.zeros((bsz, H, dk, dv), f32)
    _, o = lax.scan(step, S0, xs)
    return o.transpose(1, 0, 3, 2, 4).reshape(bsz, T, H, dv)


def _bidir_gla(q, k_f, g_f, k_b, g_b, v):
    flip = lambda t: t[:, ::-1]
    o_f = _chunk_gla(q, k_f, v, g_f)
    o_b = flip(_chunk_gla(flip(q), flip(k_b), flip(v), flip(g_b)))
    return o_f + o_b


def _dilated_window_attn(q, k, v, dil, radius, slopes):
    bsz, T, H, dh = q.shape
    f32 = jnp.float32
    L = T // dil
    nb = -(-L // B_BLOCK)
    Lp = nb * B_BLOCK

    def split(t):
        return t.astype(f32).reshape(bsz, L, dil, H, dh).transpose(0, 2, 3, 1, 4)

    qb = jnp.pad(split(q) * (dh ** -0.5), ((0, 0), (0, 0), (0, 0), (0, Lp - L), (0, 0)))
    qb = qb.reshape(bsz, dil, H, nb, B_BLOCK, dh)
    pad_kv = ((0, 0), (0, 0), (0, 0), (B_BLOCK, Lp - L + B_BLOCK), (0, 0))
    kb = jnp.pad(split(k), pad_kv).reshape(bsz, dil, H, nb + 2, B_BLOCK, dh)
    vb = jnp.pad(split(v), pad_kv).reshape(bsz, dil, H, nb + 2, B_BLOCK, dh)
    s = jnp.concatenate([jnp.einsum('brhnad,brhncd->brhnac', qb, kb[:, :, :, i:i + nb])
                         for i in range(3)], axis=-1)
    rel = jnp.arange(3 * B_BLOCK)[None, :] - B_BLOCK - jnp.arange(B_BLOCK)[:, None]
    key_idx = jnp.arange(nb)[:, None] * B_BLOCK - B_BLOCK + jnp.arange(3 * B_BLOCK)[None, :]
    valid = (jnp.abs(rel) <= radius)[None] & ((key_idx >= 0) & (key_idx < L))[:, None, :]
    bias = -slopes.astype(f32)[:, None, None, None] * (dil * jnp.abs(rel)).astype(f32)
    s = jnp.where(valid, s + bias, NEG_INF)
    m = jnp.max(s, axis=-1, keepdims=True)
    pr = jnp.exp(s - m)
    den = jnp.sum(pr, axis=-1)
    o = jnp.einsum('brhnac,brhncd->brhnad', pr[..., :B_BLOCK], vb[:, :, :, 0:nb])
    for i in range(1, 3):
        o = o + jnp.einsum('brhnac,brhncd->brhnad', pr[..., i * B_BLOCK:(i + 1) * B_BLOCK],
                           vb[:, :, :, i:i + nb])
    o = o / den[..., None]
    lse = m[..., 0] + jnp.log(den)
    o = o.reshape(bsz, dil, H, Lp, dh)[:, :, :, :L].transpose(0, 3, 1, 2, 4).reshape(bsz, T, H, dh)
    lse = lse.reshape(bsz, dil, H, Lp)[..., :L].transpose(0, 3, 1, 2).reshape(bsz, T, H)
    return o, lse


def _alibi_slopes():
    n = N_B_GROUPS * B_HEADS
    e = jnp.arange(1, n + 1, dtype=jnp.float32)
    return (2.0 ** (-ALIBI_MAX_EXP * e / n)).reshape(N_B_GROUPS, B_HEADS)


def _hgrn_gates(z, lb):
    z = z.astype(jnp.float32)
    lb = lb.astype(jnp.float32).reshape(A_HEADS, A_HD)
    log_f = jnp.logaddexp(jnp.log(lb), jnp.log1p(-lb) + jax.nn.log_sigmoid(z))
    key = (1.0 - lb) * jax.nn.sigmoid(-z)
    return key, log_f


def _even_mixer(xn, w_in, lb_f, lb_b, a_norm_g, w_out):
    bsz, T, _ = xn.shape
    u = xn @ w_in
    a_q, a_zf, a_zb, a_i, a_g, b_qkv = jnp.split(u, [A_W, 2 * A_W, 3 * A_W, 4 * A_W, 5 * A_W], axis=-1)
    hd = lambda t: t.reshape(bsz, T, A_HEADS, A_HD)
    k_f, g_f = _hgrn_gates(hd(a_zf), lb_f)
    k_b, g_b = _hgrn_gates(hd(a_zb), lb_b)
    o_a = _bidir_gla(hd(a_q), k_f, g_f, k_b, g_b, hd(a_i))
    out_a = _head_rmsnorm(o_a, a_norm_g) * jax.nn.silu(a_g.astype(jnp.float32))
    b = b_qkv.reshape(bsz, T, N_B_GROUPS, 3, B_HEADS, B_HD)
    slopes = _alibi_slopes()
    outs, lses = [], []
    for gi, (win, dil) in enumerate(B_GROUPS):
        o_g, lse_g = _dilated_window_attn(b[:, :, gi, 0], b[:, :, gi, 1], b[:, :, gi, 2],
                                          dil, win // (2 * dil), slopes[gi])
        outs.append(o_g)
        lses.append(lse_g)
    alpha = jax.nn.softmax(jnp.stack(lses, axis=0), axis=0)
    out_b = jnp.sum(alpha[..., None] * jnp.stack(outs, axis=0), axis=0).reshape(bsz, T, B_W)
    mixed = jnp.concatenate([out_a, out_b], axis=-1).astype(xn.dtype)
    return mixed @ w_out


def _odd_mixer(xn, w_in, w_gate_up, b_gate, norm_g, w_out):
    bsz, T, _ = xn.shape
    u = xn @ w_in
    q, k, v, g, lr_f, lr_b = jnp.split(
        u, [C_KD, 2 * C_KD, 2 * C_KD + C_VD, 2 * C_KD + 2 * C_VD, 2 * C_KD + 2 * C_VD + C_RANK], axis=-1)
    hk = lambda t: t.reshape(bsz, T, C_HEADS, C_HDK)

    def decay(lr, d):
        logit = (lr @ w_gate_up[d] + b_gate[d]).astype(jnp.float32)
        return hk(jax.nn.log_sigmoid(logit) / GATE_NORMALIZER)

    qh = hk(q.astype(jnp.float32) * (C_HDK ** -0.5))
    kh = hk(k)
    vh = v.reshape(bsz, T, C_HEADS, C_HDV)
    o = _bidir_gla(qh, kh, decay(lr_f, 0), kh, decay(lr_b, 1), vh)
    out = _head_rmsnorm(o, norm_g) * jax.nn.silu(g.astype(jnp.float32))
    return out.astype(xn.dtype) @ w_out


def _conv_ffn(x, w_up, conv_w, conv_b, w_down):
    u = x @ w_up
    up = jnp.pad(u, ((0, 0), (1, 1), (0, 0)))
    u = up[:, :-2] * conv_w[0] + up[:, 1:-1] * conv_w[1] + up[:, 2:] * conv_w[2] + conv_b
    a, gate = jnp.split(u, 2, axis=-1)
    return (a * jax.nn.gelu(gate, approximate=False)) @ w_down


def _trunk(x, p, norm_mix_g, ev_w_in, hgrn_lb, hgrn_norm_g, ev_w_out, od_w_in, gla_w_gate_up,
           gla_b_gate, gla_norm_g, od_w_out, norm_ffn_g, ffn_w_up, ffn_conv_w, ffn_conv_b, ffn_w_down,
           norm_ple_g, ple_w_gate, ple_w_proj, norm_out_g):
    h = x
    for l in range(DEPTH):
        xn = _rmsnorm(h, norm_mix_g[l])
        if l % 2 == 0:
            e = l // 2
            h = h + _even_mixer(xn, ev_w_in[e], hgrn_lb[0, e], hgrn_lb[1, e], hgrn_norm_g[e], ev_w_out[e])
        else:
            o = l // 2
            h = h + _odd_mixer(xn, od_w_in[o], gla_w_gate_up[o], gla_b_gate[o], gla_norm_g[o], od_w_out[o])
        h = h + _conv_ffn(_rmsnorm(h, norm_ffn_g[l]), ffn_w_up[l], ffn_conv_w[l], ffn_conv_b[l], ffn_w_down[l])
        gate = jax.nn.sigmoid(_rmsnorm(h, norm_ple_g[l]) @ ple_w_gate[l])
        h = h + gate * (p[l] @ ple_w_proj[l])
    return _rmsnorm(h, norm_out_g)


def setup_inputs(seed: int = 0) -> dict:
    key = jax.random.key(seed)
    ks = iter(jax.random.split(key, 40))
    f32 = jnp.float32
    nrm = lambda shape, scale: jax.random.normal(next(ks), shape, f32) * scale
    gain = lambda shape: 1.0 + 0.05 * jax.random.normal(next(ks), shape, f32)
    centre = jnp.array([0.0, 1.0, 0.0], f32)[None, :, None]
    return {
        'x_prompt': nrm((BATCH, SEQ, D_MODEL), 1.0),
        'x_sample': nrm((DEC_BATCH, DEC_SEQ, D_MODEL), 1.0),
        'p_prompt': nrm((DEPTH, BATCH, SEQ, PLE_DIM), 1.0),
        'p_sample': nrm((DEPTH, DEC_BATCH, DEC_SEQ, PLE_DIM), 1.0),
        'norm_mix_g': gain((DEPTH, D_MODEL)),
        'ev_w_in': nrm((N_EVEN, D_MODEL, EV_IN), D_MODEL ** -0.5),
        'hgrn_lb_logits': nrm((2, N_EVEN, A_W), 1.0),
        'hgrn_norm_g': gain((N_EVEN, A_W)),
        'ev_w_out': nrm((N_EVEN, EV_OUT, D_MODEL), EV_OUT ** -0.5),
        'od_w_in': nrm((N_ODD, D_MODEL, OD_IN), D_MODEL ** -0.5),
        'gla_w_gate_up': nrm((N_ODD, 2, C_RANK, C_KD), C_RANK ** -0.5),
        'gla_b_gate': nrm((N_ODD, 2, C_KD), 0.1),
        'gla_norm_g': gain((N_ODD, C_VD)),
        'od_w_out': nrm((N_ODD, C_VD, D_MODEL), C_VD ** -0.5),
        'norm_ffn_g': gain((DEPTH, D_MODEL)),
        'ffn_w_up': nrm((DEPTH, D_MODEL, 2 * D_FF), D_MODEL ** -0.5),
        'ffn_conv_w': centre + nrm((DEPTH, CONV_W, 2 * D_FF), 0.3),
        'ffn_conv_b': nrm((DEPTH, 2 * D_FF), 0.02),
        'ffn_w_down': nrm((DEPTH, D_FF, D_MODEL), D_FF ** -0.5),
        'norm_ple_g': gain((DEPTH, D_MODEL)),
        'ple_w_gate': nrm((DEPTH, D_MODEL, D_MODEL), D_MODEL ** -0.5),
        'ple_w_proj': nrm((DEPTH, PLE_DIM, D_MODEL), PLE_DIM ** -0.5),
        'norm_out_g': gain((D_MODEL,)),
    }


def reference(x_prompt, x_sample, p_prompt, p_sample, norm_mix_g, ev_w_in, hgrn_lb_logits, hgrn_norm_g,
              ev_w_out, od_w_in, gla_w_gate_up, gla_b_gate, gla_norm_g, od_w_out, norm_ffn_g, ffn_w_up,
              ffn_conv_w, ffn_conv_b, ffn_w_down, norm_ple_g, ple_w_gate, ple_w_proj, norm_out_g):
    lb = jnp.cumsum(jax.nn.softmax(hgrn_lb_logits.astype(jnp.float32), axis=1), axis=1)
    lb = lb - lb[:, :1]
    y_prompt = _trunk(x_prompt, p_prompt, norm_mix_g, ev_w_in, lb, hgrn_norm_g, ev_w_out, od_w_in,
                      gla_w_gate_up, gla_b_gate, gla_norm_g, od_w_out, norm_ffn_g, ffn_w_up, ffn_conv_w,
                      ffn_conv_b, ffn_w_down, norm_ple_g, ple_w_gate, ple_w_proj, norm_out_g)
    y_sample = _trunk(x_sample, p_sample, norm_mix_g, ev_w_in, lb, hgrn_norm_g, ev_w_out, od_w_in,
                      gla_w_gate_up, gla_b_gate, gla_norm_g, od_w_out, norm_ffn_g, ffn_w_up, ffn_conv_w,
                      ffn_conv_b, ffn_w_down, norm_ple_g, ple_w_gate, ple_w_proj, norm_out_g)
    return (y_prompt, y_sample)
```

```cpp
#include <hip/hip_runtime.h>
#include <hip/hip_cooperative_groups.h>
#include <cstdio>
#include <cstdint>
namespace cg = cooperative_groups;
namespace pg8 {
#define PG8_LAS __attribute__((address_space(3)))
typedef unsigned short bf16_t;
typedef short bf16x8 __attribute__((ext_vector_type(8)));
typedef float f32x4 __attribute__((ext_vector_type(4)));
typedef unsigned u32x4 __attribute__((ext_vector_type(4)));
constexpr int BM = 256, BK = 64, HALF = 128, HTB = HALF * BK * 2  , STAGE_BYTES = 8 * HTB, NXCD = 8, WGM = 8;

__host__ __device__ __forceinline__ int lds_byte(int r, int c) { const int st = (r >> 4) * 2 + (c >> 5), rr = r & 15, cc = c & 31, ob = rr * 64 + cc * 2; return st * 1024 + (ob ^ (((ob >> 9) & 1) << 5)); }
__host__ __device__ __forceinline__ void stage_rc(int b, int& R, int& C) { const int st = b / 1024, sb = b % 1024, swz = sb ^ (((sb >> 9) & 1) << 5); R = (st >> 1) * 16 + swz / 64; C = (st & 1) * 32 + (swz % 64) / 2; }
__host__ __device__ __forceinline__ int perm32(int rho) { const int n = rho >> 4, i = rho & 15; return 8 * (i >> 2) + 4 * n + (i & 3); }

struct Unit { int pm, pn; };
struct Gemm { const bf16_t* A; const bf16_t* Bt; int M, N, K; };

struct StaticOrder {
    int nM, nN, nwg, G, c;
    __host__ __device__ void init(int M, int N, int G_, int c_) { nM = M / BM; nN = N / BM; nwg = nM * nN; G = G_; c = c_; }
    __host__ __device__ bool next(int i, Unit& u) const {
        const long L = (long)i * G + c; if (L >= nwg) return false;
        int wgid = (int)L; { const int q = nwg / NXCD, r = nwg % NXCD, xcd = wgid % NXCD, off = wgid / NXCD; wgid = (xcd < r ? xcd * (q + 1) : r * (q + 1) + (xcd - r) * q) + off; }
        const int nig = WGM * nN, gid = wgid / nig, fm = gid * WGM, gsz = (nM - fm) < WGM ? (nM - fm) : WGM;
        u.pm = fm + ((wgid % nig) % gsz); u.pn = (wgid % nig) / gsz; return true;
    }
    __device__ __forceinline__ void a_ready(const Unit&) const {}
    __device__ __forceinline__ void done(const Unit&) const {}
};

__device__ __forceinline__ unsigned cvt_pk_bf16(float lo, float hi) { unsigned r; asm volatile("v_cvt_pk_bf16_f32 %0, %1, %2" : "=v"(r) : "v"(lo), "v"(hi)); return r; }
typedef float f32x2 __attribute__((ext_vector_type(2)));
__device__ __forceinline__ f32x2 gelu_pk(f32x2 v) {
    const f32x2 av = __builtin_elementwise_abs(v), d = av * 0.2316418882f + 1.0f;
    f32x2 t; t.x = __builtin_amdgcn_rcpf(d.x); t.y = __builtin_amdgcn_rcpf(d.y);
    f32x2 q = t * 0.5307027145f + (-0.7265760135f); q = q * t + 0.7107068705f; q = q * t + (-0.142248368f); q = q * t + 0.127414796f; q = q * t;
    const f32x2 s = (v * v) * (-0.72134752044f);
    f32x2 e; e.x = __builtin_amdgcn_exp2f(s.x); e.y = __builtin_amdgcn_exp2f(s.y);
    const f32x2 m = v * (q * e), r = v - m;
    f32x2 o; o.x = v.x < 0.f ? m.x : r.x; o.y = v.y < 0.f ? m.y : r.y; return o;
}

template <int ACT  > struct EpiBf16 {
    static constexpr bool PERM = true, AFTER_DRAIN = false; static_assert(ACT == 0 || ACT == 1, "EpiBf16: ACT is 0 (none) or 1 (gelu_pk)");
    bf16_t* O; int ldc; const float* bias; int split_cols; size_t split_stride; float scale0;
    __device__ __forceinline__ void operator()(const f32x4 (&acc)[2][2][4][2], const Unit& u, int wr, int wc, int fr, int fq) const {
        const int row0 = u.pm * BM + wr * 64 + fr; int colt = u.pn * BM; bf16_t* base = O;
        float sc = 1.f; if (split_cols) { const int t = colt / split_cols; base += (size_t)t * split_stride; colt -= t * split_cols; if (t == 0) sc = scale0; }
        const int col0 = colt + wc * 32 + 8 * fq, bcol0 = u.pn * BM + wc * 32 + 8 * fq;
        f32x4 bv[2][2];
#pragma unroll
        for (int bj = 0; bj < 2; ++bj)
#pragma unroll
            for (int n = 0; n < 2; ++n) bv[bj][n] = bias ? *(const f32x4*)(bias + bcol0 + bj * HALF + 4 * n) : (f32x4){0.f, 0.f, 0.f, 0.f};
#pragma unroll
        for (int ai = 0; ai < 2; ++ai)
#pragma unroll
            for (int m = 0; m < 4; ++m) { bf16_t* rowp = base + (size_t)(row0 + ai * HALF + m * 16) * ldc + col0;
#pragma unroll
                for (int bj = 0; bj < 2; ++bj) { f32x4 v0 = acc[ai][bj][m][0] + bv[bj][0], v1 = acc[ai][bj][m][1] + bv[bj][1];
                    if (ACT == 1) { f32x2 a = gelu_pk((f32x2){v0[0], v0[1]}), b = gelu_pk((f32x2){v0[2], v0[3]}), c = gelu_pk((f32x2){v1[0], v1[1]}), d = gelu_pk((f32x2){v1[2], v1[3]});
                        v0 = (f32x4){a.x, a.y, b.x, b.y}; v1 = (f32x4){c.x, c.y, d.x, d.y}; }
                    v0 = v0 * sc; v1 = v1 * sc; u32x4 w; w.x = cvt_pk_bf16(v0[0], v0[1]); w.y = cvt_pk_bf16(v0[2], v0[3]); w.z = cvt_pk_bf16(v1[0], v1[1]); w.w = cvt_pk_bf16(v1[2], v1[3]);
                    *(u32x4*)(rowp + bj * HALF) = w; } }
    }
};
template <class Epi, class Sched, bool ALIGN_EPI = false, bool SP2 = false>
__device__ __forceinline__ void gemm_phase(PG8_LAS unsigned char* lds, const Gemm g, const Sched& S, const Epi& E) {
    int tid_ = threadIdx.x; asm volatile("" : "+v"(tid_)); const int tid = tid_, wid = __builtin_amdgcn_readfirstlane(tid >> 6), lane = tid & 63, wr = wid >> 2, wc = wid & 3, fr = lane & 15, fq = lane >> 4;
    int K_ = g.K; asm volatile("" : "+s"(K_)); const int K = K_, nt = K / BK;
    unsigned voffA[2], voffB[2];
#pragma unroll
    for (int i = 0; i < 2; ++i) { int R, C; stage_rc(tid * 16 + i * 8192, R, C); const int Rb = Epi::PERM ? ((R & ~31) + perm32(R & 31)) : R;
        voffA[i] = (unsigned)(R * K + C) * 2u; voffB[i] = (unsigned)(Rb * K + C) * 2u; }
    const size_t kstep = (size_t)(BK * 2);
    const size_t hstep = (size_t)HALF * K * 2;
    const size_t tstep = 2 * hstep;
    const unsigned ldsw = (unsigned)wid * 1024u;
    const int aoff = lds_byte(wr * 64 + fr, fq * 8), boff = lds_byte(wc * 32 + fr, fq * 8);
#define PG8_SA(b, h) (((b) * 2 + (h)) * HTB)
#define PG8_SB(b, h) ((4 + (b) * 2 + (h)) * HTB)
#define PG8_STAGE(bufoff, gbase, voff) do { _Pragma("unroll") for (int _i = 0; _i < 2; ++_i) \
        __builtin_amdgcn_global_load_lds((const unsigned*)((const char*)(gbase) + (voff)[_i]), (PG8_LAS unsigned*)(lds + (bufoff) + ldsw + _i * 8192), 16, 0, 0); } while (0)
#define PG8_LDA(dst, b, h) do { _Pragma("unroll") for (int m = 0; m < 4; ++m) _Pragma("unroll") for (int k = 0; k < 2; ++k) dst[m][k] = *(const PG8_LAS bf16x8*)(lds + PG8_SA(b, h) + aoff + m * 2048 + k * 1024); } while (0)
#define PG8_LDB(dst, b, h) do { _Pragma("unroll") for (int n = 0; n < 2; ++n) _Pragma("unroll") for (int k = 0; k < 2; ++k) dst[n][k] = *(const PG8_LAS bf16x8*)(lds + PG8_SB(b, h) + boff + n * 2048 + k * 1024); } while (0)
#define PG8_MMA(ai, bj, At, Bt) do { __builtin_amdgcn_s_setprio(1); _Pragma("unroll") for (int m = 0; m < 4; ++m) _Pragma("unroll") for (int n = 0; n < 2; ++n) _Pragma("unroll") for (int k = 0; k < 2; ++k) \
        acc[ai][bj][m][n] = __builtin_amdgcn_mfma_f32_16x16x32_bf16(Bt[n][k], At[m][k], acc[ai][bj][m][n], 0, 0, 0); __builtin_amdgcn_s_setprio(0); } while (0)
#define PG8_WAIT_V(n) asm volatile("s_waitcnt vmcnt(" #n ")" ::: "memory")
#define PG8_WAIT_L(n) asm volatile("s_waitcnt lgkmcnt(" #n ")" ::: "memory")
#define PG8_BAR __builtin_amdgcn_s_barrier()
#define PG8_SCHED __builtin_amdgcn_sched_barrier(0)
    Unit cur, nxt; int ui = 0;
    if (!S.next(0, cur)) return;
    f32x4 acc[2][2][4][2];
#pragma unroll
    for (int a = 0; a < 2; ++a)
#pragma unroll
        for (int b = 0; b < 2; ++b)
#pragma unroll
            for (int m = 0; m < 4; ++m)
#pragma unroll
                for (int n = 0; n < 2; ++n) acc[a][b][m][n] = (f32x4){0.f, 0.f, 0.f, 0.f};
    bf16x8 At[4][2], B0[2][2], B1[2][2];
    const char* cA = (const char*)g.A + (size_t)cur.pm * tstep; const char* cB = (const char*)g.Bt + (size_t)cur.pn * tstep;
    S.a_ready(cur);
    if constexpr (SP2) {
        PG8_STAGE(PG8_SB(0, 0), cB, voffB); PG8_STAGE(PG8_SB(0, 1), cB + hstep, voffB); PG8_STAGE(PG8_SA(0, 0), cA, voffA); PG8_STAGE(PG8_SA(0, 1), cA + hstep, voffA);
        if (wr == 1) PG8_BAR;
        PG8_WAIT_V(2); PG8_BAR;
        PG8_STAGE(PG8_SB(1, 0), cB + kstep, voffB); PG8_STAGE(PG8_SA(1, 0), cA + kstep, voffA); PG8_STAGE(PG8_SB(1, 1), cB + hstep + kstep, voffB);
        PG8_WAIT_V(6); PG8_BAR;
    } else {
        PG8_STAGE(PG8_SB(0, 0), cB, voffB); PG8_STAGE(PG8_SA(0, 0), cA, voffA); PG8_STAGE(PG8_SB(0, 1), cB + hstep, voffB); PG8_STAGE(PG8_SA(0, 1), cA + hstep, voffA);
        if (wr == 1) PG8_BAR;
        PG8_WAIT_V(4); PG8_BAR;
        PG8_STAGE(PG8_SB(1, 0), cB + kstep, voffB); PG8_STAGE(PG8_SA(1, 0), cA + kstep, voffA); PG8_STAGE(PG8_SB(1, 1), cB + hstep + kstep, voffB);
        PG8_WAIT_V(6); PG8_BAR;
    }
    for (;;) {
        const bool has_next = S.next(ui + 1, nxt);
        const char* nA = has_next ? (const char*)g.A + (size_t)nxt.pm * tstep : cA; const char* nB = has_next ? (const char*)g.Bt + (size_t)nxt.pn * tstep : cB;
        for (int t = 0; t < nt; t += 2) {
            const bool last = (t == nt - 2);
            const char* a1 = cA + (size_t)(t + 1) * kstep;
            const char* a2 = last ? nA : cA + (size_t)(t + 2) * kstep; const char* b2 = last ? nB : cB + (size_t)(t + 2) * kstep;
            const char* a3 = a2 + kstep; const char* b3 = b2 + kstep;
            if (last && has_next) S.a_ready(nxt);
            if constexpr (SP2) {
            PG8_LDB(B0, 0, 0); PG8_LDB(B1, 0, 1); PG8_SCHED; PG8_LDA(At, 0, 0); PG8_STAGE(PG8_SA(1, 1), a1 + hstep, voffA);
            PG8_WAIT_V(8); PG8_WAIT_L(0); PG8_BAR; PG8_MMA(0, 0, At, B0); PG8_MMA(0, 1, At, B1); PG8_BAR; PG8_SCHED;
            PG8_LDA(At, 0, 1); PG8_STAGE(PG8_SB(0, 0), b2, voffB); PG8_STAGE(PG8_SB(0, 1), b2 + hstep, voffB); PG8_STAGE(PG8_SA(0, 0), a2, voffA);
            PG8_WAIT_V(8); PG8_WAIT_L(0); PG8_BAR; PG8_MMA(1, 0, At, B0); PG8_MMA(1, 1, At, B1); PG8_BAR; PG8_SCHED;
            PG8_LDB(B0, 1, 0); PG8_LDB(B1, 1, 1); PG8_SCHED; PG8_LDA(At, 1, 0); PG8_STAGE(PG8_SA(0, 1), a2 + hstep, voffA);
            PG8_WAIT_V(8); PG8_WAIT_L(0); PG8_BAR; PG8_MMA(0, 0, At, B0); PG8_MMA(0, 1, At, B1); PG8_BAR; PG8_SCHED;
            PG8_LDA(At, 1, 1); PG8_STAGE(PG8_SB(1, 0), b3, voffB); PG8_STAGE(PG8_SB(1, 1), b3 + hstep, voffB); PG8_STAGE(PG8_SA(1, 0), a3, voffA);
            PG8_WAIT_V(8); PG8_WAIT_L(0); PG8_BAR; PG8_MMA(1, 0, At, B0); PG8_MMA(1, 1, At, B1); PG8_BAR; PG8_SCHED;
            } else {
            PG8_LDB(B0, 0, 0); PG8_SCHED; PG8_LDA(At, 0, 0); PG8_STAGE(PG8_SA(1, 1), a1 + hstep, voffA);
            PG8_WAIT_L(8); PG8_BAR; PG8_WAIT_L(0); PG8_MMA(0, 0, At, B0); PG8_BAR; PG8_SCHED;
            PG8_LDB(B1, 0, 1); PG8_STAGE(PG8_SB(0, 0), b2, voffB);
            PG8_BAR; PG8_WAIT_L(0); PG8_MMA(0, 1, At, B1); PG8_BAR;
            PG8_LDA(At, 0, 1); PG8_STAGE(PG8_SA(0, 0), a2, voffA);
            PG8_BAR; PG8_WAIT_L(0); PG8_MMA(1, 0, At, B0); PG8_BAR; PG8_SCHED;
            PG8_STAGE(PG8_SB(0, 1), b2 + hstep, voffB);
            PG8_WAIT_V(6); PG8_BAR; PG8_MMA(1, 1, At, B1); PG8_BAR;
            PG8_LDB(B0, 1, 0); PG8_SCHED; PG8_LDA(At, 1, 0); PG8_STAGE(PG8_SA(0, 1), a2 + hstep, voffA);
            PG8_WAIT_L(8); PG8_BAR; PG8_WAIT_L(0); PG8_MMA(0, 0, At, B0); PG8_BAR; PG8_SCHED;
            PG8_LDB(B1, 1, 1); PG8_STAGE(PG8_SB(1, 0), b3, voffB);
            PG8_BAR; PG8_WAIT_L(0); PG8_MMA(0, 1, At, B1); PG8_BAR;
            PG8_LDA(At, 1, 1); PG8_STAGE(PG8_SA(1, 0), a3, voffA);
            PG8_BAR; PG8_WAIT_L(0); PG8_MMA(1, 0, At, B0); PG8_BAR; PG8_SCHED;
            PG8_STAGE(PG8_SB(1, 1), b3 + hstep, voffB);
            PG8_WAIT_V(6); PG8_BAR; PG8_MMA(1, 1, At, B1); PG8_BAR;
            }
        }
        if constexpr (ALIGN_EPI) { if (wr == 0) PG8_BAR; }
        if constexpr (!Epi::AFTER_DRAIN) { E(acc, cur, wr, wc, fr, fq); S.done(cur); }
        if (!has_next) break;
#pragma unroll
        for (int a = 0; a < 2; ++a)
#pragma unroll
            for (int b = 0; b < 2; ++b)
#pragma unroll
                for (int m = 0; m < 4; ++m)
#pragma unroll
                    for (int n = 0; n < 2; ++n) acc[a][b][m][n] = (f32x4){0.f, 0.f, 0.f, 0.f};
        cur = nxt; cA = nA; cB = nB; ++ui;
        if constexpr (ALIGN_EPI) { if (wr == 1) PG8_BAR; }
    }
    PG8_WAIT_V(0);
    if constexpr (!ALIGN_EPI) { if (wr == 0) PG8_BAR; }
    PG8_BAR;
    if constexpr (Epi::AFTER_DRAIN) { E.fused(acc, cur, wr, wc, fr, fq, lds, wid, lane); S.done(cur); }
#undef PG8_SA
#undef PG8_SB
#undef PG8_STAGE
#undef PG8_LDA
#undef PG8_LDB
#undef PG8_MMA
#undef PG8_WAIT_V
#undef PG8_WAIT_L
#undef PG8_BAR
#undef PG8_SCHED
}
}
typedef unsigned short bf16_t;
typedef short bf16x8 __attribute__((ext_vector_type(8)));
typedef float f32x4 __attribute__((ext_vector_type(4)));
typedef float f32x2 __attribute__((ext_vector_type(2)));
typedef float f32x16 __attribute__((ext_vector_type(16)));
typedef unsigned u32x4 __attribute__((ext_vector_type(4)));
typedef unsigned u32x2 __attribute__((ext_vector_type(2)));
#define LAS __attribute__((address_space(3)))
constexpr int DM = 1024, CH = 16384, NCHUNK = 3, DEPTH = 4, PLE = 256, DFF = 2816;
constexpr int EV_IN = 7168, OD_IN = 3104, OD_INP = 3328;
constexpr float EPS = 1e-6f;
constexpr int NT = 512, NWV = 8;
constexpr int LDS_BYTES = 147456;
constexpr size_t al256(size_t x) { return (x + 255) & ~(size_t)255; }
constexpr size_t W_EVIN = 65536;
constexpr size_t W_EVOUT = W_EVIN + (size_t)2 * EV_IN * DM * 2;
constexpr size_t W_ODIN = W_EVOUT + (size_t)2 * DM * DM * 2;
constexpr size_t W_ODOUT = W_ODIN + (size_t)2 * OD_INP * DM * 2;
constexpr size_t W_UP = W_ODOUT + (size_t)2 * DM * DM * 2;
constexpr size_t W_DOWN = W_UP + (size_t)4 * 2 * DFF * DM * 2;
constexpr size_t W_GATE = W_DOWN + (size_t)4 * DM * DFF * 2;
constexpr size_t W_PROJ = W_GATE + (size_t)4 * DM * DM * 2;
constexpr size_t W_LB = W_PROJ + (size_t)4 * DM * PLE * 2;
constexpr size_t B_PB = W_LB + 8192;
constexpr size_t B_HB0 = B_PB + (size_t)CH * PLE * 2;
constexpr size_t B_HB1 = B_HB0 + (size_t)CH * DM * 2;
constexpr size_t B_SSQ0 = B_HB1 + (size_t)CH * DM * 2;
constexpr size_t B_SSQ1 = B_SSQ0 + (size_t)CH * 16 * 4;
constexpr size_t ARENA = B_SSQ1 + (size_t)CH * 16 * 4;
constexpr size_t A_U = 0;
constexpr size_t A_QT = (size_t)CH * EV_IN * 2;
constexpr size_t A_KT = A_QT + (size_t)2 * CH * 512 * 2;
constexpr size_t A_MIX = A_QT;
constexpr size_t A_OEV = A_KT + (size_t)2 * CH * 512 * 2;
constexpr size_t A_OOD = A_OEV;
constexpr size_t A_OG = A_OEV + (size_t)2 * CH * 512 * 4;
constexpr size_t A_LSE = A_OG + (size_t)3 * CH * 512 * 2;
constexpr size_t A_DEC = A_OOD + (size_t)2 * CH * 1024 * 4;
constexpr size_t ARENA_BYTES = A_DEC + (size_t)512 * 4 * 2 * 128 * 4;
constexpr size_t A_UF = 0;
constexpr size_t A_ACT = (size_t)CH * 2 * DFF * 2;
constexpr size_t A_PP = 0;
constexpr size_t WS_NEED = ARENA + ARENA_BYTES;
static_assert(A_LSE + (size_t)3 * CH * 4 * 4 <= A_DEC, "even bufs before DEC");
static_assert(A_ACT + (size_t)CH * DFF * 2 <= ARENA_BYTES, "act fits");

__device__ __forceinline__ float bf2f(unsigned short v) { return __uint_as_float(((unsigned)v) << 16); }
__device__ __forceinline__ unsigned pk2(float lo, float hi) { return pg8::cvt_pk_bf16(lo, hi); }
__device__ __forceinline__ float wave_sum(float v) {
#pragma unroll
    for (int o = 1; o < 64; o <<= 1) v += __shfl_xor(v, o);
    return v;
}
__device__ __forceinline__ float rstd_of(const float* ssq, int row) {
    const f32x4* p = (const f32x4*)(ssq + (size_t)row * 16);
    const f32x4 a = p[0], b = p[1], c = p[2], d = p[3];
    const float s = ((a.x + a.y) + (a.z + a.w)) + ((b.x + b.y) + (b.z + b.w)) + ((c.x + c.y) + (c.z + c.w)) + ((d.x + d.y) + (d.z + d.w));
    return rsqrtf(s * (1.0f / DM) + EPS);
}
struct EpiScale {
    static constexpr bool PERM = true, AFTER_DRAIN = false;
    bf16_t* O; int ldc; const float* ssq;
    __device__ __forceinline__ void operator()(const f32x4 (&acc)[2][2][4][2], const pg8::Unit& u, int wr, int wc, int fr, int fq) const {
        const int row0 = u.pm * 256 + wr * 64 + fr, col0 = u.pn * 256 + wc * 32 + 8 * fq;
#pragma unroll
        for (int ai = 0; ai < 2; ++ai)
#pragma unroll
            for (int m = 0; m < 4; ++m) {
                const int row = row0 + ai * 128 + m * 16; const float rs = rstd_of(ssq, row);
                bf16_t* rp = O + (size_t)row * ldc + col0;
#pragma unroll
                for (int bj = 0; bj < 2; ++bj) { const f32x4 v0 = acc[ai][bj][m][0] * rs, v1 = acc[ai][bj][m][1] * rs;
                    u32x4 w; w.x = pk2(v0[0], v0[1]); w.y = pk2(v0[2], v0[3]); w.z = pk2(v1[0], v1[1]); w.w = pk2(v1[2], v1[3]);
                    *(u32x4*)(rp + bj * 128) = w; }
            }
    }
};
struct EpiF32 {
    static constexpr bool PERM = true, AFTER_DRAIN = false;
    float* O; int ldc;
    __device__ __forceinline__ void operator()(const f32x4 (&acc)[2][2][4][2], const pg8::Unit& u, int wr, int wc, int fr, int fq) const {
        const int row0 = u.pm * 256 + wr * 64 + fr, col0 = u.pn * 256 + wc * 32 + 8 * fq;
#pragma unroll
        for (int ai = 0; ai < 2; ++ai)
#pragma unroll
            for (int m = 0; m < 4; ++m) { float* rp = O + (size_t)(row0 + ai * 128 + m * 16) * ldc + col0;
#pragma unroll
                for (int bj = 0; bj < 2; ++bj) { *(f32x4*)(rp + bj * 128) = acc[ai][bj][m][0]; *(f32x4*)(rp + bj * 128 + 4) = acc[ai][bj][m][1]; } }
    }
};
template <int MODE  > struct EpiResid {
    static constexpr bool PERM = true, AFTER_DRAIN = false;
    float* h; bf16_t* hb; float* ssq_out; const float* ssq_in; const float* pp;
    __device__ __forceinline__ void operator()(const f32x4 (&acc)[2][2][4][2], const pg8::Unit& u, int wr, int wc, int fr, int fq) const {
        const int row0 = u.pm * 256 + wr * 64 + fr, col0 = u.pn * 256 + wc * 32 + 8 * fq;
#pragma unroll
        for (int ai = 0; ai < 2; ++ai)
#pragma unroll
            for (int m = 0; m < 4; ++m) {
                const int row = row0 + ai * 128 + m * 16; float rs = 1.f; if (MODE == 1) rs = rstd_of(ssq_in, row);
                float* hp = h + (size_t)row * DM + col0; bf16_t* bp = hb + (size_t)row * DM + col0; float s = 0.f;
#pragma unroll
                for (int bj = 0; bj < 2; ++bj) {
                    f32x4 a0 = acc[ai][bj][m][0], a1 = acc[ai][bj][m][1];
                    if (MODE == 1) { const float* q = pp + (size_t)row * DM + col0 + bj * 128; const f32x4 p0 = *(const f32x4*)q, p1 = *(const f32x4*)(q + 4);
#pragma unroll
                        for (int e = 0; e < 4; ++e) { a0[e] = p0[e] / (1.f + __expf(-a0[e] * rs)); a1[e] = p1[e] / (1.f + __expf(-a1[e] * rs)); } }
                    const f32x4 h0 = *(const f32x4*)(hp + bj * 128) + a0, h1 = *(const f32x4*)(hp + bj * 128 + 4) + a1;
                    *(f32x4*)(hp + bj * 128) = h0; *(f32x4*)(hp + bj * 128 + 4) = h1;
                    u32x4 w; w.x = pk2(h0[0], h0[1]); w.y = pk2(h0[2], h0[3]); w.z = pk2(h1[0], h1[1]); w.w = pk2(h1[2], h1[3]);
                    *(u32x4*)(bp + bj * 128) = w;
                    s += (h0[0] * h0[0] + h0[1] * h0[1]) + (h0[2] * h0[2] + h0[3] * h0[3]) + (h1[0] * h1[0] + h1[1] * h1[1]) + (h1[2] * h1[2] + h1[3] * h1[3]);
                }
                s += __shfl_xor(s, 16); s += __shfl_xor(s, 32);
                if (fq == 0) ssq_out[(size_t)row * 16 + u.pn * 4 + wc] = s;
            }
    }
};
struct Args {
    const float* in[23]; float* out; unsigned char* ws; int ph_lo, ph_hi;
};
enum { I_XP = 0, I_XS, I_PP, I_PS, I_NMIX, I_EVIN, I_LBL, I_HNORM, I_EVOUT, I_ODIN, I_GUP, I_GB, I_GNORM, I_ODOUT, I_NFFN, I_FUP, I_CW, I_CB, I_FDOWN, I_NPLE, I_PGATE, I_PPROJ, I_NOUT };

struct Ctx {
    LAS unsigned char* lds; int tid, lane, wave, G, bid;
    const Args* a; unsigned char* ws;
};

__device__ __forceinline__ void transpose_item(const float* W, int K, int N, const float* gk, bf16_t* WT, LAS float* scr, int item, int lane) {
    const int nblk = N / 32, kb = item / nblk, nb = item % nblk, k0 = 64 * kb, n0 = 32 * nb;
#pragma unroll 8
    for (int i = 0; i < 32; ++i) { const int kk = 2 * i + (lane >> 5); float v = W[(size_t)(k0 + kk) * N + n0 + (lane & 31)]; if (gk) v *= gk[k0 + kk]; scr[kk * 33 + (lane & 31)] = v; }
    asm volatile("s_waitcnt lgkmcnt(0)" ::: "memory");
    const int c = lane & 7;
#pragma unroll
    for (int j = 0; j < 4; ++j) { const int n = (lane >> 3) + 8 * j; const LAS float* s = scr + (8 * c) * 33 + n;
        u32x4 o; o.x = pk2(s[0 * 33], s[1 * 33]); o.y = pk2(s[2 * 33], s[3 * 33]); o.z = pk2(s[4 * 33], s[5 * 33]); o.w = pk2(s[6 * 33], s[7 * 33]);
        *(u32x4*)(WT + (size_t)(n0 + n) * K + k0 + 8 * c) = o; }
    asm volatile("s_waitcnt lgkmcnt(0)" ::: "memory");
}
__device__ __forceinline__ void weights_prologue(const Ctx& C) {
    LAS float* scr = (LAS float*)(C.lds + C.wave * 8704);
    const int gw = C.bid * NWV + C.wave, NGW = C.G * NWV;
    const Args& a = *C.a;
    for (int mat = 0; mat < 24; ++mat) {
        const float* W; const float* g = nullptr; bf16_t* WT; int K, N;
        if (mat < 2)       { const int e = mat;      W = a.in[I_EVIN] + (size_t)e * DM * EV_IN;  K = DM; N = EV_IN; g = a.in[I_NMIX] + (2 * e) * DM;     WT = (bf16_t*)(C.ws + W_EVIN) + (size_t)e * EV_IN * DM; }
        else if (mat < 4)  { const int e = mat - 2;  W = a.in[I_EVOUT] + (size_t)e * DM * DM;    K = DM; N = DM;                                        WT = (bf16_t*)(C.ws + W_EVOUT) + (size_t)e * DM * DM; }
        else if (mat < 6)  { const int o = mat - 4;  W = a.in[I_ODIN] + (size_t)o * DM * OD_IN;  K = DM; N = OD_IN; g = a.in[I_NMIX] + (2 * o + 1) * DM; WT = (bf16_t*)(C.ws + W_ODIN) + (size_t)o * OD_INP * DM; }
        else if (mat < 8)  { const int o = mat - 6;  W = a.in[I_ODOUT] + (size_t)o * DM * DM;    K = DM; N = DM;                                        WT = (bf16_t*)(C.ws + W_ODOUT) + (size_t)o * DM * DM; }
        else if (mat < 12) { const int l = mat - 8;  W = a.in[I_FUP] + (size_t)l * DM * 2 * DFF; K = DM; N = 2 * DFF; g = a.in[I_NFFN] + l * DM;         WT = (bf16_t*)(C.ws + W_UP) + (size_t)l * 2 * DFF * DM; }
        else if (mat < 16) { const int l = mat - 12; W = a.in[I_FDOWN] + (size_t)l * DFF * DM;   K = DFF; N = DM;                                       WT = (bf16_t*)(C.ws + W_DOWN) + (size_t)l * DM * DFF; }
        else if (mat < 20) { const int l = mat - 16; W = a.in[I_PGATE] + (size_t)l * DM * DM;    K = DM; N = DM; g = a.in[I_NPLE] + l * DM;              WT = (bf16_t*)(C.ws + W_GATE) + (size_t)l * DM * DM; }
        else               { const int l = mat - 20; W = a.in[I_PPROJ] + (size_t)l * PLE * DM;   K = PLE; N = DM;                                       WT = (bf16_t*)(C.ws + W_PROJ) + (size_t)l * DM * PLE; }
        const int nitems = (K / 64) * (N / 32);
        for (int it = gw; it < nitems; it += NGW) transpose_item(W, K, N, g, WT, scr, it, C.lane);
    }
    { const int gt = C.bid * NT + C.tid, GT = C.G * NT; const int per = (OD_INP - OD_IN) * DM / 8;
      for (int i = gt; i < 2 * per; i += GT) { const int o = i / per, r = i % per; *(u32x4*)((bf16_t*)(C.ws + W_ODIN) + (size_t)o * OD_INP * DM + (size_t)OD_IN * DM + (size_t)r * 8) = (u32x4){0u, 0u, 0u, 0u}; } }
    { const int gt = C.bid * NT + C.tid; if (gt < 1024) { const int dir = gt >> 9, c = gt & 511; const float* L = a.in[I_LBL] + (size_t)dir * 2 * 512;
        float* lb = (float*)(C.ws + W_LB) + dir * 1024; lb[c] = 0.f; lb[512 + c] = 1.f / (1.f + __expf(L[c] - L[512 + c])); } }
}
__device__ __forceinline__ void chunk_prologue(const Ctx& C, int chunk, bf16_t* hb, float* ssq) {
    const int gw = C.bid * NWV + C.wave, NGW = C.G * NWV; const Args& a = *C.a;
    for (int r = gw; r < CH; r += NGW) {
        const size_t R = (size_t)chunk * CH + r;
        const float* xr = (R < 16384) ? a.in[I_XP] + R * DM : a.in[I_XS] + (R - 16384) * DM;
        float* hr = a.out + R * DM; f32x4 v[4]; float s = 0.f;
#pragma unroll
        for (int j = 0; j < 4; ++j) { v[j] = ((const f32x4*)xr)[C.lane + 64 * j]; s += (v[j].x * v[j].x + v[j].y * v[j].y) + (v[j].z * v[j].z + v[j].w * v[j].w); }
        s = wave_sum(s);
#pragma unroll
        for (int j = 0; j < 4; ++j) { ((f32x4*)hr)[C.lane + 64 * j] = v[j]; u32x2 w; w.x = pk2(v[j].x, v[j].y); w.y = pk2(v[j].z, v[j].w); ((u32x2*)(hb + (size_t)r * DM))[C.lane + 64 * j] = w; }
        if (C.lane < 16) ssq[(size_t)r * 16 + C.lane] = (C.lane == 0) ? s : 0.f;
    }
}
__device__ __forceinline__ void final_norm(const Ctx& C, int chunk) {
    const int gw = C.bid * NWV + C.wave, NGW = C.G * NWV; const Args& a = *C.a; const float* g = a.in[I_NOUT];
    for (int r = gw; r < CH; r += NGW) {
        float* hr = a.out + ((size_t)chunk * CH + r) * DM; f32x4 v[4]; float s = 0.f;
#pragma unroll
        for (int j = 0; j < 4; ++j) { v[j] = ((const f32x4*)hr)[C.lane + 64 * j]; s += (v[j].x * v[j].x + v[j].y * v[j].y) + (v[j].z * v[j].z + v[j].w * v[j].w); }
        const float rs = rsqrtf(wave_sum(s) * (1.f / DM) + EPS);
#pragma unroll
        for (int j = 0; j < 4; ++j) { const f32x4 gg = ((const f32x4*)g)[C.lane + 64 * j]; ((f32x4*)hr)[C.lane + 64 * j] = v[j] * rs * gg; }
    }
}
__device__ __forceinline__ void conv_phase(const Ctx& C, int chunk, int l, int T) {
    const Args& a = *C.a;
    const bf16_t* UF = (const bf16_t*)(C.ws + ARENA + A_UF); bf16_t* ACT = (bf16_t*)(C.ws + ARENA + A_ACT);
    const float* cw = a.in[I_CW] + (size_t)l * 3 * 2 * DFF; const float* cb = a.in[I_CB] + (size_t)l * 2 * DFF;
    if (C.tid < DFF / 8) {
        const int c0 = C.tid * 8;
        float wa0[8], wa1[8], wa2[8], wg0[8], wg1[8], wg2[8], ba[8], bg[8];
#pragma unroll
        for (int e = 0; e < 8; ++e) { wa0[e] = cw[c0 + e]; wa1[e] = cw[2 * DFF + c0 + e]; wa2[e] = cw[4 * DFF + c0 + e]; wg0[e] = cw[DFF + c0 + e]; wg1[e] = cw[3 * DFF + c0 + e]; wg2[e] = cw[5 * DFF + c0 + e]; ba[e] = cb[c0 + e]; bg[e] = cb[DFF + c0 + e]; }
        for (int seg = C.bid; seg < CH / 64; seg += C.G) {
            const int r0 = seg * 64; const bool hasp = (r0 % T) != 0, hasn = ((r0 + 64) % T) != 0;
            bf16x8 pa = {0, 0, 0, 0, 0, 0, 0, 0}, pg = pa, ca, cgt, na, ng;
            if (hasp) { pa = *(const bf16x8*)(UF + (size_t)(r0 - 1) * 2 * DFF + c0); pg = *(const bf16x8*)(UF + (size_t)(r0 - 1) * 2 * DFF + DFF + c0); }
            ca = *(const bf16x8*)(UF + (size_t)r0 * 2 * DFF + c0); cgt = *(const bf16x8*)(UF + (size_t)r0 * 2 * DFF + DFF + c0);
            for (int i = 0; i < 64; ++i) {
                const int r = r0 + i;
                if (i < 63 || hasn) { na = *(const bf16x8*)(UF + (size_t)(r + 1) * 2 * DFF + c0); ng = *(const bf16x8*)(UF + (size_t)(r + 1) * 2 * DFF + DFF + c0); }
                else { na = (bf16x8){0, 0, 0, 0, 0, 0, 0, 0}; ng = na; }
                float o[8];
#pragma unroll
                for (int e = 0; e < 8; ++e) {
                    const float av = bf2f((unsigned short)pa[e]) * wa0[e] + bf2f((unsigned short)ca[e]) * wa1[e] + bf2f((unsigned short)na[e]) * wa2[e] + ba[e];
                    const float gv = bf2f((unsigned short)pg[e]) * wg0[e] + bf2f((unsigned short)cgt[e]) * wg1[e] + bf2f((unsigned short)ng[e]) * wg2[e] + bg[e];
                    o[e] = av * (0.5f * gv * (1.f + erff(gv * 0.70710678118f)));
                }
                u32x4 w; w.x = pk2(o[0], o[1]); w.y = pk2(o[2], o[3]); w.z = pk2(o[4], o[5]); w.w = pk2(o[6], o[7]);
                *(u32x4*)(ACT + (size_t)r * DFF + c0) = w;
                pa = ca; pg = cgt; ca = na; cgt = ng;
            }
        }
    }
    { bf16_t* PB = (bf16_t*)(C.ws + B_PB); const int gt = C.bid * NT + C.tid, GT = C.G * NT;
      for (int i = gt; i < CH * PLE / 4; i += GT) { const int r = i / (PLE / 4), c4 = i % (PLE / 4); const size_t R = (size_t)chunk * CH + r;
          const float* src = (R < 16384) ? a.in[I_PP] + ((size_t)l * 16384 + R) * PLE : a.in[I_PS] + ((size_t)l * 32768 + (R - 16384)) * PLE;
          const f32x4 v = ((const f32x4*)src)[c4]; u32x2 w; w.x = pk2(v.x, v.y); w.y = pk2(v.z, v.w); ((u32x2*)(PB + (size_t)r * PLE))[c4] = w; } }
}
struct Mix { int even, li, T, DV, ld, vcol, gcol; float qscale; };
#define MFMA32(a, b, c) __builtin_amdgcn_mfma_f32_32x32x16_bf16((a), (b), (c), 0, 0, 0)
#define LDSFENCE() asm volatile("s_waitcnt lgkmcnt(0)" ::: "memory")
__device__ __forceinline__ bf16x8 pack8(float a0, float a1, float a2, float a3, float a4, float a5, float a6, float a7) {
    u32x4 w; w.x = pk2(a0, a1); w.y = pk2(a2, a3); w.z = pk2(a4, a5); w.w = pk2(a6, a7); return __builtin_bit_cast(bf16x8, w);
}
__device__ __forceinline__ f32x16 zero16() { f32x16 z;
#pragma unroll
    for (int i = 0; i < 16; ++i) z[i] = 0.f; return z; }

__device__ __forceinline__ void prep_phase(const Ctx& C, const Mix& mx) {
    const Args& a = *C.a;
    const bf16_t* U = (const bf16_t*)(C.ws + ARENA + A_U);
    bf16_t* QT = (bf16_t*)(C.ws + ARENA + A_QT); bf16_t* KT = (bf16_t*)(C.ws + ARENA + A_KT);
    float* O = (float*)(C.ws + ARENA + (mx.even ? A_OEV : A_OOD)); float* DEC = (float*)(C.ws + ARENA + A_DEC);
    const float* LB = (const float*)(C.ws + W_LB);
    const int hd = C.wave & 3, dir = C.wave >> 2, lane = C.lane, ld = mx.ld, DV = mx.DV;
    LAS float* Bs = (LAS float*)(C.lds + C.wave * 16896);
    for (int b = C.bid; b < CH / 32; b += C.G) {
        const int rb = 32 * b;
#pragma unroll 1
        for (int p = 0; p < 2; ++p) {
            const int d = lane + 64 * p, col = hd * 128 + d;
            float bsum = 0.f;
            if (mx.even) {
                const float lbv = LB[dir * 1024 + mx.li * 512 + col], oml = 1.f - lbv;
                const bf16_t* zp = U + 512 + 512 * dir + col;
#pragma unroll 4
                for (int t = 0; t < 32; ++t) { const int row = rb + (dir ? 31 - t : t);
                    const float z = bf2f(zp[(size_t)row * ld]); const float sig = 1.f / (1.f + __expf(-z));
                    bsum += fmaxf(__logf(lbv + oml * sig), -30.f); Bs[t * 132 + d] = bsum; }
                DEC[(((size_t)b * 4 + hd) * 2 + dir) * 128 + d] = __expf(bsum);
#pragma unroll 4
                for (int t = 0; t < 32; ++t) { const int row = rb + (dir ? 31 - t : t);
                    const float z = bf2f(zp[(size_t)row * ld]); const float kt = oml / (1.f + __expf(z)) * __expf(bsum - Bs[t * 132 + d]);
                    KT[((size_t)dir * CH + row) * 512 + col] = (bf16_t)(pk2(kt, 0.f) & 0xffffu); }
            } else {
                float Wg[16]; const float* wp = a.in[I_GUP] + ((size_t)(mx.li * 2 + dir) * 16) * 512 + col;
#pragma unroll
                for (int r = 0; r < 16; ++r) Wg[r] = wp[r * 512];
                const float bias = a.in[I_GB][(mx.li * 2 + dir) * 512 + col];
#pragma unroll 2
                for (int t = 0; t < 32; ++t) { const int row = rb + (dir ? 31 - t : t);
                    const u32x4 l0 = *(const u32x4*)(U + (size_t)row * ld + 3072 + 16 * dir), l1 = *(const u32x4*)(U + (size_t)row * ld + 3072 + 16 * dir + 8);
                    float x = bias;
#pragma unroll
                    for (int w = 0; w < 4; ++w) { x += __uint_as_float(l0[w] << 16) * Wg[2 * w] + __uint_as_float(l0[w] & 0xffff0000u) * Wg[2 * w + 1];
                                                  x += __uint_as_float(l1[w] << 16) * Wg[8 + 2 * w] + __uint_as_float(l1[w] & 0xffff0000u) * Wg[8 + 2 * w + 1]; }
                    bsum += fmaxf((fminf(x, 0.f) - log1pf(__expf(-fabsf(x)))) * (1.f / 16.f), -30.f); Bs[t * 132 + d] = bsum; }
                DEC[(((size_t)b * 4 + hd) * 2 + dir) * 128 + d] = __expf(bsum);
#pragma unroll 4
                for (int t = 0; t < 32; ++t) { const int row = rb + (dir ? 31 - t : t);
                    const float kt = bf2f(U[(size_t)row * ld + 512 + col]) * __expf(bsum - Bs[t * 132 + d]);
                    KT[((size_t)dir * CH + row) * 512 + col] = (bf16_t)(pk2(kt, 0.f) & 0xffffu); }
            }
        }
        LDSFENCE();
        const int tau = lane & 31, h = lane >> 5, row = rb + (dir ? 31 - tau : tau);
        bf16x8 Ak[8], Bq[8];
#pragma unroll
        for (int ks = 0; ks < 8; ++ks) {
            float qh[8], kh[8];
#pragma unroll
            for (int q2 = 0; q2 < 2; ++q2) {
                const int d0 = 16 * ks + 8 * q2 + 4 * h;
                const f32x4 b4 = *(const LAS f32x4*)(Bs + tau * 132 + d0), r4 = *(const LAS f32x4*)(Bs + 15 * 132 + d0);
                const u32x2 qr = *(const u32x2*)(U + (size_t)row * ld + hd * 128 + d0);
                float q4[4] = {__uint_as_float(qr.x << 16), __uint_as_float(qr.x & 0xffff0000u), __uint_as_float(qr.y << 16), __uint_as_float(qr.y & 0xffff0000u)};
                float k4[4];
                if (mx.even) { const u32x2 zr = *(const u32x2*)(U + (size_t)row * ld + 512 + 512 * dir + hd * 128 + d0);
                    const f32x4 lb4 = *(const f32x4*)(LB + dir * 1024 + mx.li * 512 + hd * 128 + d0);
                    const float z4[4] = {__uint_as_float(zr.x << 16), __uint_as_float(zr.x & 0xffff0000u), __uint_as_float(zr.y << 16), __uint_as_float(zr.y & 0xffff0000u)};
#pragma unroll
                    for (int e = 0; e < 4; ++e) k4[e] = (1.f - lb4[e]) / (1.f + __expf(z4[e]));
                } else { const u32x2 kr = *(const u32x2*)(U + (size_t)row * ld + 512 + hd * 128 + d0);
                    k4[0] = __uint_as_float(kr.x << 16); k4[1] = __uint_as_float(kr.x & 0xffff0000u); k4[2] = __uint_as_float(kr.y << 16); k4[3] = __uint_as_float(kr.y & 0xffff0000u); }
                float qt[4];
#pragma unroll
                for (int e = 0; e < 4; ++e) { const float qq = q4[e] * mx.qscale; qt[e] = qq * __expf(b4[e]);
                    qh[4 * q2 + e] = qq * __expf(fminf(b4[e] - r4[e], 80.f)); kh[4 * q2 + e] = k4[e] * __expf(fminf(r4[e] - b4[e], 80.f)); }
                u32x2 w; w.x = pk2(qt[0], qt[1]); w.y = pk2(qt[2], qt[3]);
                *(u32x2*)(QT + ((size_t)dir * CH + row) * 512 + hd * 128 + d0) = w;
            }
            Bq[ks] = pack8(qh[0], qh[1], qh[2], qh[3], qh[4], qh[5], qh[6], qh[7]);
            Ak[ks] = pack8(kh[0], kh[1], kh[2], kh[3], kh[4], kh[5], kh[6], kh[7]);
        }
        f32x16 at = zero16();
#pragma unroll
        for (int ks = 0; ks < 8; ++ks) at = MFMA32(Ak[ks], Bq[ks], at);
#pragma unroll
        for (int i = 0; i < 16; ++i) { const int s = (i & 3) + 8 * (i >> 2) + 4 * h; if (s > tau) at[i] = 0.f; }
        bf16x8 Pa[2];
        Pa[0] = pack8(at[0], at[1], at[2], at[3], at[4], at[5], at[6], at[7]);
        Pa[1] = pack8(at[8], at[9], at[10], at[11], at[12], at[13], at[14], at[15]);
        const bf16_t* Vp = U + mx.vcol + hd * DV + (lane & 31);
        for (int et = 0; et < DV / 32; ++et) {
            f32x16 acc = zero16();
#pragma unroll
            for (int sp = 0; sp < 2; ++sp) {
                unsigned short v[8];
#pragma unroll
                for (int j = 0; j < 8; ++j) { const int sj = 16 * sp + 8 * (j >> 2) + 4 * h + (j & 3); const int rj = rb + (dir ? 31 - sj : sj); v[j] = Vp[(size_t)rj * ld + 32 * et]; }
                u32x4 w; w.x = v[0] | ((unsigned)v[1] << 16); w.y = v[2] | ((unsigned)v[3] << 16); w.z = v[4] | ((unsigned)v[5] << 16); w.w = v[6] | ((unsigned)v[7] << 16);
                acc = MFMA32(Pa[sp], __builtin_bit_cast(bf16x8, w), acc);
            }
#pragma unroll
            for (int i = 0; i < 16; ++i) { const int ti = (i & 3) + 8 * (i >> 2) + 4 * h; const int ri = rb + (dir ? 31 - ti : ti);
                O[((size_t)dir * CH + ri) * (4 * DV) + hd * DV + 32 * et + (lane & 31)] = acc[i]; }
        }
        LDSFENCE();
    }
}
__device__ __forceinline__ void scan_phase(const Ctx& C, const Mix& mx) {
    const bf16_t* U = (const bf16_t*)(C.ws + ARENA + A_U);
    const bf16_t* QT = (const bf16_t*)(C.ws + ARENA + A_QT); const bf16_t* KT = (const bf16_t*)(C.ws + ARENA + A_KT);
    float* O = (float*)(C.ws + ARENA + (mx.even ? A_OEV : A_OOD)); const float* DEC = (const float*)(C.ws + ARENA + A_DEC);
    const int lane = C.lane, h = lane >> 5, l31 = lane & 31, ld = mx.ld, DV = mx.DV, ET = DV / 32, T = mx.T, nb = T / 32;
    const int units = (CH / T) * 8 * ET;
    for (int u = C.bid + C.G * C.wave; u < units; u += C.G * NWV) {
        const int et = u % ET, x = u / ET, dir = x & 1, hd = (x >> 1) & 3, seq = x >> 3;
        f32x16 S[4];
#pragma unroll
        for (int dt = 0; dt < 4; ++dt) S[dt] = zero16();
        const size_t ocol = (size_t)hd * DV + 32 * et + l31;
        for (int j = 0; j < nb; ++j) {
            const int bl = dir ? nb - 1 - j : j, rb = seq * T + 32 * bl, blk = rb >> 5;
            f32x16 acc;
#pragma unroll
            for (int i = 0; i < 16; ++i) { const int ti = (i & 3) + 8 * (i >> 2) + 4 * h; const int ri = rb + (dir ? 31 - ti : ti); acc[i] = O[((size_t)dir * CH + ri) * (4 * DV) + ocol]; }
            const int row = rb + (dir ? 31 - l31 : l31);
            const bf16_t* qp = QT + ((size_t)dir * CH + row) * 512 + hd * 128 + 4 * h;
#pragma unroll
            for (int dt = 0; dt < 4; ++dt)
#pragma unroll
                for (int sp = 0; sp < 2; ++sp) {
                    const u32x2 a0 = *(const u32x2*)(qp + 32 * dt + 16 * sp), a1 = *(const u32x2*)(qp + 32 * dt + 16 * sp + 8);
                    u32x4 aw; aw.x = a0.x; aw.y = a0.y; aw.z = a1.x; aw.w = a1.y;
                    const bf16x8 Bf = pack8(S[dt][8 * sp + 0], S[dt][8 * sp + 1], S[dt][8 * sp + 2], S[dt][8 * sp + 3], S[dt][8 * sp + 4], S[dt][8 * sp + 5], S[dt][8 * sp + 6], S[dt][8 * sp + 7]);
                    acc = MFMA32(__builtin_bit_cast(bf16x8, aw), Bf, acc);
                }
#pragma unroll
            for (int i = 0; i < 16; ++i) { const int ti = (i & 3) + 8 * (i >> 2) + 4 * h; const int ri = rb + (dir ? 31 - ti : ti); O[((size_t)dir * CH + ri) * (4 * DV) + ocol] = acc[i]; }
            const float* dp = DEC + (((size_t)blk * 4 + hd) * 2 + dir) * 128 + 4 * h;
#pragma unroll
            for (int dt = 0; dt < 4; ++dt)
#pragma unroll
                for (int q = 0; q < 4; ++q) { const f32x4 d4 = *(const f32x4*)(dp + 32 * dt + 8 * q);
#pragma unroll
                    for (int e = 0; e < 4; ++e) S[dt][4 * q + e] *= d4[e]; }
#pragma unroll
            for (int sp = 0; sp < 2; ++sp) {
                unsigned short v[8];
#pragma unroll
                for (int jj = 0; jj < 8; ++jj) { const int tj = 16 * sp + 8 * h + jj; const int rj = rb + (dir ? 31 - tj : tj); v[jj] = U[(size_t)rj * ld + mx.vcol + ocol]; }
                u32x4 vw; vw.x = v[0] | ((unsigned)v[1] << 16); vw.y = v[2] | ((unsigned)v[3] << 16); vw.z = v[4] | ((unsigned)v[5] << 16); vw.w = v[6] | ((unsigned)v[7] << 16);
#pragma unroll
                for (int dt = 0; dt < 4; ++dt) {
                    unsigned short k[8];
#pragma unroll
                    for (int jj = 0; jj < 8; ++jj) { const int tj = 16 * sp + 8 * h + jj; const int rj = rb + (dir ? 31 - tj : tj); k[jj] = KT[((size_t)dir * CH + rj) * 512 + hd * 128 + 32 * dt + l31]; }
                    u32x4 kw; kw.x = k[0] | ((unsigned)k[1] << 16); kw.y = k[2] | ((unsigned)k[3] << 16); kw.z = k[4] | ((unsigned)k[5] << 16); kw.w = k[6] | ((unsigned)k[7] << 16);
                    S[dt] = MFMA32(__builtin_bit_cast(bf16x8, kw), __builtin_bit_cast(bf16x8, vw), S[dt]);
                }
            }
        }
    }
}
__device__ __forceinline__ void attn_phase(const Ctx& C, int T) {
    const bf16_t* U = (const bf16_t*)(C.ws + ARENA + A_U);
    bf16_t* OG = (bf16_t*)(C.ws + ARENA + A_OG); float* LSE = (float*)(C.ws + ARENA + A_LSE);
    const int lane = C.lane, h = lane >> 5, l31 = lane & 31, ld = EV_IN, tps = T / 32;
    for (int task = C.bid * NWV + C.wave; task < 3 * 4 * (CH / 32); task += C.G * NWV) {
        const int g = task / 2048, x = task % 2048, hd = x / 512, y = x % 512, seq = y / tps, z = y % tps;
        const int dil = 1 << (2 * g), L = T / dil, nqb = L / 32, r = z / nqb, qb = z % nqb, m0 = 32 * qb;
        const int qcol = 2560 + g * 1536 + hd * 128, kcol = qcol + 512, vcol = qcol + 1024;
        const float coef = exp2f(-8.0f * (float)(g * 4 + hd + 1) / 12.0f) * (float)dil, scale = 0.08838834764831845f;
        const size_t rbase = (size_t)seq * T + r;
        bf16x8 Bq[8];
        { const bf16_t* qp = U + (rbase + (size_t)(m0 + l31) * dil) * ld + qcol + 8 * h;
#pragma unroll
          for (int ks = 0; ks < 8; ++ks) Bq[ks] = *(const bf16x8*)(qp + 16 * ks); }
        f32x16 st[5];
#pragma unroll
        for (int kb = 0; kb < 5; ++kb) {
            const int mk0 = m0 - 64 + 32 * kb;
            if (mk0 >= 0 && mk0 < L) {
                const bf16_t* kp = U + (rbase + (size_t)(mk0 + l31) * dil) * ld + kcol + 8 * h;
                f32x16 s = zero16();
#pragma unroll
                for (int ks = 0; ks < 8; ++ks) s = MFMA32(*(const bf16x8*)(kp + 16 * ks), Bq[ks], s);
#pragma unroll
                for (int i = 0; i < 16; ++i) { const int rel = (mk0 + (i & 3) + 8 * (i >> 2) + 4 * h) - (m0 + l31); const int ar = rel < 0 ? -rel : rel;
                    s[i] = (ar <= 64) ? s[i] * scale - coef * (float)ar : -1e30f; }
                st[kb] = s;
            } else {
#pragma unroll
                for (int i = 0; i < 16; ++i) st[kb][i] = -1e30f;
            }
        }
        float mxv = -1e30f;
#pragma unroll
        for (int kb = 0; kb < 5; ++kb)
#pragma unroll
            for (int i = 0; i < 16; ++i) mxv = fmaxf(mxv, st[kb][i]);
        mxv = fmaxf(mxv, __shfl_xor(mxv, 32));
        float den = 0.f;
#pragma unroll
        for (int kb = 0; kb < 5; ++kb)
#pragma unroll
            for (int i = 0; i < 16; ++i) { const float p = __expf(st[kb][i] - mxv); st[kb][i] = p; den += p; }
        den += __shfl_xor(den, 32);
        f32x16 ot[4];
#pragma unroll
        for (int dt = 0; dt < 4; ++dt) ot[dt] = zero16();
#pragma unroll
        for (int kb = 0; kb < 5; ++kb) {
            const int mk0 = m0 - 64 + 32 * kb;
            if (mk0 >= 0 && mk0 < L) {
#pragma unroll
                for (int sp = 0; sp < 2; ++sp) {
                    const bf16x8 Bp = pack8(st[kb][8 * sp + 0], st[kb][8 * sp + 1], st[kb][8 * sp + 2], st[kb][8 * sp + 3], st[kb][8 * sp + 4], st[kb][8 * sp + 5], st[kb][8 * sp + 6], st[kb][8 * sp + 7]);
#pragma unroll
                    for (int dt = 0; dt < 4; ++dt) {
                        unsigned short v[8];
#pragma unroll
                        for (int j = 0; j < 8; ++j) { const int kj = mk0 + 16 * sp + 8 * (j >> 2) + 4 * h + (j & 3); v[j] = U[(rbase + (size_t)kj * dil) * ld + vcol + 32 * dt + l31]; }
                        u32x4 w; w.x = v[0] | ((unsigned)v[1] << 16); w.y = v[2] | ((unsigned)v[3] << 16); w.z = v[4] | ((unsigned)v[5] << 16); w.w = v[6] | ((unsigned)v[7] << 16);
                        ot[dt] = MFMA32(__builtin_bit_cast(bf16x8, w), Bp, ot[dt]);
                    }
                }
            }
        }
        const float inv = 1.f / den; const size_t qrow = rbase + (size_t)(m0 + l31) * dil;
        bf16_t* op = OG + ((size_t)g * CH + qrow) * 512 + hd * 128 + 4 * h;
#pragma unroll
        for (int dt = 0; dt < 4; ++dt)
#pragma unroll
            for (int q = 0; q < 4; ++q) { u32x2 w; w.x = pk2(ot[dt][4 * q] * inv, ot[dt][4 * q + 1] * inv); w.y = pk2(ot[dt][4 * q + 2] * inv, ot[dt][4 * q + 3] * inv);
                *(u32x2*)(op + 32 * dt + 8 * q) = w; }
        if (h == 0) LSE[((size_t)g * CH + qrow) * 4 + hd] = mxv + __logf(den);
    }
}
__device__ __forceinline__ void finalize_phase(const Ctx& C, const Mix& mx) {
    const Args& a = *C.a;
    const bf16_t* U = (const bf16_t*)(C.ws + ARENA + A_U); bf16_t* MIX = (bf16_t*)(C.ws + ARENA + A_MIX);
    const int gw = C.bid * NWV + C.wave, NGW = C.G * NWV, lane = C.lane, ld = mx.ld;
    if (mx.even) {
        const float* O = (const float*)(C.ws + ARENA + A_OEV); const bf16_t* OG = (const bf16_t*)(C.ws + ARENA + A_OG); const float* LSE = (const float*)(C.ws + ARENA + A_LSE);
        const float* gn = a.in[I_HNORM] + mx.li * 512;
        for (int r = gw; r < CH; r += NGW) {
#pragma unroll
            for (int hd = 0; hd < 4; ++hd) {
                const int c = hd * 128 + 2 * lane;
                const f32x2 o0 = *(const f32x2*)(O + (size_t)r * 512 + c), o1 = *(const f32x2*)(O + ((size_t)CH + r) * 512 + c);
                const float ox = o0.x + o1.x, oy = o0.y + o1.y;
                const float rs = rsqrtf(wave_sum(ox * ox + oy * oy) * (1.f / 128.f) + EPS);
                const f32x2 g2 = *(const f32x2*)(gn + c); const unsigned ag = *(const unsigned*)(U + (size_t)r * ld + 2048 + c);
                const float ax = __uint_as_float(ag << 16), ay = __uint_as_float(ag & 0xffff0000u);
                const float yx = ox * rs * g2.x * (ax / (1.f + __expf(-ax))), yy = oy * rs * g2.y * (ay / (1.f + __expf(-ay)));
                *(unsigned*)(MIX + (size_t)r * DM + c) = pk2(yx, yy);
                const float l0 = LSE[((size_t)0 * CH + r) * 4 + hd], l1 = LSE[((size_t)1 * CH + r) * 4 + hd], l2 = LSE[((size_t)2 * CH + r) * 4 + hd];
                const float m = fmaxf(l0, fmaxf(l1, l2)); float w0 = __expf(l0 - m), w1 = __expf(l1 - m), w2 = __expf(l2 - m); const float iw = 1.f / (w0 + w1 + w2);
                w0 *= iw; w1 *= iw; w2 *= iw;
                const unsigned v0 = *(const unsigned*)(OG + ((size_t)0 * CH + r) * 512 + c), v1 = *(const unsigned*)(OG + ((size_t)1 * CH + r) * 512 + c), v2 = *(const unsigned*)(OG + ((size_t)2 * CH + r) * 512 + c);
                const float bx = w0 * __uint_as_float(v0 << 16) + w1 * __uint_as_float(v1 << 16) + w2 * __uint_as_float(v2 << 16);
                const float by = w0 * __uint_as_float(v0 & 0xffff0000u) + w1 * __uint_as_float(v1 & 0xffff0000u) + w2 * __uint_as_float(v2 & 0xffff0000u);
                *(unsigned*)(MIX + (size_t)r * DM + 512 + c) = pk2(bx, by);
            }
        }
    } else {
        const float* O = (const float*)(C.ws + ARENA + A_OOD); const float* gn = a.in[I_GNORM] + mx.li * 1024;
        for (int r = gw; r < CH; r += NGW) {
#pragma unroll
            for (int hd = 0; hd < 4; ++hd) {
                const int c = hd * 256 + 4 * lane;
                const f32x4 o = *(const f32x4*)(O + (size_t)r * 1024 + c) + *(const f32x4*)(O + ((size_t)CH + r) * 1024 + c);
                const float rs = rsqrtf(wave_sum((o.x * o.x + o.y * o.y) + (o.z * o.z + o.w * o.w)) * (1.f / 256.f) + EPS);
                const f32x4 g4 = *(const f32x4*)(gn + c); const u32x2 gg = *(const u32x2*)(U + (size_t)r * ld + 2048 + c);
                const float a0 = __uint_as_float(gg.x << 16), a1 = __uint_as_float(gg.x & 0xffff0000u), a2 = __uint_as_float(gg.y << 16), a3 = __uint_as_float(gg.y & 0xffff0000u);
                u32x2 w; w.x = pk2(o.x * rs * g4.x * (a0 / (1.f + __expf(-a0))), o.y * rs * g4.y * (a1 / (1.f + __expf(-a1))));
                w.y = pk2(o.z * rs * g4.z * (a2 / (1.f + __expf(-a2))), o.w * rs * g4.w * (a3 / (1.f + __expf(-a3))));
                *(u32x2*)(MIX + (size_t)r * DM + c) = w;
            }
        }
    }
}
#define PHASE_BEGIN() do { int t_ = threadIdx.x; asm volatile("" : "+v"(t_)); C.tid = t_; C.lane = t_ & 63; C.wave = __builtin_amdgcn_readfirstlane(t_ >> 6); \
    int b_ = blockIdx.x; asm volatile("" : "+s"(b_)); C.bid = b_; unsigned char* w_ = args.ws; asm volatile("" : "+s"(w_)); C.ws = w_; ws = w_; \
    hb_c = (bf16_t*)(ws + (s ? B_HB1 : B_HB0)); hb_n = (bf16_t*)(ws + (s ? B_HB0 : B_HB1)); sq_c = (float*)(ws + (s ? B_SSQ1 : B_SSQ0)); sq_n = (float*)(ws + (s ? B_SSQ0 : B_SSQ1)); Ub = (bf16_t*)(ws + ARENA + A_U); MIXb = (bf16_t*)(ws + ARENA + A_MIX); \
    hch = args.out + (size_t)chunk * CH * DM; } while (0)
__global__ void __launch_bounds__(NT, 2) fwd_mega(Args args) {
    extern __shared__ __attribute__((aligned(16))) unsigned char lds_raw[];
    cg::grid_group grid = cg::this_grid();
    Ctx C; C.lds = (LAS unsigned char*)lds_raw; C.tid = threadIdx.x; C.lane = C.tid & 63; C.wave = __builtin_amdgcn_readfirstlane(C.tid >> 6);
    C.G = gridDim.x; C.bid = blockIdx.x; C.a = &args; C.ws = args.ws;
    unsigned char* ws = args.ws;
    bf16_t *hb_c, *hb_n; float *sq_c, *sq_n; bf16_t *Ub, *MIXb;
    weights_prologue(C);
    float* hch;
#pragma nounroll
    for (int chunk = 0; chunk < NCHUNK; ++chunk) {
        const int T = chunk == 0 ? 4096 : 2048; int s = 0;
        PHASE_BEGIN();
        chunk_prologue(C, chunk, hb_c, sq_c);
        grid.sync();
#pragma nounroll
        for (int l = 0; l < DEPTH; ++l) {
            const int even = (l & 1) == 0, li = l >> 1;
            Mix mx; mx.even = even; mx.li = li; mx.T = T; mx.DV = even ? 128 : 256; mx.ld = even ? EV_IN : OD_INP; mx.vcol = even ? 1536 : 1024; mx.gcol = 2048; mx.qscale = even ? 1.f : 0.08838834764831845f;
            PHASE_BEGIN();
            {
                const int N = even ? EV_IN : OD_INP;
                const bf16_t* Wt = even ? (const bf16_t*)(ws + W_EVIN) + (size_t)li * EV_IN * DM : (const bf16_t*)(ws + W_ODIN) + (size_t)li * OD_INP * DM;
                pg8::Gemm g{hb_c, Wt, CH, N, DM}; pg8::StaticOrder S; S.init(CH, N, C.G, C.bid);
                EpiScale E{Ub, N, sq_c};
                pg8::gemm_phase<EpiScale, pg8::StaticOrder, true, true>(C.lds, g, S, E);
            }
            grid.sync();
            PHASE_BEGIN();
#ifndef NO_PREP
            prep_phase(C, mx);
#endif
            PHASE_BEGIN();
#ifndef NO_ATTN
            if (even) attn_phase(C, T);
#endif
            grid.sync();
            PHASE_BEGIN();
#ifndef NO_SCAN
            scan_phase(C, mx);
#endif
            grid.sync();
            PHASE_BEGIN();
#ifndef NO_FIN
            finalize_phase(C, mx);
#endif
            grid.sync();
            PHASE_BEGIN();
            {
                const bf16_t* Wt = even ? (const bf16_t*)(ws + W_EVOUT) + (size_t)li * DM * DM : (const bf16_t*)(ws + W_ODOUT) + (size_t)li * DM * DM;
                pg8::Gemm g{MIXb, Wt, CH, DM, DM}; pg8::StaticOrder S; S.init(CH, DM, C.G, C.bid);
                EpiResid<0> E{hch, hb_n, sq_n, nullptr, nullptr};
                pg8::gemm_phase<EpiResid<0>, pg8::StaticOrder, true, true>(C.lds, g, S, E);
                s ^= 1;
            }
            grid.sync();
            PHASE_BEGIN();
            {
                pg8::Gemm g{hb_c, (const bf16_t*)(ws + W_UP) + (size_t)l * 2 * DFF * DM, CH, 2 * DFF, DM}; pg8::StaticOrder S; S.init(CH, 2 * DFF, C.G, C.bid);
                EpiScale E{(bf16_t*)(ws + ARENA + A_UF), 2 * DFF, sq_c};
                pg8::gemm_phase<EpiScale, pg8::StaticOrder, true, true>(C.lds, g, S, E);
            }
            grid.sync();
            PHASE_BEGIN();
#ifndef NO_CONV
            conv_phase(C, chunk, l, T);
#endif
            grid.sync();
            PHASE_BEGIN();
            {
                pg8::Gemm g{(const bf16_t*)(ws + ARENA + A_ACT), (const bf16_t*)(ws + W_DOWN) + (size_t)l * DM * DFF, CH, DM, DFF}; pg8::StaticOrder S; S.init(CH, DM, C.G, C.bid);
                EpiResid<0> E{hch, hb_n, sq_n, nullptr, nullptr};
                pg8::gemm_phase<EpiResid<0>, pg8::StaticOrder, true, true>(C.lds, g, S, E);
                s ^= 1;
                PHASE_BEGIN();
                pg8::Gemm g2{(const bf16_t*)(ws + B_PB), (const bf16_t*)(ws + W_PROJ) + (size_t)l * DM * PLE, CH, DM, PLE};
                EpiF32 E2{(float*)(ws + ARENA + A_PP), DM};
                pg8::gemm_phase<EpiF32, pg8::StaticOrder, true, true>(C.lds, g2, S, E2);
            }
            grid.sync();
            PHASE_BEGIN();
            {
                pg8::Gemm g{hb_c, (const bf16_t*)(ws + W_GATE) + (size_t)l * DM * DM, CH, DM, DM}; pg8::StaticOrder S; S.init(CH, DM, C.G, C.bid);
                EpiResid<1> E{hch, hb_n, sq_n, sq_c, (const float*)(ws + ARENA + A_PP)};
                pg8::gemm_phase<EpiResid<1>, pg8::StaticOrder, true, true>(C.lds, g, S, E);
                s ^= 1;
            }
            grid.sync();
        }
        PHASE_BEGIN();
        final_norm(C, chunk);
    }
}
extern "C" void kernel_launch(void* const* d_in, const int* in_sizes, int n_in, void* d_out, int out_size, void* d_ws, size_t ws_size, hipStream_t stream) {
    static int grid = 0;
    if (grid == 0) {
        int dev = 0, cus = 0, per = 0;
        (void)hipGetDevice(&dev); (void)hipDeviceGetAttribute(&cus, hipDeviceAttributeMultiprocessorCount, dev);
        (void)hipFuncSetAttribute((const void*)fwd_mega, hipFuncAttributeMaxDynamicSharedMemorySize, LDS_BYTES);
        (void)hipOccupancyMaxActiveBlocksPerMultiprocessor(&per, (const void*)fwd_mega, NT, LDS_BYTES);
        if (per < 1) per = 1;
        grid = cus * per;
        fprintf(stderr, "kernel_launch: grid %d (cus %d x %d), ws %zu need %zu\n", grid, cus, per, ws_size, (size_t)WS_NEED);
        if (n_in != 23 || ws_size < WS_NEED) { fprintf(stderr, "kernel_launch: bad inputs / workspace too small\n"); grid = -1; }
    }
    if (grid < 0) return;
    Args a{};
    for (int i = 0; i < 23; ++i) a.in[i] = (const float*)d_in[i];
    a.out = (float*)d_out; a.ws = (unsigned char*)d_ws; a.ph_lo = 0; a.ph_hi = 0;
    void* kargs[] = {&a};
    hipError_t e = hipLaunchCooperativeKernel((const void*)fwd_mega, dim3(grid), dim3(NT), kargs, LDS_BYTES, stream);
    if (e != hipSuccess) fprintf(stderr, "kernel_launch: cooperative launch failed: %s\n", hipGetErrorString(e));
}
```

```cpp
#include <hip/hip_runtime.h>
#include <hip/hip_cooperative_groups.h>
#include <cstdio>
#include <cstdint>
namespace cg = cooperative_groups;
namespace pg8 {
#define PG8_LAS __attribute__((address_space(3)))
typedef unsigned short bf16_t;
typedef short bf16x8 __attribute__((ext_vector_type(8)));
typedef float f32x4 __attribute__((ext_vector_type(4)));
typedef unsigned u32x4 __attribute__((ext_vector_type(4)));
constexpr int BM = 256, BK = 64, HALF = 128, HTB = HALF * BK * 2  , STAGE_BYTES = 8 * HTB, NXCD = 8, WGM = 8;

__host__ __device__ __forceinline__ int lds_byte(int r, int c) { const int st = (r >> 4) * 2 + (c >> 5), rr = r & 15, cc = c & 31, ob = rr * 64 + cc * 2; return st * 1024 + (ob ^ (((ob >> 9) & 1) << 5)); }
__host__ __device__ __forceinline__ void stage_rc(int b, int& R, int& C) { const int st = b / 1024, sb = b % 1024, swz = sb ^ (((sb >> 9) & 1) << 5); R = (st >> 1) * 16 + swz / 64; C = (st & 1) * 32 + (swz % 64) / 2; }
__host__ __device__ __forceinline__ int perm32(int rho) { const int n = rho >> 4, i = rho & 15; return 8 * (i >> 2) + 4 * n + (i & 3); }

struct Unit { int pm, pn; };
struct Gemm { const bf16_t* A; const bf16_t* Bt; int M, N, K; int arows; };

struct StaticOrder {
    int nM, nN, nwg, G, c;
    __host__ __device__ void init(int M, int N, int G_, int c_) { nM = M / BM; nN = N / BM; nwg = nM * nN; G = G_; c = c_; }
    __host__ __device__ bool next(int i, Unit& u) const {
        const long L = (long)i * G + c; if (L >= nwg) return false;
        int wgid = (int)L; { const int q = nwg / NXCD, r = nwg % NXCD, xcd = wgid % NXCD, off = wgid / NXCD; wgid = (xcd < r ? xcd * (q + 1) : r * (q + 1) + (xcd - r) * q) + off; }
        const int nig = WGM * nN, gid = wgid / nig, fm = gid * WGM, gsz = (nM - fm) < WGM ? (nM - fm) : WGM;
        u.pm = fm + ((wgid % nig) % gsz); u.pn = (wgid % nig) / gsz; return true;
    }
    __device__ __forceinline__ void a_ready(const Unit&) const {}
    __device__ __forceinline__ void done(const Unit&) const {}
};

__device__ __forceinline__ unsigned cvt_pk_bf16(float lo, float hi) { unsigned r; asm volatile("v_cvt_pk_bf16_f32 %0, %1, %2" : "=v"(r) : "v"(lo), "v"(hi)); return r; }
typedef float f32x2 __attribute__((ext_vector_type(2)));
__device__ __forceinline__ f32x2 gelu_pk(f32x2 v) {
    const f32x2 av = __builtin_elementwise_abs(v), d = av * 0.2316418882f + 1.0f;
    f32x2 t; t.x = __builtin_amdgcn_rcpf(d.x); t.y = __builtin_amdgcn_rcpf(d.y);
    f32x2 q = t * 0.5307027145f + (-0.7265760135f); q = q * t + 0.7107068705f; q = q * t + (-0.142248368f); q = q * t + 0.127414796f; q = q * t;
    const f32x2 s = (v * v) * (-0.72134752044f);
    f32x2 e; e.x = __builtin_amdgcn_exp2f(s.x); e.y = __builtin_amdgcn_exp2f(s.y);
    const f32x2 m = v * (q * e), r = v - m;
    f32x2 o; o.x = v.x < 0.f ? m.x : r.x; o.y = v.y < 0.f ? m.y : r.y; return o;
}

template <int ACT  > struct EpiBf16 {
    static constexpr bool PERM = true, AFTER_DRAIN = false; static_assert(ACT == 0 || ACT == 1, "EpiBf16: ACT is 0 (none) or 1 (gelu_pk)");
    bf16_t* O; int ldc; const float* bias; int split_cols; size_t split_stride; float scale0;
    __device__ __forceinline__ void operator()(const f32x4 (&acc)[2][2][4][2], const Unit& u, int wr, int wc, int fr, int fq) const {
        const int row0 = u.pm * BM + wr * 64 + fr; int colt = u.pn * BM; bf16_t* base = O;
        float sc = 1.f; if (split_cols) { const int t = colt / split_cols; base += (size_t)t * split_stride; colt -= t * split_cols; if (t == 0) sc = scale0; }
        const int col0 = colt + wc * 32 + 8 * fq, bcol0 = u.pn * BM + wc * 32 + 8 * fq;
        f32x4 bv[2][2];
#pragma unroll
        for (int bj = 0; bj < 2; ++bj)
#pragma unroll
            for (int n = 0; n < 2; ++n) bv[bj][n] = bias ? *(const f32x4*)(bias + bcol0 + bj * HALF + 4 * n) : (f32x4){0.f, 0.f, 0.f, 0.f};
#pragma unroll
        for (int ai = 0; ai < 2; ++ai)
#pragma unroll
            for (int m = 0; m < 4; ++m) { bf16_t* rowp = base + (size_t)(row0 + ai * HALF + m * 16) * ldc + col0;
#pragma unroll
                for (int bj = 0; bj < 2; ++bj) { f32x4 v0 = acc[ai][bj][m][0] + bv[bj][0], v1 = acc[ai][bj][m][1] + bv[bj][1];
                    if (ACT == 1) { f32x2 a = gelu_pk((f32x2){v0[0], v0[1]}), b = gelu_pk((f32x2){v0[2], v0[3]}), c = gelu_pk((f32x2){v1[0], v1[1]}), d = gelu_pk((f32x2){v1[2], v1[3]});
                        v0 = (f32x4){a.x, a.y, b.x, b.y}; v1 = (f32x4){c.x, c.y, d.x, d.y}; }
                    v0 = v0 * sc; v1 = v1 * sc; u32x4 w; w.x = cvt_pk_bf16(v0[0], v0[1]); w.y = cvt_pk_bf16(v0[2], v0[3]); w.z = cvt_pk_bf16(v1[0], v1[1]); w.w = cvt_pk_bf16(v1[2], v1[3]);
                    *(u32x4*)(rowp + bj * HALF) = w; } }
    }
};
template <class Epi, class Sched, bool ALIGN_EPI = false, bool SP2 = false>
__device__ __forceinline__ void gemm_phase(PG8_LAS unsigned char* lds, const Gemm g, const Sched& S, const Epi& E) {
    int tid_ = threadIdx.x; asm volatile("" : "+v"(tid_)); const int tid = tid_, wid = __builtin_amdgcn_readfirstlane(tid >> 6), lane = tid & 63, wr = wid >> 2, wc = wid & 3, fr = lane & 15, fq = lane >> 4;
    int K_ = g.K; asm volatile("" : "+s"(K_)); const int K = K_, nt = K / BK;
    unsigned voffA[2], voffB[2];
#pragma unroll
    for (int i = 0; i < 2; ++i) { int R, C; stage_rc(tid * 16 + i * 8192, R, C); const int Rb = Epi::PERM ? ((R & ~31) + perm32(R & 31)) : R;
        voffA[i] = (unsigned)(R * K + C) * 2u; voffB[i] = (unsigned)(Rb * K + C) * 2u; }
    const size_t kstep = (size_t)(BK * 2);
    const size_t hstep = (size_t)HALF * K * 2;
    const size_t tstep = 2 * hstep; const size_t tstepA = (size_t)g.arows * K * 2;
    const unsigned ldsw = (unsigned)wid * 1024u;
    const int aoff = lds_byte(wr * 64 + fr, fq * 8), boff = lds_byte(wc * 32 + fr, fq * 8);
#define PG8_SA(b, h) (((b) * 2 + (h)) * HTB)
#define PG8_SB(b, h) ((4 + (b) * 2 + (h)) * HTB)
#define PG8_STAGE(bufoff, gbase, voff) do { _Pragma("unroll") for (int _i = 0; _i < 2; ++_i) \
        __builtin_amdgcn_global_load_lds((const unsigned*)((const char*)(gbase) + (voff)[_i]), (PG8_LAS unsigned*)(lds + (bufoff) + ldsw + _i * 8192), 16, 0, 0); } while (0)
#define PG8_LDA(dst, b, h) do { _Pragma("unroll") for (int m = 0; m < 4; ++m) _Pragma("unroll") for (int k = 0; k < 2; ++k) dst[m][k] = *(const PG8_LAS bf16x8*)(lds + PG8_SA(b, h) + aoff + m * 2048 + k * 1024); } while (0)
#define PG8_LDB(dst, b, h) do { _Pragma("unroll") for (int n = 0; n < 2; ++n) _Pragma("unroll") for (int k = 0; k < 2; ++k) dst[n][k] = *(const PG8_LAS bf16x8*)(lds + PG8_SB(b, h) + boff + n * 2048 + k * 1024); } while (0)
#define PG8_MMA(ai, bj, At, Bt) do { __builtin_amdgcn_s_setprio(1); _Pragma("unroll") for (int m = 0; m < 4; ++m) _Pragma("unroll") for (int n = 0; n < 2; ++n) _Pragma("unroll") for (int k = 0; k < 2; ++k) \
        acc[ai][bj][m][n] = __builtin_amdgcn_mfma_f32_16x16x32_bf16(Bt[n][k], At[m][k], acc[ai][bj][m][n], 0, 0, 0); __builtin_amdgcn_s_setprio(0); } while (0)
#define PG8_WAIT_V(n) asm volatile("s_waitcnt vmcnt(" #n ")" ::: "memory")
#define PG8_WAIT_L(n) asm volatile("s_waitcnt lgkmcnt(" #n ")" ::: "memory")
#define PG8_BAR __builtin_amdgcn_s_barrier()
#define PG8_SCHED __builtin_amdgcn_sched_barrier(0)
    Unit cur, nxt; int ui = 0;
    if (!S.next(0, cur)) return;
    f32x4 acc[2][2][4][2];
#pragma unroll
    for (int a = 0; a < 2; ++a)
#pragma unroll
        for (int b = 0; b < 2; ++b)
#pragma unroll
            for (int m = 0; m < 4; ++m)
#pragma unroll
                for (int n = 0; n < 2; ++n) acc[a][b][m][n] = (f32x4){0.f, 0.f, 0.f, 0.f};
    bf16x8 At[4][2], B0[2][2], B1[2][2];
    const char* cA = (const char*)g.A + (size_t)cur.pm * tstepA; const char* cB = (const char*)g.Bt + (size_t)cur.pn * tstep;
    S.a_ready(cur);
    if constexpr (SP2) {
        PG8_STAGE(PG8_SB(0, 0), cB, voffB); PG8_STAGE(PG8_SB(0, 1), cB + hstep, voffB); PG8_STAGE(PG8_SA(0, 0), cA, voffA); PG8_STAGE(PG8_SA(0, 1), cA + hstep, voffA);
        if (wr == 1) PG8_BAR;
        PG8_WAIT_V(2); PG8_BAR;
        PG8_STAGE(PG8_SB(1, 0), cB + kstep, voffB); PG8_STAGE(PG8_SA(1, 0), cA + kstep, voffA); PG8_STAGE(PG8_SB(1, 1), cB + hstep + kstep, voffB);
        PG8_WAIT_V(6); PG8_BAR;
    } else {
        PG8_STAGE(PG8_SB(0, 0), cB, voffB); PG8_STAGE(PG8_SA(0, 0), cA, voffA); PG8_STAGE(PG8_SB(0, 1), cB + hstep, voffB); PG8_STAGE(PG8_SA(0, 1), cA + hstep, voffA);
        if (wr == 1) PG8_BAR;
        PG8_WAIT_V(4); PG8_BAR;
        PG8_STAGE(PG8_SB(1, 0), cB + kstep, voffB); PG8_STAGE(PG8_SA(1, 0), cA + kstep, voffA); PG8_STAGE(PG8_SB(1, 1), cB + hstep + kstep, voffB);
        PG8_WAIT_V(6); PG8_BAR;
    }
    for (;;) {
        const bool has_next = S.next(ui + 1, nxt);
        const char* nA = has_next ? (const char*)g.A + (size_t)nxt.pm * tstepA : cA; const char* nB = has_next ? (const char*)g.Bt + (size_t)nxt.pn * tstep : cB;
        for (int t = 0; t < nt; t += 2) {
            const bool last = (t == nt - 2);
            const char* a1 = cA + (size_t)(t + 1) * kstep;
            const char* a2 = last ? nA : cA + (size_t)(t + 2) * kstep; const char* b2 = last ? nB : cB + (size_t)(t + 2) * kstep;
            const char* a3 = a2 + kstep; const char* b3 = b2 + kstep;
            if (last && has_next) S.a_ready(nxt);
            if constexpr (SP2) {
            PG8_LDB(B0, 0, 0); PG8_LDB(B1, 0, 1); PG8_SCHED; PG8_LDA(At, 0, 0); PG8_STAGE(PG8_SA(1, 1), a1 + hstep, voffA);
            PG8_WAIT_V(8); PG8_WAIT_L(0); PG8_BAR; PG8_MMA(0, 0, At, B0); PG8_MMA(0, 1, At, B1); PG8_BAR; PG8_SCHED;
            PG8_LDA(At, 0, 1); PG8_STAGE(PG8_SB(0, 0), b2, voffB); PG8_STAGE(PG8_SB(0, 1), b2 + hstep, voffB); PG8_STAGE(PG8_SA(0, 0), a2, voffA);
            PG8_WAIT_V(8); PG8_WAIT_L(0); PG8_BAR; PG8_MMA(1, 0, At, B0); PG8_MMA(1, 1, At, B1); PG8_BAR; PG8_SCHED;
            PG8_LDB(B0, 1, 0); PG8_LDB(B1, 1, 1); PG8_SCHED; PG8_LDA(At, 1, 0); PG8_STAGE(PG8_SA(0, 1), a2 + hstep, voffA);
            PG8_WAIT_V(8); PG8_WAIT_L(0); PG8_BAR; PG8_MMA(0, 0, At, B0); PG8_MMA(0, 1, At, B1); PG8_BAR; PG8_SCHED;
            PG8_LDA(At, 1, 1); PG8_STAGE(PG8_SB(1, 0), b3, voffB); PG8_STAGE(PG8_SB(1, 1), b3 + hstep, voffB); PG8_STAGE(PG8_SA(1, 0), a3, voffA);
            PG8_WAIT_V(8); PG8_WAIT_L(0); PG8_BAR; PG8_MMA(1, 0, At, B0); PG8_MMA(1, 1, At, B1); PG8_BAR; PG8_SCHED;
            } else {
            PG8_LDB(B0, 0, 0); PG8_SCHED; PG8_LDA(At, 0, 0); PG8_STAGE(PG8_SA(1, 1), a1 + hstep, voffA);
            PG8_WAIT_L(8); PG8_BAR; PG8_WAIT_L(0); PG8_MMA(0, 0, At, B0); PG8_BAR; PG8_SCHED;
            PG8_LDB(B1, 0, 1); PG8_STAGE(PG8_SB(0, 0), b2, voffB);
            PG8_BAR; PG8_WAIT_L(0); PG8_MMA(0, 1, At, B1); PG8_BAR;
            PG8_LDA(At, 0, 1); PG8_STAGE(PG8_SA(0, 0), a2, voffA);
            PG8_BAR; PG8_WAIT_L(0); PG8_MMA(1, 0, At, B0); PG8_BAR; PG8_SCHED;
            PG8_STAGE(PG8_SB(0, 1), b2 + hstep, voffB);
            PG8_WAIT_V(6); PG8_BAR; PG8_MMA(1, 1, At, B1); PG8_BAR;
            PG8_LDB(B0, 1, 0); PG8_SCHED; PG8_LDA(At, 1, 0); PG8_STAGE(PG8_SA(0, 1), a2 + hstep, voffA);
            PG8_WAIT_L(8); PG8_BAR; PG8_WAIT_L(0); PG8_MMA(0, 0, At, B0); PG8_BAR; PG8_SCHED;
            PG8_LDB(B1, 1, 1); PG8_STAGE(PG8_SB(1, 0), b3, voffB);
            PG8_BAR; PG8_WAIT_L(0); PG8_MMA(0, 1, At, B1); PG8_BAR;
            PG8_LDA(At, 1, 1); PG8_STAGE(PG8_SA(1, 0), a3, voffA);
            PG8_BAR; PG8_WAIT_L(0); PG8_MMA(1, 0, At, B0); PG8_BAR; PG8_SCHED;
            PG8_STAGE(PG8_SB(1, 1), b3 + hstep, voffB);
            PG8_WAIT_V(6); PG8_BAR; PG8_MMA(1, 1, At, B1); PG8_BAR;
            }
        }
        if constexpr (ALIGN_EPI) { if (wr == 0) PG8_BAR; }
        if constexpr (!Epi::AFTER_DRAIN) { E(acc, cur, wr, wc, fr, fq); S.done(cur); }
        if (!has_next) break;
#pragma unroll
        for (int a = 0; a < 2; ++a)
#pragma unroll
            for (int b = 0; b < 2; ++b)
#pragma unroll
                for (int m = 0; m < 4; ++m)
#pragma unroll
                    for (int n = 0; n < 2; ++n) acc[a][b][m][n] = (f32x4){0.f, 0.f, 0.f, 0.f};
        cur = nxt; cA = nA; cB = nB; ++ui;
        if constexpr (ALIGN_EPI) { if (wr == 1) PG8_BAR; }
    }
    PG8_WAIT_V(0);
    if constexpr (!ALIGN_EPI) { if (wr == 0) PG8_BAR; }
    PG8_BAR;
    if constexpr (Epi::AFTER_DRAIN) { E.fused(acc, cur, wr, wc, fr, fq, lds, wid, lane); S.done(cur); }
#undef PG8_SA
#undef PG8_SB
#undef PG8_STAGE
#undef PG8_LDA
#undef PG8_LDB
#undef PG8_MMA
#undef PG8_WAIT_V
#undef PG8_WAIT_L
#undef PG8_BAR
#undef PG8_SCHED
}
}
typedef unsigned short bf16_t;
typedef short bf16x8 __attribute__((ext_vector_type(8)));
typedef float f32x4 __attribute__((ext_vector_type(4)));
typedef float f32x2 __attribute__((ext_vector_type(2)));
typedef float f32x16 __attribute__((ext_vector_type(16)));
typedef unsigned u32x4 __attribute__((ext_vector_type(4)));
typedef unsigned u32x2 __attribute__((ext_vector_type(2)));
#define LAS __attribute__((address_space(3)))
constexpr int DM = 1024, CH = 16384, NCHUNK = 3, DEPTH = 4, PLE = 256, DFF = 2816;
constexpr int EV_IN = 7168, OD_IN = 3104, OD_INP = 3328;
constexpr float EPS = 1e-6f;
constexpr int NT = 512, NWV = 8;
constexpr int LDS_BYTES = 147456;
constexpr size_t al256(size_t x) { return (x + 255) & ~(size_t)255; }
constexpr size_t W_EVIN = 65536;
constexpr size_t W_EVOUT = W_EVIN + (size_t)2 * EV_IN * DM * 2;
constexpr size_t W_ODIN = W_EVOUT + (size_t)2 * DM * DM * 2;
constexpr size_t W_ODOUT = W_ODIN + (size_t)2 * OD_INP * DM * 2;
constexpr size_t W_UP = W_ODOUT + (size_t)2 * DM * DM * 2;
constexpr size_t W_DOWN = W_UP + (size_t)4 * 2 * DFF * DM * 2;
constexpr size_t W_GATE = W_DOWN + (size_t)4 * DM * DFF * 2;
constexpr size_t W_PROJ = W_GATE + (size_t)4 * DM * DM * 2;
constexpr size_t W_LB = W_PROJ + (size_t)4 * DM * PLE * 2;
constexpr size_t B_PB = W_LB + 8192;
constexpr size_t B_HB0 = B_PB + (size_t)CH * PLE * 2;
constexpr size_t B_HB1 = B_HB0 + (size_t)CH * DM * 2;
constexpr size_t B_SSQ0 = B_HB1 + (size_t)CH * DM * 2;
constexpr size_t B_SSQ1 = B_SSQ0 + (size_t)CH * 16 * 4;
constexpr size_t ARENA = B_SSQ1 + (size_t)CH * 16 * 4;
constexpr size_t A_U = 0;
constexpr size_t A_QT = (size_t)CH * EV_IN * 2;
constexpr size_t A_KT = A_QT + (size_t)2 * CH * 512 * 2;
constexpr size_t A_MIX = A_QT;
constexpr size_t A_OEV = A_KT + (size_t)2 * CH * 512 * 2;
constexpr size_t A_VFOD = (size_t)CH * OD_INP * 2;
constexpr size_t A_OOD = A_OEV;
constexpr size_t A_OG = A_OEV + (size_t)2 * CH * 512 * 4;
constexpr size_t A_LSE = A_OG + (size_t)3 * CH * 512 * 2;
constexpr size_t A_DEC = A_OOD + (size_t)2 * CH * 1024 * 4;
constexpr size_t ARENA_BYTES = A_DEC + (size_t)512 * 4 * 2 * 128 * 4;
constexpr size_t A_UF = 0;
constexpr size_t A_ACT = (size_t)CH * 2 * DFF * 2;
constexpr size_t A_PP = 0;
constexpr size_t WS_NEED = ARENA + ARENA_BYTES;
static_assert(A_LSE + (size_t)3 * CH * 4 * 4 <= A_DEC, "even bufs before DEC");
static_assert(A_VFOD + (size_t)CH * 1024 * 2 * 2 <= A_QT, "odd Vf fits before QT");
static_assert(A_ACT + (size_t)CH * DFF * 2 <= ARENA_BYTES, "act fits");

__device__ __forceinline__ float bf2f(unsigned short v) { return __uint_as_float(((unsigned)v) << 16); }
__device__ __forceinline__ unsigned pk2(float lo, float hi) { return pg8::cvt_pk_bf16(lo, hi); }
__device__ __forceinline__ float shfl_xor_l(float v, int lane, int m) { return __builtin_bit_cast(float, __builtin_amdgcn_ds_bpermute((lane ^ m) << 2, __builtin_bit_cast(int, v))); }
__device__ __forceinline__ float wave_sum(float v, int lane) {
#pragma unroll
    for (int o = 1; o < 64; o <<= 1) v += shfl_xor_l(v, lane, o);
    return v;
}
__device__ __forceinline__ float rstd_of(const float* ssq, int row) {
    const f32x4* p = (const f32x4*)(ssq + (size_t)row * 16);
    const f32x4 a = p[0], b = p[1], c = p[2], d = p[3];
    const float s = ((a.x + a.y) + (a.z + a.w)) + ((b.x + b.y) + (b.z + b.w)) + ((c.x + c.y) + (c.z + c.w)) + ((d.x + d.y) + (d.z + d.w));
    return rsqrtf(s * (1.0f / DM) + EPS);
}
struct EpiScale {
    static constexpr bool PERM = true, AFTER_DRAIN = false;
    bf16_t* O; int ldc; const float* ssq;
    __device__ __forceinline__ void operator()(const f32x4 (&acc)[2][2][4][2], const pg8::Unit& u, int wr, int wc, int fr, int fq) const {
        const int row0 = u.pm * 256 + wr * 64 + fr, col0 = u.pn * 256 + wc * 32 + 8 * fq;
#pragma unroll
        for (int ai = 0; ai < 2; ++ai)
#pragma unroll
            for (int m = 0; m < 4; ++m) {
                const int row = row0 + ai * 128 + m * 16; const float rs = rstd_of(ssq, row);
                bf16_t* rp = O + (size_t)row * ldc + col0;
#pragma unroll
                for (int bj = 0; bj < 2; ++bj) { const f32x4 v0 = acc[ai][bj][m][0] * rs, v1 = acc[ai][bj][m][1] * rs;
                    u32x4 w; w.x = pk2(v0[0], v0[1]); w.y = pk2(v0[2], v0[3]); w.z = pk2(v1[0], v1[1]); w.w = pk2(v1[2], v1[3]);
                    *(u32x4*)(rp + bj * 128) = w; }
            }
    }
};
struct EpiF32 {
    static constexpr bool PERM = true, AFTER_DRAIN = false;
    bf16_t* O; int ldc;
    __device__ __forceinline__ void operator()(const f32x4 (&acc)[2][2][4][2], const pg8::Unit& u, int wr, int wc, int fr, int fq) const {
        const int row0 = u.pm * 256 + wr * 64 + fr, col0 = u.pn * 256 + wc * 32 + 8 * fq;
#pragma unroll
        for (int ai = 0; ai < 2; ++ai)
#pragma unroll
            for (int m = 0; m < 4; ++m) { bf16_t* rp = O + (size_t)(row0 + ai * 128 + m * 16) * ldc + col0;
#pragma unroll
                for (int bj = 0; bj < 2; ++bj) { const f32x4 v0 = acc[ai][bj][m][0], v1 = acc[ai][bj][m][1];
                    u32x4 w; w.x = pk2(v0[0], v0[1]); w.y = pk2(v0[2], v0[3]); w.z = pk2(v1[0], v1[1]); w.w = pk2(v1[2], v1[3]);
                    *(u32x4*)(rp + bj * 128) = w; } }
    }
};
template <int MODE  > struct EpiResid {
    static constexpr bool PERM = true, AFTER_DRAIN = false;
    float* h; bf16_t* hb; float* ssq_out; const float* ssq_in; const bf16_t* pp;
    __device__ __forceinline__ void operator()(const f32x4 (&acc)[2][2][4][2], const pg8::Unit& u, int wr, int wc, int fr, int fq) const {
        const int row0 = u.pm * 256 + wr * 64 + fr, col0 = u.pn * 256 + wc * 32 + 8 * fq;
#pragma unroll
        for (int ai = 0; ai < 2; ++ai)
#pragma unroll
            for (int m = 0; m < 4; ++m) {
                const int row = row0 + ai * 128 + m * 16; float rs = 1.f; if (MODE == 1) rs = rstd_of(ssq_in, row);
                float* hp = h + (size_t)row * DM + col0; bf16_t* bp = hb + (size_t)row * DM + col0; float s = 0.f;
#pragma unroll
                for (int bj = 0; bj < 2; ++bj) {
                    f32x4 a0 = acc[ai][bj][m][0], a1 = acc[ai][bj][m][1];
                    if (MODE == 1) { const u32x4 pw = *(const u32x4*)(pp + (size_t)row * DM + col0 + bj * 128);
                        const f32x4 p0 = {__uint_as_float(pw.x << 16), __uint_as_float(pw.x & 0xffff0000u), __uint_as_float(pw.y << 16), __uint_as_float(pw.y & 0xffff0000u)};
                        const f32x4 p1 = {__uint_as_float(pw.z << 16), __uint_as_float(pw.z & 0xffff0000u), __uint_as_float(pw.w << 16), __uint_as_float(pw.w & 0xffff0000u)};
#pragma unroll
                        for (int e = 0; e < 4; ++e) { a0[e] = p0[e] / (1.f + __expf(-a0[e] * rs)); a1[e] = p1[e] / (1.f + __expf(-a1[e] * rs)); } }
                    const f32x4 h0 = *(const f32x4*)(hp + bj * 128) + a0, h1 = *(const f32x4*)(hp + bj * 128 + 4) + a1;
                    *(f32x4*)(hp + bj * 128) = h0; *(f32x4*)(hp + bj * 128 + 4) = h1;
                    u32x4 w; w.x = pk2(h0[0], h0[1]); w.y = pk2(h0[2], h0[3]); w.z = pk2(h1[0], h1[1]); w.w = pk2(h1[2], h1[3]);
                    *(u32x4*)(bp + bj * 128) = w;
                    s += (h0[0] * h0[0] + h0[1] * h0[1]) + (h0[2] * h0[2] + h0[3] * h0[3]) + (h1[0] * h1[0] + h1[1] * h1[1]) + (h1[2] * h1[2] + h1[3] * h1[3]);
                }
                { const int ln_ = fq * 16 + fr; s += shfl_xor_l(s, ln_, 16); s += shfl_xor_l(s, ln_, 32); }
                if (fq == 0) ssq_out[(size_t)row * 16 + u.pn * 4 + wc] = s;
            }
    }
};

struct EpiConv {
    static constexpr bool PERM = true, AFTER_DRAIN = false;
    bf16_t* act; const float* ssq; const float* cw; const float* cb; int T; LAS float* halo;
    __device__ __forceinline__ void operator()(f32x4 (&acc)[2][2][4][2], const pg8::Unit& u, int wr, int wc, int fr, int fq) const {
        const int g0 = 254 * u.pm - 1, lane = fq * 16 + fr;
#pragma unroll
        for (int ai = 0; ai < 2; ++ai)
#pragma unroll
            for (int m = 0; m < 4; ++m) { const float rs = rstd_of(ssq, g0 + ai * 128 + wr * 64 + m * 16 + fr);
#pragma unroll
                for (int bj = 0; bj < 2; ++bj) { acc[ai][bj][m][0] = acc[ai][bj][m][0] * rs; acc[ai][bj][m][1] = acc[ai][bj][m][1] * rs; } }
#pragma unroll
        for (int ai = 0; ai < 2; ++ai) { const int s = 2 * ai + wr;
            if (fr == 0) {
#pragma unroll
                for (int bj = 0; bj < 2; ++bj)
#pragma unroll
                    for (int n = 0; n < 2; ++n) *(LAS f32x4*)(halo + ((((wc * 4 + s) * 2 + 0) * 2 + bj) * 32) + 8 * fq + 4 * n) = acc[ai][bj][0][n]; }
            if (fr == 15) {
#pragma unroll
                for (int bj = 0; bj < 2; ++bj)
#pragma unroll
                    for (int n = 0; n < 2; ++n) *(LAS f32x4*)(halo + ((((wc * 4 + s) * 2 + 1) * 2 + bj) * 32) + 8 * fq + 4 * n) = acc[ai][bj][3][n]; } }
        asm volatile("s_waitcnt lgkmcnt(0)" ::: "memory"); __builtin_amdgcn_s_barrier(); asm volatile("" ::: "memory");
#pragma unroll
        for (int n = 0; n < 2; ++n) {
            const int ca = u.pn * 128 + wc * 32 + 8 * fq + 4 * n;
            f32x4 w0[2], w1[2], w2[2], bb[2];
#pragma unroll
            for (int bj = 0; bj < 2; ++bj) { const int c = bj * DFF + ca;
                w0[bj] = *(const f32x4*)(cw + c); w1[bj] = *(const f32x4*)(cw + 2 * DFF + c); w2[bj] = *(const f32x4*)(cw + 4 * DFF + c); bb[bj] = *(const f32x4*)(cb + c); }
#pragma unroll
            for (int ai = 0; ai < 2; ++ai) { const int s = 2 * ai + wr;
#pragma unroll
                for (int m = 0; m < 4; ++m) {
                    const int lr = ai * 128 + wr * 64 + m * 16 + fr, g = g0 + lr; const bool tp = (g & (T - 1)) != 0, tn = ((g + 1) & (T - 1)) != 0;
                    f32x4 ph[2] = {{0.f, 0.f, 0.f, 0.f}, {0.f, 0.f, 0.f, 0.f}}, nh[2] = {{0.f, 0.f, 0.f, 0.f}, {0.f, 0.f, 0.f, 0.f}};
                    if (m == 0 && s > 0) {
#pragma unroll
                        for (int bj = 0; bj < 2; ++bj) ph[bj] = *(const LAS f32x4*)(halo + ((((wc * 4 + s - 1) * 2 + 1) * 2 + bj) * 32) + 8 * fq + 4 * n); }
                    if (m == 3 && s < 3) {
#pragma unroll
                        for (int bj = 0; bj < 2; ++bj) nh[bj] = *(const LAS f32x4*)(halo + ((((wc * 4 + s + 1) * 2 + 0) * 2 + bj) * 32) + 8 * fq + 4 * n); }
                    float cv[2][4];
#pragma unroll
                    for (int bj = 0; bj < 2; ++bj)
#pragma unroll
                        for (int e = 0; e < 4; ++e) {
                            const float cur = acc[ai][bj][m][n][e];
                            const float sp_ = (fr == 15) ? (m > 0 ? acc[ai][bj][m > 0 ? m - 1 : 0][n][e] : ph[bj][e]) : cur;
                            const float sn_ = (fr == 0) ? (m < 3 ? acc[ai][bj][m < 3 ? m + 1 : 3][n][e] : nh[bj][e]) : cur;
                            const float pv = __builtin_bit_cast(float, __builtin_amdgcn_update_dpp(0, __builtin_bit_cast(int, sp_), 0x121, 0xf, 0xf, false));
                            const float nv = __builtin_bit_cast(float, __builtin_amdgcn_update_dpp(0, __builtin_bit_cast(int, sn_), 0x12F, 0xf, 0xf, false));
                            float t_ = fmaf(cur, w1[bj][e], bb[bj][e]); t_ = tp ? fmaf(pv, w0[bj][e], t_) : t_; t_ = tn ? fmaf(nv, w2[bj][e], t_) : t_; cv[bj][e] = t_;
                        }
                    const f32x2 g01 = pg8::gelu_pk((f32x2){cv[1][0], cv[1][1]}), g23 = pg8::gelu_pk((f32x2){cv[1][2], cv[1][3]});
                    if (lr >= 1 && lr <= 254 && g < CH) { u32x2 w; w.x = pk2(cv[0][0] * g01.x, cv[0][1] * g01.y); w.y = pk2(cv[0][2] * g23.x, cv[0][3] * g23.y);
                        *(u32x2*)(act + (size_t)g * DFF + ca) = w; }
                    __builtin_amdgcn_sched_barrier(0);
                }
            }
            asm volatile("" ::: "memory");
        }
    }
};
struct Args {
    const float* in[23]; float* out; unsigned char* ws; int ph_lo, ph_hi;
};
enum { I_XP = 0, I_XS, I_PP, I_PS, I_NMIX, I_EVIN, I_LBL, I_HNORM, I_EVOUT, I_ODIN, I_GUP, I_GB, I_GNORM, I_ODOUT, I_NFFN, I_FUP, I_CW, I_CB, I_FDOWN, I_NPLE, I_PGATE, I_PPROJ, I_NOUT };

struct Ctx {
    LAS unsigned char* lds; int tid, lane, wave, G, bid;
    const Args* a; unsigned char* ws;
};

__device__ __forceinline__ void transpose_item(const float* W, int K, int N, const float* gk, bf16_t* WT, LAS float* scr, int item, int lane, bool remap) {
    const int nblk = N / 32, kb = item / nblk, nb = item % nblk, k0 = 64 * kb, n0 = 32 * nb;
#pragma unroll 8
    for (int i = 0; i < 32; ++i) { const int kk = 2 * i + (lane >> 5); float v = W[(size_t)(k0 + kk) * N + n0 + (lane & 31)]; if (gk) v *= gk[k0 + kk]; scr[kk * 33 + (lane & 31)] = v; }
    asm volatile("s_waitcnt lgkmcnt(0)" ::: "memory");
    const int c = lane & 7;
#pragma unroll
    for (int j = 0; j < 4; ++j) { const int n = (lane >> 3) + 8 * j; const LAS float* s = scr + (8 * c) * 33 + n;
        u32x4 o; o.x = pk2(s[0 * 33], s[1 * 33]); o.y = pk2(s[2 * 33], s[3 * 33]); o.z = pk2(s[4 * 33], s[5 * 33]); o.w = pk2(s[6 * 33], s[7 * 33]);
        int nr = n0 + n; if (remap) nr = (nr < DFF) ? (((nr >> 7) << 8) + (nr & 127)) : ((((nr - DFF) >> 7) << 8) + 128 + ((nr - DFF) & 127));
        *(u32x4*)(WT + (size_t)nr * K + k0 + 8 * c) = o; }
    asm volatile("s_waitcnt lgkmcnt(0)" ::: "memory");
}
__device__ __forceinline__ void weights_prologue(const Ctx& C) {
    LAS float* scr = (LAS float*)(C.lds + C.wave * 8704);
    const int gw = C.bid * NWV + C.wave, NGW = C.G * NWV;
    const Args& a = *C.a;
    for (int mat = 0; mat < 24; ++mat) {
        const float* W; const float* g = nullptr; bf16_t* WT; int K, N;
        if (mat < 2)       { const int e = mat;      W = a.in[I_EVIN] + (size_t)e * DM * EV_IN;  K = DM; N = EV_IN; g = a.in[I_NMIX] + (2 * e) * DM;     WT = (bf16_t*)(C.ws + W_EVIN) + (size_t)e * EV_IN * DM; }
        else if (mat < 4)  { const int e = mat - 2;  W = a.in[I_EVOUT] + (size_t)e * DM * DM;    K = DM; N = DM;                                        WT = (bf16_t*)(C.ws + W_EVOUT) + (size_t)e * DM * DM; }
        else if (mat < 6)  { const int o = mat - 4;  W = a.in[I_ODIN] + (size_t)o * DM * OD_IN;  K = DM; N = OD_IN; g = a.in[I_NMIX] + (2 * o + 1) * DM; WT = (bf16_t*)(C.ws + W_ODIN) + (size_t)o * OD_INP * DM; }
        else if (mat < 8)  { const int o = mat - 6;  W = a.in[I_ODOUT] + (size_t)o * DM * DM;    K = DM; N = DM;                                        WT = (bf16_t*)(C.ws + W_ODOUT) + (size_t)o * DM * DM; }
        else if (mat < 12) { const int l = mat - 8;  W = a.in[I_FUP] + (size_t)l * DM * 2 * DFF; K = DM; N = 2 * DFF; g = a.in[I_NFFN] + l * DM;         WT = (bf16_t*)(C.ws + W_UP) + (size_t)l * 2 * DFF * DM; }
        else if (mat < 16) { const int l = mat - 12; W = a.in[I_FDOWN] + (size_t)l * DFF * DM;   K = DFF; N = DM;                                       WT = (bf16_t*)(C.ws + W_DOWN) + (size_t)l * DM * DFF; }
        else if (mat < 20) { const int l = mat - 16; W = a.in[I_PGATE] + (size_t)l * DM * DM;    K = DM; N = DM; g = a.in[I_NPLE] + l * DM;              WT = (bf16_t*)(C.ws + W_GATE) + (size_t)l * DM * DM; }
        else               { const int l = mat - 20; W = a.in[I_PPROJ] + (size_t)l * PLE * DM;   K = PLE; N = DM;                                       WT = (bf16_t*)(C.ws + W_PROJ) + (size_t)l * DM * PLE; }
        const int nitems = (K / 64) * (N / 32);
        for (int it = gw; it < nitems; it += NGW) transpose_item(W, K, N, g, WT, scr, it, C.lane, mat >= 8 && mat < 12);
    }
    { const int gt = C.bid * NT + C.tid, GT = C.G * NT; const int per = (OD_INP - OD_IN) * DM / 8;
      for (int i = gt; i < 2 * per; i += GT) { const int o = i / per, r = i % per; *(u32x4*)((bf16_t*)(C.ws + W_ODIN) + (size_t)o * OD_INP * DM + (size_t)OD_IN * DM + (size_t)r * 8) = (u32x4){0u, 0u, 0u, 0u}; } }
    { const int gt = C.bid * NT + C.tid; if (gt < 1024) { const int dir = gt >> 9, c = gt & 511; const float* L = a.in[I_LBL] + (size_t)dir * 2 * 512;
        float* lb = (float*)(C.ws + W_LB) + dir * 1024; lb[c] = 0.f; lb[512 + c] = 1.f / (1.f + __expf(L[c] - L[512 + c])); } }
}
__device__ __forceinline__ void chunk_prologue(const Ctx& C, int chunk, bf16_t* hb, float* ssq) {
    const int gw = C.bid * NWV + C.wave, NGW = C.G * NWV; const Args& a = *C.a;
    for (int r = gw; r < CH; r += NGW) {
        const size_t R = (size_t)chunk * CH + r;
        const float* xr = (R < 16384) ? a.in[I_XP] + R * DM : a.in[I_XS] + (R - 16384) * DM;
        float* hr = a.out + R * DM; f32x4 v[4]; float s = 0.f;
#pragma unroll
        for (int j = 0; j < 4; ++j) { v[j] = ((const f32x4*)xr)[C.lane + 64 * j]; s += (v[j].x * v[j].x + v[j].y * v[j].y) + (v[j].z * v[j].z + v[j].w * v[j].w); }
        s = wave_sum(s, C.lane);
#pragma unroll
        for (int j = 0; j < 4; ++j) { ((f32x4*)hr)[C.lane + 64 * j] = v[j]; u32x2 w; w.x = pk2(v[j].x, v[j].y); w.y = pk2(v[j].z, v[j].w); ((u32x2*)(hb + (size_t)r * DM))[C.lane + 64 * j] = w; }
        if (C.lane < 16) ssq[(size_t)r * 16 + C.lane] = (C.lane == 0) ? s : 0.f;
    }
}
__device__ __forceinline__ void final_norm(const Ctx& C, int chunk) {
    const int gw = C.bid * NWV + C.wave, NGW = C.G * NWV; const Args& a = *C.a; const float* g = a.in[I_NOUT];
    for (int r = gw; r < CH; r += NGW) {
        float* hr = a.out + ((size_t)chunk * CH + r) * DM; f32x4 v[4]; float s = 0.f;
#pragma unroll
        for (int j = 0; j < 4; ++j) { v[j] = ((const f32x4*)hr)[C.lane + 64 * j]; s += (v[j].x * v[j].x + v[j].y * v[j].y) + (v[j].z * v[j].z + v[j].w * v[j].w); }
        const float rs = rsqrtf(wave_sum(s, C.lane) * (1.f / DM) + EPS);
#pragma unroll
        for (int j = 0; j < 4; ++j) { const f32x4 gg = ((const f32x4*)g)[C.lane + 64 * j]; ((f32x4*)hr)[C.lane + 64 * j] = v[j] * rs * gg; }
    }
}
__device__ __forceinline__ void conv_phase(const Ctx& C, int chunk, int l, int T) {
    const Args& a = *C.a;
    const bf16_t* UF = (const bf16_t*)(C.ws + ARENA + A_UF); bf16_t* ACT = (bf16_t*)(C.ws + ARENA + A_ACT);
    const float* cw = a.in[I_CW] + (size_t)l * 3 * 2 * DFF; const float* cb = a.in[I_CB] + (size_t)l * 2 * DFF;
    {
        const int ry = C.tid >> 5, cx = C.tid & 31;
        for (int tile = C.bid; tile < (CH / 64) * 11; tile += C.G) {
            const int rt = tile / 11, ct = tile % 11; const int r0 = rt * 64 + ry * 4, c0 = ct * 256 + cx * 8;
            float wa0[8], wa1[8], wa2[8], wg0[8], wg1[8], wg2[8], ba[8], bg[8];
#pragma unroll
            for (int e = 0; e < 8; e += 4) { *(f32x4*)(wa0 + e) = *(const f32x4*)(cw + c0 + e); *(f32x4*)(wa1 + e) = *(const f32x4*)(cw + 2 * DFF + c0 + e); *(f32x4*)(wa2 + e) = *(const f32x4*)(cw + 4 * DFF + c0 + e);
                *(f32x4*)(wg0 + e) = *(const f32x4*)(cw + DFF + c0 + e); *(f32x4*)(wg1 + e) = *(const f32x4*)(cw + 3 * DFF + c0 + e); *(f32x4*)(wg2 + e) = *(const f32x4*)(cw + 5 * DFF + c0 + e);
                *(f32x4*)(ba + e) = *(const f32x4*)(cb + c0 + e); *(f32x4*)(bg + e) = *(const f32x4*)(cb + DFF + c0 + e); }
            bf16x8 ua[6], ug[6];
#pragma unroll
            for (int i = 0; i < 6; ++i) { const int r = r0 - 1 + i; const bool ok = (i == 0) ? ((r0 % T) != 0) : (i == 5 ? (((r0 + 4) % T) != 0) : true);
                if (ok) { ua[i] = *(const bf16x8*)(UF + (size_t)r * 2 * DFF + c0); ug[i] = *(const bf16x8*)(UF + (size_t)r * 2 * DFF + DFF + c0); }
                else { ua[i] = (bf16x8){0, 0, 0, 0, 0, 0, 0, 0}; ug[i] = ua[i]; } }
#pragma unroll
            for (int i = 0; i < 4; ++i) {
                float o[8];
#pragma unroll
                for (int e = 0; e < 8; ++e) {
                    const float av = bf2f((unsigned short)ua[i][e]) * wa0[e] + bf2f((unsigned short)ua[i + 1][e]) * wa1[e] + bf2f((unsigned short)ua[i + 2][e]) * wa2[e] + ba[e];
                    const float gv = bf2f((unsigned short)ug[i][e]) * wg0[e] + bf2f((unsigned short)ug[i + 1][e]) * wg1[e] + bf2f((unsigned short)ug[i + 2][e]) * wg2[e] + bg[e];
                    o[e] = av * (0.5f * gv * (1.f + erff(gv * 0.70710678118f)));
                }
                u32x4 w; w.x = pk2(o[0], o[1]); w.y = pk2(o[2], o[3]); w.z = pk2(o[4], o[5]); w.w = pk2(o[6], o[7]);
                *(u32x4*)(ACT + (size_t)(r0 + i) * DFF + c0) = w;
            }
        }
    }
}
__device__ __forceinline__ void pb_convert(const Ctx& C, int chunk, int l) {
    const Args& a = *C.a;
    { bf16_t* PB = (bf16_t*)(C.ws + B_PB); const int gt = C.bid * NT + C.tid, GT = C.G * NT;
      for (int i = gt; i < CH * PLE / 4; i += GT) { const int r = i / (PLE / 4), c4 = i % (PLE / 4); const size_t R = (size_t)chunk * CH + r;
          const float* src = (R < 16384) ? a.in[I_PP] + ((size_t)l * 16384 + R) * PLE : a.in[I_PS] + ((size_t)l * 32768 + (R - 16384)) * PLE;
          const f32x4 v = ((const f32x4*)src)[c4]; u32x2 w; w.x = pk2(v.x, v.y); w.y = pk2(v.z, v.w); ((u32x2*)(PB + (size_t)r * PLE))[c4] = w; } }
}
struct Mix { int even, li, T, DV, ld, vcol, gcol; float qscale; unsigned char* vf; };
#define MFMA32(a, b, c) __builtin_amdgcn_mfma_f32_32x32x16_bf16((a), (b), (c), 0, 0, 0)
#define QK_IDX(hd, dir, blk, k) (((((size_t)((hd) * 2 + (dir))) * 512 + (size_t)(blk)) * 8 + (k)) * 64)
#define V_IDX(hd, dir, ET, et, blk, sp) ((((((size_t)((hd) * 2 + (dir))) * (ET) + (et)) * 512 + (size_t)(blk)) * 2 + (sp)) * 64)
#define O_IDX(hd, dir, ET, et, blk, q) ((((((size_t)((hd) * 2 + (dir))) * (ET) + (et)) * 512 + (size_t)(blk)) * 4 + (q)) * 64)
#define DEC_IDX(hd, dir, blk) ((((size_t)((hd) * 2 + (dir))) * 512 + (size_t)(blk)) * 128)
#define LDSFENCE() asm volatile("s_waitcnt lgkmcnt(0)" ::: "memory")
__device__ __forceinline__ bf16x8 pack8(float a0, float a1, float a2, float a3, float a4, float a5, float a6, float a7) {
    u32x4 w; w.x = pk2(a0, a1); w.y = pk2(a2, a3); w.z = pk2(a4, a5); w.w = pk2(a6, a7); return __builtin_bit_cast(bf16x8, w);
}
__device__ __forceinline__ f32x16 zero16() { f32x16 z;
#pragma unroll
    for (int i = 0; i < 16; ++i) z[i] = 0.f; return z; }

__device__ __forceinline__ void prep_phase(const Ctx& C, const Mix& mx) {
    const Args& a = *C.a;
    const bf16_t* U = (const bf16_t*)(C.ws + ARENA + A_U);
    u32x4* QTf = (u32x4*)(C.ws + ARENA + A_QT); u32x4* KTf = (u32x4*)(C.ws + ARENA + A_KT); u32x4* Vf = (u32x4*)mx.vf;
    f32x4* Of = (f32x4*)(C.ws + ARENA + A_OEV); float* DEC = (float*)(C.ws + ARENA + A_DEC);
    const float* LB = (const float*)(C.ws + W_LB);
    const int hd = C.wave & 3, dir = C.wave >> 2, lane = C.lane, ld = mx.ld, DV = mx.DV;
    LAS float* Bs = (LAS float*)(C.lds + C.wave * 16896);
    for (int b = C.bid; b < CH / 32; b += C.G) {
        int vz_ = 0; asm volatile("" : "+v"(vz_)); const int rb = 32 * b + vz_;
        {
            const int d0 = 2 * lane, col0 = hd * 128 + d0, dt0 = d0 >> 5, dp0 = d0 & 31;
            float bs0 = 0.f, bs1 = 0.f; unsigned zz[32];
            if (mx.even) {
                const f32x2 lb2 = *(const f32x2*)(LB + dir * 1024 + mx.li * 512 + col0); const float om0 = 1.f - lb2.x, om1 = 1.f - lb2.y;
                const bf16_t* zp = U + 512 + 512 * dir + col0;
#pragma unroll
                for (int t = 0; t < 32; ++t) { const int row = rb + (dir ? 31 - t : t);
                    const unsigned zw = *(const unsigned*)(zp + (size_t)row * ld); zz[t] = zw;
                    const float z0 = __uint_as_float(zw << 16), z1 = __uint_as_float(zw & 0xffff0000u);
                    bs0 += fmaxf(__logf(lb2.x + om0 / (1.f + __expf(-z0))), -30.f); bs1 += fmaxf(__logf(lb2.y + om1 / (1.f + __expf(-z1))), -30.f);
                    *(LAS f32x2*)(Bs + t * 132 + d0) = (f32x2){bs0, bs1}; }
                *(f32x2*)(DEC + DEC_IDX(hd, dir, b) + d0) = (f32x2){__expf(bs0), __expf(bs1)};
#pragma unroll
                for (int grp = 0; grp < 4; ++grp) { float k0[8], k1[8];
#pragma unroll
                    for (int j = 0; j < 8; ++j) { const int t = 16 * (grp >> 1) + 8 * (j >> 2) + 4 * (grp & 1) + (j & 3);
                        const float z0 = __uint_as_float(zz[t] << 16), z1 = __uint_as_float(zz[t] & 0xffff0000u); const f32x2 bt = *(const LAS f32x2*)(Bs + t * 132 + d0);
                        k0[j] = om0 / (1.f + __expf(z0)) * __expf(bs0 - bt.x); k1[j] = om1 / (1.f + __expf(z1)) * __expf(bs1 - bt.y); }
                    u32x4 w; w.x = pk2(k0[0], k0[1]); w.y = pk2(k0[2], k0[3]); w.z = pk2(k0[4], k0[5]); w.w = pk2(k0[6], k0[7]);
                    KTf[QK_IDX(hd, dir, b, (grp >> 1) * 4 + dt0) + 32 * (grp & 1) + dp0] = w;
                    w.x = pk2(k1[0], k1[1]); w.y = pk2(k1[2], k1[3]); w.z = pk2(k1[4], k1[5]); w.w = pk2(k1[6], k1[7]);
                    KTf[QK_IDX(hd, dir, b, (grp >> 1) * 4 + dt0) + 32 * (grp & 1) + dp0 + 1] = w; }
            } else {
                float Wg0[16], Wg1[16]; const float* wp = a.in[I_GUP] + ((size_t)(mx.li * 2 + dir) * 16) * 512 + col0;
#pragma unroll
                for (int r = 0; r < 16; ++r) { const f32x2 w2 = *(const f32x2*)(wp + r * 512); Wg0[r] = w2.x; Wg1[r] = w2.y; }
                const f32x2 bias = *(const f32x2*)(a.in[I_GB] + (mx.li * 2 + dir) * 512 + col0);
#pragma unroll
                for (int t = 0; t < 32; ++t) { const int row = rb + (dir ? 31 - t : t);
                    const u32x4 l0 = *(const u32x4*)(U + (size_t)row * ld + 3072 + 16 * dir), l1 = *(const u32x4*)(U + (size_t)row * ld + 3072 + 16 * dir + 8);
                    zz[t] = *(const unsigned*)(U + (size_t)row * ld + 512 + col0);
                    float x0 = bias.x, x1 = bias.y;
#pragma unroll
                    for (int w = 0; w < 4; ++w) { const float a0 = __uint_as_float(l0[w] << 16), a1 = __uint_as_float(l0[w] & 0xffff0000u), c0 = __uint_as_float(l1[w] << 16), c1 = __uint_as_float(l1[w] & 0xffff0000u);
                        x0 += a0 * Wg0[2 * w] + a1 * Wg0[2 * w + 1] + c0 * Wg0[8 + 2 * w] + c1 * Wg0[8 + 2 * w + 1];
                        x1 += a0 * Wg1[2 * w] + a1 * Wg1[2 * w + 1] + c0 * Wg1[8 + 2 * w] + c1 * Wg1[8 + 2 * w + 1]; }
                    bs0 += fmaxf((fminf(x0, 0.f) - log1pf(__expf(-fabsf(x0)))) * (1.f / 16.f), -30.f); bs1 += fmaxf((fminf(x1, 0.f) - log1pf(__expf(-fabsf(x1)))) * (1.f / 16.f), -30.f);
                    *(LAS f32x2*)(Bs + t * 132 + d0) = (f32x2){bs0, bs1}; }
                *(f32x2*)(DEC + DEC_IDX(hd, dir, b) + d0) = (f32x2){__expf(bs0), __expf(bs1)};
#pragma unroll
                for (int grp = 0; grp < 4; ++grp) { float k0[8], k1[8];
#pragma unroll
                    for (int j = 0; j < 8; ++j) { const int t = 16 * (grp >> 1) + 8 * (j >> 2) + 4 * (grp & 1) + (j & 3); const f32x2 bt = *(const LAS f32x2*)(Bs + t * 132 + d0);
                        k0[j] = __uint_as_float(zz[t] << 16) * __expf(bs0 - bt.x); k1[j] = __uint_as_float(zz[t] & 0xffff0000u) * __expf(bs1 - bt.y); }
                    u32x4 w; w.x = pk2(k0[0], k0[1]); w.y = pk2(k0[2], k0[3]); w.z = pk2(k0[4], k0[5]); w.w = pk2(k0[6], k0[7]);
                    KTf[QK_IDX(hd, dir, b, (grp >> 1) * 4 + dt0) + 32 * (grp & 1) + dp0] = w;
                    w.x = pk2(k1[0], k1[1]); w.y = pk2(k1[2], k1[3]); w.z = pk2(k1[4], k1[5]); w.w = pk2(k1[6], k1[7]);
                    KTf[QK_IDX(hd, dir, b, (grp >> 1) * 4 + dt0) + 32 * (grp & 1) + dp0 + 1] = w; }
            }
        }
        LDSFENCE();
        const int tau = lane & 31, h = lane >> 5, row = rb + (dir ? 31 - tau : tau);
        bf16x8 Ak[8], Bq[8];
#pragma unroll
        for (int ks = 0; ks < 8; ++ks) {
            float qh[8], kh[8], qt[8];
#pragma unroll
            for (int q2 = 0; q2 < 2; ++q2) {
                const int d0 = 16 * ks + 8 * q2 + 4 * h;
                const f32x4 b4 = *(const LAS f32x4*)(Bs + tau * 132 + d0), r4 = *(const LAS f32x4*)(Bs + 15 * 132 + d0);
                const u32x2 qr = *(const u32x2*)(U + (size_t)row * ld + hd * 128 + d0);
                float q4[4] = {__uint_as_float(qr.x << 16), __uint_as_float(qr.x & 0xffff0000u), __uint_as_float(qr.y << 16), __uint_as_float(qr.y & 0xffff0000u)};
                float k4[4];
                if (mx.even) { const u32x2 zr = *(const u32x2*)(U + (size_t)row * ld + 512 + 512 * dir + hd * 128 + d0);
                    const f32x4 lb4 = *(const f32x4*)(LB + dir * 1024 + mx.li * 512 + hd * 128 + d0);
                    const float z4[4] = {__uint_as_float(zr.x << 16), __uint_as_float(zr.x & 0xffff0000u), __uint_as_float(zr.y << 16), __uint_as_float(zr.y & 0xffff0000u)};
#pragma unroll
                    for (int e = 0; e < 4; ++e) k4[e] = (1.f - lb4[e]) / (1.f + __expf(z4[e]));
                } else { const u32x2 kr = *(const u32x2*)(U + (size_t)row * ld + 512 + hd * 128 + d0);
                    k4[0] = __uint_as_float(kr.x << 16); k4[1] = __uint_as_float(kr.x & 0xffff0000u); k4[2] = __uint_as_float(kr.y << 16); k4[3] = __uint_as_float(kr.y & 0xffff0000u); }
#pragma unroll
                for (int e = 0; e < 4; ++e) { const float qq = q4[e] * mx.qscale; qt[4 * q2 + e] = qq * __expf(b4[e]);
                    qh[4 * q2 + e] = qq * __expf(fminf(b4[e] - r4[e], 80.f)); kh[4 * q2 + e] = k4[e] * __expf(fminf(r4[e] - b4[e], 80.f)); }
            }
            { u32x4 w; w.x = pk2(qt[0], qt[1]); w.y = pk2(qt[2], qt[3]); w.z = pk2(qt[4], qt[5]); w.w = pk2(qt[6], qt[7]); QTf[QK_IDX(hd, dir, b, ks) + lane] = w; }
            Bq[ks] = pack8(qh[0], qh[1], qh[2], qh[3], qh[4], qh[5], qh[6], qh[7]);
            Ak[ks] = pack8(kh[0], kh[1], kh[2], kh[3], kh[4], kh[5], kh[6], kh[7]);
        }
        f32x16 at = zero16();
#pragma unroll
        for (int ks = 0; ks < 8; ++ks) at = MFMA32(Ak[ks], Bq[ks], at);
#pragma unroll
        for (int i = 0; i < 16; ++i) { const int s = (i & 3) + 8 * (i >> 2) + 4 * h; if (s > tau) at[i] = 0.f; }
        bf16x8 Pa[2];
        Pa[0] = pack8(at[0], at[1], at[2], at[3], at[4], at[5], at[6], at[7]);
        Pa[1] = pack8(at[8], at[9], at[10], at[11], at[12], at[13], at[14], at[15]);
        const int ET = DV / 32;
        LDSFENCE();
        LAS unsigned char* Vs = (LAS unsigned char*)Bs; const int vpitch = 2 * DV + 16;
        for (int idx = lane; idx < 32 * (DV / 8); idx += 64) { const int t = idx / (DV / 8), c8 = idx % (DV / 8); const int rj = rb + (dir ? 31 - t : t);
            *(LAS u32x4*)(Vs + t * vpitch + c8 * 16) = *(const u32x4*)(U + (size_t)rj * ld + mx.vcol + hd * DV + c8 * 8); }
        LDSFENCE();
        for (int et = 0; et < ET; ++et) {
            f32x16 acc = zero16();
#pragma unroll
            for (int sp = 0; sp < 2; ++sp) {
                unsigned short v[8];
#pragma unroll
                for (int j = 0; j < 8; ++j) { const int sj = 16 * sp + 8 * (j >> 2) + 4 * h + (j & 3); v[j] = *(const LAS unsigned short*)(Vs + sj * vpitch + (32 * et + (lane & 31)) * 2); }
                u32x4 w; w.x = v[0] | ((unsigned)v[1] << 16); w.y = v[2] | ((unsigned)v[3] << 16); w.z = v[4] | ((unsigned)v[5] << 16); w.w = v[6] | ((unsigned)v[7] << 16);
                Vf[V_IDX(hd, dir, ET, et, b, sp) + lane] = w;
                acc = MFMA32(Pa[sp], __builtin_bit_cast(bf16x8, w), acc);
            }
#pragma unroll
            for (int q = 0; q < 4; ++q) Of[O_IDX(hd, dir, ET, et, b, q) + lane] = (f32x4){acc[4 * q], acc[4 * q + 1], acc[4 * q + 2], acc[4 * q + 3]};
        }
        LDSFENCE();
    }
}
__device__ __forceinline__ void scan_phase(const Ctx& C, const Mix& mx) {
    const u32x4* QTf = (const u32x4*)(C.ws + ARENA + A_QT); const u32x4* KTf = (const u32x4*)(C.ws + ARENA + A_KT); const u32x4* Vf = (const u32x4*)mx.vf;
    u32x4* Of = (u32x4*)(C.ws + ARENA + A_OEV); const float* DEC = (const float*)(C.ws + ARENA + A_DEC);
    const int lane = C.lane, h = lane >> 5, DV = mx.DV, ET = DV / 32, T = mx.T, nb = T / 32;
    const int units = (CH / T) * 8 * ET;
    constexpr int SLOT = 23552, R = 5, NL = 4;
    LAS u32x4* SB = (LAS u32x4*)(C.lds + R * SLOT);
    for (int base = 0; base < units; base += C.G) {
        const bool loader = C.wave >= 2 && C.wave < 2 + NL;
        const int lr = C.wave - 2;
        const int u = base + C.bid;
        const bool valid = u < units;
        const int et = u % ET, x = u / ET, dir = x & 1, hd = (x >> 1) & 3, seq = x >> 3;
        LAS unsigned char* ring = C.lds;
#define SCAN_BAR() do { asm volatile("s_waitcnt lgkmcnt(0)" ::: "memory"); __builtin_amdgcn_s_barrier(); asm volatile("" ::: "memory"); } while (0)
#define GLDS16(gp, lp) __builtin_amdgcn_global_load_lds((const unsigned*)(gp), (LAS unsigned*)(lp), 16, 0, 0)
#define SCAN_ISSUE(j) do { const int blk_ = seq * nb + (dir ? nb - 1 - (j) : (j)); LAS unsigned char* sl_ = ring + ((j) % R) * SLOT; \
            _Pragma("unroll") for (int k = 0; k < 8; ++k) { GLDS16(QTf + QK_IDX(hd, dir, blk_, k) + lane, sl_ + k * 1024); GLDS16(KTf + QK_IDX(hd, dir, blk_, k) + lane, sl_ + (8 + k) * 1024); } \
            _Pragma("unroll") for (int sp = 0; sp < 2; ++sp) GLDS16(Vf + V_IDX(hd, dir, ET, et, blk_, sp) + lane, sl_ + (16 + sp) * 1024); \
            _Pragma("unroll") for (int q = 0; q < 4; ++q) GLDS16(Of + O_IDX(hd, dir, ET, et, blk_, q) + lane, sl_ + (18 + q) * 1024); \
            if (lane < 32) GLDS16(DEC + DEC_IDX(hd, dir, blk_) + 4 * lane, sl_ + 22 * 1024); } while (0)
        if (C.wave == 0) {
            SCAN_BAR();
            for (int i = 0; i < nb; ++i) {
                if (valid) {
                    const LAS u32x4* sv = (const LAS u32x4*)(ring + (i % R) * SLOT) + lane; const LAS u32x4* sb = SB + (i & 1) * 512 + lane;
                    u32x4 qf[8], on[4], bs[8];
#pragma unroll
                    for (int q = 0; q < 4; ++q) on[q] = sv[(18 + q) * 64];
#pragma unroll
                    for (int k = 0; k < 8; ++k) { qf[k] = sv[k * 64]; bs[k] = sb[k * 64]; }
                    asm volatile("s_waitcnt lgkmcnt(0)" ::: "memory");
                    f32x16 acc;
#pragma unroll
                    for (int q = 0; q < 4; ++q) { const f32x4 o4 = __builtin_bit_cast(f32x4, on[q]); acc[4 * q] = o4.x; acc[4 * q + 1] = o4.y; acc[4 * q + 2] = o4.z; acc[4 * q + 3] = o4.w; }
#pragma unroll
                    for (int k = 0; k < 8; ++k) acc = MFMA32(__builtin_bit_cast(bf16x8, qf[k]), __builtin_bit_cast(bf16x8, bs[k]), acc);
                    const int blk = seq * nb + (dir ? nb - 1 - i : i);
#pragma unroll
                    for (int q = 0; q < 4; ++q) Of[O_IDX(hd, dir, ET, et, blk, q) + lane] = __builtin_bit_cast(u32x4, (f32x4){acc[4 * q], acc[4 * q + 1], acc[4 * q + 2], acc[4 * q + 3]});
                }
                SCAN_BAR();
            }
        } else if (C.wave == 1) {
            f32x16 S[4];
#pragma unroll
            for (int dt = 0; dt < 4; ++dt) S[dt] = zero16();
#pragma unroll
            for (int k = 0; k < 8; ++k) SB[k * 64 + lane] = (u32x4){0u, 0u, 0u, 0u};
            SCAN_BAR();
            for (int i = 0; i < nb; ++i) {
                if (valid) {
                    const LAS unsigned char* sl = ring + (i % R) * SLOT; const LAS u32x4* sv = (const LAS u32x4*)sl + lane;
                    u32x4 kf[8], vf[2]; f32x4 dq[16];
#pragma unroll
                    for (int k = 0; k < 8; ++k) kf[k] = sv[(8 + k) * 64];
#pragma unroll
                    for (int sp = 0; sp < 2; ++sp) vf[sp] = sv[(16 + sp) * 64];
                    const LAS float* dp = (const LAS float*)(sl + 22 * 1024) + 4 * h;
#pragma unroll
                    for (int k = 0; k < 16; ++k) dq[k] = *(const LAS f32x4*)(dp + 8 * k);
                    asm volatile("s_waitcnt lgkmcnt(0)" ::: "memory");
#pragma unroll
                    for (int dt = 0; dt < 4; ++dt)
#pragma unroll
                        for (int q = 0; q < 4; ++q) {
#pragma unroll
                            for (int e = 0; e < 4; ++e) S[dt][4 * q + e] *= dq[4 * dt + q][e]; }
#pragma unroll
                    for (int sp = 0; sp < 2; ++sp) {
#pragma unroll
                        for (int dt = 0; dt < 4; ++dt) S[dt] = MFMA32(__builtin_bit_cast(bf16x8, kf[sp * 4 + dt]), __builtin_bit_cast(bf16x8, vf[sp]), S[dt]); }
                    LAS u32x4* sbw = SB + ((i + 1) & 1) * 512 + lane;
#pragma unroll
                    for (int dt = 0; dt < 4; ++dt)
#pragma unroll
                        for (int sp = 0; sp < 2; ++sp)
                            sbw[(2 * dt + sp) * 64] = __builtin_bit_cast(u32x4, pack8(S[dt][8 * sp + 0], S[dt][8 * sp + 1], S[dt][8 * sp + 2], S[dt][8 * sp + 3], S[dt][8 * sp + 4], S[dt][8 * sp + 5], S[dt][8 * sp + 6], S[dt][8 * sp + 7]));
                }
                SCAN_BAR();
            }
        } else {
            if (loader && valid && lr < nb) SCAN_ISSUE(lr);
            for (int i = -1; i < nb; ++i) {
                if (loader && valid) {
                    if (i >= 0 && lr == i % NL && i + NL < nb) SCAN_ISSUE(i + NL);
                    if (lr == (i + 1) % NL && i + 1 < nb) asm volatile("s_waitcnt vmcnt(0)" ::: "memory");
                }
                SCAN_BAR();
            }
        }
#undef SCAN_ISSUE
#undef GLDS16
#undef SCAN_BAR
    }
}
__device__ __forceinline__ void attn_phase(const Ctx& C, int T) {
    const bf16_t* U = (const bf16_t*)(C.ws + ARENA + A_U);
    bf16_t* OG = (bf16_t*)(C.ws + ARENA + A_OG); float* LSE = (float*)(C.ws + ARENA + A_LSE);
    const int lane = C.lane, h = lane >> 5, l31 = lane & 31, ld = EV_IN, tps = T / 32;
    for (int task = C.bid * NWV + C.wave; task < 3 * 4 * (CH / 32); task += C.G * NWV) {
        const int g = task / 2048, x = task % 2048, hd = x / 512, y = x % 512, seq = y / tps, z = y % tps;
        const int dil = 1 << (2 * g), L = T / dil, nqb = L / 32, r = z / nqb, qb = z % nqb, m0 = 32 * qb;
        const int qcol = 2560 + g * 1536 + hd * 128, kcol = qcol + 512, vcol = qcol + 1024;
        const float coef = exp2f(-8.0f * (float)(g * 4 + hd + 1) / 12.0f) * (float)dil, scale = 0.08838834764831845f;
        const size_t rbase = (size_t)seq * T + r;
        bf16x8 Bq[8];
        { const bf16_t* qp = U + (rbase + (size_t)(m0 + l31) * dil) * ld + qcol + 8 * h;
#pragma unroll
          for (int ks = 0; ks < 8; ++ks) Bq[ks] = *(const bf16x8*)(qp + 16 * ks); }
        f32x16 st[5];
#pragma unroll
        for (int kb = 0; kb < 5; ++kb) {
            const int mk0 = m0 - 64 + 32 * kb; const bool vb = (mk0 >= 0 && mk0 < L); const int mkc = mk0 < 0 ? 0 : (mk0 >= L ? L - 32 : mk0);
            const bf16_t* kp = U + (rbase + (size_t)(mkc + l31) * dil) * ld + kcol + 8 * h;
            f32x16 s = zero16();
#pragma unroll
            for (int ks = 0; ks < 8; ++ks) s = MFMA32(*(const bf16x8*)(kp + 16 * ks), Bq[ks], s);
#pragma unroll
            for (int i = 0; i < 16; ++i) { const int rel = (mk0 + (i & 3) + 8 * (i >> 2) + 4 * h) - (m0 + l31); const int ar = rel < 0 ? -rel : rel;
                s[i] = (vb && ar <= 64) ? s[i] * scale - coef * (float)ar : -1e30f; }
            st[kb] = s;
        }
        float mxv = -1e30f;
#pragma unroll
        for (int kb = 0; kb < 5; ++kb)
#pragma unroll
            for (int i = 0; i < 16; ++i) mxv = fmaxf(mxv, st[kb][i]);
        mxv = fmaxf(mxv, shfl_xor_l(mxv, lane, 32));
        float den = 0.f;
#pragma unroll
        for (int kb = 0; kb < 5; ++kb)
#pragma unroll
            for (int i = 0; i < 16; ++i) { const float p = __expf(st[kb][i] - mxv); st[kb][i] = p; den += p; }
        den += shfl_xor_l(den, lane, 32);
        f32x16 ot[4];
#pragma unroll
        for (int dt = 0; dt < 4; ++dt) ot[dt] = zero16();
        LAS unsigned char* Vs = C.lds + C.wave * 8704;
#pragma unroll
        for (int kb = 0; kb < 5; ++kb) {
            const int mk0 = m0 - 64 + 32 * kb; const int mkc = mk0 < 0 ? 0 : (mk0 >= L ? L - 32 : mk0);
            u32x4 vr[8];
#pragma unroll
            for (int it = 0; it < 8; ++it) { const int idx = lane + 64 * it, t = idx >> 4, c8 = idx & 15; vr[it] = *(const u32x4*)(U + (rbase + (size_t)(mkc + t) * dil) * ld + vcol + c8 * 8); }
            LDSFENCE();
#pragma unroll
            for (int it = 0; it < 8; ++it) { const int idx = lane + 64 * it, t = idx >> 4, c8 = idx & 15; *(LAS u32x4*)(Vs + t * 272 + c8 * 16) = vr[it]; }
            LDSFENCE();
#pragma unroll
            for (int sp = 0; sp < 2; ++sp) {
                const bf16x8 Bp = pack8(st[kb][8 * sp + 0], st[kb][8 * sp + 1], st[kb][8 * sp + 2], st[kb][8 * sp + 3], st[kb][8 * sp + 4], st[kb][8 * sp + 5], st[kb][8 * sp + 6], st[kb][8 * sp + 7]);
#pragma unroll
                for (int dt = 0; dt < 4; ++dt) {
                    unsigned short v[8];
#pragma unroll
                    for (int j = 0; j < 8; ++j) { const int kj = 16 * sp + 8 * (j >> 2) + 4 * h + (j & 3); v[j] = *(const LAS unsigned short*)(Vs + kj * 272 + (32 * dt + l31) * 2); }
                    u32x4 w; w.x = v[0] | ((unsigned)v[1] << 16); w.y = v[2] | ((unsigned)v[3] << 16); w.z = v[4] | ((unsigned)v[5] << 16); w.w = v[6] | ((unsigned)v[7] << 16);
                    ot[dt] = MFMA32(__builtin_bit_cast(bf16x8, w), Bp, ot[dt]);
                }
            }
        }
        const float inv = 1.f / den; const size_t qrow = rbase + (size_t)(m0 + l31) * dil;
        bf16_t* op = OG + ((size_t)g * CH + qrow) * 512 + hd * 128 + 4 * h;
#pragma unroll
        for (int dt = 0; dt < 4; ++dt)
#pragma unroll
            for (int q = 0; q < 4; ++q) { u32x2 w; w.x = pk2(ot[dt][4 * q] * inv, ot[dt][4 * q + 1] * inv); w.y = pk2(ot[dt][4 * q + 2] * inv, ot[dt][4 * q + 3] * inv);
                *(u32x2*)(op + 32 * dt + 8 * q) = w; }
        if (h == 0) LSE[((size_t)g * CH + qrow) * 4 + hd] = mxv + __logf(den);
    }
}
__device__ __forceinline__ void finalize_phase(const Ctx& C, const Mix& mx) {
    const Args& a = *C.a;
    const bf16_t* __restrict__ U = (const bf16_t*)(C.ws + ARENA + A_U); bf16_t* __restrict__ MIX = (bf16_t*)(C.ws + ARENA + A_MIX);
    const f32x4* __restrict__ Of = (const f32x4*)(C.ws + ARENA + A_OEV);
    const int gw = C.bid * NWV + C.wave, NGW = C.G * NWV, lane = C.lane, ld = mx.ld, DV = mx.DV, ET = DV / 32, NE = DV / 64;
    const float* gn = mx.even ? a.in[I_HNORM] + mx.li * 512 : a.in[I_GNORM] + mx.li * 1024;
#pragma unroll 2
    for (int rg = gw; rg < CH / 4; rg += NGW) {
        const int r0 = 4 * rg, blk = r0 >> 5, t0 = r0 & 31;
        const int qf = t0 >> 3, hf = (t0 >> 2) & 1, tb = 28 - t0, qb = tb >> 3, hb2 = (tb >> 2) & 1;
#pragma unroll
        for (int hd = 0; hd < 4; ++hd) {
            float o[4][4]; float ss[4] = {0.f, 0.f, 0.f, 0.f};
#pragma unroll
            for (int k = 0; k < 4; ++k) if (k < NE) {
                const int e = lane + 64 * k, et = e >> 5;
                const f32x4 vf_ = Of[O_IDX(hd, 0, ET, et, blk, qf) + 32 * hf + (e & 31)], vb_ = Of[O_IDX(hd, 1, ET, et, blk, qb) + 32 * hb2 + (e & 31)];
                o[k][0] = vf_.x + vb_.w; o[k][1] = vf_.y + vb_.z; o[k][2] = vf_.z + vb_.y; o[k][3] = vf_.w + vb_.x;
#pragma unroll
                for (int j = 0; j < 4; ++j) ss[j] += o[k][j] * o[k][j];
            }
#pragma unroll
            for (int j = 0; j < 4; ++j) ss[j] = rsqrtf(wave_sum(ss[j], lane) / (float)DV + EPS);
#pragma unroll
            for (int k = 0; k < 4; ++k) if (k < NE) {
                const int c = hd * DV + lane + 64 * k; const float g1 = gn[c];
#pragma unroll
                for (int j = 0; j < 4; ++j) { const float ag = bf2f(U[(size_t)(r0 + j) * ld + 2048 + c]);
                    MIX[(size_t)(r0 + j) * DM + c] = (bf16_t)(pk2(o[k][j] * ss[j] * g1 * (ag / (1.f + __expf(-ag))), 0.f) & 0xffffu); }
            }
        }
        if (mx.even) {
            const bf16_t* __restrict__ OG = (const bf16_t*)(C.ws + ARENA + A_OG); const float* __restrict__ LSE = (const float*)(C.ws + ARENA + A_LSE);
#pragma unroll
            for (int j = 0; j < 4; ++j) { const int r = r0 + j;
#pragma unroll
                for (int hd = 0; hd < 4; ++hd) { const int c = hd * 128 + 2 * lane;
                    const float l0 = LSE[((size_t)0 * CH + r) * 4 + hd], l1 = LSE[((size_t)1 * CH + r) * 4 + hd], l2 = LSE[((size_t)2 * CH + r) * 4 + hd];
                    const float m = fmaxf(l0, fmaxf(l1, l2)); float w0 = __expf(l0 - m), w1 = __expf(l1 - m), w2 = __expf(l2 - m); const float iw = 1.f / (w0 + w1 + w2);
                    w0 *= iw; w1 *= iw; w2 *= iw;
                    const unsigned v0 = *(const unsigned*)(OG + ((size_t)0 * CH + r) * 512 + c), v1 = *(const unsigned*)(OG + ((size_t)1 * CH + r) * 512 + c), v2 = *(const unsigned*)(OG + ((size_t)2 * CH + r) * 512 + c);
                    const float bx = w0 * __uint_as_float(v0 << 16) + w1 * __uint_as_float(v1 << 16) + w2 * __uint_as_float(v2 << 16);
                    const float by = w0 * __uint_as_float(v0 & 0xffff0000u) + w1 * __uint_as_float(v1 & 0xffff0000u) + w2 * __uint_as_float(v2 & 0xffff0000u);
                    *(unsigned*)(MIX + (size_t)r * DM + 512 + c) = pk2(bx, by); }
            }
        }
    }
}
#define XB_TMO      128
#define XB_XCNT(j)  (256  + 64 * (j))
#define XB_XSUB(j)  (1280 + 64 * (j))
#define XB_XGEN(j)  (2304 + 64 * (j))
#define XB_TOP      3328
#define XB_TOPGEN   3392
#define XCD_BAR_WORDS 3456
#define XB_SPIN_CAP (1u << 18)

__device__ __forceinline__ unsigned xb_ld(unsigned* p)              { return __hip_atomic_load(p, __ATOMIC_RELAXED, __HIP_MEMORY_SCOPE_AGENT); }
__device__ __forceinline__ unsigned xb_add(unsigned* p, unsigned v) { return __hip_atomic_fetch_add(p, v, __ATOMIC_RELAXED, __HIP_MEMORY_SCOPE_AGENT); }
__device__ __forceinline__ unsigned xb_xcc_id() { return (unsigned)__builtin_amdgcn_s_getreg((3 << 11) | 20) & 0xFu; }
#define XB_SPIN(cond, bar) do { unsigned _sp = 0; while (cond) { __builtin_amdgcn_s_sleep(1); \
    if ((++_sp & 255u) == 0u) { if (xb_ld(&(bar)[XB_TMO])) break; if (_sp > XB_SPIN_CAP) { atomicAdd(&(bar)[XB_TMO], 1u); break; } } } } while (0)

struct XcdBarrier {
    unsigned* bar; unsigned x;
    volatile LAS unsigned* st;
};

__device__ __forceinline__ XcdBarrier xcd_barrier_post(unsigned* bar, volatile LAS unsigned* st) {
    XcdBarrier b; b.bar = bar; b.x = xb_xcc_id(); b.st = st;
    if (threadIdx.x == 0) (void)xb_add(&bar[XB_XCNT(b.x)], 1u);
    return b;
}
__device__ __forceinline__ void xcd_barrier_complete(unsigned* bar, unsigned x, unsigned& nloc, unsigned& nx) {
    const unsigned G = gridDim.x * gridDim.y * gridDim.z;
    unsigned sum, cnt, mine, sp = 0u;
    for (;;) {
        sum = 0u; cnt = 0u; mine = 0u;
#pragma unroll
        for (unsigned j = 0; j < 16; ++j) { const unsigned c = xb_ld(&bar[XB_XCNT(j)]); sum += c; cnt += (c > 0u) ? 1u : 0u; mine = (j == x) ? c : mine; }
        if (sum == G) break;
        __builtin_amdgcn_s_sleep(1);
        if ((++sp & 255u) == 0u) { if (xb_ld(&bar[XB_TMO])) break; if (sp > XB_SPIN_CAP) { atomicAdd(&bar[XB_TMO], 1u); break; } }
    }
    nloc = mine > 0u ? mine : 1u; nx = cnt > 0u ? cnt : 1u;
}

__device__ __forceinline__ void xcd_barrier(const XcdBarrier& b) {
    asm volatile("s_waitcnt vmcnt(0)" ::: "memory");
    __syncthreads();
    if (threadIdx.x == 0) {
        unsigned* bar = b.bar;
        __builtin_amdgcn_s_waitcnt(0);
        unsigned nloc = b.st[0], nx = b.st[1];
        if (nloc == 0u) { xcd_barrier_complete(bar, b.x, nloc, nx); b.st[0] = nloc; b.st[1] = nx; }
        const unsigned old = xb_add(&bar[XB_XSUB(b.x)], 1u);
        const unsigned gen = old / nloc;
        if (old + 1u == (gen + 1u) * nloc) {
            __builtin_amdgcn_fence(__ATOMIC_RELEASE, "agent");
            asm volatile("s_waitcnt vmcnt(0)" ::: "memory");
            const unsigned og = xb_add(&bar[XB_TOP], 1u);
            const unsigned tg = og / nx;
            if (og + 1u == (tg + 1u) * nx) xb_add(&bar[XB_TOPGEN], 1u);
            else XB_SPIN(xb_ld(&bar[XB_TOPGEN]) == tg, bar);
            __builtin_amdgcn_fence(__ATOMIC_ACQUIRE, "agent");
            xb_add(&bar[XB_XGEN(b.x)], 1u);
            asm volatile("s_waitcnt vmcnt(0)" ::: "memory");
        } else {
            XB_SPIN(xb_ld(&bar[XB_XGEN(b.x)]) == gen, bar);
            __builtin_amdgcn_fence(__ATOMIC_ACQUIRE, "agent");
            asm volatile("s_waitcnt vmcnt(0)" ::: "memory");
        }
    }
    __syncthreads();
}
#define PHASE_BEGIN() do { int t_ = threadIdx.x; asm volatile("" : "+v"(t_)); C.tid = t_; C.lane = t_ & 63; C.wave = __builtin_amdgcn_readfirstlane(t_ >> 6); \
    int b_ = blockIdx.x; asm volatile("" : "+s"(b_)); C.bid = b_; unsigned char* w_ = args.ws; asm volatile("" : "+s"(w_)); C.ws = w_; ws = w_; \
    hb_c = (bf16_t*)(ws + (s ? B_HB1 : B_HB0)); hb_n = (bf16_t*)(ws + (s ? B_HB0 : B_HB1)); sq_c = (float*)(ws + (s ? B_SSQ1 : B_SSQ0)); sq_n = (float*)(ws + (s ? B_SSQ0 : B_SSQ1)); Ub = (bf16_t*)(ws + ARENA + A_U); MIXb = (bf16_t*)(ws + ARENA + A_MIX); \
    hch = args.out + (size_t)chunk * CH * DM; } while (0)
__global__ void __launch_bounds__(NT, 2) fwd_mega(Args args) {
    extern __shared__ __attribute__((aligned(16))) unsigned char lds_raw[];
    cg::grid_group grid = cg::this_grid();
    Ctx C; C.lds = (LAS unsigned char*)lds_raw; C.tid = threadIdx.x; C.lane = C.tid & 63; C.wave = __builtin_amdgcn_readfirstlane(C.tid >> 6);
    C.G = gridDim.x; C.bid = blockIdx.x; C.a = &args; C.ws = args.ws;
    unsigned char* ws = args.ws;
    bf16_t *hb_c, *hb_n; float *sq_c, *sq_n; bf16_t *Ub, *MIXb;
    if (blockIdx.x == 0) for (int i = threadIdx.x; i < XCD_BAR_WORDS; i += NT) ((unsigned*)args.ws)[i] = 0u;
    if (threadIdx.x < 2) ((volatile LAS unsigned*)(C.lds + LDS_BYTES - 256))[threadIdx.x] = 0u;
    weights_prologue(C);
    __syncthreads();
    grid.sync();
    XcdBarrier bar = xcd_barrier_post((unsigned*)args.ws, (volatile LAS unsigned*)(C.lds + LDS_BYTES - 256));
    float* hch;
#ifdef PROBE_A
    unsigned tacc[12];
#pragma unroll
    for (int i = 0; i < 12; ++i) tacc[i] = 0u;
    unsigned long long tprev = __builtin_amdgcn_s_memrealtime();
#define TICK(k) do { const unsigned long long now_ = __builtin_amdgcn_s_memrealtime(); tacc[k] += (unsigned)(now_ - tprev); tprev = now_; } while (0)
#else
#define TICK(k) do {} while (0)
#endif
#pragma nounroll
    for (int chunk = 0; chunk < NCHUNK; ++chunk) {
        const int T = chunk == 0 ? 4096 : 2048; int s = 0;
        PHASE_BEGIN();
        chunk_prologue(C, chunk, hb_c, sq_c);
        xcd_barrier(bar); TICK(10);
#pragma nounroll
        for (int l = 0; l < DEPTH; ++l) {
            const int even = (l & 1) == 0, li = l >> 1;
            Mix mx; mx.even = even; mx.li = li; mx.T = T; mx.DV = even ? 128 : 256; mx.ld = even ? EV_IN : OD_INP; mx.vcol = even ? 1536 : 1024; mx.gcol = 2048; mx.qscale = even ? 1.f : 0.08838834764831845f; mx.vf = nullptr;
            PHASE_BEGIN();
            {
                const int N = even ? EV_IN : OD_INP;
                const bf16_t* Wt = even ? (const bf16_t*)(ws + W_EVIN) + (size_t)li * EV_IN * DM : (const bf16_t*)(ws + W_ODIN) + (size_t)li * OD_INP * DM;
                pg8::Gemm g{hb_c, Wt, CH, N, DM, 256}; pg8::StaticOrder S; S.init(CH, N, C.G, C.bid);
                EpiScale E{Ub, N, sq_c};
                pg8::gemm_phase<EpiScale, pg8::StaticOrder, true, true>(C.lds, g, S, E);
            }
            xcd_barrier(bar); TICK(1);
            PHASE_BEGIN(); mx.vf = even ? (unsigned char*)hb_n : ws + ARENA + A_VFOD;
#ifndef NO_PREP
            prep_phase(C, mx);
#endif
            TICK(2);
            PHASE_BEGIN();
#ifndef NO_ATTN
            if (even) attn_phase(C, T);
#endif
            TICK(7);
            xcd_barrier(bar); TICK(0);
            PHASE_BEGIN(); mx.vf = even ? (unsigned char*)hb_n : ws + ARENA + A_VFOD;
#ifndef NO_SCAN
            scan_phase(C, mx);
#endif
            xcd_barrier(bar); TICK(3);
            PHASE_BEGIN();
#ifndef NO_FIN
            finalize_phase(C, mx);
#endif
            pb_convert(C, chunk, l);
            xcd_barrier(bar); TICK(4);
            PHASE_BEGIN();
            {
                const bf16_t* Wt = even ? (const bf16_t*)(ws + W_EVOUT) + (size_t)li * DM * DM : (const bf16_t*)(ws + W_ODOUT) + (size_t)li * DM * DM;
                pg8::Gemm g{MIXb, Wt, CH, DM, DM, 256}; pg8::StaticOrder S; S.init(CH, DM, C.G, C.bid);
                EpiResid<0> E{hch, hb_n, sq_n, nullptr, nullptr};
                pg8::gemm_phase<EpiResid<0>, pg8::StaticOrder, true, true>(C.lds, g, S, E);
                s ^= 1;
            }
            xcd_barrier(bar); TICK(5);
            PHASE_BEGIN();
            {
                pg8::Gemm g{hb_c - DM, (const bf16_t*)(ws + W_UP) + (size_t)l * 2 * DFF * DM, 65 * 256, 2 * DFF, DM, 254}; pg8::StaticOrder S; S.init(65 * 256, 2 * DFF, C.G, C.bid);
                EpiConv E{(bf16_t*)(ws + ARENA + A_ACT), sq_c, args.in[I_CW] + (size_t)l * 3 * 2 * DFF, args.in[I_CB] + (size_t)l * 2 * DFF, T, (LAS float*)(C.lds + 131072)};
                pg8::gemm_phase<EpiConv, pg8::StaticOrder, true, true>(C.lds, g, S, E);
            }
            {
                const int rem = (65 * 22) % C.G, c0 = rem, gs = rem ? C.G - rem : C.G;
                if (C.bid >= c0) {
                    PHASE_BEGIN();
                    pg8::Gemm g2{(const bf16_t*)(ws + B_PB), (const bf16_t*)(ws + W_PROJ) + (size_t)l * DM * PLE, CH, DM, PLE, 256}; pg8::StaticOrder S2; S2.init(CH, DM, gs, C.bid - c0);
                    EpiF32 E2{(bf16_t*)(ws + ARENA + A_PP), DM};
                    pg8::gemm_phase<EpiF32, pg8::StaticOrder, true, true>(C.lds, g2, S2, E2);
                }
            }
            xcd_barrier(bar); TICK(6);
            PHASE_BEGIN();
            {
                pg8::Gemm g{(const bf16_t*)(ws + ARENA + A_ACT), (const bf16_t*)(ws + W_DOWN) + (size_t)l * DM * DFF, CH, DM, DFF, 256}; pg8::StaticOrder S; S.init(CH, DM, C.G, C.bid);
                EpiResid<0> E{hch, hb_n, sq_n, nullptr, nullptr};
                pg8::gemm_phase<EpiResid<0>, pg8::StaticOrder, true, true>(C.lds, g, S, E);
                s ^= 1;
            }
            xcd_barrier(bar); TICK(8);
            PHASE_BEGIN();
            {
                pg8::Gemm g{hb_c, (const bf16_t*)(ws + W_GATE) + (size_t)l * DM * DM, CH, DM, DM, 256}; pg8::StaticOrder S; S.init(CH, DM, C.G, C.bid);
                EpiResid<1> E{hch, hb_n, sq_n, sq_c, (const bf16_t*)(ws + ARENA + A_PP)};
                pg8::gemm_phase<EpiResid<1>, pg8::StaticOrder, true, true>(C.lds, g, S, E);
                s ^= 1;
            }
            xcd_barrier(bar); TICK(9);
        }
        PHASE_BEGIN();
        final_norm(C, chunk);
        TICK(10);
    }
#ifdef PROBE_A
    xcd_barrier(bar); TICK(10);
    for (int i = 0; i < 100; ++i) xcd_barrier(bar);
    TICK(11);
    if (blockIdx.x == 0) {
        const float x1 = 8.f + (float)tacc[PROBE_A] * 1e-5f, t2 = 0.1f * (float)tacc[PROBE_B] * 1e-5f;
        float* o0 = args.out; float* o1 = args.out + (size_t)16384 * 1024;
        if (threadIdx.x == 0) { o0[0] += x1; o1[0] += x1; o1[1] += x1; }
        for (int i = threadIdx.x; i < 8192; i += NT) o0[1024 + i] += t2;
        for (int i = threadIdx.x; i < 16384; i += NT) o1[1024 + i] += t2;
    }
#endif
}
extern "C" void kernel_launch(void* const* d_in, const int* in_sizes, int n_in, void* d_out, int out_size, void* d_ws, size_t ws_size, hipStream_t stream) {
    static int grid = 0;
    if (grid == 0) {
        int dev = 0, cus = 0, per = 0;
        (void)hipGetDevice(&dev); (void)hipDeviceGetAttribute(&cus, hipDeviceAttributeMultiprocessorCount, dev);
        (void)hipFuncSetAttribute((const void*)fwd_mega, hipFuncAttributeMaxDynamicSharedMemorySize, LDS_BYTES);
        (void)hipOccupancyMaxActiveBlocksPerMultiprocessor(&per, (const void*)fwd_mega, NT, LDS_BYTES);
        if (per < 1) per = 1;
        grid = cus * per;
        fprintf(stderr, "kernel_launch: grid %d (cus %d x %d), ws %zu need %zu\n", grid, cus, per, ws_size, (size_t)WS_NEED);
        if (n_in != 23 || ws_size < WS_NEED) { fprintf(stderr, "kernel_launch: bad inputs / workspace too small\n"); grid = -1; }
    }
    if (grid < 0) return;
    Args a{};
    for (int i = 0; i < 23; ++i) a.in[i] = (const float*)d_in[i];
    a.out = (float*)d_out; a.ws = (unsigned char*)d_ws; a.ph_lo = 0; a.ph_hi = 0;
    void* kargs[] = {&a};
    hipError_t e = hipLaunchCooperativeKernel((const void*)fwd_mega, dim3(grid), dim3(NT), kargs, LDS_BYTES, stream);
    if (e != hipSuccess) fprintf(stderr, "kernel_launch: cooperative launch failed: %s\n", hipGetErrorString(e));
}
```

```cpp
#include <hip/hip_runtime.h>
#include <hip/hip_cooperative_groups.h>
#include <cstdio>
#include <cstdint>
namespace cg = cooperative_groups;
namespace pg8 {
#define PG8_LAS __attribute__((address_space(3)))
typedef unsigned short bf16_t;
typedef short bf16x8 __attribute__((ext_vector_type(8)));
typedef float f32x4 __attribute__((ext_vector_type(4)));
typedef unsigned u32x4 __attribute__((ext_vector_type(4)));
constexpr int BM = 256, BK = 64, HALF = 128, HTB = HALF * BK * 2  , STAGE_BYTES = 8 * HTB, NXCD = 8, WGM = 8;

__host__ __device__ __forceinline__ int lds_byte(int r, int c) { const int st = (r >> 4) * 2 + (c >> 5), rr = r & 15, cc = c & 31, ob = rr * 64 + cc * 2; return st * 1024 + (ob ^ (((ob >> 9) & 1) << 5)); }
__host__ __device__ __forceinline__ void stage_rc(int b, int& R, int& C) { const int st = b / 1024, sb = b % 1024, swz = sb ^ (((sb >> 9) & 1) << 5); R = (st >> 1) * 16 + swz / 64; C = (st & 1) * 32 + (swz % 64) / 2; }
__host__ __device__ __forceinline__ int perm32(int rho) { const int n = rho >> 4, i = rho & 15; return 8 * (i >> 2) + 4 * n + (i & 3); }

struct Unit { int pm, pn; };
struct Gemm { const bf16_t* A; const bf16_t* Bt; int M, N, K; int arows; };

struct StaticOrder {
    int nM, nN, nwg, G, c;
    __host__ __device__ void init(int M, int N, int G_, int c_) { nM = M / BM; nN = N / BM; nwg = nM * nN; G = G_; c = c_; }
    __host__ __device__ bool next(int i, Unit& u) const {
        const long L = (long)i * G + c; if (L >= nwg) return false;
        int wgid = (int)L; { const int q = nwg / NXCD, r = nwg % NXCD, xcd = wgid % NXCD, off = wgid / NXCD; wgid = (xcd < r ? xcd * (q + 1) : r * (q + 1) + (xcd - r) * q) + off; }
        const int nig = WGM * nN, gid = wgid / nig, fm = gid * WGM, gsz = (nM - fm) < WGM ? (nM - fm) : WGM;
        u.pm = fm + ((wgid % nig) % gsz); u.pn = (wgid % nig) / gsz; return true;
    }
    __device__ __forceinline__ void a_ready(const Unit&) const {}
    __device__ __forceinline__ void done(const Unit&) const {}
};

__device__ __forceinline__ unsigned cvt_pk_bf16(float lo, float hi) { unsigned r; asm volatile("v_cvt_pk_bf16_f32 %0, %1, %2" : "=v"(r) : "v"(lo), "v"(hi)); return r; }
typedef float f32x2 __attribute__((ext_vector_type(2)));
__device__ __forceinline__ f32x2 gelu_pk(f32x2 v) {
    const f32x2 av = __builtin_elementwise_abs(v), d = av * 0.2316418882f + 1.0f;
    f32x2 t; t.x = __builtin_amdgcn_rcpf(d.x); t.y = __builtin_amdgcn_rcpf(d.y);
    f32x2 q = t * 0.5307027145f + (-0.7265760135f); q = q * t + 0.7107068705f; q = q * t + (-0.142248368f); q = q * t + 0.127414796f; q = q * t;
    const f32x2 s = (v * v) * (-0.72134752044f);
    f32x2 e; e.x = __builtin_amdgcn_exp2f(s.x); e.y = __builtin_amdgcn_exp2f(s.y);
    const f32x2 m = v * (q * e), r = v - m;
    f32x2 o; o.x = v.x < 0.f ? m.x : r.x; o.y = v.y < 0.f ? m.y : r.y; return o;
}

template <int ACT  > struct EpiBf16 {
    static constexpr bool PERM = true, AFTER_DRAIN = false; static_assert(ACT == 0 || ACT == 1, "EpiBf16: ACT is 0 (none) or 1 (gelu_pk)");
    bf16_t* O; int ldc; const float* bias; int split_cols; size_t split_stride; float scale0;
    __device__ __forceinline__ void operator()(const f32x4 (&acc)[2][2][4][2], const Unit& u, int wr, int wc, int fr, int fq) const {
        const int row0 = u.pm * BM + wr * 64 + fr; int colt = u.pn * BM; bf16_t* base = O;
        float sc = 1.f; if (split_cols) { const int t = colt / split_cols; base += (size_t)t * split_stride; colt -= t * split_cols; if (t == 0) sc = scale0; }
        const int col0 = colt + wc * 32 + 8 * fq, bcol0 = u.pn * BM + wc * 32 + 8 * fq;
        f32x4 bv[2][2];
#pragma unroll
        for (int bj = 0; bj < 2; ++bj)
#pragma unroll
            for (int n = 0; n < 2; ++n) bv[bj][n] = bias ? *(const f32x4*)(bias + bcol0 + bj * HALF + 4 * n) : (f32x4){0.f, 0.f, 0.f, 0.f};
#pragma unroll
        for (int ai = 0; ai < 2; ++ai)
#pragma unroll
            for (int m = 0; m < 4; ++m) { bf16_t* rowp = base + (size_t)(row0 + ai * HALF + m * 16) * ldc + col0;
#pragma unroll
                for (int bj = 0; bj < 2; ++bj) { f32x4 v0 = acc[ai][bj][m][0] + bv[bj][0], v1 = acc[ai][bj][m][1] + bv[bj][1];
                    if (ACT == 1) { f32x2 a = gelu_pk((f32x2){v0[0], v0[1]}), b = gelu_pk((f32x2){v0[2], v0[3]}), c = gelu_pk((f32x2){v1[0], v1[1]}), d = gelu_pk((f32x2){v1[2], v1[3]});
                        v0 = (f32x4){a.x, a.y, b.x, b.y}; v1 = (f32x4){c.x, c.y, d.x, d.y}; }
                    v0 = v0 * sc; v1 = v1 * sc; u32x4 w; w.x = cvt_pk_bf16(v0[0], v0[1]); w.y = cvt_pk_bf16(v0[2], v0[3]); w.z = cvt_pk_bf16(v1[0], v1[1]); w.w = cvt_pk_bf16(v1[2], v1[3]);
                    *(u32x4*)(rowp + bj * HALF) = w; } }
    }
};
template <class Epi, class Sched, bool ALIGN_EPI = false, bool SP2 = false>
__device__ __forceinline__ void gemm_phase(PG8_LAS unsigned char* lds, const Gemm g, const Sched& S, const Epi& E) {
    int tid_ = threadIdx.x; asm volatile("" : "+v"(tid_)); const int tid = tid_, wid = __builtin_amdgcn_readfirstlane(tid >> 6), lane = tid & 63, wr = wid >> 2, wc = wid & 3, fr = lane & 15, fq = lane >> 4;
    int K_ = g.K; asm volatile("" : "+s"(K_)); const int K = K_, nt = K / BK;
    unsigned voffA[2], voffB[2];
#pragma unroll
    for (int i = 0; i < 2; ++i) { int R, C; stage_rc(tid * 16 + i * 8192, R, C); const int Rb = Epi::PERM ? ((R & ~31) + perm32(R & 31)) : R;
        voffA[i] = (unsigned)(R * K + C) * 2u; voffB[i] = (unsigned)(Rb * K + C) * 2u; }
    const size_t kstep = (size_t)(BK * 2);
    const size_t hstep = (size_t)HALF * K * 2;
    const size_t tstep = 2 * hstep; const size_t tstepA = (size_t)g.arows * K * 2;
    const unsigned ldsw = (unsigned)wid * 1024u;
    const int aoff = lds_byte(wr * 64 + fr, fq * 8), boff = lds_byte(wc * 32 + fr, fq * 8);
#define PG8_SA(b, h) (((b) * 2 + (h)) * HTB)
#define PG8_SB(b, h) ((4 + (b) * 2 + (h)) * HTB)
#define PG8_STAGE(bufoff, gbase, voff) do { _Pragma("unroll") for (int _i = 0; _i < 2; ++_i) \
        __builtin_amdgcn_global_load_lds((const unsigned*)((const char*)(gbase) + (voff)[_i]), (PG8_LAS unsigned*)(lds + (bufoff) + ldsw + _i * 8192), 16, 0, 0); } while (0)
#define PG8_LDA(dst, b, h) do { _Pragma("unroll") for (int m = 0; m < 4; ++m) _Pragma("unroll") for (int k = 0; k < 2; ++k) dst[m][k] = *(const PG8_LAS bf16x8*)(lds + PG8_SA(b, h) + aoff + m * 2048 + k * 1024); } while (0)
#define PG8_LDB(dst, b, h) do { _Pragma("unroll") for (int n = 0; n < 2; ++n) _Pragma("unroll") for (int k = 0; k < 2; ++k) dst[n][k] = *(const PG8_LAS bf16x8*)(lds + PG8_SB(b, h) + boff + n * 2048 + k * 1024); } while (0)
#define PG8_MMA(ai, bj, At, Bt) do { __builtin_amdgcn_s_setprio(1); _Pragma("unroll") for (int m = 0; m < 4; ++m) _Pragma("unroll") for (int n = 0; n < 2; ++n) _Pragma("unroll") for (int k = 0; k < 2; ++k) \
        acc[ai][bj][m][n] = __builtin_amdgcn_mfma_f32_16x16x32_bf16(Bt[n][k], At[m][k], acc[ai][bj][m][n], 0, 0, 0); __builtin_amdgcn_s_setprio(0); } while (0)
#define PG8_WAIT_V(n) asm volatile("s_waitcnt vmcnt(" #n ")" ::: "memory")
#define PG8_WAIT_L(n) asm volatile("s_waitcnt lgkmcnt(" #n ")" ::: "memory")
#define PG8_BAR __builtin_amdgcn_s_barrier()
#define PG8_SCHED __builtin_amdgcn_sched_barrier(0)
    Unit cur, nxt; int ui = 0;
    if (!S.next(0, cur)) return;
    f32x4 acc[2][2][4][2];
#pragma unroll
    for (int a = 0; a < 2; ++a)
#pragma unroll
        for (int b = 0; b < 2; ++b)
#pragma unroll
            for (int m = 0; m < 4; ++m)
#pragma unroll
                for (int n = 0; n < 2; ++n) acc[a][b][m][n] = (f32x4){0.f, 0.f, 0.f, 0.f};
    bf16x8 At[4][2], B0[2][2], B1[2][2];
    const char* cA = (const char*)g.A + (size_t)cur.pm * tstepA; const char* cB = (const char*)g.Bt + (size_t)cur.pn * tstep;
    S.a_ready(cur);
    if constexpr (SP2) {
        PG8_STAGE(PG8_SB(0, 0), cB, voffB); PG8_STAGE(PG8_SB(0, 1), cB + hstep, voffB); PG8_STAGE(PG8_SA(0, 0), cA, voffA); PG8_STAGE(PG8_SA(0, 1), cA + hstep, voffA);
        if (wr == 1) PG8_BAR;
        PG8_WAIT_V(2); PG8_BAR;
        PG8_STAGE(PG8_SB(1, 0), cB + kstep, voffB); PG8_STAGE(PG8_SA(1, 0), cA + kstep, voffA); PG8_STAGE(PG8_SB(1, 1), cB + hstep + kstep, voffB);
        PG8_WAIT_V(6); PG8_BAR;
    } else {
        PG8_STAGE(PG8_SB(0, 0), cB, voffB); PG8_STAGE(PG8_SA(0, 0), cA, voffA); PG8_STAGE(PG8_SB(0, 1), cB + hstep, voffB); PG8_STAGE(PG8_SA(0, 1), cA + hstep, voffA);
        if (wr == 1) PG8_BAR;
        PG8_WAIT_V(4); PG8_BAR;
        PG8_STAGE(PG8_SB(1, 0), cB + kstep, voffB); PG8_STAGE(PG8_SA(1, 0), cA + kstep, voffA); PG8_STAGE(PG8_SB(1, 1), cB + hstep + kstep, voffB);
        PG8_WAIT_V(6); PG8_BAR;
    }
    for (;;) {
        const bool has_next = S.next(ui + 1, nxt);
        const char* nA = has_next ? (const char*)g.A + (size_t)nxt.pm * tstepA : cA; const char* nB = has_next ? (const char*)g.Bt + (size_t)nxt.pn * tstep : cB;
        for (int t = 0; t < nt; t += 2) {
            const bool last = (t == nt - 2);
            const char* a1 = cA + (size_t)(t + 1) * kstep;
            const char* a2 = last ? nA : cA + (size_t)(t + 2) * kstep; const char* b2 = last ? nB : cB + (size_t)(t + 2) * kstep;
            const char* a3 = a2 + kstep; const char* b3 = b2 + kstep;
            if (last && has_next) S.a_ready(nxt);
            if constexpr (SP2) {
            PG8_LDB(B0, 0, 0); PG8_LDB(B1, 0, 1); PG8_SCHED; PG8_LDA(At, 0, 0); PG8_STAGE(PG8_SA(1, 1), a1 + hstep, voffA);
            PG8_WAIT_V(8); PG8_WAIT_L(0); PG8_BAR; PG8_MMA(0, 0, At, B0); PG8_MMA(0, 1, At, B1); PG8_BAR; PG8_SCHED;
            PG8_LDA(At, 0, 1); PG8_STAGE(PG8_SB(0, 0), b2, voffB); PG8_STAGE(PG8_SB(0, 1), b2 + hstep, voffB); PG8_STAGE(PG8_SA(0, 0), a2, voffA);
            PG8_WAIT_V(8); PG8_WAIT_L(0); PG8_BAR; PG8_MMA(1, 0, At, B0); PG8_MMA(1, 1, At, B1); PG8_BAR; PG8_SCHED;
            PG8_LDB(B0, 1, 0); PG8_LDB(B1, 1, 1); PG8_SCHED; PG8_LDA(At, 1, 0); PG8_STAGE(PG8_SA(0, 1), a2 + hstep, voffA);
            PG8_WAIT_V(8); PG8_WAIT_L(0); PG8_BAR; PG8_MMA(0, 0, At, B0); PG8_MMA(0, 1, At, B1); PG8_BAR; PG8_SCHED;
            PG8_LDA(At, 1, 1); PG8_STAGE(PG8_SB(1, 0), b3, voffB); PG8_STAGE(PG8_SB(1, 1), b3 + hstep, voffB); PG8_STAGE(PG8_SA(1, 0), a3, voffA);
            PG8_WAIT_V(8); PG8_WAIT_L(0); PG8_BAR; PG8_MMA(1, 0, At, B0); PG8_MMA(1, 1, At, B1); PG8_BAR; PG8_SCHED;
            } else {
            PG8_LDB(B0, 0, 0); PG8_SCHED; PG8_LDA(At, 0, 0); PG8_STAGE(PG8_SA(1, 1), a1 + hstep, voffA);
            PG8_WAIT_L(8); PG8_BAR; PG8_WAIT_L(0); PG8_MMA(0, 0, At, B0); PG8_BAR; PG8_SCHED;
            PG8_LDB(B1, 0, 1); PG8_STAGE(PG8_SB(0, 0), b2, voffB);
            PG8_BAR; PG8_WAIT_L(0); PG8_MMA(0, 1, At, B1); PG8_BAR;
            PG8_LDA(At, 0, 1); PG8_STAGE(PG8_SA(0, 0), a2, voffA);
            PG8_BAR; PG8_WAIT_L(0); PG8_MMA(1, 0, At, B0); PG8_BAR; PG8_SCHED;
            PG8_STAGE(PG8_SB(0, 1), b2 + hstep, voffB);
            PG8_WAIT_V(6); PG8_BAR; PG8_MMA(1, 1, At, B1); PG8_BAR;
            PG8_LDB(B0, 1, 0); PG8_SCHED; PG8_LDA(At, 1, 0); PG8_STAGE(PG8_SA(0, 1), a2 + hstep, voffA);
            PG8_WAIT_L(8); PG8_BAR; PG8_WAIT_L(0); PG8_MMA(0, 0, At, B0); PG8_BAR; PG8_SCHED;
            PG8_LDB(B1, 1, 1); PG8_STAGE(PG8_SB(1, 0), b3, voffB);
            PG8_BAR; PG8_WAIT_L(0); PG8_MMA(0, 1, At, B1); PG8_BAR;
            PG8_LDA(At, 1, 1); PG8_STAGE(PG8_SA(1, 0), a3, voffA);
            PG8_BAR; PG8_WAIT_L(0); PG8_MMA(1, 0, At, B0); PG8_BAR; PG8_SCHED;
            PG8_STAGE(PG8_SB(1, 1), b3 + hstep, voffB);
            PG8_WAIT_V(6); PG8_BAR; PG8_MMA(1, 1, At, B1); PG8_BAR;
            }
        }
        if constexpr (ALIGN_EPI) { if (wr == 0) PG8_BAR; }
        if constexpr (!Epi::AFTER_DRAIN) { E(acc, cur, wr, wc, fr, fq); S.done(cur); }
        if (!has_next) break;
#pragma unroll
        for (int a = 0; a < 2; ++a)
#pragma unroll
            for (int b = 0; b < 2; ++b)
#pragma unroll
                for (int m = 0; m < 4; ++m)
#pragma unroll
                    for (int n = 0; n < 2; ++n) acc[a][b][m][n] = (f32x4){0.f, 0.f, 0.f, 0.f};
        cur = nxt; cA = nA; cB = nB; ++ui;
        if constexpr (ALIGN_EPI) { if (wr == 1) PG8_BAR; }
    }
    PG8_WAIT_V(0);
    if constexpr (!ALIGN_EPI) { if (wr == 0) PG8_BAR; }
    PG8_BAR;
    if constexpr (Epi::AFTER_DRAIN) { E.fused(acc, cur, wr, wc, fr, fq, lds, wid, lane); S.done(cur); }
#undef PG8_SA
#undef PG8_SB
#undef PG8_STAGE
#undef PG8_LDA
#undef PG8_LDB
#undef PG8_MMA
#undef PG8_WAIT_V
#undef PG8_WAIT_L
#undef PG8_BAR
#undef PG8_SCHED
}
}
typedef unsigned short bf16_t;
typedef short bf16x8 __attribute__((ext_vector_type(8)));
typedef float f32x4 __attribute__((ext_vector_type(4)));
typedef float f32x2 __attribute__((ext_vector_type(2)));
typedef float f32x16 __attribute__((ext_vector_type(16)));
typedef unsigned u32x4 __attribute__((ext_vector_type(4)));
typedef unsigned u32x2 __attribute__((ext_vector_type(2)));
#define LAS __attribute__((address_space(3)))
constexpr int DM = 1024, CH = 16384, NCHUNK = 3, DEPTH = 4, PLE = 256, DFF = 2816;
constexpr int EV_IN = 7168, OD_IN = 3104, OD_INP = 3328;
constexpr float EPS = 1e-6f;
constexpr int NT = 512, NWV = 8;
constexpr int LDS_BYTES = 147456;
constexpr size_t al256(size_t x) { return (x + 255) & ~(size_t)255; }
constexpr size_t W_EVIN = 65536;
constexpr size_t W_EVOUT = W_EVIN + (size_t)2 * EV_IN * DM * 2;
constexpr size_t W_ODIN = W_EVOUT + (size_t)2 * DM * DM * 2;
constexpr size_t W_ODOUT = W_ODIN + (size_t)2 * OD_INP * DM * 2;
constexpr size_t W_UP = W_ODOUT + (size_t)2 * DM * DM * 2;
constexpr size_t W_DOWN = W_UP + (size_t)4 * 2 * DFF * DM * 2;
constexpr size_t W_GATE = W_DOWN + (size_t)4 * DM * DFF * 2;
constexpr size_t W_PROJ = W_GATE + (size_t)4 * DM * DM * 2;
constexpr size_t W_LB = W_PROJ + (size_t)4 * DM * PLE * 2;
constexpr size_t B_PB = W_LB + 8192;
constexpr size_t B_HB0 = B_PB + (size_t)CH * PLE * 2;
constexpr size_t B_HB1 = B_HB0 + (size_t)CH * DM * 2;
constexpr size_t B_SSQ0 = B_HB1 + (size_t)CH * DM * 2;
constexpr size_t B_SSQ1 = B_SSQ0 + (size_t)CH * 16 * 4;
constexpr size_t ARENA = B_SSQ1 + (size_t)CH * 16 * 4;
constexpr size_t A_U = 0;
constexpr size_t A_QT = (size_t)CH * EV_IN * 2;
constexpr size_t A_KT = A_QT + (size_t)2 * CH * 512 * 2;
constexpr size_t A_MIX = A_QT;
constexpr size_t A_OEV = A_KT + (size_t)2 * CH * 512 * 2;
constexpr size_t A_VFOD = (size_t)CH * OD_INP * 2;
constexpr size_t A_OOD = A_OEV;
constexpr size_t A_OG = A_OEV + (size_t)2 * CH * 512 * 4;
constexpr size_t A_LSE = A_OG + (size_t)3 * CH * 512 * 2;
constexpr size_t A_DEC = A_OOD + (size_t)2 * CH * 1024 * 4;
constexpr size_t ARENA_BYTES = A_DEC + (size_t)512 * 4 * 2 * 128 * 4;
constexpr size_t A_UF = 0;
constexpr size_t A_ACT = (size_t)CH * 2 * DFF * 2;
constexpr size_t A_PP = 0;
constexpr size_t WS_NEED = ARENA + ARENA_BYTES;
static_assert(A_LSE + (size_t)3 * CH * 4 * 4 <= A_DEC, "even bufs before DEC");
static_assert(A_VFOD + (size_t)CH * 1024 * 2 * 2 <= A_QT, "odd Vf fits before QT");
static_assert(A_ACT + (size_t)CH * DFF * 2 <= ARENA_BYTES, "act fits");

__device__ __forceinline__ float bf2f(unsigned short v) { return __uint_as_float(((unsigned)v) << 16); }
__device__ __forceinline__ unsigned pk2(float lo, float hi) { return pg8::cvt_pk_bf16(lo, hi); }
typedef float f32x2_cv __attribute__((ext_vector_type(2))); typedef __bf16 bf16x2_cv __attribute__((ext_vector_type(2)));
__device__ __forceinline__ unsigned pk2s(float lo, float hi) { const f32x2_cv v = {lo, hi}; const bf16x2_cv c = __builtin_convertvector(v, bf16x2_cv); return __builtin_bit_cast(unsigned, c); }
__device__ __forceinline__ float shfl_xor_l(float v, int lane, int m) { return __builtin_bit_cast(float, __builtin_amdgcn_ds_bpermute((lane ^ m) << 2, __builtin_bit_cast(int, v))); }
__device__ __forceinline__ float wave_sum(float v, int lane) {
#pragma unroll
    for (int o = 1; o < 64; o <<= 1) v += shfl_xor_l(v, lane, o);
    return v;
}
__device__ __forceinline__ float rstd_of(const float* ssq, int row) {
    const f32x4* p = (const f32x4*)(ssq + (size_t)row * 16);
    const f32x4 a = p[0], b = p[1], c = p[2], d = p[3];
    const float s = ((a.x + a.y) + (a.z + a.w)) + ((b.x + b.y) + (b.z + b.w)) + ((c.x + c.y) + (c.z + c.w)) + ((d.x + d.y) + (d.z + d.w));
    return rsqrtf(s * (1.0f / DM) + EPS);
}
struct EpiScale {
    static constexpr bool PERM = true, AFTER_DRAIN = false;
    bf16_t* O; int ldc; const float* ssq;
    __device__ __forceinline__ void operator()(const f32x4 (&acc)[2][2][4][2], const pg8::Unit& u, int wr, int wc, int fr, int fq) const {
        const int row0 = u.pm * 256 + wr * 64 + fr, col0 = u.pn * 256 + wc * 32 + 8 * fq;
#pragma unroll
        for (int ai = 0; ai < 2; ++ai)
#pragma unroll
            for (int m = 0; m < 4; ++m) {
                const int row = row0 + ai * 128 + m * 16; const float rs = rstd_of(ssq, row);
                bf16_t* rp = O + (size_t)row * ldc + col0;
#pragma unroll
                for (int bj = 0; bj < 2; ++bj) { const f32x4 v0 = acc[ai][bj][m][0] * rs, v1 = acc[ai][bj][m][1] * rs;
                    u32x4 w; w.x = pk2(v0[0], v0[1]); w.y = pk2(v0[2], v0[3]); w.z = pk2(v1[0], v1[1]); w.w = pk2(v1[2], v1[3]);
                    *(u32x4*)(rp + bj * 128) = w; }
            }
    }
};
struct EpiF32 {
    static constexpr bool PERM = true, AFTER_DRAIN = false;
    bf16_t* O; int ldc;
    __device__ __forceinline__ void operator()(const f32x4 (&acc)[2][2][4][2], const pg8::Unit& u, int wr, int wc, int fr, int fq) const {
        const int row0 = u.pm * 256 + wr * 64 + fr, col0 = u.pn * 256 + wc * 32 + 8 * fq;
#pragma unroll
        for (int ai = 0; ai < 2; ++ai)
#pragma unroll
            for (int m = 0; m < 4; ++m) { bf16_t* rp = O + (size_t)(row0 + ai * 128 + m * 16) * ldc + col0;
#pragma unroll
                for (int bj = 0; bj < 2; ++bj) { const f32x4 v0 = acc[ai][bj][m][0], v1 = acc[ai][bj][m][1];
                    u32x4 w; w.x = pk2s(v0[0], v0[1]); w.y = pk2s(v0[2], v0[3]); w.z = pk2s(v1[0], v1[1]); w.w = pk2s(v1[2], v1[3]);
                    *(u32x4*)(rp + bj * 128) = w; } }
    }
};
template <int MODE  > struct EpiResid {
    static constexpr bool PERM = true, AFTER_DRAIN = false;
    float* h; bf16_t* hb; float* ssq_out; const float* ssq_in; const bf16_t* pp;
    __device__ __forceinline__ void operator()(const f32x4 (&acc)[2][2][4][2], const pg8::Unit& u, int wr, int wc, int fr, int fq) const {
        const int row0 = u.pm * 256 + wr * 64 + fr, col0 = u.pn * 256 + wc * 32 + 8 * fq;
#pragma unroll
        for (int ai = 0; ai < 2; ++ai)
#pragma unroll
            for (int m = 0; m < 4; ++m) {
                const int row = row0 + ai * 128 + m * 16; float rs = 1.f; if (MODE == 1) rs = rstd_of(ssq_in, row);
                float* hp = h + (size_t)row * DM + col0; bf16_t* bp = hb + (size_t)row * DM + col0; float s = 0.f;
#pragma unroll
                for (int bj = 0; bj < 2; ++bj) {
                    f32x4 a0 = acc[ai][bj][m][0], a1 = acc[ai][bj][m][1];
                    if (MODE == 1) { const u32x4 pw = *(const u32x4*)(pp + (size_t)row * DM + col0 + bj * 128);
                        const f32x4 p0 = {__uint_as_float(pw.x << 16), __uint_as_float(pw.x & 0xffff0000u), __uint_as_float(pw.y << 16), __uint_as_float(pw.y & 0xffff0000u)};
                        const f32x4 p1 = {__uint_as_float(pw.z << 16), __uint_as_float(pw.z & 0xffff0000u), __uint_as_float(pw.w << 16), __uint_as_float(pw.w & 0xffff0000u)};
#pragma unroll
                        for (int e = 0; e < 4; ++e) { a0[e] = p0[e] / (1.f + __expf(-a0[e] * rs)); a1[e] = p1[e] / (1.f + __expf(-a1[e] * rs)); } }
                    const f32x4 h0 = *(const f32x4*)(hp + bj * 128) + a0, h1 = *(const f32x4*)(hp + bj * 128 + 4) + a1;
                    *(f32x4*)(hp + bj * 128) = h0; *(f32x4*)(hp + bj * 128 + 4) = h1;
                    u32x4 w; w.x = pk2(h0[0], h0[1]); w.y = pk2(h0[2], h0[3]); w.z = pk2(h1[0], h1[1]); w.w = pk2(h1[2], h1[3]);
                    *(u32x4*)(bp + bj * 128) = w;
                    s += (h0[0] * h0[0] + h0[1] * h0[1]) + (h0[2] * h0[2] + h0[3] * h0[3]) + (h1[0] * h1[0] + h1[1] * h1[1]) + (h1[2] * h1[2] + h1[3] * h1[3]);
                }
                { const int ln_ = fq * 16 + fr; s += shfl_xor_l(s, ln_, 16); s += shfl_xor_l(s, ln_, 32); }
                if (fq == 0) ssq_out[(size_t)row * 16 + u.pn * 4 + wc] = s;
            }
    }
};

struct EpiConv {
    static constexpr bool PERM = true, AFTER_DRAIN = false;
    bf16_t* act; const float* ssq; const float* cw; const float* cb; int T; LAS float* halo;
    __device__ __forceinline__ void operator()(f32x4 (&acc)[2][2][4][2], const pg8::Unit& u, int wr, int wc, int fr, int fq) const {
        const int g0 = 254 * u.pm - 1, lane = fq * 16 + fr;
#pragma unroll
        for (int ai = 0; ai < 2; ++ai)
#pragma unroll
            for (int m = 0; m < 4; ++m) { const float rs = rstd_of(ssq, g0 + ai * 128 + wr * 64 + m * 16 + fr);
#pragma unroll
                for (int bj = 0; bj < 2; ++bj) { acc[ai][bj][m][0] = acc[ai][bj][m][0] * rs; acc[ai][bj][m][1] = acc[ai][bj][m][1] * rs; } }
#pragma unroll
        for (int ai = 0; ai < 2; ++ai) { const int s = 2 * ai + wr;
            if (fr == 0) {
#pragma unroll
                for (int bj = 0; bj < 2; ++bj)
#pragma unroll
                    for (int n = 0; n < 2; ++n) *(LAS f32x4*)(halo + ((((wc * 4 + s) * 2 + 0) * 2 + bj) * 32) + 8 * fq + 4 * n) = acc[ai][bj][0][n]; }
            if (fr == 15) {
#pragma unroll
                for (int bj = 0; bj < 2; ++bj)
#pragma unroll
                    for (int n = 0; n < 2; ++n) *(LAS f32x4*)(halo + ((((wc * 4 + s) * 2 + 1) * 2 + bj) * 32) + 8 * fq + 4 * n) = acc[ai][bj][3][n]; } }
        asm volatile("s_waitcnt lgkmcnt(0)" ::: "memory"); __builtin_amdgcn_s_barrier(); asm volatile("" ::: "memory");
#pragma unroll
        for (int n = 0; n < 2; ++n) {
            const int ca = u.pn * 128 + wc * 32 + 8 * fq + 4 * n;
            f32x4 w0[2], w1[2], w2[2], bb[2];
#pragma unroll
            for (int bj = 0; bj < 2; ++bj) { const int c = bj * DFF + ca;
                w0[bj] = *(const f32x4*)(cw + c); w1[bj] = *(const f32x4*)(cw + 2 * DFF + c); w2[bj] = *(const f32x4*)(cw + 4 * DFF + c); bb[bj] = *(const f32x4*)(cb + c); }
#pragma unroll
            for (int ai = 0; ai < 2; ++ai) { const int s = 2 * ai + wr;
#pragma unroll
                for (int m = 0; m < 4; ++m) {
                    const int lr = ai * 128 + wr * 64 + m * 16 + fr, g = g0 + lr; const bool tp = (g & (T - 1)) != 0, tn = ((g + 1) & (T - 1)) != 0;
                    f32x4 ph[2] = {{0.f, 0.f, 0.f, 0.f}, {0.f, 0.f, 0.f, 0.f}}, nh[2] = {{0.f, 0.f, 0.f, 0.f}, {0.f, 0.f, 0.f, 0.f}};
                    if (m == 0 && s > 0) {
#pragma unroll
                        for (int bj = 0; bj < 2; ++bj) ph[bj] = *(const LAS f32x4*)(halo + ((((wc * 4 + s - 1) * 2 + 1) * 2 + bj) * 32) + 8 * fq + 4 * n); }
                    if (m == 3 && s < 3) {
#pragma unroll
                        for (int bj = 0; bj < 2; ++bj) nh[bj] = *(const LAS f32x4*)(halo + ((((wc * 4 + s + 1) * 2 + 0) * 2 + bj) * 32) + 8 * fq + 4 * n); }
                    float cv[2][4];
#pragma unroll
                    for (int bj = 0; bj < 2; ++bj)
#pragma unroll
                        for (int e = 0; e < 4; ++e) {
                            const float cur = acc[ai][bj][m][n][e];
                            const float sp_ = (fr == 15) ? (m > 0 ? acc[ai][bj][m > 0 ? m - 1 : 0][n][e] : ph[bj][e]) : cur;
                            const float sn_ = (fr == 0) ? (m < 3 ? acc[ai][bj][m < 3 ? m + 1 : 3][n][e] : nh[bj][e]) : cur;
                            const float pv = __builtin_bit_cast(float, __builtin_amdgcn_update_dpp(0, __builtin_bit_cast(int, sp_), 0x121, 0xf, 0xf, false));
                            const float nv = __builtin_bit_cast(float, __builtin_amdgcn_update_dpp(0, __builtin_bit_cast(int, sn_), 0x12F, 0xf, 0xf, false));
                            float t_ = fmaf(cur, w1[bj][e], bb[bj][e]); t_ = tp ? fmaf(pv, w0[bj][e], t_) : t_; t_ = tn ? fmaf(nv, w2[bj][e], t_) : t_; cv[bj][e] = t_;
                        }
                    const f32x2 g01 = pg8::gelu_pk((f32x2){cv[1][0], cv[1][1]}), g23 = pg8::gelu_pk((f32x2){cv[1][2], cv[1][3]});
                    if (lr >= 1 && lr <= 254 && g < CH) { u32x2 w; w.x = pk2(cv[0][0] * g01.x, cv[0][1] * g01.y); w.y = pk2(cv[0][2] * g23.x, cv[0][3] * g23.y);
                        *(u32x2*)(act + (size_t)g * DFF + ca) = w; }
                    __builtin_amdgcn_sched_barrier(0);
                }
            }
            asm volatile("" ::: "memory");
        }
    }
};
struct Args {
    const float* in[23]; float* out; unsigned char* ws; int ph_lo, ph_hi;
};
enum { I_XP = 0, I_XS, I_PP, I_PS, I_NMIX, I_EVIN, I_LBL, I_HNORM, I_EVOUT, I_ODIN, I_GUP, I_GB, I_GNORM, I_ODOUT, I_NFFN, I_FUP, I_CW, I_CB, I_FDOWN, I_NPLE, I_PGATE, I_PPROJ, I_NOUT };

struct Ctx {
    LAS unsigned char* lds; int tid, lane, wave, G, bid;
    const Args* a; unsigned char* ws;
};

__device__ __forceinline__ void transpose_item(const float* W, int K, int N, const float* gk, bf16_t* WT, LAS float* scr, int item, int lane, bool remap) {
    const int nblk = N / 32, kb = item / nblk, nb = item % nblk, k0 = 64 * kb, n0 = 32 * nb;
#pragma unroll 8
    for (int i = 0; i < 32; ++i) { const int kk = 2 * i + (lane >> 5); float v = W[(size_t)(k0 + kk) * N + n0 + (lane & 31)]; if (gk) v *= gk[k0 + kk]; scr[kk * 33 + (lane & 31)] = v; }
    asm volatile("s_waitcnt lgkmcnt(0)" ::: "memory");
    const int c = lane & 7;
#pragma unroll
    for (int j = 0; j < 4; ++j) { const int n = (lane >> 3) + 8 * j; const LAS float* s = scr + (8 * c) * 33 + n;
        u32x4 o; o.x = pk2(s[0 * 33], s[1 * 33]); o.y = pk2(s[2 * 33], s[3 * 33]); o.z = pk2(s[4 * 33], s[5 * 33]); o.w = pk2(s[6 * 33], s[7 * 33]);
        int nr = n0 + n; if (remap) nr = (nr < DFF) ? (((nr >> 7) << 8) + (nr & 127)) : ((((nr - DFF) >> 7) << 8) + 128 + ((nr - DFF) & 127));
        *(u32x4*)(WT + (size_t)nr * K + k0 + 8 * c) = o; }
    asm volatile("s_waitcnt lgkmcnt(0)" ::: "memory");
}
__device__ __forceinline__ void weights_prologue(const Ctx& C) {
    LAS float* scr = (LAS float*)(C.lds + C.wave * 8704);
    const int gw = C.bid * NWV + C.wave, NGW = C.G * NWV;
    const Args& a = *C.a;
    for (int mat = 0; mat < 24; ++mat) {
        const float* W; const float* g = nullptr; bf16_t* WT; int K, N;
        if (mat < 2)       { const int e = mat;      W = a.in[I_EVIN] + (size_t)e * DM * EV_IN;  K = DM; N = EV_IN; g = a.in[I_NMIX] + (2 * e) * DM;     WT = (bf16_t*)(C.ws + W_EVIN) + (size_t)e * EV_IN * DM; }
        else if (mat < 4)  { const int e = mat - 2;  W = a.in[I_EVOUT] + (size_t)e * DM * DM;    K = DM; N = DM;                                        WT = (bf16_t*)(C.ws + W_EVOUT) + (size_t)e * DM * DM; }
        else if (mat < 6)  { const int o = mat - 4;  W = a.in[I_ODIN] + (size_t)o * DM * OD_IN;  K = DM; N = OD_IN; g = a.in[I_NMIX] + (2 * o + 1) * DM; WT = (bf16_t*)(C.ws + W_ODIN) + (size_t)o * OD_INP * DM; }
        else if (mat < 8)  { const int o = mat - 6;  W = a.in[I_ODOUT] + (size_t)o * DM * DM;    K = DM; N = DM;                                        WT = (bf16_t*)(C.ws + W_ODOUT) + (size_t)o * DM * DM; }
        else if (mat < 12) { const int l = mat - 8;  W = a.in[I_FUP] + (size_t)l * DM * 2 * DFF; K = DM; N = 2 * DFF; g = a.in[I_NFFN] + l * DM;         WT = (bf16_t*)(C.ws + W_UP) + (size_t)l * 2 * DFF * DM; }
        else if (mat < 16) { const int l = mat - 12; W = a.in[I_FDOWN] + (size_t)l * DFF * DM;   K = DFF; N = DM;                                       WT = (bf16_t*)(C.ws + W_DOWN) + (size_t)l * DM * DFF; }
        else if (mat < 20) { const int l = mat - 16; W = a.in[I_PGATE] + (size_t)l * DM * DM;    K = DM; N = DM; g = a.in[I_NPLE] + l * DM;              WT = (bf16_t*)(C.ws + W_GATE) + (size_t)l * DM * DM; }
        else               { const int l = mat - 20; W = a.in[I_PPROJ] + (size_t)l * PLE * DM;   K = PLE; N = DM;                                       WT = (bf16_t*)(C.ws + W_PROJ) + (size_t)l * DM * PLE; }
        const int nitems = (K / 64) * (N / 32);
        for (int it = gw; it < nitems; it += NGW) transpose_item(W, K, N, g, WT, scr, it, C.lane, mat >= 8 && mat < 12);
    }
    { const int gt = C.bid * NT + C.tid, GT = C.G * NT; const int per = (OD_INP - OD_IN) * DM / 8;
      for (int i = gt; i < 2 * per; i += GT) { const int o = i / per, r = i % per; *(u32x4*)((bf16_t*)(C.ws + W_ODIN) + (size_t)o * OD_INP * DM + (size_t)OD_IN * DM + (size_t)r * 8) = (u32x4){0u, 0u, 0u, 0u}; } }
    { const int gt = C.bid * NT + C.tid; if (gt < 1024) { const int dir = gt >> 9, c = gt & 511; const float* L = a.in[I_LBL] + (size_t)dir * 2 * 512;
        float* lb = (float*)(C.ws + W_LB) + dir * 1024; lb[c] = 0.f; lb[512 + c] = 1.f / (1.f + __expf(L[c] - L[512 + c])); } }
}
__device__ __forceinline__ void chunk_prologue(const Ctx& C, int chunk, bf16_t* hb, float* ssq) {
    const int gw = C.bid * NWV + C.wave, NGW = C.G * NWV; const Args& a = *C.a;
    for (int r = gw; r < CH; r += NGW) {
        const size_t R = (size_t)chunk * CH + r;
        const float* xr = (R < 16384) ? a.in[I_XP] + R * DM : a.in[I_XS] + (R - 16384) * DM;
        float* hr = a.out + R * DM; f32x4 v[4]; float s = 0.f;
#pragma unroll
        for (int j = 0; j < 4; ++j) { v[j] = ((const f32x4*)xr)[C.lane + 64 * j]; s += (v[j].x * v[j].x + v[j].y * v[j].y) + (v[j].z * v[j].z + v[j].w * v[j].w); }
        s = wave_sum(s, C.lane);
#pragma unroll
        for (int j = 0; j < 4; ++j) { ((f32x4*)hr)[C.lane + 64 * j] = v[j]; u32x2 w; w.x = pk2(v[j].x, v[j].y); w.y = pk2(v[j].z, v[j].w); ((u32x2*)(hb + (size_t)r * DM))[C.lane + 64 * j] = w; }
        if (C.lane < 16) ssq[(size_t)r * 16 + C.lane] = (C.lane == 0) ? s : 0.f;
    }
}
__device__ __forceinline__ void final_norm(const Ctx& C, int chunk) {
    const int gw = C.bid * NWV + C.wave, NGW = C.G * NWV; const Args& a = *C.a; const float* g = a.in[I_NOUT];
    for (int r = gw; r < CH; r += NGW) {
        float* hr = a.out + ((size_t)chunk * CH + r) * DM; f32x4 v[4]; float s = 0.f;
#pragma unroll
        for (int j = 0; j < 4; ++j) { v[j] = ((const f32x4*)hr)[C.lane + 64 * j]; s += (v[j].x * v[j].x + v[j].y * v[j].y) + (v[j].z * v[j].z + v[j].w * v[j].w); }
        const float rs = rsqrtf(wave_sum(s, C.lane) * (1.f / DM) + EPS);
#pragma unroll
        for (int j = 0; j < 4; ++j) { const f32x4 gg = ((const f32x4*)g)[C.lane + 64 * j]; ((f32x4*)hr)[C.lane + 64 * j] = v[j] * rs * gg; }
    }
}
__device__ __forceinline__ void conv_phase(const Ctx& C, int chunk, int l, int T) {
    const Args& a = *C.a;
    const bf16_t* UF = (const bf16_t*)(C.ws + ARENA + A_UF); bf16_t* ACT = (bf16_t*)(C.ws + ARENA + A_ACT);
    const float* cw = a.in[I_CW] + (size_t)l * 3 * 2 * DFF; const float* cb = a.in[I_CB] + (size_t)l * 2 * DFF;
    {
        const int ry = C.tid >> 5, cx = C.tid & 31;
        for (int tile = C.bid; tile < (CH / 64) * 11; tile += C.G) {
            const int rt = tile / 11, ct = tile % 11; const int r0 = rt * 64 + ry * 4, c0 = ct * 256 + cx * 8;
            float wa0[8], wa1[8], wa2[8], wg0[8], wg1[8], wg2[8], ba[8], bg[8];
#pragma unroll
            for (int e = 0; e < 8; e += 4) { *(f32x4*)(wa0 + e) = *(const f32x4*)(cw + c0 + e); *(f32x4*)(wa1 + e) = *(const f32x4*)(cw + 2 * DFF + c0 + e); *(f32x4*)(wa2 + e) = *(const f32x4*)(cw + 4 * DFF + c0 + e);
                *(f32x4*)(wg0 + e) = *(const f32x4*)(cw + DFF + c0 + e); *(f32x4*)(wg1 + e) = *(const f32x4*)(cw + 3 * DFF + c0 + e); *(f32x4*)(wg2 + e) = *(const f32x4*)(cw + 5 * DFF + c0 + e);
                *(f32x4*)(ba + e) = *(const f32x4*)(cb + c0 + e); *(f32x4*)(bg + e) = *(const f32x4*)(cb + DFF + c0 + e); }
            bf16x8 ua[6], ug[6];
#pragma unroll
            for (int i = 0; i < 6; ++i) { const int r = r0 - 1 + i; const bool ok = (i == 0) ? ((r0 % T) != 0) : (i == 5 ? (((r0 + 4) % T) != 0) : true);
                if (ok) { ua[i] = *(const bf16x8*)(UF + (size_t)r * 2 * DFF + c0); ug[i] = *(const bf16x8*)(UF + (size_t)r * 2 * DFF + DFF + c0); }
                else { ua[i] = (bf16x8){0, 0, 0, 0, 0, 0, 0, 0}; ug[i] = ua[i]; } }
#pragma unroll
            for (int i = 0; i < 4; ++i) {
                float o[8];
#pragma unroll
                for (int e = 0; e < 8; ++e) {
                    const float av = bf2f((unsigned short)ua[i][e]) * wa0[e] + bf2f((unsigned short)ua[i + 1][e]) * wa1[e] + bf2f((unsigned short)ua[i + 2][e]) * wa2[e] + ba[e];
                    const float gv = bf2f((unsigned short)ug[i][e]) * wg0[e] + bf2f((unsigned short)ug[i + 1][e]) * wg1[e] + bf2f((unsigned short)ug[i + 2][e]) * wg2[e] + bg[e];
                    o[e] = av * (0.5f * gv * (1.f + erff(gv * 0.70710678118f)));
                }
                u32x4 w; w.x = pk2(o[0], o[1]); w.y = pk2(o[2], o[3]); w.z = pk2(o[4], o[5]); w.w = pk2(o[6], o[7]);
                *(u32x4*)(ACT + (size_t)(r0 + i) * DFF + c0) = w;
            }
        }
    }
}
__device__ __forceinline__ void pb_convert(const Ctx& C, int chunk, int l) {
    const Args& a = *C.a;
    { bf16_t* PB = (bf16_t*)(C.ws + B_PB); const int gt = C.bid * NT + C.tid, GT = C.G * NT;
      for (int i = gt; i < CH * PLE / 4; i += GT) { const int r = i / (PLE / 4), c4 = i % (PLE / 4); const size_t R = (size_t)chunk * CH + r;
          const float* src = (R < 16384) ? a.in[I_PP] + ((size_t)l * 16384 + R) * PLE : a.in[I_PS] + ((size_t)l * 32768 + (R - 16384)) * PLE;
          const f32x4 v = ((const f32x4*)src)[c4]; u32x2 w; w.x = pk2(v.x, v.y); w.y = pk2(v.z, v.w); ((u32x2*)(PB + (size_t)r * PLE))[c4] = w; } }
}
struct Mix { int even, li, T, DV, ld, vcol, gcol; float qscale; unsigned char* vf; };
#define MFMA32(a, b, c) __builtin_amdgcn_mfma_f32_32x32x16_bf16((a), (b), (c), 0, 0, 0)
#define QK_IDX(hd, dir, blk, k) (((((size_t)((hd) * 2 + (dir))) * 512 + (size_t)(blk)) * 8 + (k)) * 64)
#define V_IDX(hd, dir, ET, et, blk, sp) ((((((size_t)((hd) * 2 + (dir))) * (ET) + (et)) * 512 + (size_t)(blk)) * 2 + (sp)) * 64)
#define O_IDX(hd, dir, ET, et, blk, q) ((((((size_t)((hd) * 2 + (dir))) * (ET) + (et)) * 512 + (size_t)(blk)) * 4 + (q)) * 64)
#define OB_IDX(hd, dir, ET, et, blk, r) ((((((size_t)((hd) * 2 + (dir))) * (ET) + (et)) * 512 + (size_t)(blk)) * 2 + (r)) * 64)
#define DEC_IDX(hd, dir, blk) ((((size_t)((hd) * 2 + (dir))) * 512 + (size_t)(blk)) * 128)
#define LDSFENCE() asm volatile("s_waitcnt lgkmcnt(0)" ::: "memory")
__device__ __forceinline__ bf16x8 pack8(float a0, float a1, float a2, float a3, float a4, float a5, float a6, float a7) {
    u32x4 w; w.x = pk2(a0, a1); w.y = pk2(a2, a3); w.z = pk2(a4, a5); w.w = pk2(a6, a7); return __builtin_bit_cast(bf16x8, w);
}
__device__ __forceinline__ bf16x8 pack8s(float a0, float a1, float a2, float a3, float a4, float a5, float a6, float a7) {
    u32x4 w; w.x = pk2s(a0, a1); w.y = pk2s(a2, a3); w.z = pk2s(a4, a5); w.w = pk2s(a6, a7); return __builtin_bit_cast(bf16x8, w);
}
__device__ __forceinline__ f32x16 zero16() { f32x16 z;
#pragma unroll
    for (int i = 0; i < 16; ++i) z[i] = 0.f; return z; }

__device__ __forceinline__ void prep_phase(const Ctx& C, const Mix& mx) {
    const Args& a = *C.a;
    const bf16_t* U = (const bf16_t*)(C.ws + ARENA + A_U);
    u32x4* QTf = (u32x4*)(C.ws + ARENA + A_QT); u32x4* KTf = (u32x4*)(C.ws + ARENA + A_KT); u32x4* Vf = (u32x4*)mx.vf;
    f32x4* Of = (f32x4*)(C.ws + ARENA + A_OEV); float* DEC = (float*)(C.ws + ARENA + A_DEC);
    const float* LB = (const float*)(C.ws + W_LB);
    const int hd = C.wave & 3, dir = C.wave >> 2, lane = C.lane, ld = mx.ld, DV = mx.DV;
    LAS float* Bs = (LAS float*)(C.lds + C.wave * 16896);
    for (int b = C.bid; b < CH / 32; b += C.G) {
        int vz_ = 0; asm volatile("" : "+v"(vz_)); const int rb = 32 * b + vz_;
        {
            const int d0 = 2 * lane, col0 = hd * 128 + d0, dt0 = d0 >> 5, dp0 = d0 & 31;
            float bs0 = 0.f, bs1 = 0.f; unsigned zz[32];
            if (mx.even) {
                const f32x2 lb2 = *(const f32x2*)(LB + dir * 1024 + mx.li * 512 + col0); const float om0 = 1.f - lb2.x, om1 = 1.f - lb2.y;
                const bf16_t* zp = U + 512 + 512 * dir + col0;
#pragma unroll
                for (int t = 0; t < 32; ++t) { const int row = rb + (dir ? 31 - t : t);
                    const unsigned zw = *(const unsigned*)(zp + (size_t)row * ld); zz[t] = zw;
                    const float z0 = __uint_as_float(zw << 16), z1 = __uint_as_float(zw & 0xffff0000u);
                    bs0 += fmaxf(__logf(lb2.x + om0 / (1.f + __expf(-z0))), -30.f); bs1 += fmaxf(__logf(lb2.y + om1 / (1.f + __expf(-z1))), -30.f);
                    *(LAS f32x2*)(Bs + t * 132 + d0) = (f32x2){bs0, bs1}; }
                *(f32x2*)(DEC + DEC_IDX(hd, dir, b) + d0) = (f32x2){__expf(bs0), __expf(bs1)};
#pragma unroll
                for (int grp = 0; grp < 4; ++grp) { float k0[8], k1[8];
#pragma unroll
                    for (int j = 0; j < 8; ++j) { const int t = 16 * (grp >> 1) + 8 * (j >> 2) + 4 * (grp & 1) + (j & 3);
                        const float z0 = __uint_as_float(zz[t] << 16), z1 = __uint_as_float(zz[t] & 0xffff0000u); const f32x2 bt = *(const LAS f32x2*)(Bs + t * 132 + d0);
                        k0[j] = om0 / (1.f + __expf(z0)) * __expf(bs0 - bt.x); k1[j] = om1 / (1.f + __expf(z1)) * __expf(bs1 - bt.y); }
                    u32x4 w; w.x = pk2(k0[0], k0[1]); w.y = pk2(k0[2], k0[3]); w.z = pk2(k0[4], k0[5]); w.w = pk2(k0[6], k0[7]);
                    KTf[QK_IDX(hd, dir, b, (grp >> 1) * 4 + dt0) + 32 * (grp & 1) + dp0] = w;
                    w.x = pk2(k1[0], k1[1]); w.y = pk2(k1[2], k1[3]); w.z = pk2(k1[4], k1[5]); w.w = pk2(k1[6], k1[7]);
                    KTf[QK_IDX(hd, dir, b, (grp >> 1) * 4 + dt0) + 32 * (grp & 1) + dp0 + 1] = w; }
            } else {
                float Wg0[16], Wg1[16]; const float* wp = a.in[I_GUP] + ((size_t)(mx.li * 2 + dir) * 16) * 512 + col0;
#pragma unroll
                for (int r = 0; r < 16; ++r) { const f32x2 w2 = *(const f32x2*)(wp + r * 512); Wg0[r] = w2.x; Wg1[r] = w2.y; }
                const f32x2 bias = *(const f32x2*)(a.in[I_GB] + (mx.li * 2 + dir) * 512 + col0);
#pragma unroll
                for (int t = 0; t < 32; ++t) { const int row = rb + (dir ? 31 - t : t);
                    const u32x4 l0 = *(const u32x4*)(U + (size_t)row * ld + 3072 + 16 * dir), l1 = *(const u32x4*)(U + (size_t)row * ld + 3072 + 16 * dir + 8);
                    zz[t] = *(const unsigned*)(U + (size_t)row * ld + 512 + col0);
                    float x0 = bias.x, x1 = bias.y;
#pragma unroll
                    for (int w = 0; w < 4; ++w) { const float a0 = __uint_as_float(l0[w] << 16), a1 = __uint_as_float(l0[w] & 0xffff0000u), c0 = __uint_as_float(l1[w] << 16), c1 = __uint_as_float(l1[w] & 0xffff0000u);
                        x0 += a0 * Wg0[2 * w] + a1 * Wg0[2 * w + 1] + c0 * Wg0[8 + 2 * w] + c1 * Wg0[8 + 2 * w + 1];
                        x1 += a0 * Wg1[2 * w] + a1 * Wg1[2 * w + 1] + c0 * Wg1[8 + 2 * w] + c1 * Wg1[8 + 2 * w + 1]; }
                    bs0 += fmaxf((fminf(x0, 0.f) - log1pf(__expf(-fabsf(x0)))) * (1.f / 16.f), -30.f); bs1 += fmaxf((fminf(x1, 0.f) - log1pf(__expf(-fabsf(x1)))) * (1.f / 16.f), -30.f);
                    *(LAS f32x2*)(Bs + t * 132 + d0) = (f32x2){bs0, bs1}; }
                *(f32x2*)(DEC + DEC_IDX(hd, dir, b) + d0) = (f32x2){__expf(bs0), __expf(bs1)};
#pragma unroll
                for (int grp = 0; grp < 4; ++grp) { float k0[8], k1[8];
#pragma unroll
                    for (int j = 0; j < 8; ++j) { const int t = 16 * (grp >> 1) + 8 * (j >> 2) + 4 * (grp & 1) + (j & 3); const f32x2 bt = *(const LAS f32x2*)(Bs + t * 132 + d0);
                        k0[j] = __uint_as_float(zz[t] << 16) * __expf(bs0 - bt.x); k1[j] = __uint_as_float(zz[t] & 0xffff0000u) * __expf(bs1 - bt.y); }
                    u32x4 w; w.x = pk2(k0[0], k0[1]); w.y = pk2(k0[2], k0[3]); w.z = pk2(k0[4], k0[5]); w.w = pk2(k0[6], k0[7]);
                    KTf[QK_IDX(hd, dir, b, (grp >> 1) * 4 + dt0) + 32 * (grp & 1) + dp0] = w;
                    w.x = pk2(k1[0], k1[1]); w.y = pk2(k1[2], k1[3]); w.z = pk2(k1[4], k1[5]); w.w = pk2(k1[6], k1[7]);
                    KTf[QK_IDX(hd, dir, b, (grp >> 1) * 4 + dt0) + 32 * (grp & 1) + dp0 + 1] = w; }
            }
        }
        LDSFENCE();
        const int tau = lane & 31, h = lane >> 5, row = rb + (dir ? 31 - tau : tau);
        bf16x8 Ak[8], Bq[8];
#pragma unroll
        for (int ks = 0; ks < 8; ++ks) {
            float qh[8], kh[8], qt[8];
#pragma unroll
            for (int q2 = 0; q2 < 2; ++q2) {
                const int d0 = 16 * ks + 8 * q2 + 4 * h;
                const f32x4 b4 = *(const LAS f32x4*)(Bs + tau * 132 + d0), r4 = *(const LAS f32x4*)(Bs + 15 * 132 + d0);
                const u32x2 qr = *(const u32x2*)(U + (size_t)row * ld + hd * 128 + d0);
                float q4[4] = {__uint_as_float(qr.x << 16), __uint_as_float(qr.x & 0xffff0000u), __uint_as_float(qr.y << 16), __uint_as_float(qr.y & 0xffff0000u)};
                float k4[4];
                if (mx.even) { const u32x2 zr = *(const u32x2*)(U + (size_t)row * ld + 512 + 512 * dir + hd * 128 + d0);
                    const f32x4 lb4 = *(const f32x4*)(LB + dir * 1024 + mx.li * 512 + hd * 128 + d0);
                    const float z4[4] = {__uint_as_float(zr.x << 16), __uint_as_float(zr.x & 0xffff0000u), __uint_as_float(zr.y << 16), __uint_as_float(zr.y & 0xffff0000u)};
#pragma unroll
                    for (int e = 0; e < 4; ++e) k4[e] = (1.f - lb4[e]) / (1.f + __expf(z4[e]));
                } else { const u32x2 kr = *(const u32x2*)(U + (size_t)row * ld + 512 + hd * 128 + d0);
                    k4[0] = __uint_as_float(kr.x << 16); k4[1] = __uint_as_float(kr.x & 0xffff0000u); k4[2] = __uint_as_float(kr.y << 16); k4[3] = __uint_as_float(kr.y & 0xffff0000u); }
#pragma unroll
                for (int e = 0; e < 4; ++e) { const float qq = q4[e] * mx.qscale; qt[4 * q2 + e] = qq * __expf(b4[e]);
                    qh[4 * q2 + e] = qq * __expf(fminf(b4[e] - r4[e], 80.f)); kh[4 * q2 + e] = k4[e] * __expf(fminf(r4[e] - b4[e], 80.f)); }
            }
            { u32x4 w; w.x = pk2(qt[0], qt[1]); w.y = pk2(qt[2], qt[3]); w.z = pk2(qt[4], qt[5]); w.w = pk2(qt[6], qt[7]); QTf[QK_IDX(hd, dir, b, ks) + lane] = w; }
            Bq[ks] = pack8(qh[0], qh[1], qh[2], qh[3], qh[4], qh[5], qh[6], qh[7]);
            Ak[ks] = pack8(kh[0], kh[1], kh[2], kh[3], kh[4], kh[5], kh[6], kh[7]);
        }
        f32x16 at = zero16();
#pragma unroll
        for (int ks = 0; ks < 8; ++ks) at = MFMA32(Ak[ks], Bq[ks], at);
#pragma unroll
        for (int i = 0; i < 16; ++i) { const int s = (i & 3) + 8 * (i >> 2) + 4 * h; if (s > tau) at[i] = 0.f; }
        bf16x8 Pa[2];
        Pa[0] = pack8(at[0], at[1], at[2], at[3], at[4], at[5], at[6], at[7]);
        Pa[1] = pack8(at[8], at[9], at[10], at[11], at[12], at[13], at[14], at[15]);
        const int ET = DV / 32;
        LDSFENCE();
        LAS unsigned char* Vs = (LAS unsigned char*)Bs; const int vpitch = 2 * DV + 16;
        for (int idx = lane; idx < 32 * (DV / 8); idx += 64) { const int t = idx / (DV / 8), c8 = idx % (DV / 8); const int rj = rb + (dir ? 31 - t : t);
            *(LAS u32x4*)(Vs + t * vpitch + c8 * 16) = *(const u32x4*)(U + (size_t)rj * ld + mx.vcol + hd * DV + c8 * 8); }
        LDSFENCE();
        for (int et = 0; et < ET; ++et) {
            f32x16 acc = zero16();
#pragma unroll
            for (int sp = 0; sp < 2; ++sp) {
                unsigned short v[8];
#pragma unroll
                for (int j = 0; j < 8; ++j) { const int sj = 16 * sp + 8 * (j >> 2) + 4 * h + (j & 3); v[j] = *(const LAS unsigned short*)(Vs + sj * vpitch + (32 * et + (lane & 31)) * 2); }
                u32x4 w; w.x = v[0] | ((unsigned)v[1] << 16); w.y = v[2] | ((unsigned)v[3] << 16); w.z = v[4] | ((unsigned)v[5] << 16); w.w = v[6] | ((unsigned)v[7] << 16);
                Vf[V_IDX(hd, dir, ET, et, b, sp) + lane] = w;
                acc = MFMA32(Pa[sp], __builtin_bit_cast(bf16x8, w), acc);
            }
#pragma unroll
            for (int r = 0; r < 2; ++r) { u32x4 w; w.x = pk2s(acc[8 * r], acc[8 * r + 1]); w.y = pk2s(acc[8 * r + 2], acc[8 * r + 3]); w.z = pk2s(acc[8 * r + 4], acc[8 * r + 5]); w.w = pk2s(acc[8 * r + 6], acc[8 * r + 7]);
                ((u32x4*)Of)[OB_IDX(hd, dir, ET, et, b, r) + lane] = w; }
        }
        LDSFENCE();
    }
}
__device__ __forceinline__ void scan_phase(const Ctx& C, const Mix& mx) {
    const u32x4* QTf = (const u32x4*)(C.ws + ARENA + A_QT); const u32x4* KTf = (const u32x4*)(C.ws + ARENA + A_KT); const u32x4* Vf = (const u32x4*)mx.vf;
    u32x4* Of = (u32x4*)(C.ws + ARENA + A_OEV); const float* DEC = (const float*)(C.ws + ARENA + A_DEC);
    const int lane = C.lane, h = lane >> 5, DV = mx.DV, ET = DV / 32, T = mx.T, nb = T / 32;
    const int units = (CH / T) * 8 * ET;
    constexpr int SLOT = 23552, R = 5, NL = 4;
    LAS u32x4* SB = (LAS u32x4*)(C.lds + R * SLOT);
    for (int base = 0; base < units; base += C.G) {
        const bool loader = C.wave >= 2 && C.wave < 2 + NL;
        const int lr = C.wave - 2;
        const int u = base + C.bid;
        const bool valid = u < units;
        const int et = u % ET, x = u / ET, dir = x & 1, hd = (x >> 1) & 3, seq = x >> 3;
        LAS unsigned char* ring = C.lds;
#define SCAN_BAR() do { asm volatile("s_waitcnt lgkmcnt(0)" ::: "memory"); __builtin_amdgcn_s_barrier(); asm volatile("" ::: "memory"); } while (0)
#define GLDS16(gp, lp) __builtin_amdgcn_global_load_lds((const unsigned*)(gp), (LAS unsigned*)(lp), 16, 0, 0)
#define SCAN_ISSUE(j) do { const int blk_ = seq * nb + (dir ? nb - 1 - (j) : (j)); LAS unsigned char* sl_ = ring + ((j) % R) * SLOT; \
            _Pragma("unroll") for (int k = 0; k < 8; ++k) { GLDS16(QTf + QK_IDX(hd, dir, blk_, k) + lane, sl_ + k * 1024); GLDS16(KTf + QK_IDX(hd, dir, blk_, k) + lane, sl_ + (8 + k) * 1024); } \
            _Pragma("unroll") for (int sp = 0; sp < 2; ++sp) GLDS16(Vf + V_IDX(hd, dir, ET, et, blk_, sp) + lane, sl_ + (16 + sp) * 1024); \
            _Pragma("unroll") for (int r = 0; r < 2; ++r) GLDS16(Of + OB_IDX(hd, dir, ET, et, blk_, r) + lane, sl_ + (18 + r) * 1024); \
            if (lane < 32) GLDS16(DEC + DEC_IDX(hd, dir, blk_) + 4 * lane, sl_ + 22 * 1024); } while (0)
        if (C.wave == 0) {
            SCAN_BAR();
            for (int i = 0; i < nb; ++i) {
                if (valid) {
                    const LAS u32x4* sv = (const LAS u32x4*)(ring + (i % R) * SLOT) + lane; const LAS u32x4* sb = SB + (i & 1) * 512 + lane;
                    u32x4 qf[8], on[2], bs[8];
#pragma unroll
                    for (int r = 0; r < 2; ++r) on[r] = sv[(18 + r) * 64];
#pragma unroll
                    for (int k = 0; k < 8; ++k) { qf[k] = sv[k * 64]; bs[k] = sb[k * 64]; }
                    asm volatile("s_waitcnt lgkmcnt(0)" ::: "memory");
                    f32x16 acc;
#pragma unroll
                    for (int r = 0; r < 2; ++r) {
                        acc[8 * r + 0] = __uint_as_float(on[r].x << 16); acc[8 * r + 1] = __uint_as_float(on[r].x & 0xffff0000u); acc[8 * r + 2] = __uint_as_float(on[r].y << 16); acc[8 * r + 3] = __uint_as_float(on[r].y & 0xffff0000u);
                        acc[8 * r + 4] = __uint_as_float(on[r].z << 16); acc[8 * r + 5] = __uint_as_float(on[r].z & 0xffff0000u); acc[8 * r + 6] = __uint_as_float(on[r].w << 16); acc[8 * r + 7] = __uint_as_float(on[r].w & 0xffff0000u); }
#pragma unroll
                    for (int k = 0; k < 8; ++k) acc = MFMA32(__builtin_bit_cast(bf16x8, qf[k]), __builtin_bit_cast(bf16x8, bs[k]), acc);
                    const int blk = seq * nb + (dir ? nb - 1 - i : i);
#pragma unroll
                    for (int r = 0; r < 2; ++r) { u32x4 w; w.x = pk2s(acc[8 * r], acc[8 * r + 1]); w.y = pk2s(acc[8 * r + 2], acc[8 * r + 3]); w.z = pk2s(acc[8 * r + 4], acc[8 * r + 5]); w.w = pk2s(acc[8 * r + 6], acc[8 * r + 7]);
                        Of[OB_IDX(hd, dir, ET, et, blk, r) + lane] = w; }
                }
                SCAN_BAR();
            }
        } else if (C.wave == 1) {
            f32x16 S[4];
#pragma unroll
            for (int dt = 0; dt < 4; ++dt) S[dt] = zero16();
#pragma unroll
            for (int k = 0; k < 8; ++k) SB[k * 64 + lane] = (u32x4){0u, 0u, 0u, 0u};
            SCAN_BAR();
            for (int i = 0; i < nb; ++i) {
                if (valid) {
                    const LAS unsigned char* sl = ring + (i % R) * SLOT; const LAS u32x4* sv = (const LAS u32x4*)sl + lane;
                    u32x4 kf[8], vf[2]; f32x4 dq[16];
#pragma unroll
                    for (int k = 0; k < 8; ++k) kf[k] = sv[(8 + k) * 64];
#pragma unroll
                    for (int sp = 0; sp < 2; ++sp) vf[sp] = sv[(16 + sp) * 64];
                    const LAS float* dp = (const LAS float*)(sl + 22 * 1024) + 4 * h;
#pragma unroll
                    for (int k = 0; k < 16; ++k) dq[k] = *(const LAS f32x4*)(dp + 8 * k);
                    asm volatile("s_waitcnt lgkmcnt(0)" ::: "memory");
#pragma unroll
                    for (int dt = 0; dt < 4; ++dt)
#pragma unroll
                        for (int q = 0; q < 4; ++q) {
#pragma unroll
                            for (int e = 0; e < 4; ++e) S[dt][4 * q + e] *= dq[4 * dt + q][e]; }
#pragma unroll
                    for (int sp = 0; sp < 2; ++sp) {
#pragma unroll
                        for (int dt = 0; dt < 4; ++dt) S[dt] = MFMA32(__builtin_bit_cast(bf16x8, kf[sp * 4 + dt]), __builtin_bit_cast(bf16x8, vf[sp]), S[dt]); }
                    LAS u32x4* sbw = SB + ((i + 1) & 1) * 512 + lane;
#pragma unroll
                    for (int dt = 0; dt < 4; ++dt)
#pragma unroll
                        for (int sp = 0; sp < 2; ++sp)
                            sbw[(2 * dt + sp) * 64] = __builtin_bit_cast(u32x4, pack8s(S[dt][8 * sp + 0], S[dt][8 * sp + 1], S[dt][8 * sp + 2], S[dt][8 * sp + 3], S[dt][8 * sp + 4], S[dt][8 * sp + 5], S[dt][8 * sp + 6], S[dt][8 * sp + 7]));
                }
                SCAN_BAR();
            }
        } else {
            if (loader && valid && lr < nb) SCAN_ISSUE(lr);
            for (int i = -1; i < nb; ++i) {
                if (loader && valid) {
                    if (i >= 0 && lr == i % NL && i + NL < nb) SCAN_ISSUE(i + NL);
                    if (lr == (i + 1) % NL && i + 1 < nb) asm volatile("s_waitcnt vmcnt(0)" ::: "memory");
                }
                SCAN_BAR();
            }
        }
#undef SCAN_ISSUE
#undef GLDS16
#undef SCAN_BAR
    }
}
__device__ __forceinline__ void attn_phase(const Ctx& C, int T) {
    const bf16_t* U = (const bf16_t*)(C.ws + ARENA + A_U);
    bf16_t* OG = (bf16_t*)(C.ws + ARENA + A_OG); float* LSE = (float*)(C.ws + ARENA + A_LSE);
    const int lane = C.lane, h = lane >> 5, l31 = lane & 31, ld = EV_IN, tps = T / 32;
    for (int task = C.bid * NWV + C.wave; task < 3 * 4 * (CH / 32); task += C.G * NWV) {
        const int g = task / 2048, x = task % 2048, hd = x / 512, y = x % 512, seq = y / tps, z = y % tps;
        const int dil = 1 << (2 * g), L = T / dil, nqb = L / 32, r = z / nqb, qb = z % nqb, m0 = 32 * qb;
        const int qcol = 2560 + g * 1536 + hd * 128, kcol = qcol + 512, vcol = qcol + 1024;
        const float coef = exp2f(-8.0f * (float)(g * 4 + hd + 1) / 12.0f) * (float)dil, scale = 0.08838834764831845f;
        const size_t rbase = (size_t)seq * T + r;
        bf16x8 Bq[8];
        { const bf16_t* qp = U + (rbase + (size_t)(m0 + l31) * dil) * ld + qcol + 8 * h;
#pragma unroll
          for (int ks = 0; ks < 8; ++ks) Bq[ks] = *(const bf16x8*)(qp + 16 * ks); }
        f32x16 st[5];
#pragma unroll
        for (int kb = 0; kb < 5; ++kb) {
            const int mk0 = m0 - 64 + 32 * kb; const bool vb = (mk0 >= 0 && mk0 < L); const int mkc = mk0 < 0 ? 0 : (mk0 >= L ? L - 32 : mk0);
            const bf16_t* kp = U + (rbase + (size_t)(mkc + l31) * dil) * ld + kcol + 8 * h;
            f32x16 s = zero16();
#pragma unroll
            for (int ks = 0; ks < 8; ++ks) s = MFMA32(*(const bf16x8*)(kp + 16 * ks), Bq[ks], s);
#pragma unroll
            for (int i = 0; i < 16; ++i) { const int rel = (mk0 + (i & 3) + 8 * (i >> 2) + 4 * h) - (m0 + l31); const int ar = rel < 0 ? -rel : rel;
                s[i] = (vb && ar <= 64) ? s[i] * scale - coef * (float)ar : -1e30f; }
            st[kb] = s;
        }
        float mxv = -1e30f;
#pragma unroll
        for (int kb = 0; kb < 5; ++kb)
#pragma unroll
            for (int i = 0; i < 16; ++i) mxv = fmaxf(mxv, st[kb][i]);
        mxv = fmaxf(mxv, shfl_xor_l(mxv, lane, 32));
        float den = 0.f;
#pragma unroll
        for (int kb = 0; kb < 5; ++kb)
#pragma unroll
            for (int i = 0; i < 16; ++i) { const float p = __expf(st[kb][i] - mxv); st[kb][i] = p; den += p; }
        den += shfl_xor_l(den, lane, 32);
        f32x16 ot[4];
#pragma unroll
        for (int dt = 0; dt < 4; ++dt) ot[dt] = zero16();
        LAS unsigned char* Vs = C.lds + C.wave * 8704;
#pragma unroll
        for (int kb = 0; kb < 5; ++kb) {
            const int mk0 = m0 - 64 + 32 * kb; const int mkc = mk0 < 0 ? 0 : (mk0 >= L ? L - 32 : mk0);
            u32x4 vr[8];
#pragma unroll
            for (int it = 0; it < 8; ++it) { const int idx = lane + 64 * it, t = idx >> 4, c8 = idx & 15; vr[it] = *(const u32x4*)(U + (rbase + (size_t)(mkc + t) * dil) * ld + vcol + c8 * 8); }
            LDSFENCE();
#pragma unroll
            for (int it = 0; it < 8; ++it) { const int idx = lane + 64 * it, t = idx >> 4, c8 = idx & 15; *(LAS u32x4*)(Vs + t * 272 + c8 * 16) = vr[it]; }
            LDSFENCE();
#pragma unroll
            for (int sp = 0; sp < 2; ++sp) {
                const bf16x8 Bp = pack8(st[kb][8 * sp + 0], st[kb][8 * sp + 1], st[kb][8 * sp + 2], st[kb][8 * sp + 3], st[kb][8 * sp + 4], st[kb][8 * sp + 5], st[kb][8 * sp + 6], st[kb][8 * sp + 7]);
#pragma unroll
                for (int dt = 0; dt < 4; ++dt) {
                    unsigned short v[8];
#pragma unroll
                    for (int j = 0; j < 8; ++j) { const int kj = 16 * sp + 8 * (j >> 2) + 4 * h + (j & 3); v[j] = *(const LAS unsigned short*)(Vs + kj * 272 + (32 * dt + l31) * 2); }
                    u32x4 w; w.x = v[0] | ((unsigned)v[1] << 16); w.y = v[2] | ((unsigned)v[3] << 16); w.z = v[4] | ((unsigned)v[5] << 16); w.w = v[6] | ((unsigned)v[7] << 16);
                    ot[dt] = MFMA32(__builtin_bit_cast(bf16x8, w), Bp, ot[dt]);
                }
            }
        }
        const float inv = 1.f / den; const size_t qrow = rbase + (size_t)(m0 + l31) * dil;
        bf16_t* op = OG + ((size_t)g * CH + qrow) * 512 + hd * 128 + 4 * h;
#pragma unroll
        for (int dt = 0; dt < 4; ++dt)
#pragma unroll
            for (int q = 0; q < 4; ++q) { u32x2 w; w.x = pk2(ot[dt][4 * q] * inv, ot[dt][4 * q + 1] * inv); w.y = pk2(ot[dt][4 * q + 2] * inv, ot[dt][4 * q + 3] * inv);
                *(u32x2*)(op + 32 * dt + 8 * q) = w; }
        if (h == 0) LSE[((size_t)g * CH + qrow) * 4 + hd] = mxv + __logf(den);
    }
}
__device__ __forceinline__ void finalize_phase(const Ctx& C, const Mix& mx) {
    const Args& a = *C.a;
    const bf16_t* __restrict__ U = (const bf16_t*)(C.ws + ARENA + A_U); bf16_t* __restrict__ MIX = (bf16_t*)(C.ws + ARENA + A_MIX);
    const f32x4* __restrict__ Of = (const f32x4*)(C.ws + ARENA + A_OEV);
    const int gw = C.bid * NWV + C.wave, NGW = C.G * NWV, lane = C.lane, ld = mx.ld, DV = mx.DV, ET = DV / 32, NE = DV / 64;
    const float* gn = mx.even ? a.in[I_HNORM] + mx.li * 512 : a.in[I_GNORM] + mx.li * 1024;
#pragma unroll 2
    for (int rg = gw; rg < CH / 4; rg += NGW) {
        const int r0 = 4 * rg, blk = r0 >> 5, t0 = r0 & 31;
        const int qf = t0 >> 3, hf = (t0 >> 2) & 1, tb = 28 - t0, qb = tb >> 3, hb2 = (tb >> 2) & 1;
#pragma unroll
        for (int hd = 0; hd < 4; ++hd) {
            float o[4][4]; float ss[4] = {0.f, 0.f, 0.f, 0.f};
#pragma unroll
            for (int k = 0; k < 4; ++k) if (k < NE) {
                const int e = lane + 64 * k, et = e >> 5;
                const u32x2* Ob2 = (const u32x2*)Of;
                const u32x2 vf_ = Ob2[(OB_IDX(hd, 0, ET, et, blk, qf >> 1) + 32 * hf + (e & 31)) * 2 + (qf & 1)], vb_ = Ob2[(OB_IDX(hd, 1, ET, et, blk, qb >> 1) + 32 * hb2 + (e & 31)) * 2 + (qb & 1)];
                o[k][0] = __uint_as_float(vf_.x << 16) + __uint_as_float(vb_.y & 0xffff0000u); o[k][1] = __uint_as_float(vf_.x & 0xffff0000u) + __uint_as_float(vb_.y << 16);
                o[k][2] = __uint_as_float(vf_.y << 16) + __uint_as_float(vb_.x & 0xffff0000u); o[k][3] = __uint_as_float(vf_.y & 0xffff0000u) + __uint_as_float(vb_.x << 16);
#pragma unroll
                for (int j = 0; j < 4; ++j) ss[j] += o[k][j] * o[k][j];
            }
#pragma unroll
            for (int j = 0; j < 4; ++j) ss[j] = rsqrtf(wave_sum(ss[j], lane) / (float)DV + EPS);
#pragma unroll
            for (int k = 0; k < 4; ++k) if (k < NE) {
                const int c = hd * DV + lane + 64 * k; const float g1 = gn[c];
#pragma unroll
                for (int j = 0; j < 4; ++j) { const float ag = bf2f(U[(size_t)(r0 + j) * ld + 2048 + c]);
                    MIX[(size_t)(r0 + j) * DM + c] = (bf16_t)(pk2(o[k][j] * ss[j] * g1 * (ag / (1.f + __expf(-ag))), 0.f) & 0xffffu); }
            }
        }
        if (mx.even) {
            const bf16_t* __restrict__ OG = (const bf16_t*)(C.ws + ARENA + A_OG); const float* __restrict__ LSE = (const float*)(C.ws + ARENA + A_LSE);
#pragma unroll
            for (int j = 0; j < 4; ++j) { const int r = r0 + j;
#pragma unroll
                for (int hd = 0; hd < 4; ++hd) { const int c = hd * 128 + 2 * lane;
                    const float l0 = LSE[((size_t)0 * CH + r) * 4 + hd], l1 = LSE[((size_t)1 * CH + r) * 4 + hd], l2 = LSE[((size_t)2 * CH + r) * 4 + hd];
                    const float m = fmaxf(l0, fmaxf(l1, l2)); float w0 = __expf(l0 - m), w1 = __expf(l1 - m), w2 = __expf(l2 - m); const float iw = 1.f / (w0 + w1 + w2);
                    w0 *= iw; w1 *= iw; w2 *= iw;
                    const unsigned v0 = *(const unsigned*)(OG + ((size_t)0 * CH + r) * 512 + c), v1 = *(const unsigned*)(OG + ((size_t)1 * CH + r) * 512 + c), v2 = *(const unsigned*)(OG + ((size_t)2 * CH + r) * 512 + c);
                    const float bx = w0 * __uint_as_float(v0 << 16) + w1 * __uint_as_float(v1 << 16) + w2 * __uint_as_float(v2 << 16);
                    const float by = w0 * __uint_as_float(v0 & 0xffff0000u) + w1 * __uint_as_float(v1 & 0xffff0000u) + w2 * __uint_as_float(v2 & 0xffff0000u);
                    *(unsigned*)(MIX + (size_t)r * DM + 512 + c) = pk2(bx, by); }
            }
        }
    }
}
#define XB_TMO      128
#define XB_XCNT(j)  (256  + 64 * (j))
#define XB_XSUB(j)  (1280 + 64 * (j))
#define XB_XGEN(j)  (2304 + 64 * (j))
#define XB_TOP      3328
#define XB_TOPGEN   3392
#define XCD_BAR_WORDS 3456
#define XB_SPIN_CAP (1u << 18)

__device__ __forceinline__ unsigned xb_ld(unsigned* p)              { return __hip_atomic_load(p, __ATOMIC_RELAXED, __HIP_MEMORY_SCOPE_AGENT); }
__device__ __forceinline__ unsigned xb_add(unsigned* p, unsigned v) { return __hip_atomic_fetch_add(p, v, __ATOMIC_RELAXED, __HIP_MEMORY_SCOPE_AGENT); }
__device__ __forceinline__ unsigned xb_xcc_id() { return (unsigned)__builtin_amdgcn_s_getreg((3 << 11) | 20) & 0xFu; }
#define XB_SPIN(cond, bar) do { unsigned _sp = 0; while (cond) { __builtin_amdgcn_s_sleep(1); \
    if ((++_sp & 255u) == 0u) { if (xb_ld(&(bar)[XB_TMO])) break; if (_sp > XB_SPIN_CAP) { atomicAdd(&(bar)[XB_TMO], 1u); break; } } } } while (0)

struct XcdBarrier {
    unsigned* bar; unsigned x;
    volatile LAS unsigned* st;
};

__device__ __forceinline__ XcdBarrier xcd_barrier_post(unsigned* bar, volatile LAS unsigned* st) {
    XcdBarrier b; b.bar = bar; b.x = xb_xcc_id(); b.st = st;
    if (threadIdx.x == 0) (void)xb_add(&bar[XB_XCNT(b.x)], 1u);
    return b;
}
__device__ __forceinline__ void xcd_barrier_complete(unsigned* bar, unsigned x, unsigned& nloc, unsigned& nx) {
    const unsigned G = gridDim.x * gridDim.y * gridDim.z;
    unsigned sum, cnt, mine, sp = 0u;
    for (;;) {
        sum = 0u; cnt = 0u; mine = 0u;
#pragma unroll
        for (unsigned j = 0; j < 16; ++j) { const unsigned c = xb_ld(&bar[XB_XCNT(j)]); sum += c; cnt += (c > 0u) ? 1u : 0u; mine = (j == x) ? c : mine; }
        if (sum == G) break;
        __builtin_amdgcn_s_sleep(1);
        if ((++sp & 255u) == 0u) { if (xb_ld(&bar[XB_TMO])) break; if (sp > XB_SPIN_CAP) { atomicAdd(&bar[XB_TMO], 1u); break; } }
    }
    nloc = mine > 0u ? mine : 1u; nx = cnt > 0u ? cnt : 1u;
}

__device__ __forceinline__ void xcd_barrier(const XcdBarrier& b) {
    asm volatile("s_waitcnt vmcnt(0)" ::: "memory");
    __syncthreads();
    if (threadIdx.x == 0) {
        unsigned* bar = b.bar;
        __builtin_amdgcn_s_waitcnt(0);
        unsigned nloc = b.st[0], nx = b.st[1];
        if (nloc == 0u) { xcd_barrier_complete(bar, b.x, nloc, nx); b.st[0] = nloc; b.st[1] = nx; }
        const unsigned old = xb_add(&bar[XB_XSUB(b.x)], 1u);
        const unsigned gen = old / nloc;
        if (old + 1u == (gen + 1u) * nloc) {
            __builtin_amdgcn_fence(__ATOMIC_RELEASE, "agent");
            asm volatile("s_waitcnt vmcnt(0)" ::: "memory");
            const unsigned og = xb_add(&bar[XB_TOP], 1u);
            const unsigned tg = og / nx;
            if (og + 1u == (tg + 1u) * nx) xb_add(&bar[XB_TOPGEN], 1u);
            else XB_SPIN(xb_ld(&bar[XB_TOPGEN]) == tg, bar);
            __builtin_amdgcn_fence(__ATOMIC_ACQUIRE, "agent");
            xb_add(&bar[XB_XGEN(b.x)], 1u);
            asm volatile("s_waitcnt vmcnt(0)" ::: "memory");
        } else {
            XB_SPIN(xb_ld(&bar[XB_XGEN(b.x)]) == gen, bar);
            __builtin_amdgcn_fence(__ATOMIC_ACQUIRE, "agent");
            asm volatile("s_waitcnt vmcnt(0)" ::: "memory");
        }
    }
    __syncthreads();
}
#define PHASE_BEGIN() do { int t_ = threadIdx.x; asm volatile("" : "+v"(t_)); C.tid = t_; C.lane = t_ & 63; C.wave = __builtin_amdgcn_readfirstlane(t_ >> 6); \
    int b_ = blockIdx.x; asm volatile("" : "+s"(b_)); C.bid = b_; unsigned char* w_ = args.ws; asm volatile("" : "+s"(w_)); C.ws = w_; ws = w_; \
    hb_c = (bf16_t*)(ws + (s ? B_HB1 : B_HB0)); hb_n = (bf16_t*)(ws + (s ? B_HB0 : B_HB1)); sq_c = (float*)(ws + (s ? B_SSQ1 : B_SSQ0)); sq_n = (float*)(ws + (s ? B_SSQ0 : B_SSQ1)); Ub = (bf16_t*)(ws + ARENA + A_U); MIXb = (bf16_t*)(ws + ARENA + A_MIX); \
    hch = args.out + (size_t)chunk * CH * DM; } while (0)
__global__ void __launch_bounds__(NT, 2) fwd_mega(Args args) {
    extern __shared__ __attribute__((aligned(16))) unsigned char lds_raw[];
    cg::grid_group grid = cg::this_grid();
    Ctx C; C.lds = (LAS unsigned char*)lds_raw; C.tid = threadIdx.x; C.lane = C.tid & 63; C.wave = __builtin_amdgcn_readfirstlane(C.tid >> 6);
    C.G = gridDim.x; C.bid = blockIdx.x; C.a = &args; C.ws = args.ws;
    unsigned char* ws = args.ws;
    bf16_t *hb_c, *hb_n; float *sq_c, *sq_n; bf16_t *Ub, *MIXb;
    if (blockIdx.x == 0) for (int i = threadIdx.x; i < XCD_BAR_WORDS; i += NT) ((unsigned*)args.ws)[i] = 0u;
    if (threadIdx.x < 2) ((volatile LAS unsigned*)(C.lds + LDS_BYTES - 256))[threadIdx.x] = 0u;
    weights_prologue(C);
    __syncthreads();
    grid.sync();
    XcdBarrier bar = xcd_barrier_post((unsigned*)args.ws, (volatile LAS unsigned*)(C.lds + LDS_BYTES - 256));
    float* hch;
#ifdef PROBE_A
    unsigned tacc[12];
#pragma unroll
    for (int i = 0; i < 12; ++i) tacc[i] = 0u;
    unsigned long long tprev = __builtin_amdgcn_s_memrealtime();
#define TICK(k) do { const unsigned long long now_ = __builtin_amdgcn_s_memrealtime(); tacc[k] += (unsigned)(now_ - tprev); tprev = now_; } while (0)
#else
#define TICK(k) do {} while (0)
#endif
#pragma nounroll
    for (int chunk = 0; chunk < NCHUNK; ++chunk) {
        const int T = chunk == 0 ? 4096 : 2048; int s = 0;
        PHASE_BEGIN();
        chunk_prologue(C, chunk, hb_c, sq_c);
        xcd_barrier(bar); TICK(10);
#pragma nounroll
        for (int l = 0; l < DEPTH; ++l) {
            const int even = (l & 1) == 0, li = l >> 1;
            Mix mx; mx.even = even; mx.li = li; mx.T = T; mx.DV = even ? 128 : 256; mx.ld = even ? EV_IN : OD_INP; mx.vcol = even ? 1536 : 1024; mx.gcol = 2048; mx.qscale = even ? 1.f : 0.08838834764831845f; mx.vf = nullptr;
            PHASE_BEGIN();
            {
                const int N = even ? EV_IN : OD_INP;
                const bf16_t* Wt = even ? (const bf16_t*)(ws + W_EVIN) + (size_t)li * EV_IN * DM : (const bf16_t*)(ws + W_ODIN) + (size_t)li * OD_INP * DM;
                pg8::Gemm g{hb_c, Wt, CH, N, DM, 256}; pg8::StaticOrder S; S.init(CH, N, C.G, C.bid);
                EpiScale E{Ub, N, sq_c};
                pg8::gemm_phase<EpiScale, pg8::StaticOrder, true, true>(C.lds, g, S, E);
            }
            xcd_barrier(bar); TICK(1);
            PHASE_BEGIN(); mx.vf = even ? (unsigned char*)hb_n : ws + ARENA + A_VFOD;
#ifndef NO_PREP
            prep_phase(C, mx);
#endif
            TICK(2);
            PHASE_BEGIN();
#ifndef NO_ATTN
            if (even) attn_phase(C, T);
#endif
            TICK(7);
            xcd_barrier(bar); TICK(0);
            PHASE_BEGIN(); mx.vf = even ? (unsigned char*)hb_n : ws + ARENA + A_VFOD;
#ifndef NO_SCAN
            scan_phase(C, mx);
#endif
            xcd_barrier(bar); TICK(3);
            PHASE_BEGIN();
#ifndef NO_FIN
            finalize_phase(C, mx);
#endif
            pb_convert(C, chunk, l);
            xcd_barrier(bar); TICK(4);
            PHASE_BEGIN();
            {
                const bf16_t* Wt = even ? (const bf16_t*)(ws + W_EVOUT) + (size_t)li * DM * DM : (const bf16_t*)(ws + W_ODOUT) + (size_t)li * DM * DM;
                pg8::Gemm g{MIXb, Wt, CH, DM, DM, 256}; pg8::StaticOrder S; S.init(CH, DM, C.G, C.bid);
                EpiResid<0> E{hch, hb_n, sq_n, nullptr, nullptr};
                pg8::gemm_phase<EpiResid<0>, pg8::StaticOrder, true, true>(C.lds, g, S, E);
                s ^= 1;
            }
            xcd_barrier(bar); TICK(5);
            PHASE_BEGIN();
            {
                pg8::Gemm g{hb_c - DM, (const bf16_t*)(ws + W_UP) + (size_t)l * 2 * DFF * DM, 65 * 256, 2 * DFF, DM, 254}; pg8::StaticOrder S; S.init(65 * 256, 2 * DFF, C.G, C.bid);
                EpiConv E{(bf16_t*)(ws + ARENA + A_ACT), sq_c, args.in[I_CW] + (size_t)l * 3 * 2 * DFF, args.in[I_CB] + (size_t)l * 2 * DFF, T, (LAS float*)(C.lds + 131072)};
                pg8::gemm_phase<EpiConv, pg8::StaticOrder, true, true>(C.lds, g, S, E);
            }
            {
                const int rem = (65 * 22) % C.G, c0 = rem, gs = rem ? C.G - rem : C.G;
                if (C.bid >= c0) {
                    PHASE_BEGIN();
                    pg8::Gemm g2{(const bf16_t*)(ws + B_PB), (const bf16_t*)(ws + W_PROJ) + (size_t)l * DM * PLE, CH, DM, PLE, 256}; pg8::StaticOrder S2; S2.init(CH, DM, gs, C.bid - c0);
                    EpiF32 E2{(bf16_t*)(ws + ARENA + A_PP), DM};
                    pg8::gemm_phase<EpiF32, pg8::StaticOrder, true, true>(C.lds, g2, S2, E2);
                }
            }
            xcd_barrier(bar); TICK(6);
            PHASE_BEGIN();
            {
                pg8::Gemm g{(const bf16_t*)(ws + ARENA + A_ACT), (const bf16_t*)(ws + W_DOWN) + (size_t)l * DM * DFF, CH, DM, DFF, 256}; pg8::StaticOrder S; S.init(CH, DM, C.G, C.bid);
                EpiResid<0> E{hch, hb_n, sq_n, nullptr, nullptr};
                pg8::gemm_phase<EpiResid<0>, pg8::StaticOrder, true, true>(C.lds, g, S, E);
                s ^= 1;
            }
            xcd_barrier(bar); TICK(8);
            PHASE_BEGIN();
            {
                pg8::Gemm g{hb_c, (const bf16_t*)(ws + W_GATE) + (size_t)l * DM * DM, CH, DM, DM, 256}; pg8::StaticOrder S; S.init(CH, DM, C.G, C.bid);
                EpiResid<1> E{hch, hb_n, sq_n, sq_c, (const bf16_t*)(ws + ARENA + A_PP)};
                pg8::gemm_phase<EpiResid<1>, pg8::StaticOrder, true, true>(C.lds, g, S, E);
                s ^= 1;
            }
            xcd_barrier(bar); TICK(9);
        }
        PHASE_BEGIN();
        final_norm(C, chunk);
        TICK(10);
    }
#ifdef PROBE_A
    xcd_barrier(bar); TICK(10);
    for (int i = 0; i < 100; ++i) xcd_barrier(bar);
    TICK(11);
    if (blockIdx.x == 0) {
        const float x1 = 8.f + (float)tacc[PROBE_A] * 1e-5f, t2 = 0.1f * (float)tacc[PROBE_B] * 1e-5f;
        float* o0 = args.out; float* o1 = args.out + (size_t)16384 * 1024;
        if (threadIdx.x == 0) { o0[0] += x1; o1[0] += x1; o1[1] += x1; }
        for (int i = threadIdx.x; i < 8192; i += NT) o0[1024 + i] += t2;
        for (int i = threadIdx.x; i < 16384; i += NT) o1[1024 + i] += t2;
    }
#endif
}
extern "C" void kernel_launch(void* const* d_in, const int* in_sizes, int n_in, void* d_out, int out_size, void* d_ws, size_t ws_size, hipStream_t stream) {
    static int grid = 0;
    if (grid == 0) {
        int dev = 0, cus = 0, per = 0;
        (void)hipGetDevice(&dev); (void)hipDeviceGetAttribute(&cus, hipDeviceAttributeMultiprocessorCount, dev);
        (void)hipFuncSetAttribute((const void*)fwd_mega, hipFuncAttributeMaxDynamicSharedMemorySize, LDS_BYTES);
        (void)hipOccupancyMaxActiveBlocksPerMultiprocessor(&per, (const void*)fwd_mega, NT, LDS_BYTES);
        if (per < 1) per = 1;
        grid = cus * per;
        fprintf(stderr, "kernel_launch: grid %d (cus %d x %d), ws %zu need %zu\n", grid, cus, per, ws_size, (size_t)WS_NEED);
        if (n_in != 23 || ws_size < WS_NEED) { fprintf(stderr, "kernel_launch: bad inputs / workspace too small\n"); grid = -1; }
    }
    if (grid < 0) return;
    Args a{};
    for (int i = 0; i < 23; ++i) a.in[i] = (const float*)d_in[i];
    a.out = (float*)d_out; a.ws = (unsigned char*)d_ws; a.ph_lo = 0; a.ph_hi = 0;
    void* kargs[] = {&a};
    hipError_t e = hipLaunchCooperativeKernel((const void*)fwd_mega, dim3(grid), dim3(NT), kargs, LDS_BYTES, stream);
    if (e != hipSuccess) fprintf(stderr, "kernel_launch: cooperative launch failed: %s\n", hipGetErrorString(e));
}
```

```cpp
#include <hip/hip_runtime.h>
#include <hip/hip_cooperative_groups.h>
#include <cstdio>
#include <cstdint>
namespace cg = cooperative_groups;
namespace pg8 {
#define PG8_LAS __attribute__((address_space(3)))
typedef unsigned short bf16_t;
typedef short bf16x8 __attribute__((ext_vector_type(8)));
typedef float f32x4 __attribute__((ext_vector_type(4)));
typedef unsigned u32x4 __attribute__((ext_vector_type(4)));
constexpr int BM = 256, BK = 64, HALF = 128, HTB = HALF * BK * 2  , STAGE_BYTES = 8 * HTB, NXCD = 8, WGM = 8;

__host__ __device__ __forceinline__ int lds_byte(int r, int c) { const int st = (r >> 4) * 2 + (c >> 5), rr = r & 15, cc = c & 31, ob = rr * 64 + cc * 2; return st * 1024 + (ob ^ (((ob >> 9) & 1) << 5)); }
__host__ __device__ __forceinline__ void stage_rc(int b, int& R, int& C) { const int st = b / 1024, sb = b % 1024, swz = sb ^ (((sb >> 9) & 1) << 5); R = (st >> 1) * 16 + swz / 64; C = (st & 1) * 32 + (swz % 64) / 2; }
__host__ __device__ __forceinline__ int perm32(int rho) { const int n = rho >> 4, i = rho & 15; return 8 * (i >> 2) + 4 * n + (i & 3); }

struct Unit { int pm, pn; };
struct Gemm { const bf16_t* A; const bf16_t* Bt; int M, N, K; int arows; };

struct StaticOrder {
    int nM, nN, nwg, G, c;
    __host__ __device__ void init(int M, int N, int G_, int c_) { nM = M / BM; nN = N / BM; nwg = nM * nN; G = G_; c = c_; }
    __host__ __device__ bool next(int i, Unit& u) const {
        const long L = (long)i * G + c; if (L >= nwg) return false;
        int wgid = (int)L; { const int q = nwg / NXCD, r = nwg % NXCD, xcd = wgid % NXCD, off = wgid / NXCD; wgid = (xcd < r ? xcd * (q + 1) : r * (q + 1) + (xcd - r) * q) + off; }
        const int nig = WGM * nN, gid = wgid / nig, fm = gid * WGM, gsz = (nM - fm) < WGM ? (nM - fm) : WGM;
        u.pm = fm + ((wgid % nig) % gsz); u.pn = (wgid % nig) / gsz; return true;
    }
    __device__ __forceinline__ void a_ready(const Unit&) const {}
    __device__ __forceinline__ void done(const Unit&) const {}
};

__device__ __forceinline__ unsigned cvt_pk_bf16(float lo, float hi) { unsigned r; asm volatile("v_cvt_pk_bf16_f32 %0, %1, %2" : "=v"(r) : "v"(lo), "v"(hi)); return r; }
typedef float f32x2 __attribute__((ext_vector_type(2)));
__device__ __forceinline__ f32x2 gelu_pk(f32x2 v) {
    const f32x2 av = __builtin_elementwise_abs(v), d = av * 0.2316418882f + 1.0f;
    f32x2 t; t.x = __builtin_amdgcn_rcpf(d.x); t.y = __builtin_amdgcn_rcpf(d.y);
    f32x2 q = t * 0.5307027145f + (-0.7265760135f); q = q * t + 0.7107068705f; q = q * t + (-0.142248368f); q = q * t + 0.127414796f; q = q * t;
    const f32x2 s = (v * v) * (-0.72134752044f);
    f32x2 e; e.x = __builtin_amdgcn_exp2f(s.x); e.y = __builtin_amdgcn_exp2f(s.y);
    const f32x2 m = v * (q * e), r = v - m;
    f32x2 o; o.x = v.x < 0.f ? m.x : r.x; o.y = v.y < 0.f ? m.y : r.y; return o;
}

template <int ACT  > struct EpiBf16 {
    static constexpr bool PERM = true, AFTER_DRAIN = false; static_assert(ACT == 0 || ACT == 1, "EpiBf16: ACT is 0 (none) or 1 (gelu_pk)");
    bf16_t* O; int ldc; const float* bias; int split_cols; size_t split_stride; float scale0;
    __device__ __forceinline__ void operator()(const f32x4 (&acc)[2][2][4][2], const Unit& u, int wr, int wc, int fr, int fq) const {
        const int row0 = u.pm * BM + wr * 64 + fr; int colt = u.pn * BM; bf16_t* base = O;
        float sc = 1.f; if (split_cols) { const int t = colt / split_cols; base += (size_t)t * split_stride; colt -= t * split_cols; if (t == 0) sc = scale0; }
        const int col0 = colt + wc * 32 + 8 * fq, bcol0 = u.pn * BM + wc * 32 + 8 * fq;
        f32x4 bv[2][2];
#pragma unroll
        for (int bj = 0; bj < 2; ++bj)
#pragma unroll
            for (int n = 0; n < 2; ++n) bv[bj][n] = bias ? *(const f32x4*)(bias + bcol0 + bj * HALF + 4 * n) : (f32x4){0.f, 0.f, 0.f, 0.f};
#pragma unroll
        for (int ai = 0; ai < 2; ++ai)
#pragma unroll
            for (int m = 0; m < 4; ++m) { bf16_t* rowp = base + (size_t)(row0 + ai * HALF + m * 16) * ldc + col0;
#pragma unroll
                for (int bj = 0; bj < 2; ++bj) { f32x4 v0 = acc[ai][bj][m][0] + bv[bj][0], v1 = acc[ai][bj][m][1] + bv[bj][1];
                    if (ACT == 1) { f32x2 a = gelu_pk((f32x2){v0[0], v0[1]}), b = gelu_pk((f32x2){v0[2], v0[3]}), c = gelu_pk((f32x2){v1[0], v1[1]}), d = gelu_pk((f32x2){v1[2], v1[3]});
                        v0 = (f32x4){a.x, a.y, b.x, b.y}; v1 = (f32x4){c.x, c.y, d.x, d.y}; }
                    v0 = v0 * sc; v1 = v1 * sc; u32x4 w; w.x = cvt_pk_bf16(v0[0], v0[1]); w.y = cvt_pk_bf16(v0[2], v0[3]); w.z = cvt_pk_bf16(v1[0], v1[1]); w.w = cvt_pk_bf16(v1[2], v1[3]);
                    *(u32x4*)(rowp + bj * HALF) = w; } }
    }
};
template <class Epi, class Sched, bool ALIGN_EPI = false, bool SP2 = false>
__device__ __forceinline__ void gemm_phase(PG8_LAS unsigned char* lds, const Gemm g, const Sched& S, const Epi& E) {
    int tid_ = threadIdx.x; asm volatile("" : "+v"(tid_)); const int tid = tid_, wid = __builtin_amdgcn_readfirstlane(tid >> 6), lane = tid & 63, wr = wid >> 2, wc = wid & 3, fr = lane & 15, fq = lane >> 4;
    int K_ = g.K; asm volatile("" : "+s"(K_)); const int K = K_, nt = K / BK;
    unsigned voffA[2], voffB[2];
#pragma unroll
    for (int i = 0; i < 2; ++i) { int R, C; stage_rc(tid * 16 + i * 8192, R, C); const int Rb = Epi::PERM ? ((R & ~31) + perm32(R & 31)) : R;
        voffA[i] = (unsigned)(R * K + C) * 2u; voffB[i] = (unsigned)(Rb * K + C) * 2u; }
    const size_t kstep = (size_t)(BK * 2);
    const size_t hstep = (size_t)HALF * K * 2;
    const size_t tstep = 2 * hstep; const size_t tstepA = (size_t)g.arows * K * 2;
    const unsigned ldsw = (unsigned)wid * 1024u;
    const int aoff = lds_byte(wr * 64 + fr, fq * 8), boff = lds_byte(wc * 32 + fr, fq * 8);
#define PG8_SA(b, h) (((b) * 2 + (h)) * HTB)
#define PG8_SB(b, h) ((4 + (b) * 2 + (h)) * HTB)
#define PG8_STAGE(bufoff, gbase, voff) do { _Pragma("unroll") for (int _i = 0; _i < 2; ++_i) \
        __builtin_amdgcn_global_load_lds((const unsigned*)((const char*)(gbase) + (voff)[_i]), (PG8_LAS unsigned*)(lds + (bufoff) + ldsw + _i * 8192), 16, 0, 0); } while (0)
#define PG8_LDA(dst, b, h) do { _Pragma("unroll") for (int m = 0; m < 4; ++m) _Pragma("unroll") for (int k = 0; k < 2; ++k) dst[m][k] = *(const PG8_LAS bf16x8*)(lds + PG8_SA(b, h) + aoff + m * 2048 + k * 1024); } while (0)
#define PG8_LDB(dst, b, h) do { _Pragma("unroll") for (int n = 0; n < 2; ++n) _Pragma("unroll") for (int k = 0; k < 2; ++k) dst[n][k] = *(const PG8_LAS bf16x8*)(lds + PG8_SB(b, h) + boff + n * 2048 + k * 1024); } while (0)
#define PG8_MMA(ai, bj, At, Bt) do { __builtin_amdgcn_s_setprio(1); _Pragma("unroll") for (int m = 0; m < 4; ++m) _Pragma("unroll") for (int n = 0; n < 2; ++n) _Pragma("unroll") for (int k = 0; k < 2; ++k) \
        acc[ai][bj][m][n] = __builtin_amdgcn_mfma_f32_16x16x32_bf16(Bt[n][k], At[m][k], acc[ai][bj][m][n], 0, 0, 0); __builtin_amdgcn_s_setprio(0); } while (0)
#define PG8_WAIT_V(n) asm volatile("s_waitcnt vmcnt(" #n ")" ::: "memory")
#define PG8_WAIT_L(n) asm volatile("s_waitcnt lgkmcnt(" #n ")" ::: "memory")
#define PG8_BAR __builtin_amdgcn_s_barrier()
#define PG8_SCHED __builtin_amdgcn_sched_barrier(0)
    Unit cur, nxt; int ui = 0;
    if (!S.next(0, cur)) return;
    f32x4 acc[2][2][4][2];
#pragma unroll
    for (int a = 0; a < 2; ++a)
#pragma unroll
        for (int b = 0; b < 2; ++b)
#pragma unroll
            for (int m = 0; m < 4; ++m)
#pragma unroll
                for (int n = 0; n < 2; ++n) acc[a][b][m][n] = (f32x4){0.f, 0.f, 0.f, 0.f};
    bf16x8 At[4][2], B0[2][2], B1[2][2];
    const char* cA = (const char*)g.A + (size_t)cur.pm * tstepA; const char* cB = (const char*)g.Bt + (size_t)cur.pn * tstep;
    S.a_ready(cur);
    if constexpr (SP2) {
        PG8_STAGE(PG8_SB(0, 0), cB, voffB); PG8_STAGE(PG8_SB(0, 1), cB + hstep, voffB); PG8_STAGE(PG8_SA(0, 0), cA, voffA); PG8_STAGE(PG8_SA(0, 1), cA + hstep, voffA);
        if (wr == 1) PG8_BAR;
        PG8_WAIT_V(2); PG8_BAR;
        PG8_STAGE(PG8_SB(1, 0), cB + kstep, voffB); PG8_STAGE(PG8_SA(1, 0), cA + kstep, voffA); PG8_STAGE(PG8_SB(1, 1), cB + hstep + kstep, voffB);
        PG8_WAIT_V(6); PG8_BAR;
    } else {
        PG8_STAGE(PG8_SB(0, 0), cB, voffB); PG8_STAGE(PG8_SA(0, 0), cA, voffA); PG8_STAGE(PG8_SB(0, 1), cB + hstep, voffB); PG8_STAGE(PG8_SA(0, 1), cA + hstep, voffA);
        if (wr == 1) PG8_BAR;
        PG8_WAIT_V(4); PG8_BAR;
        PG8_STAGE(PG8_SB(1, 0), cB + kstep, voffB); PG8_STAGE(PG8_SA(1, 0), cA + kstep, voffA); PG8_STAGE(PG8_SB(1, 1), cB + hstep + kstep, voffB);
        PG8_WAIT_V(6); PG8_BAR;
    }
    for (;;) {
        const bool has_next = S.next(ui + 1, nxt);
        const char* nA = has_next ? (const char*)g.A + (size_t)nxt.pm * tstepA : cA; const char* nB = has_next ? (const char*)g.Bt + (size_t)nxt.pn * tstep : cB;
        for (int t = 0; t < nt; t += 2) {
            const bool last = (t == nt - 2);
            const char* a1 = cA + (size_t)(t + 1) * kstep;
            const char* a2 = last ? nA : cA + (size_t)(t + 2) * kstep; const char* b2 = last ? nB : cB + (size_t)(t + 2) * kstep;
            const char* a3 = a2 + kstep; const char* b3 = b2 + kstep;
            if (last && has_next) S.a_ready(nxt);
            if constexpr (SP2) {
            PG8_LDB(B0, 0, 0); PG8_LDB(B1, 0, 1); PG8_SCHED; PG8_LDA(At, 0, 0); PG8_STAGE(PG8_SA(1, 1), a1 + hstep, voffA);
            PG8_WAIT_V(8); PG8_WAIT_L(0); PG8_BAR; PG8_MMA(0, 0, At, B0); PG8_MMA(0, 1, At, B1); PG8_BAR; PG8_SCHED;
            PG8_LDA(At, 0, 1); PG8_STAGE(PG8_SB(0, 0), b2, voffB); PG8_STAGE(PG8_SB(0, 1), b2 + hstep, voffB); PG8_STAGE(PG8_SA(0, 0), a2, voffA);
            PG8_WAIT_V(8); PG8_WAIT_L(0); PG8_BAR; PG8_MMA(1, 0, At, B0); PG8_MMA(1, 1, At, B1); PG8_BAR; PG8_SCHED;
            PG8_LDB(B0, 1, 0); PG8_LDB(B1, 1, 1); PG8_SCHED; PG8_LDA(At, 1, 0); PG8_STAGE(PG8_SA(0, 1), a2 + hstep, voffA);
            PG8_WAIT_V(8); PG8_WAIT_L(0); PG8_BAR; PG8_MMA(0, 0, At, B0); PG8_MMA(0, 1, At, B1); PG8_BAR; PG8_SCHED;
            PG8_LDA(At, 1, 1); PG8_STAGE(PG8_SB(1, 0), b3, voffB); PG8_STAGE(PG8_SB(1, 1), b3 + hstep, voffB); PG8_STAGE(PG8_SA(1, 0), a3, voffA);
            PG8_WAIT_V(8); PG8_WAIT_L(0); PG8_BAR; PG8_MMA(1, 0, At, B0); PG8_MMA(1, 1, At, B1); PG8_BAR; PG8_SCHED;
            } else {
            PG8_LDB(B0, 0, 0); PG8_SCHED; PG8_LDA(At, 0, 0); PG8_STAGE(PG8_SA(1, 1), a1 + hstep, voffA);
            PG8_WAIT_L(8); PG8_BAR; PG8_WAIT_L(0); PG8_MMA(0, 0, At, B0); PG8_BAR; PG8_SCHED;
            PG8_LDB(B1, 0, 1); PG8_STAGE(PG8_SB(0, 0), b2, voffB);
            PG8_BAR; PG8_WAIT_L(0); PG8_MMA(0, 1, At, B1); PG8_BAR;
            PG8_LDA(At, 0, 1); PG8_STAGE(PG8_SA(0, 0), a2, voffA);
            PG8_BAR; PG8_WAIT_L(0); PG8_MMA(1, 0, At, B0); PG8_BAR; PG8_SCHED;
            PG8_STAGE(PG8_SB(0, 1), b2 + hstep, voffB);
            PG8_WAIT_V(6); PG8_BAR; PG8_MMA(1, 1, At, B1); PG8_BAR;
            PG8_LDB(B0, 1, 0); PG8_SCHED; PG8_LDA(At, 1, 0); PG8_STAGE(PG8_SA(0, 1), a2 + hstep, voffA);
            PG8_WAIT_L(8); PG8_BAR; PG8_WAIT_L(0); PG8_MMA(0, 0, At, B0); PG8_BAR; PG8_SCHED;
            PG8_LDB(B1, 1, 1); PG8_STAGE(PG8_SB(1, 0), b3, voffB);
            PG8_BAR; PG8_WAIT_L(0); PG8_MMA(0, 1, At, B1); PG8_BAR;
            PG8_LDA(At, 1, 1); PG8_STAGE(PG8_SA(1, 0), a3, voffA);
            PG8_BAR; PG8_WAIT_L(0); PG8_MMA(1, 0, At, B0); PG8_BAR; PG8_SCHED;
            PG8_STAGE(PG8_SB(1, 1), b3 + hstep, voffB);
            PG8_WAIT_V(6); PG8_BAR; PG8_MMA(1, 1, At, B1); PG8_BAR;
            }
        }
        if constexpr (ALIGN_EPI) { if (wr == 0) PG8_BAR; }
        if constexpr (!Epi::AFTER_DRAIN) { E(acc, cur, wr, wc, fr, fq); S.done(cur); }
        if (!has_next) break;
#pragma unroll
        for (int a = 0; a < 2; ++a)
#pragma unroll
            for (int b = 0; b < 2; ++b)
#pragma unroll
                for (int m = 0; m < 4; ++m)
#pragma unroll
                    for (int n = 0; n < 2; ++n) acc[a][b][m][n] = (f32x4){0.f, 0.f, 0.f, 0.f};
        cur = nxt; cA = nA; cB = nB; ++ui;
        if constexpr (ALIGN_EPI) { if (wr == 1) PG8_BAR; }
    }
    PG8_WAIT_V(0);
    if constexpr (!ALIGN_EPI) { if (wr == 0) PG8_BAR; }
    PG8_BAR;
    if constexpr (Epi::AFTER_DRAIN) { E.fused(acc, cur, wr, wc, fr, fq, lds, wid, lane); S.done(cur); }
#undef PG8_SA
#undef PG8_SB
#undef PG8_STAGE
#undef PG8_LDA
#undef PG8_LDB
#undef PG8_MMA
#undef PG8_WAIT_V
#undef PG8_WAIT_L
#undef PG8_BAR
#undef PG8_SCHED
}
}
typedef unsigned short bf16_t;
typedef short bf16x8 __attribute__((ext_vector_type(8)));
typedef float f32x4 __attribute__((ext_vector_type(4)));
typedef float f32x2 __attribute__((ext_vector_type(2)));
typedef float f32x16 __attribute__((ext_vector_type(16)));
typedef unsigned u32x4 __attribute__((ext_vector_type(4)));
typedef unsigned u32x2 __attribute__((ext_vector_type(2)));
#define LAS __attribute__((address_space(3)))
constexpr int DM = 1024, CH = 16384, NCHUNK = 3, DEPTH = 4, PLE = 256, DFF = 2816;
constexpr int EV_IN = 7168, OD_IN = 3104, OD_INP = 3328;
constexpr float EPS = 1e-6f;
constexpr int NT = 512, NWV = 8;
constexpr int LDS_BYTES = 147456;
constexpr size_t al256(size_t x) { return (x + 255) & ~(size_t)255; }
constexpr size_t W_EVIN = 65536;
constexpr size_t W_EVOUT = W_EVIN + (size_t)2 * EV_IN * DM * 2;
constexpr size_t W_ODIN = W_EVOUT + (size_t)2 * DM * DM * 2;
constexpr size_t W_ODOUT = W_ODIN + (size_t)2 * OD_INP * DM * 2;
constexpr size_t W_UP = W_ODOUT + (size_t)2 * DM * DM * 2;
constexpr size_t W_DOWN = W_UP + (size_t)4 * 2 * DFF * DM * 2;
constexpr size_t W_GATE = W_DOWN + (size_t)4 * DM * DFF * 2;
constexpr size_t W_PROJ = W_GATE + (size_t)4 * DM * DM * 2;
constexpr size_t W_LB = W_PROJ + (size_t)4 * DM * PLE * 2;
constexpr size_t B_PB = W_LB + 8192;
constexpr size_t B_HB0 = B_PB + (size_t)CH * PLE * 2;
constexpr size_t B_HB1 = B_HB0 + (size_t)CH * DM * 2;
constexpr size_t B_SSQ0 = B_HB1 + (size_t)CH * DM * 2;
constexpr size_t B_SSQ1 = B_SSQ0 + (size_t)CH * 16 * 4;
constexpr size_t ARENA = B_SSQ1 + (size_t)CH * 16 * 4;
constexpr size_t A_U = 0;
constexpr size_t A_QT = (size_t)CH * EV_IN * 2;
constexpr size_t A_KT = A_QT + (size_t)2 * CH * 512 * 2;
constexpr size_t A_MIX = A_QT;
constexpr size_t A_OEV = A_KT + (size_t)2 * CH * 512 * 2;
constexpr size_t A_VFOD = (size_t)CH * OD_INP * 2;
constexpr size_t A_OOD = A_OEV;
constexpr size_t A_OG = A_OEV + (size_t)2 * CH * 512 * 4;
constexpr size_t A_LSE = A_OG + (size_t)3 * CH * 512 * 2;
constexpr size_t A_DEC = A_OOD + (size_t)2 * CH * 1024 * 4;
constexpr size_t ARENA_BYTES = A_DEC + (size_t)512 * 4 * 2 * 128 * 4;
constexpr size_t A_UF = 0;
constexpr size_t A_ACT = (size_t)CH * 2 * DFF * 2;
constexpr size_t A_PP = 0;
constexpr size_t WS_NEED = ARENA + ARENA_BYTES;
static_assert(A_LSE + (size_t)3 * CH * 4 * 4 <= A_DEC, "even bufs before DEC");
static_assert(A_VFOD + (size_t)CH * 1024 * 2 * 2 <= A_QT, "odd Vf fits before QT");
static_assert(A_ACT + (size_t)CH * DFF * 2 <= ARENA_BYTES, "act fits");

__device__ __forceinline__ float bf2f(unsigned short v) { return __uint_as_float(((unsigned)v) << 16); }
__device__ __forceinline__ unsigned pk2(float lo, float hi) { return pg8::cvt_pk_bf16(lo, hi); }
typedef float f32x2_cv __attribute__((ext_vector_type(2))); typedef __bf16 bf16x2_cv __attribute__((ext_vector_type(2)));
__device__ __forceinline__ unsigned pk2s(float lo, float hi) { const f32x2_cv v = {lo, hi}; const bf16x2_cv c = __builtin_convertvector(v, bf16x2_cv); return __builtin_bit_cast(unsigned, c); }
__device__ __forceinline__ float shfl_xor_l(float v, int lane, int m) { return __builtin_bit_cast(float, __builtin_amdgcn_ds_bpermute((lane ^ m) << 2, __builtin_bit_cast(int, v))); }
__device__ __forceinline__ float wave_sum(float v, int lane) {
#pragma unroll
    for (int o = 1; o < 64; o <<= 1) v += shfl_xor_l(v, lane, o);
    return v;
}
__device__ __forceinline__ float rstd_of(const float* ssq, int row) {
    const f32x4* p = (const f32x4*)(ssq + (size_t)row * 16);
    const f32x4 a = p[0], b = p[1], c = p[2], d = p[3];
    const float s = ((a.x + a.y) + (a.z + a.w)) + ((b.x + b.y) + (b.z + b.w)) + ((c.x + c.y) + (c.z + c.w)) + ((d.x + d.y) + (d.z + d.w));
    return rsqrtf(s * (1.0f / DM) + EPS);
}
struct EpiScale {
    static constexpr bool PERM = true, AFTER_DRAIN = false;
    bf16_t* O; int ldc; const float* ssq;
    __device__ __forceinline__ void operator()(const f32x4 (&acc)[2][2][4][2], const pg8::Unit& u, int wr, int wc, int fr, int fq) const {
        const int row0 = u.pm * 256 + wr * 64 + fr, col0 = u.pn * 256 + wc * 32 + 8 * fq;
#pragma unroll
        for (int ai = 0; ai < 2; ++ai)
#pragma unroll
            for (int m = 0; m < 4; ++m) {
                const int row = row0 + ai * 128 + m * 16; const float rs = rstd_of(ssq, row);
                bf16_t* rp = O + (size_t)row * ldc + col0;
#pragma unroll
                for (int bj = 0; bj < 2; ++bj) { const f32x4 v0 = acc[ai][bj][m][0] * rs, v1 = acc[ai][bj][m][1] * rs;
                    u32x4 w; w.x = pk2(v0[0], v0[1]); w.y = pk2(v0[2], v0[3]); w.z = pk2(v1[0], v1[1]); w.w = pk2(v1[2], v1[3]);
                    *(u32x4*)(rp + bj * 128) = w; }
            }
    }
};
struct EpiF32 {
    static constexpr bool PERM = true, AFTER_DRAIN = false;
    bf16_t* O; int ldc;
    __device__ __forceinline__ void operator()(const f32x4 (&acc)[2][2][4][2], const pg8::Unit& u, int wr, int wc, int fr, int fq) const {
        const int row0 = u.pm * 256 + wr * 64 + fr, col0 = u.pn * 256 + wc * 32 + 8 * fq;
#pragma unroll
        for (int ai = 0; ai < 2; ++ai)
#pragma unroll
            for (int m = 0; m < 4; ++m) { bf16_t* rp = O + (size_t)(row0 + ai * 128 + m * 16) * ldc + col0;
#pragma unroll
                for (int bj = 0; bj < 2; ++bj) { const f32x4 v0 = acc[ai][bj][m][0], v1 = acc[ai][bj][m][1];
                    u32x4 w; w.x = pk2s(v0[0], v0[1]); w.y = pk2s(v0[2], v0[3]); w.z = pk2s(v1[0], v1[1]); w.w = pk2s(v1[2], v1[3]);
                    *(u32x4*)(rp + bj * 128) = w; } }
    }
};
template <int MODE  > struct EpiResid {
    static constexpr bool PERM = true, AFTER_DRAIN = false;
    float* h; bf16_t* hb; float* ssq_out; const float* ssq_in; const bf16_t* pp;
    __device__ __forceinline__ void operator()(const f32x4 (&acc)[2][2][4][2], const pg8::Unit& u, int wr, int wc, int fr, int fq) const {
        const int row0 = u.pm * 256 + wr * 64 + fr, col0 = u.pn * 256 + wc * 32 + 8 * fq;
#pragma unroll
        for (int ai = 0; ai < 2; ++ai)
#pragma unroll
            for (int m = 0; m < 4; ++m) {
                const int row = row0 + ai * 128 + m * 16; float rs = 1.f; if (MODE == 1) rs = rstd_of(ssq_in, row);
                float* hp = h + (size_t)row * DM + col0; bf16_t* bp = hb + (size_t)row * DM + col0; float s = 0.f;
#pragma unroll
                for (int bj = 0; bj < 2; ++bj) {
                    f32x4 a0 = acc[ai][bj][m][0], a1 = acc[ai][bj][m][1];
                    if (MODE == 1) { const u32x4 pw = *(const u32x4*)(pp + (size_t)row * DM + col0 + bj * 128);
                        const f32x4 p0 = {__uint_as_float(pw.x << 16), __uint_as_float(pw.x & 0xffff0000u), __uint_as_float(pw.y << 16), __uint_as_float(pw.y & 0xffff0000u)};
                        const f32x4 p1 = {__uint_as_float(pw.z << 16), __uint_as_float(pw.z & 0xffff0000u), __uint_as_float(pw.w << 16), __uint_as_float(pw.w & 0xffff0000u)};
#pragma unroll
                        for (int e = 0; e < 4; ++e) { a0[e] = p0[e] / (1.f + __expf(-a0[e] * rs)); a1[e] = p1[e] / (1.f + __expf(-a1[e] * rs)); } }
                    const f32x4 h0 = *(const f32x4*)(hp + bj * 128) + a0, h1 = *(const f32x4*)(hp + bj * 128 + 4) + a1;
                    *(f32x4*)(hp + bj * 128) = h0; *(f32x4*)(hp + bj * 128 + 4) = h1;
                    u32x4 w; w.x = pk2(h0[0], h0[1]); w.y = pk2(h0[2], h0[3]); w.z = pk2(h1[0], h1[1]); w.w = pk2(h1[2], h1[3]);
                    *(u32x4*)(bp + bj * 128) = w;
                    s += (h0[0] * h0[0] + h0[1] * h0[1]) + (h0[2] * h0[2] + h0[3] * h0[3]) + (h1[0] * h1[0] + h1[1] * h1[1]) + (h1[2] * h1[2] + h1[3] * h1[3]);
                }
                { const int ln_ = fq * 16 + fr; s += shfl_xor_l(s, ln_, 16); s += shfl_xor_l(s, ln_, 32); }
                if (fq == 0) ssq_out[(size_t)row * 16 + u.pn * 4 + wc] = s;
            }
    }
};

struct EpiConv {
    static constexpr bool PERM = true, AFTER_DRAIN = false;
    bf16_t* act; const float* ssq; const float* cw; const float* cb; int T; LAS float* halo;
    __device__ __forceinline__ void operator()(f32x4 (&acc)[2][2][4][2], const pg8::Unit& u, int wr, int wc, int fr, int fq) const {
        const int g0 = 254 * u.pm - 1, lane = fq * 16 + fr;
#pragma unroll
        for (int ai = 0; ai < 2; ++ai)
#pragma unroll
            for (int m = 0; m < 4; ++m) { const float rs = rstd_of(ssq, g0 + ai * 128 + wr * 64 + m * 16 + fr);
#pragma unroll
                for (int bj = 0; bj < 2; ++bj) { acc[ai][bj][m][0] = acc[ai][bj][m][0] * rs; acc[ai][bj][m][1] = acc[ai][bj][m][1] * rs; } }
#pragma unroll
        for (int ai = 0; ai < 2; ++ai) { const int s = 2 * ai + wr;
            if (fr == 0) {
#pragma unroll
                for (int bj = 0; bj < 2; ++bj)
#pragma unroll
                    for (int n = 0; n < 2; ++n) *(LAS f32x4*)(halo + ((((wc * 4 + s) * 2 + 0) * 2 + bj) * 32) + 8 * fq + 4 * n) = acc[ai][bj][0][n]; }
            if (fr == 15) {
#pragma unroll
                for (int bj = 0; bj < 2; ++bj)
#pragma unroll
                    for (int n = 0; n < 2; ++n) *(LAS f32x4*)(halo + ((((wc * 4 + s) * 2 + 1) * 2 + bj) * 32) + 8 * fq + 4 * n) = acc[ai][bj][3][n]; } }
        asm volatile("s_waitcnt lgkmcnt(0)" ::: "memory"); __builtin_amdgcn_s_barrier(); asm volatile("" ::: "memory");
#pragma unroll
        for (int n = 0; n < 2; ++n) {
            const int ca = u.pn * 128 + wc * 32 + 8 * fq + 4 * n;
            f32x4 w0[2], w1[2], w2[2], bb[2];
#pragma unroll
            for (int bj = 0; bj < 2; ++bj) { const int c = bj * DFF + ca;
                w0[bj] = *(const f32x4*)(cw + c); w1[bj] = *(const f32x4*)(cw + 2 * DFF + c); w2[bj] = *(const f32x4*)(cw + 4 * DFF + c); bb[bj] = *(const f32x4*)(cb + c); }
#pragma unroll
            for (int ai = 0; ai < 2; ++ai) { const int s = 2 * ai + wr;
#pragma unroll
                for (int m = 0; m < 4; ++m) {
                    const int lr = ai * 128 + wr * 64 + m * 16 + fr, g = g0 + lr; const bool tp = (g & (T - 1)) != 0, tn = ((g + 1) & (T - 1)) != 0;
                    f32x4 ph[2] = {{0.f, 0.f, 0.f, 0.f}, {0.f, 0.f, 0.f, 0.f}}, nh[2] = {{0.f, 0.f, 0.f, 0.f}, {0.f, 0.f, 0.f, 0.f}};
                    if (m == 0 && s > 0) {
#pragma unroll
                        for (int bj = 0; bj < 2; ++bj) ph[bj] = *(const LAS f32x4*)(halo + ((((wc * 4 + s - 1) * 2 + 1) * 2 + bj) * 32) + 8 * fq + 4 * n); }
                    if (m == 3 && s < 3) {
#pragma unroll
                        for (int bj = 0; bj < 2; ++bj) nh[bj] = *(const LAS f32x4*)(halo + ((((wc * 4 + s + 1) * 2 + 0) * 2 + bj) * 32) + 8 * fq + 4 * n); }
                    float cv[2][4];
#pragma unroll
                    for (int bj = 0; bj < 2; ++bj)
#pragma unroll
                        for (int e = 0; e < 4; ++e) {
                            const float cur = acc[ai][bj][m][n][e];
                            const float sp_ = (fr == 15) ? (m > 0 ? acc[ai][bj][m > 0 ? m - 1 : 0][n][e] : ph[bj][e]) : cur;
                            const float sn_ = (fr == 0) ? (m < 3 ? acc[ai][bj][m < 3 ? m + 1 : 3][n][e] : nh[bj][e]) : cur;
                            const float pv = __builtin_bit_cast(float, __builtin_amdgcn_update_dpp(0, __builtin_bit_cast(int, sp_), 0x121, 0xf, 0xf, false));
                            const float nv = __builtin_bit_cast(float, __builtin_amdgcn_update_dpp(0, __builtin_bit_cast(int, sn_), 0x12F, 0xf, 0xf, false));
                            float t_ = fmaf(cur, w1[bj][e], bb[bj][e]); t_ = tp ? fmaf(pv, w0[bj][e], t_) : t_; t_ = tn ? fmaf(nv, w2[bj][e], t_) : t_; cv[bj][e] = t_;
                        }
                    const f32x2 g01 = pg8::gelu_pk((f32x2){cv[1][0], cv[1][1]}), g23 = pg8::gelu_pk((f32x2){cv[1][2], cv[1][3]});
                    if (lr >= 1 && lr <= 254 && g < CH) { u32x2 w; w.x = pk2(cv[0][0] * g01.x, cv[0][1] * g01.y); w.y = pk2(cv[0][2] * g23.x, cv[0][3] * g23.y);
                        *(u32x2*)(act + (size_t)g * DFF + ca) = w; }
                    __builtin_amdgcn_sched_barrier(0);
                }
            }
            asm volatile("" ::: "memory");
        }
    }
};
struct Args {
    const float* in[23]; float* out; unsigned char* ws; int ph_lo, ph_hi;
};
enum { I_XP = 0, I_XS, I_PP, I_PS, I_NMIX, I_EVIN, I_LBL, I_HNORM, I_EVOUT, I_ODIN, I_GUP, I_GB, I_GNORM, I_ODOUT, I_NFFN, I_FUP, I_CW, I_CB, I_FDOWN, I_NPLE, I_PGATE, I_PPROJ, I_NOUT };

struct Ctx {
    LAS unsigned char* lds; int tid, lane, wave, G, bid;
    const Args* a; unsigned char* ws;
};

__device__ __forceinline__ void transpose_item(const float* W, int K, int N, const float* gk, bf16_t* WT, LAS float* scr, int item, int lane, bool remap) {
    const int nblk = N / 32, kb = item / nblk, nb = item % nblk, k0 = 64 * kb, n0 = 32 * nb;
#pragma unroll 8
    for (int i = 0; i < 32; ++i) { const int kk = 2 * i + (lane >> 5); float v = W[(size_t)(k0 + kk) * N + n0 + (lane & 31)]; if (gk) v *= gk[k0 + kk]; scr[kk * 33 + (lane & 31)] = v; }
    asm volatile("s_waitcnt lgkmcnt(0)" ::: "memory");
    const int c = lane & 7;
#pragma unroll
    for (int j = 0; j < 4; ++j) { const int n = (lane >> 3) + 8 * j; const LAS float* s = scr + (8 * c) * 33 + n;
        u32x4 o; o.x = pk2(s[0 * 33], s[1 * 33]); o.y = pk2(s[2 * 33], s[3 * 33]); o.z = pk2(s[4 * 33], s[5 * 33]); o.w = pk2(s[6 * 33], s[7 * 33]);
        int nr = n0 + n; if (remap) nr = (nr < DFF) ? (((nr >> 7) << 8) + (nr & 127)) : ((((nr - DFF) >> 7) << 8) + 128 + ((nr - DFF) & 127));
        *(u32x4*)(WT + (size_t)nr * K + k0 + 8 * c) = o; }
    asm volatile("s_waitcnt lgkmcnt(0)" ::: "memory");
}
__device__ __forceinline__ void weights_prologue(const Ctx& C) {
    LAS float* scr = (LAS float*)(C.lds + C.wave * 8704);
    const int gw = C.bid * NWV + C.wave, NGW = C.G * NWV;
    const Args& a = *C.a;
    for (int mat = 0; mat < 24; ++mat) {
        const float* W; const float* g = nullptr; bf16_t* WT; int K, N;
        if (mat < 2)       { const int e = mat;      W = a.in[I_EVIN] + (size_t)e * DM * EV_IN;  K = DM; N = EV_IN; g = a.in[I_NMIX] + (2 * e) * DM;     WT = (bf16_t*)(C.ws + W_EVIN) + (size_t)e * EV_IN * DM; }
        else if (mat < 4)  { const int e = mat - 2;  W = a.in[I_EVOUT] + (size_t)e * DM * DM;    K = DM; N = DM;                                        WT = (bf16_t*)(C.ws + W_EVOUT) + (size_t)e * DM * DM; }
        else if (mat < 6)  { const int o = mat - 4;  W = a.in[I_ODIN] + (size_t)o * DM * OD_IN;  K = DM; N = OD_IN; g = a.in[I_NMIX] + (2 * o + 1) * DM; WT = (bf16_t*)(C.ws + W_ODIN) + (size_t)o * OD_INP * DM; }
        else if (mat < 8)  { const int o = mat - 6;  W = a.in[I_ODOUT] + (size_t)o * DM * DM;    K = DM; N = DM;                                        WT = (bf16_t*)(C.ws + W_ODOUT) + (size_t)o * DM * DM; }
        else if (mat < 12) { const int l = mat - 8;  W = a.in[I_FUP] + (size_t)l * DM * 2 * DFF; K = DM; N = 2 * DFF; g = a.in[I_NFFN] + l * DM;         WT = (bf16_t*)(C.ws + W_UP) + (size_t)l * 2 * DFF * DM; }
        else if (mat < 16) { const int l = mat - 12; W = a.in[I_FDOWN] + (size_t)l * DFF * DM;   K = DFF; N = DM;                                       WT = (bf16_t*)(C.ws + W_DOWN) + (size_t)l * DM * DFF; }
        else if (mat < 20) { const int l = mat - 16; W = a.in[I_PGATE] + (size_t)l * DM * DM;    K = DM; N = DM; g = a.in[I_NPLE] + l * DM;              WT = (bf16_t*)(C.ws + W_GATE) + (size_t)l * DM * DM; }
        else               { const int l = mat - 20; W = a.in[I_PPROJ] + (size_t)l * PLE * DM;   K = PLE; N = DM;                                       WT = (bf16_t*)(C.ws + W_PROJ) + (size_t)l * DM * PLE; }
        const int nitems = (K / 64) * (N / 32);
        for (int it = gw; it < nitems; it += NGW) transpose_item(W, K, N, g, WT, scr, it, C.lane, mat >= 8 && mat < 12);
    }
    { const int gt = C.bid * NT + C.tid, GT = C.G * NT; const int per = (OD_INP - OD_IN) * DM / 8;
      for (int i = gt; i < 2 * per; i += GT) { const int o = i / per, r = i % per; *(u32x4*)((bf16_t*)(C.ws + W_ODIN) + (size_t)o * OD_INP * DM + (size_t)OD_IN * DM + (size_t)r * 8) = (u32x4){0u, 0u, 0u, 0u}; } }
    { const int gt = C.bid * NT + C.tid; if (gt < 1024) { const int dir = gt >> 9, c = gt & 511; const float* L = a.in[I_LBL] + (size_t)dir * 2 * 512;
        float* lb = (float*)(C.ws + W_LB) + dir * 1024; lb[c] = 0.f; lb[512 + c] = 1.f / (1.f + __expf(L[c] - L[512 + c])); } }
}
__device__ __forceinline__ void chunk_prologue(const Ctx& C, int chunk, bf16_t* hb, float* ssq) {
    const int gw = C.bid * NWV + C.wave, NGW = C.G * NWV; const Args& a = *C.a;
    for (int r = gw; r < CH; r += NGW) {
        const size_t R = (size_t)chunk * CH + r;
        const float* xr = (R < 16384) ? a.in[I_XP] + R * DM : a.in[I_XS] + (R - 16384) * DM;
        float* hr = a.out + R * DM; f32x4 v[4]; float s = 0.f;
#pragma unroll
        for (int j = 0; j < 4; ++j) { v[j] = ((const f32x4*)xr)[C.lane + 64 * j]; s += (v[j].x * v[j].x + v[j].y * v[j].y) + (v[j].z * v[j].z + v[j].w * v[j].w); }
        s = wave_sum(s, C.lane);
#pragma unroll
        for (int j = 0; j < 4; ++j) { ((f32x4*)hr)[C.lane + 64 * j] = v[j]; u32x2 w; w.x = pk2(v[j].x, v[j].y); w.y = pk2(v[j].z, v[j].w); ((u32x2*)(hb + (size_t)r * DM))[C.lane + 64 * j] = w; }
        if (C.lane < 16) ssq[(size_t)r * 16 + C.lane] = (C.lane == 0) ? s : 0.f;
    }
}
__device__ __forceinline__ void final_norm(const Ctx& C, int chunk) {
    const int gw = C.bid * NWV + C.wave, NGW = C.G * NWV; const Args& a = *C.a; const float* g = a.in[I_NOUT];
    for (int r = gw; r < CH; r += NGW) {
        float* hr = a.out + ((size_t)chunk * CH + r) * DM; f32x4 v[4]; float s = 0.f;
#pragma unroll
        for (int j = 0; j < 4; ++j) { v[j] = ((const f32x4*)hr)[C.lane + 64 * j]; s += (v[j].x * v[j].x + v[j].y * v[j].y) + (v[j].z * v[j].z + v[j].w * v[j].w); }
        const float rs = rsqrtf(wave_sum(s, C.lane) * (1.f / DM) + EPS);
#pragma unroll
        for (int j = 0; j < 4; ++j) { const f32x4 gg = ((const f32x4*)g)[C.lane + 64 * j]; ((f32x4*)hr)[C.lane + 64 * j] = v[j] * rs * gg; }
    }
}
__device__ __forceinline__ void conv_phase(const Ctx& C, int chunk, int l, int T) {
    const Args& a = *C.a;
    const bf16_t* UF = (const bf16_t*)(C.ws + ARENA + A_UF); bf16_t* ACT = (bf16_t*)(C.ws + ARENA + A_ACT);
    const float* cw = a.in[I_CW] + (size_t)l * 3 * 2 * DFF; const float* cb = a.in[I_CB] + (size_t)l * 2 * DFF;
    {
        const int ry = C.tid >> 5, cx = C.tid & 31;
        for (int tile = C.bid; tile < (CH / 64) * 11; tile += C.G) {
            const int rt = tile / 11, ct = tile % 11; const int r0 = rt * 64 + ry * 4, c0 = ct * 256 + cx * 8;
            float wa0[8], wa1[8], wa2[8], wg0[8], wg1[8], wg2[8], ba[8], bg[8];
#pragma unroll
            for (int e = 0; e < 8; e += 4) { *(f32x4*)(wa0 + e) = *(const f32x4*)(cw + c0 + e); *(f32x4*)(wa1 + e) = *(const f32x4*)(cw + 2 * DFF + c0 + e); *(f32x4*)(wa2 + e) = *(const f32x4*)(cw + 4 * DFF + c0 + e);
                *(f32x4*)(wg0 + e) = *(const f32x4*)(cw + DFF + c0 + e); *(f32x4*)(wg1 + e) = *(const f32x4*)(cw + 3 * DFF + c0 + e); *(f32x4*)(wg2 + e) = *(const f32x4*)(cw + 5 * DFF + c0 + e);
                *(f32x4*)(ba + e) = *(const f32x4*)(cb + c0 + e); *(f32x4*)(bg + e) = *(const f32x4*)(cb + DFF + c0 + e); }
            bf16x8 ua[6], ug[6];
#pragma unroll
            for (int i = 0; i < 6; ++i) { const int r = r0 - 1 + i; const bool ok = (i == 0) ? ((r0 % T) != 0) : (i == 5 ? (((r0 + 4) % T) != 0) : true);
                if (ok) { ua[i] = *(const bf16x8*)(UF + (size_t)r * 2 * DFF + c0); ug[i] = *(const bf16x8*)(UF + (size_t)r * 2 * DFF + DFF + c0); }
                else { ua[i] = (bf16x8){0, 0, 0, 0, 0, 0, 0, 0}; ug[i] = ua[i]; } }
#pragma unroll
            for (int i = 0; i < 4; ++i) {
                float o[8];
#pragma unroll
                for (int e = 0; e < 8; ++e) {
                    const float av = bf2f((unsigned short)ua[i][e]) * wa0[e] + bf2f((unsigned short)ua[i + 1][e]) * wa1[e] + bf2f((unsigned short)ua[i + 2][e]) * wa2[e] + ba[e];
                    const float gv = bf2f((unsigned short)ug[i][e]) * wg0[e] + bf2f((unsigned short)ug[i + 1][e]) * wg1[e] + bf2f((unsigned short)ug[i + 2][e]) * wg2[e] + bg[e];
                    o[e] = av * (0.5f * gv * (1.f + erff(gv * 0.70710678118f)));
                }
                u32x4 w; w.x = pk2(o[0], o[1]); w.y = pk2(o[2], o[3]); w.z = pk2(o[4], o[5]); w.w = pk2(o[6], o[7]);
                *(u32x4*)(ACT + (size_t)(r0 + i) * DFF + c0) = w;
            }
        }
    }
}
__device__ __forceinline__ void pb_convert(const Ctx& C, int chunk, int l) {
    const Args& a = *C.a;
    { bf16_t* PB = (bf16_t*)(C.ws + B_PB); const int gt = C.bid * NT + C.tid, GT = C.G * NT;
      for (int i = gt; i < CH * PLE / 4; i += GT) { const int r = i / (PLE / 4), c4 = i % (PLE / 4); const size_t R = (size_t)chunk * CH + r;
          const float* src = (R < 16384) ? a.in[I_PP] + ((size_t)l * 16384 + R) * PLE : a.in[I_PS] + ((size_t)l * 32768 + (R - 16384)) * PLE;
          const f32x4 v = ((const f32x4*)src)[c4]; u32x2 w; w.x = pk2(v.x, v.y); w.y = pk2(v.z, v.w); ((u32x2*)(PB + (size_t)r * PLE))[c4] = w; } }
}
struct Mix { int even, li, T, DV, ld, vcol, gcol; float qscale; unsigned char* vf; };
#define MFMA32(a, b, c) __builtin_amdgcn_mfma_f32_32x32x16_bf16((a), (b), (c), 0, 0, 0)
#define QK_IDX(hd, dir, blk, k) (((((size_t)((hd) * 2 + (dir))) * 512 + (size_t)(blk)) * 8 + (k)) * 64)
#define V_IDX(hd, dir, ET, et, blk, sp) ((((((size_t)((hd) * 2 + (dir))) * (ET) + (et)) * 512 + (size_t)(blk)) * 2 + (sp)) * 64)
#define O_IDX(hd, dir, ET, et, blk, q) ((((((size_t)((hd) * 2 + (dir))) * (ET) + (et)) * 512 + (size_t)(blk)) * 4 + (q)) * 64)
#define OB_IDX(hd, dir, ET, et, blk, r) ((((((size_t)((hd) * 2 + (dir))) * (ET) + (et)) * 512 + (size_t)(blk)) * 2 + (r)) * 64)
#define DEC_IDX(hd, dir, blk) ((((size_t)((hd) * 2 + (dir))) * 512 + (size_t)(blk)) * 128)
#define LDSFENCE() asm volatile("s_waitcnt lgkmcnt(0)" ::: "memory")
__device__ __forceinline__ bf16x8 pack8(float a0, float a1, float a2, float a3, float a4, float a5, float a6, float a7) {
    u32x4 w; w.x = pk2(a0, a1); w.y = pk2(a2, a3); w.z = pk2(a4, a5); w.w = pk2(a6, a7); return __builtin_bit_cast(bf16x8, w);
}
__device__ __forceinline__ bf16x8 pack8s(float a0, float a1, float a2, float a3, float a4, float a5, float a6, float a7) {
    u32x4 w; w.x = pk2s(a0, a1); w.y = pk2s(a2, a3); w.z = pk2s(a4, a5); w.w = pk2s(a6, a7); return __builtin_bit_cast(bf16x8, w);
}
__device__ __forceinline__ f32x16 zero16() { f32x16 z;
#pragma unroll
    for (int i = 0; i < 16; ++i) z[i] = 0.f; return z; }

__device__ __forceinline__ void prep_phase(const Ctx& C, const Mix& mx) {
    const Args& a = *C.a;
    const bf16_t* U = (const bf16_t*)(C.ws + ARENA + A_U);
    u32x4* QTf = (u32x4*)(C.ws + ARENA + A_QT); u32x4* KTf = (u32x4*)(C.ws + ARENA + A_KT); u32x4* Vf = (u32x4*)mx.vf;
    f32x4* Of = (f32x4*)(C.ws + ARENA + A_OEV); float* DEC = (float*)(C.ws + ARENA + A_DEC);
    const float* LB = (const float*)(C.ws + W_LB);
    const int hd = C.wave & 3, dir = C.wave >> 2, lane = C.lane, ld = mx.ld, DV = mx.DV;
    LAS float* Bs = (LAS float*)(C.lds + C.wave * 16896);
    for (int b = C.bid; b < CH / 32; b += C.G) {
        int vz_ = 0; asm volatile("" : "+v"(vz_)); const int rb = 32 * b + vz_;
        {
            const int d0 = 2 * lane, col0 = hd * 128 + d0, dt0 = d0 >> 5, dp0 = d0 & 31;
            float bs0 = 0.f, bs1 = 0.f; unsigned zz[32];
            if (mx.even) {
                const f32x2 lb2 = *(const f32x2*)(LB + dir * 1024 + mx.li * 512 + col0); const float om0 = 1.f - lb2.x, om1 = 1.f - lb2.y;
                const bf16_t* zp = U + 512 + 512 * dir + col0;
#pragma unroll
                for (int t = 0; t < 32; ++t) { const int row = rb + (dir ? 31 - t : t);
                    const unsigned zw = *(const unsigned*)(zp + (size_t)row * ld); zz[t] = zw;
                    const float z0 = __uint_as_float(zw << 16), z1 = __uint_as_float(zw & 0xffff0000u);
                    bs0 += fmaxf(__logf(lb2.x + om0 / (1.f + __expf(-z0))), -30.f); bs1 += fmaxf(__logf(lb2.y + om1 / (1.f + __expf(-z1))), -30.f);
                    *(LAS f32x2*)(Bs + t * 132 + d0) = (f32x2){bs0, bs1}; }
                *(f32x2*)(DEC + DEC_IDX(hd, dir, b) + d0) = (f32x2){__expf(bs0), __expf(bs1)};
#pragma unroll
                for (int grp = 0; grp < 4; ++grp) { float k0[8], k1[8];
#pragma unroll
                    for (int j = 0; j < 8; ++j) { const int t = 16 * (grp >> 1) + 8 * (j >> 2) + 4 * (grp & 1) + (j & 3);
                        const float z0 = __uint_as_float(zz[t] << 16), z1 = __uint_as_float(zz[t] & 0xffff0000u); const f32x2 bt = *(const LAS f32x2*)(Bs + t * 132 + d0);
                        k0[j] = om0 / (1.f + __expf(z0)) * __expf(bs0 - bt.x); k1[j] = om1 / (1.f + __expf(z1)) * __expf(bs1 - bt.y); }
                    u32x4 w; w.x = pk2(k0[0], k0[1]); w.y = pk2(k0[2], k0[3]); w.z = pk2(k0[4], k0[5]); w.w = pk2(k0[6], k0[7]);
                    KTf[QK_IDX(hd, dir, b, (grp >> 1) * 4 + dt0) + 32 * (grp & 1) + dp0] = w;
                    w.x = pk2(k1[0], k1[1]); w.y = pk2(k1[2], k1[3]); w.z = pk2(k1[4], k1[5]); w.w = pk2(k1[6], k1[7]);
                    KTf[QK_IDX(hd, dir, b, (grp >> 1) * 4 + dt0) + 32 * (grp & 1) + dp0 + 1] = w; }
            } else {
                float Wg0[16], Wg1[16]; const float* wp = a.in[I_GUP] + ((size_t)(mx.li * 2 + dir) * 16) * 512 + col0;
#pragma unroll
                for (int r = 0; r < 16; ++r) { const f32x2 w2 = *(const f32x2*)(wp + r * 512); Wg0[r] = w2.x; Wg1[r] = w2.y; }
                const f32x2 bias = *(const f32x2*)(a.in[I_GB] + (mx.li * 2 + dir) * 512 + col0);
#pragma unroll
                for (int t = 0; t < 32; ++t) { const int row = rb + (dir ? 31 - t : t);
                    const u32x4 l0 = *(const u32x4*)(U + (size_t)row * ld + 3072 + 16 * dir), l1 = *(const u32x4*)(U + (size_t)row * ld + 3072 + 16 * dir + 8);
                    zz[t] = *(const unsigned*)(U + (size_t)row * ld + 512 + col0);
                    float x0 = bias.x, x1 = bias.y;
#pragma unroll
                    for (int w = 0; w < 4; ++w) { const float a0 = __uint_as_float(l0[w] << 16), a1 = __uint_as_float(l0[w] & 0xffff0000u), c0 = __uint_as_float(l1[w] << 16), c1 = __uint_as_float(l1[w] & 0xffff0000u);
                        x0 += a0 * Wg0[2 * w] + a1 * Wg0[2 * w + 1] + c0 * Wg0[8 + 2 * w] + c1 * Wg0[8 + 2 * w + 1];
                        x1 += a0 * Wg1[2 * w] + a1 * Wg1[2 * w + 1] + c0 * Wg1[8 + 2 * w] + c1 * Wg1[8 + 2 * w + 1]; }
                    bs0 += fmaxf((fminf(x0, 0.f) - log1pf(__expf(-fabsf(x0)))) * (1.f / 16.f), -30.f); bs1 += fmaxf((fminf(x1, 0.f) - log1pf(__expf(-fabsf(x1)))) * (1.f / 16.f), -30.f);
                    *(LAS f32x2*)(Bs + t * 132 + d0) = (f32x2){bs0, bs1}; }
                *(f32x2*)(DEC + DEC_IDX(hd, dir, b) + d0) = (f32x2){__expf(bs0), __expf(bs1)};
#pragma unroll
                for (int grp = 0; grp < 4; ++grp) { float k0[8], k1[8];
#pragma unroll
                    for (int j = 0; j < 8; ++j) { const int t = 16 * (grp >> 1) + 8 * (j >> 2) + 4 * (grp & 1) + (j & 3); const f32x2 bt = *(const LAS f32x2*)(Bs + t * 132 + d0);
                        k0[j] = __uint_as_float(zz[t] << 16) * __expf(bs0 - bt.x); k1[j] = __uint_as_float(zz[t] & 0xffff0000u) * __expf(bs1 - bt.y); }
                    u32x4 w; w.x = pk2(k0[0], k0[1]); w.y = pk2(k0[2], k0[3]); w.z = pk2(k0[4], k0[5]); w.w = pk2(k0[6], k0[7]);
                    KTf[QK_IDX(hd, dir, b, (grp >> 1) * 4 + dt0) + 32 * (grp & 1) + dp0] = w;
                    w.x = pk2(k1[0], k1[1]); w.y = pk2(k1[2], k1[3]); w.z = pk2(k1[4], k1[5]); w.w = pk2(k1[6], k1[7]);
                    KTf[QK_IDX(hd, dir, b, (grp >> 1) * 4 + dt0) + 32 * (grp & 1) + dp0 + 1] = w; }
            }
        }
        LDSFENCE();
        const int tau = lane & 31, h = lane >> 5, row = rb + (dir ? 31 - tau : tau);
        bf16x8 Ak[8], Bq[8];
#pragma unroll
        for (int ks = 0; ks < 8; ++ks) {
            float qh[8], kh[8], qt[8];
#pragma unroll
            for (int q2 = 0; q2 < 2; ++q2) {
                const int d0 = 16 * ks + 8 * q2 + 4 * h;
                const f32x4 b4 = *(const LAS f32x4*)(Bs + tau * 132 + d0), r4 = *(const LAS f32x4*)(Bs + 15 * 132 + d0);
                const u32x2 qr = *(const u32x2*)(U + (size_t)row * ld + hd * 128 + d0);
                float q4[4] = {__uint_as_float(qr.x << 16), __uint_as_float(qr.x & 0xffff0000u), __uint_as_float(qr.y << 16), __uint_as_float(qr.y & 0xffff0000u)};
                float k4[4];
                if (mx.even) { const u32x2 zr = *(const u32x2*)(U + (size_t)row * ld + 512 + 512 * dir + hd * 128 + d0);
                    const f32x4 lb4 = *(const f32x4*)(LB + dir * 1024 + mx.li * 512 + hd * 128 + d0);
                    const float z4[4] = {__uint_as_float(zr.x << 16), __uint_as_float(zr.x & 0xffff0000u), __uint_as_float(zr.y << 16), __uint_as_float(zr.y & 0xffff0000u)};
#pragma unroll
                    for (int e = 0; e < 4; ++e) k4[e] = (1.f - lb4[e]) / (1.f + __expf(z4[e]));
                } else { const u32x2 kr = *(const u32x2*)(U + (size_t)row * ld + 512 + hd * 128 + d0);
                    k4[0] = __uint_as_float(kr.x << 16); k4[1] = __uint_as_float(kr.x & 0xffff0000u); k4[2] = __uint_as_float(kr.y << 16); k4[3] = __uint_as_float(kr.y & 0xffff0000u); }
#pragma unroll
                for (int e = 0; e < 4; ++e) { const float qq = q4[e] * mx.qscale; qt[4 * q2 + e] = qq * __expf(b4[e]);
                    qh[4 * q2 + e] = qq * __expf(fminf(b4[e] - r4[e], 80.f)); kh[4 * q2 + e] = k4[e] * __expf(fminf(r4[e] - b4[e], 80.f)); }
            }
            { u32x4 w; w.x = pk2(qt[0], qt[1]); w.y = pk2(qt[2], qt[3]); w.z = pk2(qt[4], qt[5]); w.w = pk2(qt[6], qt[7]); QTf[QK_IDX(hd, dir, b, ks) + lane] = w; }
            Bq[ks] = pack8(qh[0], qh[1], qh[2], qh[3], qh[4], qh[5], qh[6], qh[7]);
            Ak[ks] = pack8(kh[0], kh[1], kh[2], kh[3], kh[4], kh[5], kh[6], kh[7]);
        }
        f32x16 at = zero16();
#pragma unroll
        for (int ks = 0; ks < 8; ++ks) at = MFMA32(Ak[ks], Bq[ks], at);
#pragma unroll
        for (int i = 0; i < 16; ++i) { const int s = (i & 3) + 8 * (i >> 2) + 4 * h; if (s > tau) at[i] = 0.f; }
        bf16x8 Pa[2];
        Pa[0] = pack8(at[0], at[1], at[2], at[3], at[4], at[5], at[6], at[7]);
        Pa[1] = pack8(at[8], at[9], at[10], at[11], at[12], at[13], at[14], at[15]);
        const int ET = DV / 32;
        LDSFENCE();
        LAS unsigned char* Vs = (LAS unsigned char*)Bs; const int vpitch = 2 * DV + 16;
        for (int idx = lane; idx < 32 * (DV / 8); idx += 64) { const int t = idx / (DV / 8), c8 = idx % (DV / 8); const int rj = rb + (dir ? 31 - t : t);
            *(LAS u32x4*)(Vs + t * vpitch + c8 * 16) = *(const u32x4*)(U + (size_t)rj * ld + mx.vcol + hd * DV + c8 * 8); }
        LDSFENCE();
        for (int et = 0; et < ET; ++et) {
            f32x16 acc = zero16();
#pragma unroll
            for (int sp = 0; sp < 2; ++sp) {
                unsigned short v[8];
#pragma unroll
                for (int j = 0; j < 8; ++j) { const int sj = 16 * sp + 8 * (j >> 2) + 4 * h + (j & 3); v[j] = *(const LAS unsigned short*)(Vs + sj * vpitch + (32 * et + (lane & 31)) * 2); }
                u32x4 w; w.x = v[0] | ((unsigned)v[1] << 16); w.y = v[2] | ((unsigned)v[3] << 16); w.z = v[4] | ((unsigned)v[5] << 16); w.w = v[6] | ((unsigned)v[7] << 16);
                Vf[V_IDX(hd, dir, ET, et, b, sp) + lane] = w;
                acc = MFMA32(Pa[sp], __builtin_bit_cast(bf16x8, w), acc);
            }
#pragma unroll
            for (int r = 0; r < 2; ++r) { u32x4 w; w.x = pk2s(acc[8 * r], acc[8 * r + 1]); w.y = pk2s(acc[8 * r + 2], acc[8 * r + 3]); w.z = pk2s(acc[8 * r + 4], acc[8 * r + 5]); w.w = pk2s(acc[8 * r + 6], acc[8 * r + 7]);
                ((u32x4*)Of)[OB_IDX(hd, dir, ET, et, b, r) + lane] = w; }
        }
        LDSFENCE();
    }
}
__device__ __forceinline__ void scan_phase(const Ctx& C, const Mix& mx) {
    const u32x4* QTf = (const u32x4*)(C.ws + ARENA + A_QT); const u32x4* KTf = (const u32x4*)(C.ws + ARENA + A_KT); const u32x4* Vf = (const u32x4*)mx.vf;
    u32x4* Of = (u32x4*)(C.ws + ARENA + A_OEV); const float* DEC = (const float*)(C.ws + ARENA + A_DEC);
    const int lane = C.lane, h = lane >> 5, DV = mx.DV, ET = DV / 32, T = mx.T, nb = T / 32;
    const int units = (CH / T) * 8 * ET;
    constexpr int SLOT = 23552, R = 5, NL = 4;
    LAS u32x4* SB = (LAS u32x4*)(C.lds + R * SLOT);
    for (int base = 0; base < units; base += C.G) {
        const bool loader = C.wave >= 2 && C.wave < 2 + NL;
        const int lr = C.wave - 2;
        const int u = base + C.bid;
        const bool valid = u < units;
        const int et = u % ET, x = u / ET, dir = x & 1, hd = (x >> 1) & 3, seq = x >> 3;
        LAS unsigned char* ring = C.lds;
#define SCAN_BAR() do { asm volatile("s_waitcnt lgkmcnt(0)" ::: "memory"); __builtin_amdgcn_s_barrier(); asm volatile("" ::: "memory"); } while (0)
#define GLDS16(gp, lp) __builtin_amdgcn_global_load_lds((const unsigned*)(gp), (LAS unsigned*)(lp), 16, 0, 0)
#define SCAN_ISSUE(j) do { const int blk_ = seq * nb + (dir ? nb - 1 - (j) : (j)); LAS unsigned char* sl_ = ring + ((j) % R) * SLOT; \
            _Pragma("unroll") for (int k = 0; k < 8; ++k) { GLDS16(QTf + QK_IDX(hd, dir, blk_, k) + lane, sl_ + k * 1024); GLDS16(KTf + QK_IDX(hd, dir, blk_, k) + lane, sl_ + (8 + k) * 1024); } \
            _Pragma("unroll") for (int sp = 0; sp < 2; ++sp) GLDS16(Vf + V_IDX(hd, dir, ET, et, blk_, sp) + lane, sl_ + (16 + sp) * 1024); \
            _Pragma("unroll") for (int r = 0; r < 2; ++r) GLDS16(Of + OB_IDX(hd, dir, ET, et, blk_, r) + lane, sl_ + (18 + r) * 1024); \
            if (lane < 32) GLDS16(DEC + DEC_IDX(hd, dir, blk_) + 4 * lane, sl_ + 22 * 1024); } while (0)
        if (C.wave == 0) {
            SCAN_BAR();
            for (int i = 0; i < nb; ++i) {
                if (valid) {
                    const LAS u32x4* sv = (const LAS u32x4*)(ring + (i % R) * SLOT) + lane; const LAS u32x4* sb = SB + (i & 1) * 512 + lane;
                    u32x4 qf[8], on[2], bs[8];
#pragma unroll
                    for (int r = 0; r < 2; ++r) on[r] = sv[(18 + r) * 64];
#pragma unroll
                    for (int k = 0; k < 8; ++k) { qf[k] = sv[k * 64]; bs[k] = sb[k * 64]; }
                    asm volatile("s_waitcnt lgkmcnt(0)" ::: "memory");
                    f32x16 acc;
#pragma unroll
                    for (int r = 0; r < 2; ++r) {
                        acc[8 * r + 0] = __uint_as_float(on[r].x << 16); acc[8 * r + 1] = __uint_as_float(on[r].x & 0xffff0000u); acc[8 * r + 2] = __uint_as_float(on[r].y << 16); acc[8 * r + 3] = __uint_as_float(on[r].y & 0xffff0000u);
                        acc[8 * r + 4] = __uint_as_float(on[r].z << 16); acc[8 * r + 5] = __uint_as_float(on[r].z & 0xffff0000u); acc[8 * r + 6] = __uint_as_float(on[r].w << 16); acc[8 * r + 7] = __uint_as_float(on[r].w & 0xffff0000u); }
#pragma unroll
                    for (int k = 0; k < 8; ++k) acc = MFMA32(__builtin_bit_cast(bf16x8, qf[k]), __builtin_bit_cast(bf16x8, bs[k]), acc);
                    const int blk = seq * nb + (dir ? nb - 1 - i : i);
#pragma unroll
                    for (int r = 0; r < 2; ++r) { u32x4 w; w.x = pk2s(acc[8 * r], acc[8 * r + 1]); w.y = pk2s(acc[8 * r + 2], acc[8 * r + 3]); w.z = pk2s(acc[8 * r + 4], acc[8 * r + 5]); w.w = pk2s(acc[8 * r + 6], acc[8 * r + 7]);
                        Of[OB_IDX(hd, dir, ET, et, blk, r) + lane] = w; }
                }
                SCAN_BAR();
            }
        } else if (C.wave == 1) {
            f32x16 S[4];
#pragma unroll
            for (int dt = 0; dt < 4; ++dt) S[dt] = zero16();
#pragma unroll
            for (int k = 0; k < 8; ++k) SB[k * 64 + lane] = (u32x4){0u, 0u, 0u, 0u};
            SCAN_BAR();
            for (int i = 0; i < nb; ++i) {
                if (valid) {
                    const LAS unsigned char* sl = ring + (i % R) * SLOT; const LAS u32x4* sv = (const LAS u32x4*)sl + lane;
                    u32x4 kf[8], vf[2]; f32x4 dq[16];
#pragma unroll
                    for (int k = 0; k < 8; ++k) kf[k] = sv[(8 + k) * 64];
#pragma unroll
                    for (int sp = 0; sp < 2; ++sp) vf[sp] = sv[(16 + sp) * 64];
                    const LAS float* dp = (const LAS float*)(sl + 22 * 1024) + 4 * h;
#pragma unroll
                    for (int k = 0; k < 16; ++k) dq[k] = *(const LAS f32x4*)(dp + 8 * k);
                    asm volatile("s_waitcnt lgkmcnt(0)" ::: "memory");
#pragma unroll
                    for (int dt = 0; dt < 4; ++dt)
#pragma unroll
                        for (int q = 0; q < 4; ++q) {
#pragma unroll
                            for (int e = 0; e < 4; ++e) S[dt][4 * q + e] *= dq[4 * dt + q][e]; }
#pragma unroll
                    for (int sp = 0; sp < 2; ++sp) {
#pragma unroll
                        for (int dt = 0; dt < 4; ++dt) S[dt] = MFMA32(__builtin_bit_cast(bf16x8, kf[sp * 4 + dt]), __builtin_bit_cast(bf16x8, vf[sp]), S[dt]); }
                    LAS u32x4* sbw = SB + ((i + 1) & 1) * 512 + lane;
#pragma unroll
                    for (int dt = 0; dt < 4; ++dt)
#pragma unroll
                        for (int sp = 0; sp < 2; ++sp)
                            sbw[(2 * dt + sp) * 64] = __builtin_bit_cast(u32x4, pack8s(S[dt][8 * sp + 0], S[dt][8 * sp + 1], S[dt][8 * sp + 2], S[dt][8 * sp + 3], S[dt][8 * sp + 4], S[dt][8 * sp + 5], S[dt][8 * sp + 6], S[dt][8 * sp + 7]));
                }
                SCAN_BAR();
            }
        } else {
            if (loader && valid && lr < nb) SCAN_ISSUE(lr);
            for (int i = -1; i < nb; ++i) {
                if (loader && valid) {
                    if (i >= 0 && lr == i % NL && i + NL < nb) SCAN_ISSUE(i + NL);
                    if (lr == (i + 1) % NL && i + 1 < nb) asm volatile("s_waitcnt vmcnt(0)" ::: "memory");
                }
                SCAN_BAR();
            }
        }
#undef SCAN_ISSUE
#undef GLDS16
#undef SCAN_BAR
    }
}
__device__ __forceinline__ void attn_phase(const Ctx& C, int T) {
    const bf16_t* U = (const bf16_t*)(C.ws + ARENA + A_U);
    bf16_t* OG = (bf16_t*)(C.ws + ARENA + A_OG); float* LSE = (float*)(C.ws + ARENA + A_LSE);
    const int lane = C.lane, h = lane >> 5, l31 = lane & 31, ld = EV_IN, tps = T / 32;
    for (int task = C.bid * NWV + C.wave; task < 3 * 4 * (CH / 32); task += C.G * NWV) {
        const int g = task / 2048, x = task % 2048, hd = x / 512, y = x % 512, seq = y / tps, z = y % tps;
        const int dil = 1 << (2 * g), L = T / dil, nqb = L / 32, r = z / nqb, qb = z % nqb, m0 = 32 * qb;
        const int qcol = 2560 + g * 1536 + hd * 128, kcol = qcol + 512, vcol = qcol + 1024;
        const float coef = exp2f(-8.0f * (float)(g * 4 + hd + 1) / 12.0f) * (float)dil, scale = 0.08838834764831845f;
        const size_t rbase = (size_t)seq * T + r;
        bf16x8 Bq[8];
        { const bf16_t* qp = U + (rbase + (size_t)(m0 + l31) * dil) * ld + qcol + 8 * h;
#pragma unroll
          for (int ks = 0; ks < 8; ++ks) Bq[ks] = *(const bf16x8*)(qp + 16 * ks); }
        f32x16 st[5];
        bf16x8 Kc[8], Kn[8];
        {   const int mkc0 = (m0 - 64) < 0 ? 0 : (m0 - 64);
            const bf16_t* kp = U + (rbase + (size_t)(mkc0 + l31) * dil) * ld + kcol + 8 * h;
#pragma unroll
            for (int ks = 0; ks < 8; ++ks) Kc[ks] = *(const bf16x8*)(kp + 16 * ks); }
#pragma unroll
        for (int kb = 0; kb < 5; ++kb) {
            const int mk0 = m0 - 64 + 32 * kb; const bool vb = (mk0 >= 0 && mk0 < L);
            if (kb < 4) { const int mk1 = mk0 + 32; const int mkc1 = mk1 < 0 ? 0 : (mk1 >= L ? L - 32 : mk1);
                const bf16_t* kp = U + (rbase + (size_t)(mkc1 + l31) * dil) * ld + kcol + 8 * h;
#pragma unroll
                for (int ks = 0; ks < 8; ++ks) Kn[ks] = *(const bf16x8*)(kp + 16 * ks); }
            f32x16 s = zero16();
#pragma unroll
            for (int ks = 0; ks < 8; ++ks) s = MFMA32(Kc[ks], Bq[ks], s);
#pragma unroll
            for (int i = 0; i < 16; ++i) { const int rel = (mk0 + (i & 3) + 8 * (i >> 2) + 4 * h) - (m0 + l31); const int ar = rel < 0 ? -rel : rel;
                s[i] = (vb && ar <= 64) ? s[i] * scale - coef * (float)ar : -1e30f; }
            st[kb] = s;
#pragma unroll
            for (int ks = 0; ks < 8; ++ks) Kc[ks] = Kn[ks];
        }
        float mxv = -1e30f;
#pragma unroll
        for (int kb = 0; kb < 5; ++kb)
#pragma unroll
            for (int i = 0; i < 16; ++i) mxv = fmaxf(mxv, st[kb][i]);
        mxv = fmaxf(mxv, shfl_xor_l(mxv, lane, 32));
        float den = 0.f;
#pragma unroll
        for (int kb = 0; kb < 5; ++kb)
#pragma unroll
            for (int i = 0; i < 16; ++i) { const float p = __expf(st[kb][i] - mxv); st[kb][i] = p; den += p; }
        den += shfl_xor_l(den, lane, 32);
        f32x16 ot[4];
#pragma unroll
        for (int dt = 0; dt < 4; ++dt) ot[dt] = zero16();
        LAS unsigned char* Vs = C.lds + C.wave * 16896;
#pragma unroll
        for (int kb = 0; kb < 5; ++kb) {
            const int mk0 = m0 - 64 + 32 * kb; const int mkc = mk0 < 0 ? 0 : (mk0 >= L ? L - 32 : mk0);
            u32x4 vr[8];
#pragma unroll
            for (int it = 0; it < 8; ++it) { const int idx = lane + 64 * it, t = idx >> 4, c8 = idx & 15; vr[it] = *(const u32x4*)(U + (rbase + (size_t)(mkc + t) * dil) * ld + vcol + c8 * 8); }
            LDSFENCE();
#pragma unroll
            for (int it = 0; it < 8; ++it) { const int idx = lane + 64 * it, t = idx >> 4, c8 = idx & 15; *(LAS u32x4*)(Vs + t * 272 + c8 * 16) = vr[it]; }
            LDSFENCE();
#pragma unroll
            for (int sp = 0; sp < 2; ++sp) {
                const bf16x8 Bp = pack8(st[kb][8 * sp + 0], st[kb][8 * sp + 1], st[kb][8 * sp + 2], st[kb][8 * sp + 3], st[kb][8 * sp + 4], st[kb][8 * sp + 5], st[kb][8 * sp + 6], st[kb][8 * sp + 7]);
#pragma unroll
                for (int dt = 0; dt < 4; ++dt) {
                    unsigned short v[8];
#pragma unroll
                    for (int j = 0; j < 8; ++j) { const int kj = 16 * sp + 8 * (j >> 2) + 4 * h + (j & 3); v[j] = *(const LAS unsigned short*)(Vs + kj * 272 + (32 * dt + l31) * 2); }
                    u32x4 w; w.x = v[0] | ((unsigned)v[1] << 16); w.y = v[2] | ((unsigned)v[3] << 16); w.z = v[4] | ((unsigned)v[5] << 16); w.w = v[6] | ((unsigned)v[7] << 16);
                    ot[dt] = MFMA32(__builtin_bit_cast(bf16x8, w), Bp, ot[dt]);
                }
            }
        }
        const float inv = 1.f / den; const size_t qrow = rbase + (size_t)(m0 + l31) * dil;
        bf16_t* op = OG + ((size_t)g * CH + qrow) * 512 + hd * 128 + 4 * h;
#pragma unroll
        for (int dt = 0; dt < 4; ++dt)
#pragma unroll
            for (int q = 0; q < 4; ++q) { u32x2 w; w.x = pk2(ot[dt][4 * q] * inv, ot[dt][4 * q + 1] * inv); w.y = pk2(ot[dt][4 * q + 2] * inv, ot[dt][4 * q + 3] * inv);
                *(u32x2*)(op + 32 * dt + 8 * q) = w; }
        if (h == 0) LSE[((size_t)g * CH + qrow) * 4 + hd] = mxv + __logf(den);
    }
}
__device__ __forceinline__ void finalize_phase(const Ctx& C, const Mix& mx) {
    const Args& a = *C.a;
    const bf16_t* __restrict__ U = (const bf16_t*)(C.ws + ARENA + A_U); bf16_t* __restrict__ MIX = (bf16_t*)(C.ws + ARENA + A_MIX);
    const f32x4* __restrict__ Of = (const f32x4*)(C.ws + ARENA + A_OEV);
    const int gw = C.bid * NWV + C.wave, NGW = C.G * NWV, lane = C.lane, ld = mx.ld, DV = mx.DV, ET = DV / 32, NE = DV / 64;
    const float* gn = mx.even ? a.in[I_HNORM] + mx.li * 512 : a.in[I_GNORM] + mx.li * 1024;
#pragma unroll 2
    for (int rg = gw; rg < CH / 4; rg += NGW) {
        const int r0 = 4 * rg, blk = r0 >> 5, t0 = r0 & 31;
        const int qf = t0 >> 3, hf = (t0 >> 2) & 1, tb = 28 - t0, qb = tb >> 3, hb2 = (tb >> 2) & 1;
#pragma unroll
        for (int hd = 0; hd < 4; ++hd) {
            float o[4][4]; float ss[4] = {0.f, 0.f, 0.f, 0.f};
#pragma unroll
            for (int k = 0; k < 4; ++k) if (k < NE) {
                const int e = lane + 64 * k, et = e >> 5;
                const u32x2* Ob2 = (const u32x2*)Of;
                const u32x2 vf_ = Ob2[(OB_IDX(hd, 0, ET, et, blk, qf >> 1) + 32 * hf + (e & 31)) * 2 + (qf & 1)], vb_ = Ob2[(OB_IDX(hd, 1, ET, et, blk, qb >> 1) + 32 * hb2 + (e & 31)) * 2 + (qb & 1)];
                o[k][0] = __uint_as_float(vf_.x << 16) + __uint_as_float(vb_.y & 0xffff0000u); o[k][1] = __uint_as_float(vf_.x & 0xffff0000u) + __uint_as_float(vb_.y << 16);
                o[k][2] = __uint_as_float(vf_.y << 16) + __uint_as_float(vb_.x & 0xffff0000u); o[k][3] = __uint_as_float(vf_.y & 0xffff0000u) + __uint_as_float(vb_.x << 16);
#pragma unroll
                for (int j = 0; j < 4; ++j) ss[j] += o[k][j] * o[k][j];
            }
#pragma unroll
            for (int j = 0; j < 4; ++j) ss[j] = rsqrtf(wave_sum(ss[j], lane) / (float)DV + EPS);
#pragma unroll
            for (int k = 0; k < 4; ++k) if (k < NE) {
                const int c = hd * DV + lane + 64 * k; const float g1 = gn[c];
#pragma unroll
                for (int j = 0; j < 4; ++j) { const float ag = bf2f(U[(size_t)(r0 + j) * ld + 2048 + c]);
                    MIX[(size_t)(r0 + j) * DM + c] = (bf16_t)(pk2(o[k][j] * ss[j] * g1 * (ag / (1.f + __expf(-ag))), 0.f) & 0xffffu); }
            }
        }
        if (mx.even) {
            const bf16_t* __restrict__ OG = (const bf16_t*)(C.ws + ARENA + A_OG); const float* __restrict__ LSE = (const float*)(C.ws + ARENA + A_LSE);
#pragma unroll
            for (int j = 0; j < 4; ++j) { const int r = r0 + j;
#pragma unroll
                for (int hd = 0; hd < 4; ++hd) { const int c = hd * 128 + 2 * lane;
                    const float l0 = LSE[((size_t)0 * CH + r) * 4 + hd], l1 = LSE[((size_t)1 * CH + r) * 4 + hd], l2 = LSE[((size_t)2 * CH + r) * 4 + hd];
                    const float m = fmaxf(l0, fmaxf(l1, l2)); float w0 = __expf(l0 - m), w1 = __expf(l1 - m), w2 = __expf(l2 - m); const float iw = 1.f / (w0 + w1 + w2);
                    w0 *= iw; w1 *= iw; w2 *= iw;
                    const unsigned v0 = *(const unsigned*)(OG + ((size_t)0 * CH + r) * 512 + c), v1 = *(const unsigned*)(OG + ((size_t)1 * CH + r) * 512 + c), v2 = *(const unsigned*)(OG + ((size_t)2 * CH + r) * 512 + c);
                    const float bx = w0 * __uint_as_float(v0 << 16) + w1 * __uint_as_float(v1 << 16) + w2 * __uint_as_float(v2 << 16);
                    const float by = w0 * __uint_as_float(v0 & 0xffff0000u) + w1 * __uint_as_float(v1 & 0xffff0000u) + w2 * __uint_as_float(v2 & 0xffff0000u);
                    *(unsigned*)(MIX + (size_t)r * DM + 512 + c) = pk2(bx, by); }
            }
        }
    }
}
#define XB_TMO      128
#define XB_XCNT(j)  (256  + 64 * (j))
#define XB_XSUB(j)  (1280 + 64 * (j))
#define XB_XGEN(j)  (2304 + 64 * (j))
#define XB_TOP      3328
#define XB_TOPGEN   3392
#define XCD_BAR_WORDS 3456
#define XB_SPIN_CAP (1u << 18)

__device__ __forceinline__ unsigned xb_ld(unsigned* p)              { return __hip_atomic_load(p, __ATOMIC_RELAXED, __HIP_MEMORY_SCOPE_AGENT); }
__device__ __forceinline__ unsigned xb_add(unsigned* p, unsigned v) { return __hip_atomic_fetch_add(p, v, __ATOMIC_RELAXED, __HIP_MEMORY_SCOPE_AGENT); }
__device__ __forceinline__ unsigned xb_xcc_id() { return (unsigned)__builtin_amdgcn_s_getreg((3 << 11) | 20) & 0xFu; }
#define XB_SPIN(cond, bar) do { unsigned _sp = 0; while (cond) { __builtin_amdgcn_s_sleep(1); \
    if ((++_sp & 255u) == 0u) { if (xb_ld(&(bar)[XB_TMO])) break; if (_sp > XB_SPIN_CAP) { atomicAdd(&(bar)[XB_TMO], 1u); break; } } } } while (0)

struct XcdBarrier {
    unsigned* bar; unsigned x;
    volatile LAS unsigned* st;
};

__device__ __forceinline__ XcdBarrier xcd_barrier_post(unsigned* bar, volatile LAS unsigned* st) {
    XcdBarrier b; b.bar = bar; b.x = xb_xcc_id(); b.st = st;
    if (threadIdx.x == 0) (void)xb_add(&bar[XB_XCNT(b.x)], 1u);
    return b;
}
__device__ __forceinline__ void xcd_barrier_complete(unsigned* bar, unsigned x, unsigned& nloc, unsigned& nx) {
    const unsigned G = gridDim.x * gridDim.y * gridDim.z;
    unsigned sum, cnt, mine, sp = 0u;
    for (;;) {
        sum = 0u; cnt = 0u; mine = 0u;
#pragma unroll
        for (unsigned j = 0; j < 16; ++j) { const unsigned c = xb_ld(&bar[XB_XCNT(j)]); sum += c; cnt += (c > 0u) ? 1u : 0u; mine = (j == x) ? c : mine; }
        if (sum == G) break;
        __builtin_amdgcn_s_sleep(1);
        if ((++sp & 255u) == 0u) { if (xb_ld(&bar[XB_TMO])) break; if (sp > XB_SPIN_CAP) { atomicAdd(&bar[XB_TMO], 1u); break; } }
    }
    nloc = mine > 0u ? mine : 1u; nx = cnt > 0u ? cnt : 1u;
}

__device__ __forceinline__ void xcd_barrier(const XcdBarrier& b) {
    asm volatile("s_waitcnt vmcnt(0)" ::: "memory");
    __syncthreads();
    if (threadIdx.x == 0) {
        unsigned* bar = b.bar;
        __builtin_amdgcn_s_waitcnt(0);
        unsigned nloc = b.st[0], nx = b.st[1];
        if (nloc == 0u) { xcd_barrier_complete(bar, b.x, nloc, nx); b.st[0] = nloc; b.st[1] = nx; }
        const unsigned old = xb_add(&bar[XB_XSUB(b.x)], 1u);
        const unsigned gen = old / nloc;
        if (old + 1u == (gen + 1u) * nloc) {
            __builtin_amdgcn_fence(__ATOMIC_RELEASE, "agent");
            asm volatile("s_waitcnt vmcnt(0)" ::: "memory");
            const unsigned og = xb_add(&bar[XB_TOP], 1u);
            const unsigned tg = og / nx;
            if (og + 1u == (tg + 1u) * nx) xb_add(&bar[XB_TOPGEN], 1u);
            else XB_SPIN(xb_ld(&bar[XB_TOPGEN]) == tg, bar);
            __builtin_amdgcn_fence(__ATOMIC_ACQUIRE, "agent");
            xb_add(&bar[XB_XGEN(b.x)], 1u);
            asm volatile("s_waitcnt vmcnt(0)" ::: "memory");
        } else {
            XB_SPIN(xb_ld(&bar[XB_XGEN(b.x)]) == gen, bar);
            __builtin_amdgcn_fence(__ATOMIC_ACQUIRE, "agent");
            asm volatile("s_waitcnt vmcnt(0)" ::: "memory");
        }
    }
    __syncthreads();
}
#define PHASE_BEGIN() do { int t_ = threadIdx.x; asm volatile("" : "+v"(t_)); C.tid = t_; C.lane = t_ & 63; C.wave = __builtin_amdgcn_readfirstlane(t_ >> 6); \
    int b_ = blockIdx.x; asm volatile("" : "+s"(b_)); C.bid = b_; unsigned char* w_ = args.ws; asm volatile("" : "+s"(w_)); C.ws = w_; ws = w_; \
    hb_c = (bf16_t*)(ws + (s ? B_HB1 : B_HB0)); hb_n = (bf16_t*)(ws + (s ? B_HB0 : B_HB1)); sq_c = (float*)(ws + (s ? B_SSQ1 : B_SSQ0)); sq_n = (float*)(ws + (s ? B_SSQ0 : B_SSQ1)); Ub = (bf16_t*)(ws + ARENA + A_U); MIXb = (bf16_t*)(ws + ARENA + A_MIX); \
    hch = args.out + (size_t)chunk * CH * DM; } while (0)
__global__ void __launch_bounds__(NT, 2) fwd_mega(Args args) {
    extern __shared__ __attribute__((aligned(16))) unsigned char lds_raw[];
    cg::grid_group grid = cg::this_grid();
    Ctx C; C.lds = (LAS unsigned char*)lds_raw; C.tid = threadIdx.x; C.lane = C.tid & 63; C.wave = __builtin_amdgcn_readfirstlane(C.tid >> 6);
    C.G = gridDim.x; C.bid = blockIdx.x; C.a = &args; C.ws = args.ws;
    unsigned char* ws = args.ws;
    bf16_t *hb_c, *hb_n; float *sq_c, *sq_n; bf16_t *Ub, *MIXb;
    if (blockIdx.x == 0) for (int i = threadIdx.x; i < XCD_BAR_WORDS; i += NT) ((unsigned*)args.ws)[i] = 0u;
    if (threadIdx.x < 2) ((volatile LAS unsigned*)(C.lds + LDS_BYTES - 256))[threadIdx.x] = 0u;
    weights_prologue(C);
    __syncthreads();
    grid.sync();
    XcdBarrier bar = xcd_barrier_post((unsigned*)args.ws, (volatile LAS unsigned*)(C.lds + LDS_BYTES - 256));
    float* hch;
#ifdef PROBE_A
    unsigned tacc[12];
#pragma unroll
    for (int i = 0; i < 12; ++i) tacc[i] = 0u;
    unsigned long long tprev = __builtin_amdgcn_s_memrealtime();
#define TICK(k) do { const unsigned long long now_ = __builtin_amdgcn_s_memrealtime(); tacc[k] += (unsigned)(now_ - tprev); tprev = now_; } while (0)
#else
#define TICK(k) do {} while (0)
#endif
#pragma nounroll
    for (int chunk = 0; chunk < NCHUNK; ++chunk) {
        const int T = chunk == 0 ? 4096 : 2048; int s = 0;
        PHASE_BEGIN();
        chunk_prologue(C, chunk, hb_c, sq_c);
        xcd_barrier(bar); TICK(10);
#pragma nounroll
        for (int l = 0; l < DEPTH; ++l) {
            const int even = (l & 1) == 0, li = l >> 1;
            Mix mx; mx.even = even; mx.li = li; mx.T = T; mx.DV = even ? 128 : 256; mx.ld = even ? EV_IN : OD_INP; mx.vcol = even ? 1536 : 1024; mx.gcol = 2048; mx.qscale = even ? 1.f : 0.08838834764831845f; mx.vf = nullptr;
            PHASE_BEGIN();
            {
                const int N = even ? EV_IN : OD_INP;
                const bf16_t* Wt = even ? (const bf16_t*)(ws + W_EVIN) + (size_t)li * EV_IN * DM : (const bf16_t*)(ws + W_ODIN) + (size_t)li * OD_INP * DM;
                pg8::Gemm g{hb_c, Wt, CH, N, DM, 256}; pg8::StaticOrder S; S.init(CH, N, C.G, C.bid);
                EpiScale E{Ub, N, sq_c};
                pg8::gemm_phase<EpiScale, pg8::StaticOrder, true, true>(C.lds, g, S, E);
            }
            xcd_barrier(bar); TICK(1);
            PHASE_BEGIN(); mx.vf = even ? (unsigned char*)hb_n : ws + ARENA + A_VFOD;
#ifndef NO_PREP
            prep_phase(C, mx);
#endif
            TICK(2);
            PHASE_BEGIN();
#ifndef NO_ATTN
            if (even) attn_phase(C, T);
#endif
            TICK(7);
            xcd_barrier(bar); TICK(0);
            PHASE_BEGIN(); mx.vf = even ? (unsigned char*)hb_n : ws + ARENA + A_VFOD;
#ifndef NO_SCAN
            scan_phase(C, mx);
#endif
            xcd_barrier(bar); TICK(3);
            PHASE_BEGIN();
#ifndef NO_FIN
            finalize_phase(C, mx);
#endif
            pb_convert(C, chunk, l);
            xcd_barrier(bar); TICK(4);
            PHASE_BEGIN();
            {
                const bf16_t* Wt = even ? (const bf16_t*)(ws + W_EVOUT) + (size_t)li * DM * DM : (const bf16_t*)(ws + W_ODOUT) + (size_t)li * DM * DM;
                pg8::Gemm g{MIXb, Wt, CH, DM, DM, 256}; pg8::StaticOrder S; S.init(CH, DM, C.G, C.bid);
                EpiResid<0> E{hch, hb_n, sq_n, nullptr, nullptr};
                pg8::gemm_phase<EpiResid<0>, pg8::StaticOrder, true, true>(C.lds, g, S, E);
                s ^= 1;
            }
            xcd_barrier(bar); TICK(5);
            PHASE_BEGIN();
            {
                pg8::Gemm g{hb_c - DM, (const bf16_t*)(ws + W_UP) + (size_t)l * 2 * DFF * DM, 65 * 256, 2 * DFF, DM, 254}; pg8::StaticOrder S; S.init(65 * 256, 2 * DFF, C.G, C.bid);
                EpiConv E{(bf16_t*)(ws + ARENA + A_ACT), sq_c, args.in[I_CW] + (size_t)l * 3 * 2 * DFF, args.in[I_CB] + (size_t)l * 2 * DFF, T, (LAS float*)(C.lds + 131072)};
                pg8::gemm_phase<EpiConv, pg8::StaticOrder, true, true>(C.lds, g, S, E);
            }
            {
                const int rem = (65 * 22) % C.G, c0 = rem, gs = rem ? C.G - rem : C.G;
                if (C.bid >= c0) {
                    PHASE_BEGIN();
                    pg8::Gemm g2{(const bf16_t*)(ws + B_PB), (const bf16_t*)(ws + W_PROJ) + (size_t)l * DM * PLE, CH, DM, PLE, 256}; pg8::StaticOrder S2; S2.init(CH, DM, gs, C.bid - c0);
                    EpiF32 E2{(bf16_t*)(ws + ARENA + A_PP), DM};
                    pg8::gemm_phase<EpiF32, pg8::StaticOrder, true, true>(C.lds, g2, S2, E2);
                }
            }
            xcd_barrier(bar); TICK(6);
            PHASE_BEGIN();
            {
                pg8::Gemm g{(const bf16_t*)(ws + ARENA + A_ACT), (const bf16_t*)(ws + W_DOWN) + (size_t)l * DM * DFF, CH, DM, DFF, 256}; pg8::StaticOrder S; S.init(CH, DM, C.G, C.bid);
                EpiResid<0> E{hch, hb_n, sq_n, nullptr, nullptr};
                pg8::gemm_phase<EpiResid<0>, pg8::StaticOrder, true, true>(C.lds, g, S, E);
                s ^= 1;
            }
            xcd_barrier(bar); TICK(8);
            PHASE_BEGIN();
            {
                pg8::Gemm g{hb_c, (const bf16_t*)(ws + W_GATE) + (size_t)l * DM * DM, CH, DM, DM, 256}; pg8::StaticOrder S; S.init(CH, DM, C.G, C.bid);
                EpiResid<1> E{hch, hb_n, sq_n, sq_c, (const bf16_t*)(ws + ARENA + A_PP)};
                pg8::gemm_phase<EpiResid<1>, pg8::StaticOrder, true, true>(C.lds, g, S, E);
                s ^= 1;
            }
            xcd_barrier(bar); TICK(9);
        }
        PHASE_BEGIN();
        final_norm(C, chunk);
        TICK(10);
    }
#ifdef PROBE_A
    xcd_barrier(bar); TICK(10);
    for (int i = 0; i < 100; ++i) xcd_barrier(bar);
    TICK(11);
    if (blockIdx.x == 0) {
        const float x1 = 8.f + (float)tacc[PROBE_A] * 1e-5f, t2 = 0.1f * (float)tacc[PROBE_B] * 1e-5f;
        float* o0 = args.out; float* o1 = args.out + (size_t)16384 * 1024;
        if (threadIdx.x == 0) { o0[0] += x1; o1[0] += x1; o1[1] += x1; }
        for (int i = threadIdx.x; i < 8192; i += NT) o0[1024 + i] += t2;
        for (int i = threadIdx.x; i < 16384; i += NT) o1[1024 + i] += t2;
    }
#endif
}
extern "C" void kernel_launch(void* const* d_in, const int* in_sizes, int n_in, void* d_out, int out_size, void* d_ws, size_t ws_size, hipStream_t stream) {
    static int grid = 0;
    if (grid == 0) {
        int dev = 0, cus = 0, per = 0;
        (void)hipGetDevice(&dev); (void)hipDeviceGetAttribute(&cus, hipDeviceAttributeMultiprocessorCount, dev);
        (void)hipFuncSetAttribute((const void*)fwd_mega, hipFuncAttributeMaxDynamicSharedMemorySize, LDS_BYTES);
        (void)hipOccupancyMaxActiveBlocksPerMultiprocessor(&per, (const void*)fwd_mega, NT, LDS_BYTES);
        if (per < 1) per = 1;
        grid = cus * per;
        fprintf(stderr, "kernel_launch: grid %d (cus %d x %d), ws %zu need %zu\n", grid, cus, per, ws_size, (size_t)WS_NEED);
        if (n_in != 23 || ws_size < WS_NEED) { fprintf(stderr, "kernel_launch: bad inputs / workspace too small\n"); grid = -1; }
    }
    if (grid < 0) return;
    Args a{};
    for (int i = 0; i < 23; ++i) a.in[i] = (const float*)d_in[i];
    a.out = (float*)d_out; a.ws = (unsigned char*)d_ws; a.ph_lo = 0; a.ph_hi = 0;
    void* kargs[] = {&a};
    hipError_t e = hipLaunchCooperativeKernel((const void*)fwd_mega, dim3(grid), dim3(NT), kargs, LDS_BYTES, stream);
    if (e != hipSuccess) fprintf(stderr, "kernel_launch: cooperative launch failed: %s\n", hipGetErrorString(e));
}
```

```cpp
#include <hip/hip_runtime.h>
#include <hip/hip_cooperative_groups.h>
#include <cstdio>
#include <cstdint>
namespace cg = cooperative_groups;
namespace pg8 {
#define PG8_LAS __attribute__((address_space(3)))
typedef unsigned short bf16_t;
typedef short bf16x8 __attribute__((ext_vector_type(8)));
typedef float f32x4 __attribute__((ext_vector_type(4)));
typedef unsigned u32x4 __attribute__((ext_vector_type(4)));
constexpr int BM = 256, BK = 64, HALF = 128, HTB = HALF * BK * 2  , STAGE_BYTES = 8 * HTB, NXCD = 8, WGM = 8;

__host__ __device__ __forceinline__ int lds_byte(int r, int c) { const int st = (r >> 4) * 2 + (c >> 5), rr = r & 15, cc = c & 31, ob = rr * 64 + cc * 2; return st * 1024 + (ob ^ (((ob >> 9) & 1) << 5)); }
__host__ __device__ __forceinline__ void stage_rc(int b, int& R, int& C) { const int st = b / 1024, sb = b % 1024, swz = sb ^ (((sb >> 9) & 1) << 5); R = (st >> 1) * 16 + swz / 64; C = (st & 1) * 32 + (swz % 64) / 2; }
__host__ __device__ __forceinline__ int perm32(int rho) { const int n = rho >> 4, i = rho & 15; return 8 * (i >> 2) + 4 * n + (i & 3); }

struct Unit { int pm, pn; };
struct Gemm { const bf16_t* A; const bf16_t* Bt; int M, N, K; int arows; };

struct StaticOrder {
    int nM, nN, nwg, G, c;
    __host__ __device__ void init(int M, int N, int G_, int c_) { nM = M / BM; nN = N / BM; nwg = nM * nN; G = G_; c = c_; }
    __host__ __device__ bool next(int i, Unit& u) const {
        const long L = (long)i * G + c; if (L >= nwg) return false;
        int wgid = (int)L; { const int q = nwg / NXCD, r = nwg % NXCD, xcd = wgid % NXCD, off = wgid / NXCD; wgid = (xcd < r ? xcd * (q + 1) : r * (q + 1) + (xcd - r) * q) + off; }
        const int nig = WGM * nN, gid = wgid / nig, fm = gid * WGM, gsz = (nM - fm) < WGM ? (nM - fm) : WGM;
        u.pm = fm + ((wgid % nig) % gsz); u.pn = (wgid % nig) / gsz; return true;
    }
    __device__ __forceinline__ void a_ready(const Unit&) const {}
    __device__ __forceinline__ void done(const Unit&) const {}
};

__device__ __forceinline__ unsigned cvt_pk_bf16(float lo, float hi) { unsigned r; asm volatile("v_cvt_pk_bf16_f32 %0, %1, %2" : "=v"(r) : "v"(lo), "v"(hi)); return r; }
typedef float f32x2 __attribute__((ext_vector_type(2)));
__device__ __forceinline__ f32x2 gelu_pk(f32x2 v) {
    const f32x2 av = __builtin_elementwise_abs(v), d = av * 0.2316418882f + 1.0f;
    f32x2 t; t.x = __builtin_amdgcn_rcpf(d.x); t.y = __builtin_amdgcn_rcpf(d.y);
    f32x2 q = t * 0.5307027145f + (-0.7265760135f); q = q * t + 0.7107068705f; q = q * t + (-0.142248368f); q = q * t + 0.127414796f; q = q * t;
    const f32x2 s = (v * v) * (-0.72134752044f);
    f32x2 e; e.x = __builtin_amdgcn_exp2f(s.x); e.y = __builtin_amdgcn_exp2f(s.y);
    const f32x2 m = v * (q * e), r = v - m;
    f32x2 o; o.x = v.x < 0.f ? m.x : r.x; o.y = v.y < 0.f ? m.y : r.y; return o;
}

template <int ACT  > struct EpiBf16 {
    static constexpr bool PERM = true, AFTER_DRAIN = false; static_assert(ACT == 0 || ACT == 1, "EpiBf16: ACT is 0 (none) or 1 (gelu_pk)");
    bf16_t* O; int ldc; const float* bias; int split_cols; size_t split_stride; float scale0;
    __device__ __forceinline__ void operator()(const f32x4 (&acc)[2][2][4][2], const Unit& u, int wr, int wc, int fr, int fq) const {
        const int row0 = u.pm * BM + wr * 64 + fr; int colt = u.pn * BM; bf16_t* base = O;
        float sc = 1.f; if (split_cols) { const int t = colt / split_cols; base += (size_t)t * split_stride; colt -= t * split_cols; if (t == 0) sc = scale0; }
        const int col0 = colt + wc * 32 + 8 * fq, bcol0 = u.pn * BM + wc * 32 + 8 * fq;
        f32x4 bv[2][2];
#pragma unroll
        for (int bj = 0; bj < 2; ++bj)
#pragma unroll
            for (int n = 0; n < 2; ++n) bv[bj][n] = bias ? *(const f32x4*)(bias + bcol0 + bj * HALF + 4 * n) : (f32x4){0.f, 0.f, 0.f, 0.f};
#pragma unroll
        for (int ai = 0; ai < 2; ++ai)
#pragma unroll
            for (int m = 0; m < 4; ++m) { bf16_t* rowp = base + (size_t)(row0 + ai * HALF + m * 16) * ldc + col0;
#pragma unroll
                for (int bj = 0; bj < 2; ++bj) { f32x4 v0 = acc[ai][bj][m][0] + bv[bj][0], v1 = acc[ai][bj][m][1] + bv[bj][1];
                    if (ACT == 1) { f32x2 a = gelu_pk((f32x2){v0[0], v0[1]}), b = gelu_pk((f32x2){v0[2], v0[3]}), c = gelu_pk((f32x2){v1[0], v1[1]}), d = gelu_pk((f32x2){v1[2], v1[3]});
                        v0 = (f32x4){a.x, a.y, b.x, b.y}; v1 = (f32x4){c.x, c.y, d.x, d.y}; }
                    v0 = v0 * sc; v1 = v1 * sc; u32x4 w; w.x = cvt_pk_bf16(v0[0], v0[1]); w.y = cvt_pk_bf16(v0[2], v0[3]); w.z = cvt_pk_bf16(v1[0], v1[1]); w.w = cvt_pk_bf16(v1[2], v1[3]);
                    *(u32x4*)(rowp + bj * HALF) = w; } }
    }
};
template <class Epi, class Sched, bool ALIGN_EPI = false, bool SP2 = false>
__device__ __forceinline__ void gemm_phase(PG8_LAS unsigned char* lds, const Gemm g, const Sched& S, const Epi& E) {
    int tid_ = threadIdx.x; asm volatile("" : "+v"(tid_)); const int tid = tid_, wid = __builtin_amdgcn_readfirstlane(tid >> 6), lane = tid & 63, wr = wid >> 2, wc = wid & 3, fr = lane & 15, fq = lane >> 4;
    int K_ = g.K; asm volatile("" : "+s"(K_)); const int K = K_, nt = K / BK;
    unsigned voffA[2], voffB[2];
#pragma unroll
    for (int i = 0; i < 2; ++i) { int R, C; stage_rc(tid * 16 + i * 8192, R, C); const int Rb = Epi::PERM ? ((R & ~31) + perm32(R & 31)) : R;
        voffA[i] = (unsigned)(R * K + C) * 2u; voffB[i] = (unsigned)(Rb * K + C) * 2u; }
    const size_t kstep = (size_t)(BK * 2);
    const size_t hstep = (size_t)HALF * K * 2;
    const size_t tstep = 2 * hstep; const size_t tstepA = (size_t)g.arows * K * 2;
    const unsigned ldsw = (unsigned)wid * 1024u;
    const int aoff = lds_byte(wr * 64 + fr, fq * 8), boff = lds_byte(wc * 32 + fr, fq * 8);
#define PG8_SA(b, h) (((b) * 2 + (h)) * HTB)
#define PG8_SB(b, h) ((4 + (b) * 2 + (h)) * HTB)
#define PG8_STAGE(bufoff, gbase, voff) do { _Pragma("unroll") for (int _i = 0; _i < 2; ++_i) \
        __builtin_amdgcn_global_load_lds((const unsigned*)((const char*)(gbase) + (voff)[_i]), (PG8_LAS unsigned*)(lds + (bufoff) + ldsw + _i * 8192), 16, 0, 0); } while (0)
#define PG8_LDA(dst, b, h) do { _Pragma("unroll") for (int m = 0; m < 4; ++m) _Pragma("unroll") for (int k = 0; k < 2; ++k) dst[m][k] = *(const PG8_LAS bf16x8*)(lds + PG8_SA(b, h) + aoff + m * 2048 + k * 1024); } while (0)
#define PG8_LDB(dst, b, h) do { _Pragma("unroll") for (int n = 0; n < 2; ++n) _Pragma("unroll") for (int k = 0; k < 2; ++k) dst[n][k] = *(const PG8_LAS bf16x8*)(lds + PG8_SB(b, h) + boff + n * 2048 + k * 1024); } while (0)
#define PG8_MMA(ai, bj, At, Bt) do { __builtin_amdgcn_s_setprio(1); _Pragma("unroll") for (int m = 0; m < 4; ++m) _Pragma("unroll") for (int n = 0; n < 2; ++n) _Pragma("unroll") for (int k = 0; k < 2; ++k) \
        acc[ai][bj][m][n] = __builtin_amdgcn_mfma_f32_16x16x32_bf16(Bt[n][k], At[m][k], acc[ai][bj][m][n], 0, 0, 0); __builtin_amdgcn_s_setprio(0); } while (0)
#define PG8_WAIT_V(n) asm volatile("s_waitcnt vmcnt(" #n ")" ::: "memory")
#define PG8_WAIT_L(n) asm volatile("s_waitcnt lgkmcnt(" #n ")" ::: "memory")
#define PG8_BAR __builtin_amdgcn_s_barrier()
#define PG8_SCHED __builtin_amdgcn_sched_barrier(0)
    Unit cur, nxt; int ui = 0;
    if (!S.next(0, cur)) return;
    f32x4 acc[2][2][4][2];
#pragma unroll
    for (int a = 0; a < 2; ++a)
#pragma unroll
        for (int b = 0; b < 2; ++b)
#pragma unroll
            for (int m = 0; m < 4; ++m)
#pragma unroll
                for (int n = 0; n < 2; ++n) acc[a][b][m][n] = (f32x4){0.f, 0.f, 0.f, 0.f};
    bf16x8 At[4][2], B0[2][2], B1[2][2];
    const char* cA = (const char*)g.A + (size_t)cur.pm * tstepA; const char* cB = (const char*)g.Bt + (size_t)cur.pn * tstep;
    S.a_ready(cur);
    if constexpr (SP2) {
        PG8_STAGE(PG8_SB(0, 0), cB, voffB); PG8_STAGE(PG8_SB(0, 1), cB + hstep, voffB); PG8_STAGE(PG8_SA(0, 0), cA, voffA); PG8_STAGE(PG8_SA(0, 1), cA + hstep, voffA);
        if (wr == 1) PG8_BAR;
        PG8_WAIT_V(2); PG8_BAR;
        PG8_STAGE(PG8_SB(1, 0), cB + kstep, voffB); PG8_STAGE(PG8_SA(1, 0), cA + kstep, voffA); PG8_STAGE(PG8_SB(1, 1), cB + hstep + kstep, voffB);
        PG8_WAIT_V(6); PG8_BAR;
    } else {
        PG8_STAGE(PG8_SB(0, 0), cB, voffB); PG8_STAGE(PG8_SA(0, 0), cA, voffA); PG8_STAGE(PG8_SB(0, 1), cB + hstep, voffB); PG8_STAGE(PG8_SA(0, 1), cA + hstep, voffA);
        if (wr == 1) PG8_BAR;
        PG8_WAIT_V(4); PG8_BAR;
        PG8_STAGE(PG8_SB(1, 0), cB + kstep, voffB); PG8_STAGE(PG8_SA(1, 0), cA + kstep, voffA); PG8_STAGE(PG8_SB(1, 1), cB + hstep + kstep, voffB);
        PG8_WAIT_V(6); PG8_BAR;
    }
    for (;;) {
        const bool has_next = S.next(ui + 1, nxt);
        const char* nA = has_next ? (const char*)g.A + (size_t)nxt.pm * tstepA : cA; const char* nB = has_next ? (const char*)g.Bt + (size_t)nxt.pn * tstep : cB;
        for (int t = 0; t < nt; t += 2) {
            const bool last = (t == nt - 2);
            const char* a1 = cA + (size_t)(t + 1) * kstep;
            const char* a2 = last ? nA : cA + (size_t)(t + 2) * kstep; const char* b2 = last ? nB : cB + (size_t)(t + 2) * kstep;
            const char* a3 = a2 + kstep; const char* b3 = b2 + kstep;
            if (last && has_next) S.a_ready(nxt);
            if constexpr (SP2) {
            PG8_LDB(B0, 0, 0); PG8_LDB(B1, 0, 1); PG8_SCHED; PG8_LDA(At, 0, 0); PG8_STAGE(PG8_SA(1, 1), a1 + hstep, voffA);
            PG8_WAIT_V(8); PG8_WAIT_L(0); PG8_BAR; PG8_MMA(0, 0, At, B0); PG8_MMA(0, 1, At, B1); PG8_BAR; PG8_SCHED;
            PG8_LDA(At, 0, 1); PG8_STAGE(PG8_SB(0, 0), b2, voffB); PG8_STAGE(PG8_SB(0, 1), b2 + hstep, voffB); PG8_STAGE(PG8_SA(0, 0), a2, voffA);
            PG8_WAIT_V(8); PG8_WAIT_L(0); PG8_BAR; PG8_MMA(1, 0, At, B0); PG8_MMA(1, 1, At, B1); PG8_BAR; PG8_SCHED;
            PG8_LDB(B0, 1, 0); PG8_LDB(B1, 1, 1); PG8_SCHED; PG8_LDA(At, 1, 0); PG8_STAGE(PG8_SA(0, 1), a2 + hstep, voffA);
            PG8_WAIT_V(8); PG8_WAIT_L(0); PG8_BAR; PG8_MMA(0, 0, At, B0); PG8_MMA(0, 1, At, B1); PG8_BAR; PG8_SCHED;
            PG8_LDA(At, 1, 1); PG8_STAGE(PG8_SB(1, 0), b3, voffB); PG8_STAGE(PG8_SB(1, 1), b3 + hstep, voffB); PG8_STAGE(PG8_SA(1, 0), a3, voffA);
            PG8_WAIT_V(8); PG8_WAIT_L(0); PG8_BAR; PG8_MMA(1, 0, At, B0); PG8_MMA(1, 1, At, B1); PG8_BAR; PG8_SCHED;
            } else {
            PG8_LDB(B0, 0, 0); PG8_SCHED; PG8_LDA(At, 0, 0); PG8_STAGE(PG8_SA(1, 1), a1 + hstep, voffA);
            PG8_WAIT_L(8); PG8_BAR; PG8_WAIT_L(0); PG8_MMA(0, 0, At, B0); PG8_BAR; PG8_SCHED;
            PG8_LDB(B1, 0, 1); PG8_STAGE(PG8_SB(0, 0), b2, voffB);
            PG8_BAR; PG8_WAIT_L(0); PG8_MMA(0, 1, At, B1); PG8_BAR;
            PG8_LDA(At, 0, 1); PG8_STAGE(PG8_SA(0, 0), a2, voffA);
            PG8_BAR; PG8_WAIT_L(0); PG8_MMA(1, 0, At, B0); PG8_BAR; PG8_SCHED;
            PG8_STAGE(PG8_SB(0, 1), b2 + hstep, voffB);
            PG8_WAIT_V(6); PG8_BAR; PG8_MMA(1, 1, At, B1); PG8_BAR;
            PG8_LDB(B0, 1, 0); PG8_SCHED; PG8_LDA(At, 1, 0); PG8_STAGE(PG8_SA(0, 1), a2 + hstep, voffA);
            PG8_WAIT_L(8); PG8_BAR; PG8_WAIT_L(0); PG8_MMA(0, 0, At, B0); PG8_BAR; PG8_SCHED;
            PG8_LDB(B1, 1, 1); PG8_STAGE(PG8_SB(1, 0), b3, voffB);
            PG8_BAR; PG8_WAIT_L(0); PG8_MMA(0, 1, At, B1); PG8_BAR;
            PG8_LDA(At, 1, 1); PG8_STAGE(PG8_SA(1, 0), a3, voffA);
            PG8_BAR; PG8_WAIT_L(0); PG8_MMA(1, 0, At, B0); PG8_BAR; PG8_SCHED;
            PG8_STAGE(PG8_SB(1, 1), b3 + hstep, voffB);
            PG8_WAIT_V(6); PG8_BAR; PG8_MMA(1, 1, At, B1); PG8_BAR;
            }
        }
        if constexpr (ALIGN_EPI) { if (wr == 0) PG8_BAR; }
        if constexpr (!Epi::AFTER_DRAIN) { E(acc, cur, wr, wc, fr, fq); S.done(cur); }
        if (!has_next) break;
#pragma unroll
        for (int a = 0; a < 2; ++a)
#pragma unroll
            for (int b = 0; b < 2; ++b)
#pragma unroll
                for (int m = 0; m < 4; ++m)
#pragma unroll
                    for (int n = 0; n < 2; ++n) acc[a][b][m][n] = (f32x4){0.f, 0.f, 0.f, 0.f};
        cur = nxt; cA = nA; cB = nB; ++ui;
        if constexpr (ALIGN_EPI) { if (wr == 1) PG8_BAR; }
    }
    PG8_WAIT_V(0);
    if constexpr (!ALIGN_EPI) { if (wr == 0) PG8_BAR; }
    PG8_BAR;
    if constexpr (Epi::AFTER_DRAIN) { E.fused(acc, cur, wr, wc, fr, fq, lds, wid, lane); S.done(cur); }
#undef PG8_SA
#undef PG8_SB
#undef PG8_STAGE
#undef PG8_LDA
#undef PG8_LDB
#undef PG8_MMA
#undef PG8_WAIT_V
#undef PG8_WAIT_L
#undef PG8_BAR
#undef PG8_SCHED
}
}
typedef unsigned short bf16_t;
typedef short bf16x8 __attribute__((ext_vector_type(8)));
typedef float f32x4 __attribute__((ext_vector_type(4)));
typedef float f32x2 __attribute__((ext_vector_type(2)));
typedef float f32x16 __attribute__((ext_vector_type(16)));
typedef unsigned u32x4 __attribute__((ext_vector_type(4)));
typedef unsigned u32x2 __attribute__((ext_vector_type(2)));
#define LAS __attribute__((address_space(3)))
constexpr int DM = 1024, CH = 16384, NCHUNK = 3, DEPTH = 4, PLE = 256, DFF = 2816;
constexpr int EV_IN = 7168, OD_IN = 3104, OD_INP = 3328;
constexpr float EPS = 1e-6f;
constexpr int NT = 512, NWV = 8;
constexpr int LDS_BYTES = 147456;
constexpr size_t al256(size_t x) { return (x + 255) & ~(size_t)255; }
constexpr size_t W_EVIN = 65536;
constexpr size_t W_EVOUT = W_EVIN + (size_t)2 * EV_IN * DM * 2;
constexpr size_t W_ODIN = W_EVOUT + (size_t)2 * DM * DM * 2;
constexpr size_t W_ODOUT = W_ODIN + (size_t)2 * OD_INP * DM * 2;
constexpr size_t W_UP = W_ODOUT + (size_t)2 * DM * DM * 2;
constexpr size_t W_DOWN = W_UP + (size_t)4 * 2 * DFF * DM * 2;
constexpr size_t W_GATE = W_DOWN + (size_t)4 * DM * DFF * 2;
constexpr size_t W_PROJ = W_GATE + (size_t)4 * DM * DM * 2;
constexpr size_t W_LB = W_PROJ + (size_t)4 * DM * PLE * 2;
constexpr size_t B_PB = W_LB + 8192;
constexpr size_t B_HB0 = B_PB + (size_t)CH * PLE * 2;
constexpr size_t B_HB1 = B_HB0 + (size_t)CH * DM * 2;
constexpr size_t B_SSQ0 = B_HB1 + (size_t)CH * DM * 2;
constexpr size_t B_SSQ1 = B_SSQ0 + (size_t)CH * 16 * 4;
constexpr size_t ARENA = B_SSQ1 + (size_t)CH * 16 * 4;
constexpr size_t A_U = 0;
constexpr size_t A_QT = (size_t)CH * EV_IN * 2;
constexpr size_t A_KT = A_QT + (size_t)2 * CH * 512 * 2;
constexpr size_t A_MIX = A_QT;
constexpr size_t A_OEV = A_KT + (size_t)2 * CH * 512 * 2;
constexpr size_t A_VFOD = (size_t)CH * OD_INP * 2;
constexpr size_t A_OOD = A_OEV;
constexpr size_t A_OG = A_OEV + (size_t)2 * CH * 512 * 4;
constexpr size_t A_LSE = A_OG + (size_t)3 * CH * 512 * 2;
constexpr size_t A_DEC = A_OOD + (size_t)2 * CH * 1024 * 4;
constexpr size_t ARENA_BYTES = A_DEC + (size_t)512 * 4 * 2 * 128 * 4;
constexpr size_t A_UF = 0;
constexpr size_t A_ACT = (size_t)CH * 2 * DFF * 2;
constexpr size_t A_PP = 0;
constexpr size_t WS_NEED = ARENA + ARENA_BYTES;
static_assert(A_LSE + (size_t)3 * CH * 4 * 4 <= A_DEC, "even bufs before DEC");
static_assert(A_VFOD + (size_t)CH * 1024 * 2 * 2 <= A_QT, "odd Vf fits before QT");
static_assert(A_ACT + (size_t)CH * DFF * 2 <= ARENA_BYTES, "act fits");

__device__ __forceinline__ float bf2f(unsigned short v) { return __uint_as_float(((unsigned)v) << 16); }
__device__ __forceinline__ unsigned pk2(float lo, float hi) { return pg8::cvt_pk_bf16(lo, hi); }
typedef float f32x2_cv __attribute__((ext_vector_type(2))); typedef __bf16 bf16x2_cv __attribute__((ext_vector_type(2)));
__device__ __forceinline__ unsigned pk2s(float lo, float hi) { const f32x2_cv v = {lo, hi}; const bf16x2_cv c = __builtin_convertvector(v, bf16x2_cv); return __builtin_bit_cast(unsigned, c); }
__device__ __forceinline__ float shfl_xor_l(float v, int lane, int m) { return __builtin_bit_cast(float, __builtin_amdgcn_ds_bpermute((lane ^ m) << 2, __builtin_bit_cast(int, v))); }
__device__ __forceinline__ float wave_sum(float v, int lane) {
#pragma unroll
    for (int o = 1; o < 64; o <<= 1) v += shfl_xor_l(v, lane, o);
    return v;
}
__device__ __forceinline__ float rstd_of(const float* ssq, int row) {
    const f32x4* p = (const f32x4*)(ssq + (size_t)row * 16);
    const f32x4 a = p[0], b = p[1], c = p[2], d = p[3];
    const float s = ((a.x + a.y) + (a.z + a.w)) + ((b.x + b.y) + (b.z + b.w)) + ((c.x + c.y) + (c.z + c.w)) + ((d.x + d.y) + (d.z + d.w));
    return rsqrtf(s * (1.0f / DM) + EPS);
}
struct EpiScale {
    static constexpr bool PERM = true, AFTER_DRAIN = false;
    bf16_t* O; int ldc; const float* ssq;
    __device__ __forceinline__ void operator()(const f32x4 (&acc)[2][2][4][2], const pg8::Unit& u, int wr, int wc, int fr, int fq) const {
        const int row0 = u.pm * 256 + wr * 64 + fr, col0 = u.pn * 256 + wc * 32 + 8 * fq;
#pragma unroll
        for (int ai = 0; ai < 2; ++ai)
#pragma unroll
            for (int m = 0; m < 4; ++m) {
                const int row = row0 + ai * 128 + m * 16; const float rs = rstd_of(ssq, row);
                bf16_t* rp = O + (size_t)row * ldc + col0;
#pragma unroll
                for (int bj = 0; bj < 2; ++bj) { const f32x4 v0 = acc[ai][bj][m][0] * rs, v1 = acc[ai][bj][m][1] * rs;
                    u32x4 w; w.x = pk2(v0[0], v0[1]); w.y = pk2(v0[2], v0[3]); w.z = pk2(v1[0], v1[1]); w.w = pk2(v1[2], v1[3]);
                    *(u32x4*)(rp + bj * 128) = w; }
            }
    }
};
struct EpiF32 {
    static constexpr bool PERM = true, AFTER_DRAIN = false;
    bf16_t* O; int ldc;
    __device__ __forceinline__ void operator()(const f32x4 (&acc)[2][2][4][2], const pg8::Unit& u, int wr, int wc, int fr, int fq) const {
        const int row0 = u.pm * 256 + wr * 64 + fr, col0 = u.pn * 256 + wc * 32 + 8 * fq;
#pragma unroll
        for (int ai = 0; ai < 2; ++ai)
#pragma unroll
            for (int m = 0; m < 4; ++m) { bf16_t* rp = O + (size_t)(row0 + ai * 128 + m * 16) * ldc + col0;
#pragma unroll
                for (int bj = 0; bj < 2; ++bj) { const f32x4 v0 = acc[ai][bj][m][0], v1 = acc[ai][bj][m][1];
                    u32x4 w; w.x = pk2s(v0[0], v0[1]); w.y = pk2s(v0[2], v0[3]); w.z = pk2s(v1[0], v1[1]); w.w = pk2s(v1[2], v1[3]);
                    *(u32x4*)(rp + bj * 128) = w; } }
    }
};
template <int MODE  > struct EpiResid {
    static constexpr bool PERM = true, AFTER_DRAIN = false;
    float* h; bf16_t* hb; float* ssq_out; const float* ssq_in; const bf16_t* pp;
    __device__ __forceinline__ void operator()(const f32x4 (&acc)[2][2][4][2], const pg8::Unit& u, int wr, int wc, int fr, int fq) const {
        const int row0 = u.pm * 256 + wr * 64 + fr, col0 = u.pn * 256 + wc * 32 + 8 * fq;
#pragma unroll
        for (int ai = 0; ai < 2; ++ai)
#pragma unroll
            for (int m = 0; m < 4; ++m) {
                const int row = row0 + ai * 128 + m * 16; float rs = 1.f; if (MODE == 1) rs = rstd_of(ssq_in, row);
                float* hp = h + (size_t)row * DM + col0; bf16_t* bp = hb + (size_t)row * DM + col0; float s = 0.f;
#pragma unroll
                for (int bj = 0; bj < 2; ++bj) {
                    f32x4 a0 = acc[ai][bj][m][0], a1 = acc[ai][bj][m][1];
                    if (MODE == 1) { const u32x4 pw = *(const u32x4*)(pp + (size_t)row * DM + col0 + bj * 128);
                        const f32x4 p0 = {__uint_as_float(pw.x << 16), __uint_as_float(pw.x & 0xffff0000u), __uint_as_float(pw.y << 16), __uint_as_float(pw.y & 0xffff0000u)};
                        const f32x4 p1 = {__uint_as_float(pw.z << 16), __uint_as_float(pw.z & 0xffff0000u), __uint_as_float(pw.w << 16), __uint_as_float(pw.w & 0xffff0000u)};
#pragma unroll
                        for (int e = 0; e < 4; ++e) { a0[e] = p0[e] / (1.f + __expf(-a0[e] * rs)); a1[e] = p1[e] / (1.f + __expf(-a1[e] * rs)); } }
                    const f32x4 h0 = *(const f32x4*)(hp + bj * 128) + a0, h1 = *(const f32x4*)(hp + bj * 128 + 4) + a1;
                    *(f32x4*)(hp + bj * 128) = h0; *(f32x4*)(hp + bj * 128 + 4) = h1;
                    u32x4 w; w.x = pk2(h0[0], h0[1]); w.y = pk2(h0[2], h0[3]); w.z = pk2(h1[0], h1[1]); w.w = pk2(h1[2], h1[3]);
                    *(u32x4*)(bp + bj * 128) = w;
                    s += (h0[0] * h0[0] + h0[1] * h0[1]) + (h0[2] * h0[2] + h0[3] * h0[3]) + (h1[0] * h1[0] + h1[1] * h1[1]) + (h1[2] * h1[2] + h1[3] * h1[3]);
                }
                { const int ln_ = fq * 16 + fr; s += shfl_xor_l(s, ln_, 16); s += shfl_xor_l(s, ln_, 32); }
                if (fq == 0) ssq_out[(size_t)row * 16 + u.pn * 4 + wc] = s;
            }
    }
};

struct EpiConv {
    static constexpr bool PERM = true, AFTER_DRAIN = false;
    bf16_t* act; const float* ssq; const float* cw; const float* cb; int T; LAS float* halo;
    __device__ __forceinline__ void operator()(f32x4 (&acc)[2][2][4][2], const pg8::Unit& u, int wr, int wc, int fr, int fq) const {
        const int g0 = 254 * u.pm - 1, lane = fq * 16 + fr;
#pragma unroll
        for (int ai = 0; ai < 2; ++ai)
#pragma unroll
            for (int m = 0; m < 4; ++m) { const float rs = rstd_of(ssq, g0 + ai * 128 + wr * 64 + m * 16 + fr);
#pragma unroll
                for (int bj = 0; bj < 2; ++bj) { acc[ai][bj][m][0] = acc[ai][bj][m][0] * rs; acc[ai][bj][m][1] = acc[ai][bj][m][1] * rs; } }
#pragma unroll
        for (int ai = 0; ai < 2; ++ai) { const int s = 2 * ai + wr;
            if (fr == 0) {
#pragma unroll
                for (int bj = 0; bj < 2; ++bj)
#pragma unroll
                    for (int n = 0; n < 2; ++n) *(LAS f32x4*)(halo + ((((wc * 4 + s) * 2 + 0) * 2 + bj) * 32) + 8 * fq + 4 * n) = acc[ai][bj][0][n]; }
            if (fr == 15) {
#pragma unroll
                for (int bj = 0; bj < 2; ++bj)
#pragma unroll
                    for (int n = 0; n < 2; ++n) *(LAS f32x4*)(halo + ((((wc * 4 + s) * 2 + 1) * 2 + bj) * 32) + 8 * fq + 4 * n) = acc[ai][bj][3][n]; } }
        asm volatile("s_waitcnt lgkmcnt(0)" ::: "memory"); __builtin_amdgcn_s_barrier(); asm volatile("" ::: "memory");
#pragma unroll
        for (int n = 0; n < 2; ++n) {
            const int ca = u.pn * 128 + wc * 32 + 8 * fq + 4 * n;
            f32x4 w0[2], w1[2], w2[2], bb[2];
#pragma unroll
            for (int bj = 0; bj < 2; ++bj) { const int c = bj * DFF + ca;
                w0[bj] = *(const f32x4*)(cw + c); w1[bj] = *(const f32x4*)(cw + 2 * DFF + c); w2[bj] = *(const f32x4*)(cw + 4 * DFF + c); bb[bj] = *(const f32x4*)(cb + c); }
#pragma unroll
            for (int ai = 0; ai < 2; ++ai) { const int s = 2 * ai + wr;
#pragma unroll
                for (int m = 0; m < 4; ++m) {
                    const int lr = ai * 128 + wr * 64 + m * 16 + fr, g = g0 + lr; const bool tp = (g & (T - 1)) != 0, tn = ((g + 1) & (T - 1)) != 0;
                    f32x4 ph[2] = {{0.f, 0.f, 0.f, 0.f}, {0.f, 0.f, 0.f, 0.f}}, nh[2] = {{0.f, 0.f, 0.f, 0.f}, {0.f, 0.f, 0.f, 0.f}};
                    if (m == 0 && s > 0) {
#pragma unroll
                        for (int bj = 0; bj < 2; ++bj) ph[bj] = *(const LAS f32x4*)(halo + ((((wc * 4 + s - 1) * 2 + 1) * 2 + bj) * 32) + 8 * fq + 4 * n); }
                    if (m == 3 && s < 3) {
#pragma unroll
                        for (int bj = 0; bj < 2; ++bj) nh[bj] = *(const LAS f32x4*)(halo + ((((wc * 4 + s + 1) * 2 + 0) * 2 + bj) * 32) + 8 * fq + 4 * n); }
                    float cv[2][4];
#pragma unroll
                    for (int bj = 0; bj < 2; ++bj)
#pragma unroll
                        for (int e = 0; e < 4; ++e) {
                            const float cur = acc[ai][bj][m][n][e];
                            const float sp_ = (fr == 15) ? (m > 0 ? acc[ai][bj][m > 0 ? m - 1 : 0][n][e] : ph[bj][e]) : cur;
                            const float sn_ = (fr == 0) ? (m < 3 ? acc[ai][bj][m < 3 ? m + 1 : 3][n][e] : nh[bj][e]) : cur;
                            const float pv = __builtin_bit_cast(float, __builtin_amdgcn_update_dpp(0, __builtin_bit_cast(int, sp_), 0x121, 0xf, 0xf, false));
                            const float nv = __builtin_bit_cast(float, __builtin_amdgcn_update_dpp(0, __builtin_bit_cast(int, sn_), 0x12F, 0xf, 0xf, false));
                            float t_ = fmaf(cur, w1[bj][e], bb[bj][e]); t_ = tp ? fmaf(pv, w0[bj][e], t_) : t_; t_ = tn ? fmaf(nv, w2[bj][e], t_) : t_; cv[bj][e] = t_;
                        }
                    const f32x2 g01 = pg8::gelu_pk((f32x2){cv[1][0], cv[1][1]}), g23 = pg8::gelu_pk((f32x2){cv[1][2], cv[1][3]});
                    if (lr >= 1 && lr <= 254 && g < CH) { u32x2 w; w.x = pk2(cv[0][0] * g01.x, cv[0][1] * g01.y); w.y = pk2(cv[0][2] * g23.x, cv[0][3] * g23.y);
                        *(u32x2*)(act + (size_t)g * DFF + ca) = w; }
                    __builtin_amdgcn_sched_barrier(0);
                }
            }
            asm volatile("" ::: "memory");
        }
    }
};
struct Args {
    const float* in[23]; float* out; unsigned char* ws; int ph_lo, ph_hi;
};
enum { I_XP = 0, I_XS, I_PP, I_PS, I_NMIX, I_EVIN, I_LBL, I_HNORM, I_EVOUT, I_ODIN, I_GUP, I_GB, I_GNORM, I_ODOUT, I_NFFN, I_FUP, I_CW, I_CB, I_FDOWN, I_NPLE, I_PGATE, I_PPROJ, I_NOUT };

struct Ctx {
    LAS unsigned char* lds; int tid, lane, wave, G, bid;
    const Args* a; unsigned char* ws;
};

__device__ __forceinline__ void transpose_item(const float* W, int K, int N, const float* gk, bf16_t* WT, LAS float* scr, int item, int lane, bool remap) {
    const int nblk = N / 32, kb = item / nblk, nb = item % nblk, k0 = 64 * kb, n0 = 32 * nb;
#pragma unroll 8
    for (int i = 0; i < 32; ++i) { const int kk = 2 * i + (lane >> 5); float v = W[(size_t)(k0 + kk) * N + n0 + (lane & 31)]; if (gk) v *= gk[k0 + kk]; scr[kk * 33 + (lane & 31)] = v; }
    asm volatile("s_waitcnt lgkmcnt(0)" ::: "memory");
    const int c = lane & 7;
#pragma unroll
    for (int j = 0; j < 4; ++j) { const int n = (lane >> 3) + 8 * j; const LAS float* s = scr + (8 * c) * 33 + n;
        u32x4 o; o.x = pk2(s[0 * 33], s[1 * 33]); o.y = pk2(s[2 * 33], s[3 * 33]); o.z = pk2(s[4 * 33], s[5 * 33]); o.w = pk2(s[6 * 33], s[7 * 33]);
        int nr = n0 + n; if (remap) nr = (nr < DFF) ? (((nr >> 7) << 8) + (nr & 127)) : ((((nr - DFF) >> 7) << 8) + 128 + ((nr - DFF) & 127));
        *(u32x4*)(WT + (size_t)nr * K + k0 + 8 * c) = o; }
    asm volatile("s_waitcnt lgkmcnt(0)" ::: "memory");
}
__device__ __forceinline__ void weights_prologue(const Ctx& C) {
    LAS float* scr = (LAS float*)(C.lds + C.wave * 8704);
    const int gw = C.bid * NWV + C.wave, NGW = C.G * NWV;
    const Args& a = *C.a;
    for (int mat = 0; mat < 24; ++mat) {
        const float* W; const float* g = nullptr; bf16_t* WT; int K, N;
        if (mat < 2)       { const int e = mat;      W = a.in[I_EVIN] + (size_t)e * DM * EV_IN;  K = DM; N = EV_IN; g = a.in[I_NMIX] + (2 * e) * DM;     WT = (bf16_t*)(C.ws + W_EVIN) + (size_t)e * EV_IN * DM; }
        else if (mat < 4)  { const int e = mat - 2;  W = a.in[I_EVOUT] + (size_t)e * DM * DM;    K = DM; N = DM;                                        WT = (bf16_t*)(C.ws + W_EVOUT) + (size_t)e * DM * DM; }
        else if (mat < 6)  { const int o = mat - 4;  W = a.in[I_ODIN] + (size_t)o * DM * OD_IN;  K = DM; N = OD_IN; g = a.in[I_NMIX] + (2 * o + 1) * DM; WT = (bf16_t*)(C.ws + W_ODIN) + (size_t)o * OD_INP * DM; }
        else if (mat < 8)  { const int o = mat - 6;  W = a.in[I_ODOUT] + (size_t)o * DM * DM;    K = DM; N = DM;                                        WT = (bf16_t*)(C.ws + W_ODOUT) + (size_t)o * DM * DM; }
        else if (mat < 12) { const int l = mat - 8;  W = a.in[I_FUP] + (size_t)l * DM * 2 * DFF; K = DM; N = 2 * DFF; g = a.in[I_NFFN] + l * DM;         WT = (bf16_t*)(C.ws + W_UP) + (size_t)l * 2 * DFF * DM; }
        else if (mat < 16) { const int l = mat - 12; W = a.in[I_FDOWN] + (size_t)l * DFF * DM;   K = DFF; N = DM;                                       WT = (bf16_t*)(C.ws + W_DOWN) + (size_t)l * DM * DFF; }
        else if (mat < 20) { const int l = mat - 16; W = a.in[I_PGATE] + (size_t)l * DM * DM;    K = DM; N = DM; g = a.in[I_NPLE] + l * DM;              WT = (bf16_t*)(C.ws + W_GATE) + (size_t)l * DM * DM; }
        else               { const int l = mat - 20; W = a.in[I_PPROJ] + (size_t)l * PLE * DM;   K = PLE; N = DM;                                       WT = (bf16_t*)(C.ws + W_PROJ) + (size_t)l * DM * PLE; }
        const int nitems = (K / 64) * (N / 32);
        for (int it = gw; it < nitems; it += NGW) transpose_item(W, K, N, g, WT, scr, it, C.lane, mat >= 8 && mat < 12);
    }
    { const int gt = C.bid * NT + C.tid, GT = C.G * NT; const int per = (OD_INP - OD_IN) * DM / 8;
      for (int i = gt; i < 2 * per; i += GT) { const int o = i / per, r = i % per; *(u32x4*)((bf16_t*)(C.ws + W_ODIN) + (size_t)o * OD_INP * DM + (size_t)OD_IN * DM + (size_t)r * 8) = (u32x4){0u, 0u, 0u, 0u}; } }
    { const int gt = C.bid * NT + C.tid; if (gt < 1024) { const int dir = gt >> 9, c = gt & 511; const float* L = a.in[I_LBL] + (size_t)dir * 2 * 512;
        float* lb = (float*)(C.ws + W_LB) + dir * 1024; lb[c] = 0.f; lb[512 + c] = 1.f / (1.f + __expf(L[c] - L[512 + c])); } }
}
__device__ __forceinline__ void chunk_prologue(const Ctx& C, int chunk, bf16_t* hb, float* ssq) {
    const int gw = C.bid * NWV + C.wave, NGW = C.G * NWV; const Args& a = *C.a;
    for (int r = gw; r < CH; r += NGW) {
        const size_t R = (size_t)chunk * CH + r;
        const float* xr = (R < 16384) ? a.in[I_XP] + R * DM : a.in[I_XS] + (R - 16384) * DM;
        float* hr = a.out + R * DM; f32x4 v[4]; float s = 0.f;
#pragma unroll
        for (int j = 0; j < 4; ++j) { v[j] = ((const f32x4*)xr)[C.lane + 64 * j]; s += (v[j].x * v[j].x + v[j].y * v[j].y) + (v[j].z * v[j].z + v[j].w * v[j].w); }
        s = wave_sum(s, C.lane);
#pragma unroll
        for (int j = 0; j < 4; ++j) { ((f32x4*)hr)[C.lane + 64 * j] = v[j]; u32x2 w; w.x = pk2(v[j].x, v[j].y); w.y = pk2(v[j].z, v[j].w); ((u32x2*)(hb + (size_t)r * DM))[C.lane + 64 * j] = w; }
        if (C.lane < 16) ssq[(size_t)r * 16 + C.lane] = (C.lane == 0) ? s : 0.f;
    }
}
__device__ __forceinline__ void final_norm(const Ctx& C, int chunk) {
    const int gw = C.bid * NWV + C.wave, NGW = C.G * NWV; const Args& a = *C.a; const float* g = a.in[I_NOUT];
    for (int r = gw; r < CH; r += NGW) {
        float* hr = a.out + ((size_t)chunk * CH + r) * DM; f32x4 v[4]; float s = 0.f;
#pragma unroll
        for (int j = 0; j < 4; ++j) { v[j] = ((const f32x4*)hr)[C.lane + 64 * j]; s += (v[j].x * v[j].x + v[j].y * v[j].y) + (v[j].z * v[j].z + v[j].w * v[j].w); }
        const float rs = rsqrtf(wave_sum(s, C.lane) * (1.f / DM) + EPS);
#pragma unroll
        for (int j = 0; j < 4; ++j) { const f32x4 gg = ((const f32x4*)g)[C.lane + 64 * j]; ((f32x4*)hr)[C.lane + 64 * j] = v[j] * rs * gg; }
    }
}
__device__ __forceinline__ void conv_phase(const Ctx& C, int chunk, int l, int T) {
    const Args& a = *C.a;
    const bf16_t* UF = (const bf16_t*)(C.ws + ARENA + A_UF); bf16_t* ACT = (bf16_t*)(C.ws + ARENA + A_ACT);
    const float* cw = a.in[I_CW] + (size_t)l * 3 * 2 * DFF; const float* cb = a.in[I_CB] + (size_t)l * 2 * DFF;
    {
        const int ry = C.tid >> 5, cx = C.tid & 31;
        for (int tile = C.bid; tile < (CH / 64) * 11; tile += C.G) {
            const int rt = tile / 11, ct = tile % 11; const int r0 = rt * 64 + ry * 4, c0 = ct * 256 + cx * 8;
            float wa0[8], wa1[8], wa2[8], wg0[8], wg1[8], wg2[8], ba[8], bg[8];
#pragma unroll
            for (int e = 0; e < 8; e += 4) { *(f32x4*)(wa0 + e) = *(const f32x4*)(cw + c0 + e); *(f32x4*)(wa1 + e) = *(const f32x4*)(cw + 2 * DFF + c0 + e); *(f32x4*)(wa2 + e) = *(const f32x4*)(cw + 4 * DFF + c0 + e);
                *(f32x4*)(wg0 + e) = *(const f32x4*)(cw + DFF + c0 + e); *(f32x4*)(wg1 + e) = *(const f32x4*)(cw + 3 * DFF + c0 + e); *(f32x4*)(wg2 + e) = *(const f32x4*)(cw + 5 * DFF + c0 + e);
                *(f32x4*)(ba + e) = *(const f32x4*)(cb + c0 + e); *(f32x4*)(bg + e) = *(const f32x4*)(cb + DFF + c0 + e); }
            bf16x8 ua[6], ug[6];
#pragma unroll
            for (int i = 0; i < 6; ++i) { const int r = r0 - 1 + i; const bool ok = (i == 0) ? ((r0 % T) != 0) : (i == 5 ? (((r0 + 4) % T) != 0) : true);
                if (ok) { ua[i] = *(const bf16x8*)(UF + (size_t)r * 2 * DFF + c0); ug[i] = *(const bf16x8*)(UF + (size_t)r * 2 * DFF + DFF + c0); }
                else { ua[i] = (bf16x8){0, 0, 0, 0, 0, 0, 0, 0}; ug[i] = ua[i]; } }
#pragma unroll
            for (int i = 0; i < 4; ++i) {
                float o[8];
#pragma unroll
                for (int e = 0; e < 8; ++e) {
                    const float av = bf2f((unsigned short)ua[i][e]) * wa0[e] + bf2f((unsigned short)ua[i + 1][e]) * wa1[e] + bf2f((unsigned short)ua[i + 2][e]) * wa2[e] + ba[e];
                    const float gv = bf2f((unsigned short)ug[i][e]) * wg0[e] + bf2f((unsigned short)ug[i + 1][e]) * wg1[e] + bf2f((unsigned short)ug[i + 2][e]) * wg2[e] + bg[e];
                    o[e] = av * (0.5f * gv * (1.f + erff(gv * 0.70710678118f)));
                }
                u32x4 w; w.x = pk2(o[0], o[1]); w.y = pk2(o[2], o[3]); w.z = pk2(o[4], o[5]); w.w = pk2(o[6], o[7]);
                *(u32x4*)(ACT + (size_t)(r0 + i) * DFF + c0) = w;
            }
        }
    }
}
__device__ __forceinline__ void pb_convert(const Ctx& C, int chunk, int l) {
    const Args& a = *C.a;
    { bf16_t* PB = (bf16_t*)(C.ws + B_PB); const int gt = C.bid * NT + C.tid, GT = C.G * NT;
      for (int i = gt; i < CH * PLE / 4; i += GT) { const int r = i / (PLE / 4), c4 = i % (PLE / 4); const size_t R = (size_t)chunk * CH + r;
          const float* src = (R < 16384) ? a.in[I_PP] + ((size_t)l * 16384 + R) * PLE : a.in[I_PS] + ((size_t)l * 32768 + (R - 16384)) * PLE;
          const f32x4 v = ((const f32x4*)src)[c4]; u32x2 w; w.x = pk2(v.x, v.y); w.y = pk2(v.z, v.w); ((u32x2*)(PB + (size_t)r * PLE))[c4] = w; } }
}
struct Mix { int even, li, T, DV, ld, vcol, gcol; float qscale; unsigned char* vf; };
#define MFMA32(a, b, c) __builtin_amdgcn_mfma_f32_32x32x16_bf16((a), (b), (c), 0, 0, 0)
#define QK_IDX(hd, dir, blk, k) (((((size_t)((hd) * 2 + (dir))) * 512 + (size_t)(blk)) * 8 + (k)) * 64)
#define V_IDX(hd, dir, ET, et, blk, sp) ((((((size_t)((hd) * 2 + (dir))) * (ET) + (et)) * 512 + (size_t)(blk)) * 2 + (sp)) * 64)
#define O_IDX(hd, dir, ET, et, blk, q) ((((((size_t)((hd) * 2 + (dir))) * (ET) + (et)) * 512 + (size_t)(blk)) * 4 + (q)) * 64)
#define OB_IDX(hd, dir, ET, et, blk, r) ((((((size_t)((hd) * 2 + (dir))) * (ET) + (et)) * 512 + (size_t)(blk)) * 2 + (r)) * 64)
#define DEC_IDX(hd, dir, blk) ((((size_t)((hd) * 2 + (dir))) * 512 + (size_t)(blk)) * 128)
#define LDSFENCE() asm volatile("s_waitcnt lgkmcnt(0)" ::: "memory")
__device__ __forceinline__ bf16x8 pack8(float a0, float a1, float a2, float a3, float a4, float a5, float a6, float a7) {
    u32x4 w; w.x = pk2(a0, a1); w.y = pk2(a2, a3); w.z = pk2(a4, a5); w.w = pk2(a6, a7); return __builtin_bit_cast(bf16x8, w);
}
__device__ __forceinline__ bf16x8 pack8s(float a0, float a1, float a2, float a3, float a4, float a5, float a6, float a7) {
    u32x4 w; w.x = pk2s(a0, a1); w.y = pk2s(a2, a3); w.z = pk2s(a4, a5); w.w = pk2s(a6, a7); return __builtin_bit_cast(bf16x8, w);
}
__device__ __forceinline__ f32x16 zero16() { f32x16 z;
#pragma unroll
    for (int i = 0; i < 16; ++i) z[i] = 0.f; return z; }

__device__ __forceinline__ void prep_phase(const Ctx& C, const Mix& mx) {
    const Args& a = *C.a;
    const bf16_t* U = (const bf16_t*)(C.ws + ARENA + A_U);
    u32x4* QTf = (u32x4*)(C.ws + ARENA + A_QT); u32x4* KTf = (u32x4*)(C.ws + ARENA + A_KT); u32x4* Vf = (u32x4*)mx.vf;
    f32x4* Of = (f32x4*)(C.ws + ARENA + A_OEV); float* DEC = (float*)(C.ws + ARENA + A_DEC);
    const float* LB = (const float*)(C.ws + W_LB);
    const int hd = C.wave & 3, dir = C.wave >> 2, lane = C.lane, ld = mx.ld, DV = mx.DV;
    LAS float* Bs = (LAS float*)(C.lds + C.wave * 16896);
    for (int b = C.bid; b < CH / 32; b += C.G) {
        int vz_ = 0; asm volatile("" : "+v"(vz_)); const int rb = 32 * b + vz_;
        {
            const int d0 = 2 * lane, col0 = hd * 128 + d0, dt0 = d0 >> 5, dp0 = d0 & 31;
            float bs0 = 0.f, bs1 = 0.f; unsigned zz[32];
            if (mx.even) {
                const f32x2 lb2 = *(const f32x2*)(LB + dir * 1024 + mx.li * 512 + col0); const float om0 = 1.f - lb2.x, om1 = 1.f - lb2.y;
                const bf16_t* zp = U + 512 + 512 * dir + col0;
#pragma unroll
                for (int t = 0; t < 32; ++t) { const int row = rb + (dir ? 31 - t : t);
                    const unsigned zw = *(const unsigned*)(zp + (size_t)row * ld); zz[t] = zw;
                    const float z0 = __uint_as_float(zw << 16), z1 = __uint_as_float(zw & 0xffff0000u);
                    bs0 += fmaxf(__logf(lb2.x + om0 / (1.f + __expf(-z0))), -30.f); bs1 += fmaxf(__logf(lb2.y + om1 / (1.f + __expf(-z1))), -30.f);
                    *(LAS f32x2*)(Bs + t * 132 + d0) = (f32x2){bs0, bs1}; }
                *(f32x2*)(DEC + DEC_IDX(hd, dir, b) + d0) = (f32x2){__expf(bs0), __expf(bs1)};
#pragma unroll
                for (int grp = 0; grp < 4; ++grp) { float k0[8], k1[8];
#pragma unroll
                    for (int j = 0; j < 8; ++j) { const int t = 16 * (grp >> 1) + 8 * (j >> 2) + 4 * (grp & 1) + (j & 3);
                        const float z0 = __uint_as_float(zz[t] << 16), z1 = __uint_as_float(zz[t] & 0xffff0000u); const f32x2 bt = *(const LAS f32x2*)(Bs + t * 132 + d0);
                        k0[j] = om0 / (1.f + __expf(z0)) * __expf(bs0 - bt.x); k1[j] = om1 / (1.f + __expf(z1)) * __expf(bs1 - bt.y); }
                    u32x4 w; w.x = pk2(k0[0], k0[1]); w.y = pk2(k0[2], k0[3]); w.z = pk2(k0[4], k0[5]); w.w = pk2(k0[6], k0[7]);
                    KTf[QK_IDX(hd, dir, b, (grp >> 1) * 4 + dt0) + 32 * (grp & 1) + dp0] = w;
                    w.x = pk2(k1[0], k1[1]); w.y = pk2(k1[2], k1[3]); w.z = pk2(k1[4], k1[5]); w.w = pk2(k1[6], k1[7]);
                    KTf[QK_IDX(hd, dir, b, (grp >> 1) * 4 + dt0) + 32 * (grp & 1) + dp0 + 1] = w; }
            } else {
                float Wg0[16], Wg1[16]; const float* wp = a.in[I_GUP] + ((size_t)(mx.li * 2 + dir) * 16) * 512 + col0;
#pragma unroll
                for (int r = 0; r < 16; ++r) { const f32x2 w2 = *(const f32x2*)(wp + r * 512); Wg0[r] = w2.x; Wg1[r] = w2.y; }
                const f32x2 bias = *(const f32x2*)(a.in[I_GB] + (mx.li * 2 + dir) * 512 + col0);
#pragma unroll
                for (int t = 0; t < 32; ++t) { const int row = rb + (dir ? 31 - t : t);
                    const u32x4 l0 = *(const u32x4*)(U + (size_t)row * ld + 3072 + 16 * dir), l1 = *(const u32x4*)(U + (size_t)row * ld + 3072 + 16 * dir + 8);
                    zz[t] = *(const unsigned*)(U + (size_t)row * ld + 512 + col0);
                    float x0 = bias.x, x1 = bias.y;
#pragma unroll
                    for (int w = 0; w < 4; ++w) { const float a0 = __uint_as_float(l0[w] << 16), a1 = __uint_as_float(l0[w] & 0xffff0000u), c0 = __uint_as_float(l1[w] << 16), c1 = __uint_as_float(l1[w] & 0xffff0000u);
                        x0 += a0 * Wg0[2 * w] + a1 * Wg0[2 * w + 1] + c0 * Wg0[8 + 2 * w] + c1 * Wg0[8 + 2 * w + 1];
                        x1 += a0 * Wg1[2 * w] + a1 * Wg1[2 * w + 1] + c0 * Wg1[8 + 2 * w] + c1 * Wg1[8 + 2 * w + 1]; }
                    bs0 += fmaxf((fminf(x0, 0.f) - log1pf(__expf(-fabsf(x0)))) * (1.f / 16.f), -30.f); bs1 += fmaxf((fminf(x1, 0.f) - log1pf(__expf(-fabsf(x1)))) * (1.f / 16.f), -30.f);
                    *(LAS f32x2*)(Bs + t * 132 + d0) = (f32x2){bs0, bs1}; }
                *(f32x2*)(DEC + DEC_IDX(hd, dir, b) + d0) = (f32x2){__expf(bs0), __expf(bs1)};
#pragma unroll
                for (int grp = 0; grp < 4; ++grp) { float k0[8], k1[8];
#pragma unroll
                    for (int j = 0; j < 8; ++j) { const int t = 16 * (grp >> 1) + 8 * (j >> 2) + 4 * (grp & 1) + (j & 3); const f32x2 bt = *(const LAS f32x2*)(Bs + t * 132 + d0);
                        k0[j] = __uint_as_float(zz[t] << 16) * __expf(bs0 - bt.x); k1[j] = __uint_as_float(zz[t] & 0xffff0000u) * __expf(bs1 - bt.y); }
                    u32x4 w; w.x = pk2(k0[0], k0[1]); w.y = pk2(k0[2], k0[3]); w.z = pk2(k0[4], k0[5]); w.w = pk2(k0[6], k0[7]);
                    KTf[QK_IDX(hd, dir, b, (grp >> 1) * 4 + dt0) + 32 * (grp & 1) + dp0] = w;
                    w.x = pk2(k1[0], k1[1]); w.y = pk2(k1[2], k1[3]); w.z = pk2(k1[4], k1[5]); w.w = pk2(k1[6], k1[7]);
                    KTf[QK_IDX(hd, dir, b, (grp >> 1) * 4 + dt0) + 32 * (grp & 1) + dp0 + 1] = w; }
            }
        }
        LDSFENCE();
        const int tau = lane & 31, h = lane >> 5, row = rb + (dir ? 31 - tau : tau);
        u32x4 vt[8];
#pragma unroll
        for (int it = 0; it < 8; ++it) { const int idx = lane + 64 * it, t = idx / (DV / 8), c8 = idx % (DV / 8); const int rj = rb + (dir ? 31 - t : t);
            vt[it] = *(const u32x4*)(U + (size_t)rj * ld + mx.vcol + hd * DV + c8 * 8); }
        bf16x8 Ak[8], Bq[8];
#pragma unroll
        for (int ks = 0; ks < 8; ++ks) {
            float qh[8], kh[8], qt[8];
#pragma unroll
            for (int q2 = 0; q2 < 2; ++q2) {
                const int d0 = 16 * ks + 8 * q2 + 4 * h;
                const f32x4 b4 = *(const LAS f32x4*)(Bs + tau * 132 + d0), r4 = *(const LAS f32x4*)(Bs + 15 * 132 + d0);
                const u32x2 qr = *(const u32x2*)(U + (size_t)row * ld + hd * 128 + d0);
                float q4[4] = {__uint_as_float(qr.x << 16), __uint_as_float(qr.x & 0xffff0000u), __uint_as_float(qr.y << 16), __uint_as_float(qr.y & 0xffff0000u)};
                float k4[4];
                if (mx.even) { const u32x2 zr = *(const u32x2*)(U + (size_t)row * ld + 512 + 512 * dir + hd * 128 + d0);
                    const f32x4 lb4 = *(const f32x4*)(LB + dir * 1024 + mx.li * 512 + hd * 128 + d0);
                    const float z4[4] = {__uint_as_float(zr.x << 16), __uint_as_float(zr.x & 0xffff0000u), __uint_as_float(zr.y << 16), __uint_as_float(zr.y & 0xffff0000u)};
#pragma unroll
                    for (int e = 0; e < 4; ++e) k4[e] = (1.f - lb4[e]) / (1.f + __expf(z4[e]));
                } else { const u32x2 kr = *(const u32x2*)(U + (size_t)row * ld + 512 + hd * 128 + d0);
                    k4[0] = __uint_as_float(kr.x << 16); k4[1] = __uint_as_float(kr.x & 0xffff0000u); k4[2] = __uint_as_float(kr.y << 16); k4[3] = __uint_as_float(kr.y & 0xffff0000u); }
#pragma unroll
                for (int e = 0; e < 4; ++e) { const float qq = q4[e] * mx.qscale; qt[4 * q2 + e] = qq * __expf(b4[e]);
                    qh[4 * q2 + e] = qq * __expf(fminf(b4[e] - r4[e], 80.f)); kh[4 * q2 + e] = k4[e] * __expf(fminf(r4[e] - b4[e], 80.f)); }
            }
            { u32x4 w; w.x = pk2(qt[0], qt[1]); w.y = pk2(qt[2], qt[3]); w.z = pk2(qt[4], qt[5]); w.w = pk2(qt[6], qt[7]); QTf[QK_IDX(hd, dir, b, ks) + lane] = w; }
            Bq[ks] = pack8(qh[0], qh[1], qh[2], qh[3], qh[4], qh[5], qh[6], qh[7]);
            Ak[ks] = pack8(kh[0], kh[1], kh[2], kh[3], kh[4], kh[5], kh[6], kh[7]);
        }
        f32x16 at = zero16();
#pragma unroll
        for (int ks = 0; ks < 8; ++ks) at = MFMA32(Ak[ks], Bq[ks], at);
#pragma unroll
        for (int i = 0; i < 16; ++i) { const int s = (i & 3) + 8 * (i >> 2) + 4 * h; if (s > tau) at[i] = 0.f; }
        bf16x8 Pa[2];
        Pa[0] = pack8(at[0], at[1], at[2], at[3], at[4], at[5], at[6], at[7]);
        Pa[1] = pack8(at[8], at[9], at[10], at[11], at[12], at[13], at[14], at[15]);
        const int ET = DV / 32;
        LDSFENCE();
        LAS unsigned char* Vs = (LAS unsigned char*)Bs; const int vpitch = 2 * DV + 16;
#pragma unroll
        for (int it = 0; it < 8; ++it) { const int idx = lane + 64 * it, t = idx / (DV / 8), c8 = idx % (DV / 8); *(LAS u32x4*)(Vs + t * vpitch + c8 * 16) = vt[it]; }
        for (int idx = lane + 512; idx < 32 * (DV / 8); idx += 64) { const int t = idx / (DV / 8), c8 = idx % (DV / 8); const int rj = rb + (dir ? 31 - t : t);
            *(LAS u32x4*)(Vs + t * vpitch + c8 * 16) = *(const u32x4*)(U + (size_t)rj * ld + mx.vcol + hd * DV + c8 * 8); }
        LDSFENCE();
        for (int et = 0; et < ET; ++et) {
            f32x16 acc = zero16();
#pragma unroll
            for (int sp = 0; sp < 2; ++sp) {
                unsigned short v[8];
#pragma unroll
                for (int j = 0; j < 8; ++j) { const int sj = 16 * sp + 8 * (j >> 2) + 4 * h + (j & 3); v[j] = *(const LAS unsigned short*)(Vs + sj * vpitch + (32 * et + (lane & 31)) * 2); }
                u32x4 w; w.x = v[0] | ((unsigned)v[1] << 16); w.y = v[2] | ((unsigned)v[3] << 16); w.z = v[4] | ((unsigned)v[5] << 16); w.w = v[6] | ((unsigned)v[7] << 16);
                Vf[V_IDX(hd, dir, ET, et, b, sp) + lane] = w;
                acc = MFMA32(Pa[sp], __builtin_bit_cast(bf16x8, w), acc);
            }
#pragma unroll
            for (int r = 0; r < 2; ++r) { u32x4 w; w.x = pk2s(acc[8 * r], acc[8 * r + 1]); w.y = pk2s(acc[8 * r + 2], acc[8 * r + 3]); w.z = pk2s(acc[8 * r + 4], acc[8 * r + 5]); w.w = pk2s(acc[8 * r + 6], acc[8 * r + 7]);
                ((u32x4*)Of)[OB_IDX(hd, dir, ET, et, b, r) + lane] = w; }
        }
        LDSFENCE();
    }
}
__device__ __forceinline__ void scan_phase(const Ctx& C, const Mix& mx) {
    const u32x4* QTf = (const u32x4*)(C.ws + ARENA + A_QT); const u32x4* KTf = (const u32x4*)(C.ws + ARENA + A_KT); const u32x4* Vf = (const u32x4*)mx.vf;
    u32x4* Of = (u32x4*)(C.ws + ARENA + A_OEV); const float* DEC = (const float*)(C.ws + ARENA + A_DEC);
    const int lane = C.lane, h = lane >> 5, DV = mx.DV, ET = DV / 32, T = mx.T, nb = T / 32;
    const int units = (CH / T) * 8 * ET;
    constexpr int SLOT = 23552, R = 5, NL = 4;
    LAS u32x4* SB = (LAS u32x4*)(C.lds + R * SLOT);
    for (int base = 0; base < units; base += C.G) {
        const bool loader = C.wave >= 2 && C.wave < 2 + NL;
        const int lr = C.wave - 2;
        const int u = base + C.bid;
        const bool valid = u < units;
        const int et = u % ET, x = u / ET, dir = x & 1, hd = (x >> 1) & 3, seq = x >> 3;
        LAS unsigned char* ring = C.lds;
#define SCAN_BAR() do { asm volatile("s_waitcnt lgkmcnt(0)" ::: "memory"); __builtin_amdgcn_s_barrier(); asm volatile("" ::: "memory"); } while (0)
#define GLDS16(gp, lp) __builtin_amdgcn_global_load_lds((const unsigned*)(gp), (LAS unsigned*)(lp), 16, 0, 0)
#define SCAN_ISSUE(j) do { const int blk_ = seq * nb + (dir ? nb - 1 - (j) : (j)); LAS unsigned char* sl_ = ring + ((j) % R) * SLOT; \
            _Pragma("unroll") for (int k = 0; k < 8; ++k) { GLDS16(QTf + QK_IDX(hd, dir, blk_, k) + lane, sl_ + k * 1024); GLDS16(KTf + QK_IDX(hd, dir, blk_, k) + lane, sl_ + (8 + k) * 1024); } \
            _Pragma("unroll") for (int sp = 0; sp < 2; ++sp) GLDS16(Vf + V_IDX(hd, dir, ET, et, blk_, sp) + lane, sl_ + (16 + sp) * 1024); \
            _Pragma("unroll") for (int r = 0; r < 2; ++r) GLDS16(Of + OB_IDX(hd, dir, ET, et, blk_, r) + lane, sl_ + (18 + r) * 1024); \
            if (lane < 32) GLDS16(DEC + DEC_IDX(hd, dir, blk_) + 4 * lane, sl_ + 22 * 1024); } while (0)
        if (C.wave == 0) {
            SCAN_BAR();
            for (int i = 0; i < nb; ++i) {
                if (valid) {
                    const LAS u32x4* sv = (const LAS u32x4*)(ring + (i % R) * SLOT) + lane; const LAS u32x4* sb = SB + (i & 1) * 512 + lane;
                    u32x4 qf[8], on[2], bs[8];
#pragma unroll
                    for (int r = 0; r < 2; ++r) on[r] = sv[(18 + r) * 64];
#pragma unroll
                    for (int k = 0; k < 8; ++k) { qf[k] = sv[k * 64]; bs[k] = sb[k * 64]; }
                    asm volatile("s_waitcnt lgkmcnt(0)" ::: "memory");
                    f32x16 acc;
#pragma unroll
                    for (int r = 0; r < 2; ++r) {
                        acc[8 * r + 0] = __uint_as_float(on[r].x << 16); acc[8 * r + 1] = __uint_as_float(on[r].x & 0xffff0000u); acc[8 * r + 2] = __uint_as_float(on[r].y << 16); acc[8 * r + 3] = __uint_as_float(on[r].y & 0xffff0000u);
                        acc[8 * r + 4] = __uint_as_float(on[r].z << 16); acc[8 * r + 5] = __uint_as_float(on[r].z & 0xffff0000u); acc[8 * r + 6] = __uint_as_float(on[r].w << 16); acc[8 * r + 7] = __uint_as_float(on[r].w & 0xffff0000u); }
#pragma unroll
                    for (int k = 0; k < 8; ++k) acc = MFMA32(__builtin_bit_cast(bf16x8, qf[k]), __builtin_bit_cast(bf16x8, bs[k]), acc);
                    const int blk = seq * nb + (dir ? nb - 1 - i : i);
#pragma unroll
                    for (int r = 0; r < 2; ++r) { u32x4 w; w.x = pk2s(acc[8 * r], acc[8 * r + 1]); w.y = pk2s(acc[8 * r + 2], acc[8 * r + 3]); w.z = pk2s(acc[8 * r + 4], acc[8 * r + 5]); w.w = pk2s(acc[8 * r + 6], acc[8 * r + 7]);
                        Of[OB_IDX(hd, dir, ET, et, blk, r) + lane] = w; }
                }
                SCAN_BAR();
            }
        } else if (C.wave == 1) {
            f32x16 S[4];
#pragma unroll
            for (int dt = 0; dt < 4; ++dt) S[dt] = zero16();
#pragma unroll
            for (int k = 0; k < 8; ++k) SB[k * 64 + lane] = (u32x4){0u, 0u, 0u, 0u};
            SCAN_BAR();
            for (int i = 0; i < nb; ++i) {
                if (valid) {
                    const LAS unsigned char* sl = ring + (i % R) * SLOT; const LAS u32x4* sv = (const LAS u32x4*)sl + lane;
                    u32x4 kf[8], vf[2]; f32x4 dq[16];
#pragma unroll
                    for (int k = 0; k < 8; ++k) kf[k] = sv[(8 + k) * 64];
#pragma unroll
                    for (int sp = 0; sp < 2; ++sp) vf[sp] = sv[(16 + sp) * 64];
                    const LAS float* dp = (const LAS float*)(sl + 22 * 1024) + 4 * h;
#pragma unroll
                    for (int k = 0; k < 16; ++k) dq[k] = *(const LAS f32x4*)(dp + 8 * k);
                    asm volatile("s_waitcnt lgkmcnt(0)" ::: "memory");
#pragma unroll
                    for (int dt = 0; dt < 4; ++dt)
#pragma unroll
                        for (int q = 0; q < 4; ++q) {
#pragma unroll
                            for (int e = 0; e < 4; ++e) S[dt][4 * q + e] *= dq[4 * dt + q][e]; }
#pragma unroll
                    for (int sp = 0; sp < 2; ++sp) {
#pragma unroll
                        for (int dt = 0; dt < 4; ++dt) S[dt] = MFMA32(__builtin_bit_cast(bf16x8, kf[sp * 4 + dt]), __builtin_bit_cast(bf16x8, vf[sp]), S[dt]); }
                    LAS u32x4* sbw = SB + ((i + 1) & 1) * 512 + lane;
#pragma unroll
                    for (int dt = 0; dt < 4; ++dt)
#pragma unroll
                        for (int sp = 0; sp < 2; ++sp)
                            sbw[(2 * dt + sp) * 64] = __builtin_bit_cast(u32x4, pack8s(S[dt][8 * sp + 0], S[dt][8 * sp + 1], S[dt][8 * sp + 2], S[dt][8 * sp + 3], S[dt][8 * sp + 4], S[dt][8 * sp + 5], S[dt][8 * sp + 6], S[dt][8 * sp + 7]));
                }
                SCAN_BAR();
            }
        } else {
            if (loader && valid && lr < nb) SCAN_ISSUE(lr);
            for (int i = -1; i < nb; ++i) {
                if (loader && valid) {
                    if (i >= 0 && lr == i % NL && i + NL < nb) SCAN_ISSUE(i + NL);
                    if (lr == (i + 1) % NL && i + 1 < nb) asm volatile("s_waitcnt vmcnt(0)" ::: "memory");
                }
                SCAN_BAR();
            }
        }
#undef SCAN_ISSUE
#undef GLDS16
#undef SCAN_BAR
    }
}
__device__ __forceinline__ void attn_phase(const Ctx& C, int T) {
    const bf16_t* U = (const bf16_t*)(C.ws + ARENA + A_U);
    bf16_t* OG = (bf16_t*)(C.ws + ARENA + A_OG); float* LSE = (float*)(C.ws + ARENA + A_LSE);
    const int lane = C.lane, h = lane >> 5, l31 = lane & 31, ld = EV_IN, tps = T / 32;
    for (int task = C.bid * NWV + C.wave; task < 3 * 4 * (CH / 32); task += C.G * NWV) {
        const int g = task / 2048, x = task % 2048, hd = x / 512, y = x % 512, seq = y / tps, z = y % tps;
        const int dil = 1 << (2 * g), L = T / dil, nqb = L / 32, r = z / nqb, qb = z % nqb, m0 = 32 * qb;
        const int qcol = 2560 + g * 1536 + hd * 128, kcol = qcol + 512, vcol = qcol + 1024;
        const float coef = exp2f(-8.0f * (float)(g * 4 + hd + 1) / 12.0f) * (float)dil, scale = 0.08838834764831845f;
        const size_t rbase = (size_t)seq * T + r;
        bf16x8 Bq[8];
        { const bf16_t* qp = U + (rbase + (size_t)(m0 + l31) * dil) * ld + qcol + 8 * h;
#pragma unroll
          for (int ks = 0; ks < 8; ++ks) Bq[ks] = *(const bf16x8*)(qp + 16 * ks); }
        f32x16 st[5];
        bf16x8 Kc[8], Kn[8];
        {   const int mkc0 = (m0 - 64) < 0 ? 0 : (m0 - 64);
            const bf16_t* kp = U + (rbase + (size_t)(mkc0 + l31) * dil) * ld + kcol + 8 * h;
#pragma unroll
            for (int ks = 0; ks < 8; ++ks) Kc[ks] = *(const bf16x8*)(kp + 16 * ks); }
#pragma unroll
        for (int kb = 0; kb < 5; ++kb) {
            const int mk0 = m0 - 64 + 32 * kb; const bool vb = (mk0 >= 0 && mk0 < L);
            if (kb < 4) { const int mk1 = mk0 + 32; const int mkc1 = mk1 < 0 ? 0 : (mk1 >= L ? L - 32 : mk1);
                const bf16_t* kp = U + (rbase + (size_t)(mkc1 + l31) * dil) * ld + kcol + 8 * h;
#pragma unroll
                for (int ks = 0; ks < 8; ++ks) Kn[ks] = *(const bf16x8*)(kp + 16 * ks); }
            f32x16 s = zero16();
#pragma unroll
            for (int ks = 0; ks < 8; ++ks) s = MFMA32(Kc[ks], Bq[ks], s);
#pragma unroll
            for (int i = 0; i < 16; ++i) { const int rel = (mk0 + (i & 3) + 8 * (i >> 2) + 4 * h) - (m0 + l31); const int ar = rel < 0 ? -rel : rel;
                s[i] = (vb && ar <= 64) ? s[i] * scale - coef * (float)ar : -1e30f; }
            st[kb] = s;
#pragma unroll
            for (int ks = 0; ks < 8; ++ks) Kc[ks] = Kn[ks];
        }
        float mxv = -1e30f;
#pragma unroll
        for (int kb = 0; kb < 5; ++kb)
#pragma unroll
            for (int i = 0; i < 16; ++i) mxv = fmaxf(mxv, st[kb][i]);
        mxv = fmaxf(mxv, shfl_xor_l(mxv, lane, 32));
        float den = 0.f;
#pragma unroll
        for (int kb = 0; kb < 5; ++kb)
#pragma unroll
            for (int i = 0; i < 16; ++i) { const float p = __expf(st[kb][i] - mxv); st[kb][i] = p; den += p; }
        den += shfl_xor_l(den, lane, 32);
        f32x16 ot[4];
#pragma unroll
        for (int dt = 0; dt < 4; ++dt) ot[dt] = zero16();
        LAS unsigned char* Vs = C.lds + C.wave * 16896;
#pragma unroll
        for (int kb = 0; kb < 5; ++kb) {
            const int mk0 = m0 - 64 + 32 * kb; const int mkc = mk0 < 0 ? 0 : (mk0 >= L ? L - 32 : mk0);
            u32x4 vr[8];
#pragma unroll
            for (int it = 0; it < 8; ++it) { const int idx = lane + 64 * it, t = idx >> 4, c8 = idx & 15; vr[it] = *(const u32x4*)(U + (rbase + (size_t)(mkc + t) * dil) * ld + vcol + c8 * 8); }
            LDSFENCE();
#pragma unroll
            for (int it = 0; it < 8; ++it) { const int idx = lane + 64 * it, t = idx >> 4, c8 = idx & 15; *(LAS u32x4*)(Vs + t * 272 + c8 * 16) = vr[it]; }
            LDSFENCE();
#pragma unroll
            for (int sp = 0; sp < 2; ++sp) {
                const bf16x8 Bp = pack8(st[kb][8 * sp + 0], st[kb][8 * sp + 1], st[kb][8 * sp + 2], st[kb][8 * sp + 3], st[kb][8 * sp + 4], st[kb][8 * sp + 5], st[kb][8 * sp + 6], st[kb][8 * sp + 7]);
#pragma unroll
                for (int dt = 0; dt < 4; ++dt) {
                    unsigned short v[8];
#pragma unroll
                    for (int j = 0; j < 8; ++j) { const int kj = 16 * sp + 8 * (j >> 2) + 4 * h + (j & 3); v[j] = *(const LAS unsigned short*)(Vs + kj * 272 + (32 * dt + l31) * 2); }
                    u32x4 w; w.x = v[0] | ((unsigned)v[1] << 16); w.y = v[2] | ((unsigned)v[3] << 16); w.z = v[4] | ((unsigned)v[5] << 16); w.w = v[6] | ((unsigned)v[7] << 16);
                    ot[dt] = MFMA32(__builtin_bit_cast(bf16x8, w), Bp, ot[dt]);
                }
            }
        }
        const float inv = 1.f / den; const size_t qrow = rbase + (size_t)(m0 + l31) * dil;
        bf16_t* op = OG + ((size_t)g * CH + qrow) * 512 + hd * 128 + 4 * h;
#pragma unroll
        for (int dt = 0; dt < 4; ++dt)
#pragma unroll
            for (int q = 0; q < 4; ++q) { u32x2 w; w.x = pk2(ot[dt][4 * q] * inv, ot[dt][4 * q + 1] * inv); w.y = pk2(ot[dt][4 * q + 2] * inv, ot[dt][4 * q + 3] * inv);
                *(u32x2*)(op + 32 * dt + 8 * q) = w; }
        if (h == 0) LSE[((size_t)g * CH + qrow) * 4 + hd] = mxv + __logf(den);
    }
}
__device__ __forceinline__ void finalize_phase(const Ctx& C, const Mix& mx) {
    const Args& a = *C.a;
    const bf16_t* __restrict__ U = (const bf16_t*)(C.ws + ARENA + A_U); bf16_t* __restrict__ MIX = (bf16_t*)(C.ws + ARENA + A_MIX);
    const f32x4* __restrict__ Of = (const f32x4*)(C.ws + ARENA + A_OEV);
    const int gw = C.bid * NWV + C.wave, NGW = C.G * NWV, lane = C.lane, ld = mx.ld, DV = mx.DV, ET = DV / 32, NE = DV / 64;
    const float* gn = mx.even ? a.in[I_HNORM] + mx.li * 512 : a.in[I_GNORM] + mx.li * 1024;
#pragma unroll 2
    for (int rg = gw; rg < CH / 4; rg += NGW) {
        const int r0 = 4 * rg, blk = r0 >> 5, t0 = r0 & 31;
        const int qf = t0 >> 3, hf = (t0 >> 2) & 1, tb = 28 - t0, qb = tb >> 3, hb2 = (tb >> 2) & 1;
#pragma unroll
        for (int hd = 0; hd < 4; ++hd) {
            float o[2][2][4]; float ss[4] = {0.f, 0.f, 0.f, 0.f};
            const u32x2* Ob2 = (const u32x2*)Of;
#pragma unroll
            for (int k = 0; k < 2; ++k) if (2 * k < NE) {
                const int e0 = 2 * lane + 128 * k, et = e0 >> 5;
#pragma unroll
                for (int p = 0; p < 2; ++p) {
                    const u32x2 vf_ = Ob2[(OB_IDX(hd, 0, ET, et, blk, qf >> 1) + 32 * hf + (e0 & 31) + p) * 2 + (qf & 1)], vb_ = Ob2[(OB_IDX(hd, 1, ET, et, blk, qb >> 1) + 32 * hb2 + (e0 & 31) + p) * 2 + (qb & 1)];
                    o[k][p][0] = __uint_as_float(vf_.x << 16) + __uint_as_float(vb_.y & 0xffff0000u); o[k][p][1] = __uint_as_float(vf_.x & 0xffff0000u) + __uint_as_float(vb_.y << 16);
                    o[k][p][2] = __uint_as_float(vf_.y << 16) + __uint_as_float(vb_.x & 0xffff0000u); o[k][p][3] = __uint_as_float(vf_.y & 0xffff0000u) + __uint_as_float(vb_.x << 16);
#pragma unroll
                    for (int j = 0; j < 4; ++j) ss[j] += o[k][p][j] * o[k][p][j];
                }
            }
#pragma unroll
            for (int j = 0; j < 4; ++j) ss[j] = rsqrtf(wave_sum(ss[j], lane) / (float)DV + EPS);
#pragma unroll
            for (int k = 0; k < 2; ++k) if (2 * k < NE) {
                const int c = hd * DV + 2 * lane + 128 * k; const f32x2 g2 = *(const f32x2*)(gn + c);
#pragma unroll
                for (int j = 0; j < 4; ++j) { const unsigned agw = *(const unsigned*)(U + (size_t)(r0 + j) * ld + 2048 + c);
                    const float a0 = __uint_as_float(agw << 16), a1 = __uint_as_float(agw & 0xffff0000u);
                    *(unsigned*)(MIX + (size_t)(r0 + j) * DM + c) = pk2(o[k][0][j] * ss[j] * g2.x * (a0 / (1.f + __expf(-a0))), o[k][1][j] * ss[j] * g2.y * (a1 / (1.f + __expf(-a1)))); }
            }
        }
        if (mx.even) {
            const bf16_t* __restrict__ OG = (const bf16_t*)(C.ws + ARENA + A_OG); const float* __restrict__ LSE = (const float*)(C.ws + ARENA + A_LSE);
            const int c8 = lane * 8, hd = lane >> 4;
#pragma unroll
            for (int j = 0; j < 4; ++j) { const int r = r0 + j;
                const float l0 = LSE[((size_t)0 * CH + r) * 4 + hd], l1 = LSE[((size_t)1 * CH + r) * 4 + hd], l2 = LSE[((size_t)2 * CH + r) * 4 + hd];
                const float m = fmaxf(l0, fmaxf(l1, l2)); float w0 = __expf(l0 - m), w1 = __expf(l1 - m), w2 = __expf(l2 - m); const float iw = 1.f / (w0 + w1 + w2);
                w0 *= iw; w1 *= iw; w2 *= iw;
                const u32x4 v0 = *(const u32x4*)(OG + ((size_t)0 * CH + r) * 512 + c8), v1 = *(const u32x4*)(OG + ((size_t)1 * CH + r) * 512 + c8), v2 = *(const u32x4*)(OG + ((size_t)2 * CH + r) * 512 + c8);
                u32x4 o;
#pragma unroll
                for (int k = 0; k < 4; ++k) {
                    const float bx = w0 * __uint_as_float(v0[k] << 16) + w1 * __uint_as_float(v1[k] << 16) + w2 * __uint_as_float(v2[k] << 16);
                    const float by = w0 * __uint_as_float(v0[k] & 0xffff0000u) + w1 * __uint_as_float(v1[k] & 0xffff0000u) + w2 * __uint_as_float(v2[k] & 0xffff0000u);
                    o[k] = pk2(bx, by); }
                *(u32x4*)(MIX + (size_t)r * DM + 512 + c8) = o;
            }
        }
    }
}
#define XB_TMO      128
#define XB_XCNT(j)  (256  + 64 * (j))
#define XB_XSUB(j)  (1280 + 64 * (j))
#define XB_XGEN(j)  (2304 + 64 * (j))
#define XB_TOP      3328
#define XB_TOPGEN   3392
#define XCD_BAR_WORDS 3456
#define XB_SPIN_CAP (1u << 18)

__device__ __forceinline__ unsigned xb_ld(unsigned* p)              { return __hip_atomic_load(p, __ATOMIC_RELAXED, __HIP_MEMORY_SCOPE_AGENT); }
__device__ __forceinline__ unsigned xb_add(unsigned* p, unsigned v) { return __hip_atomic_fetch_add(p, v, __ATOMIC_RELAXED, __HIP_MEMORY_SCOPE_AGENT); }
__device__ __forceinline__ unsigned xb_xcc_id() { return (unsigned)__builtin_amdgcn_s_getreg((3 << 11) | 20) & 0xFu; }
#define XB_SPIN(cond, bar) do { unsigned _sp = 0; while (cond) { __builtin_amdgcn_s_sleep(1); \
    if ((++_sp & 255u) == 0u) { if (xb_ld(&(bar)[XB_TMO])) break; if (_sp > XB_SPIN_CAP) { atomicAdd(&(bar)[XB_TMO], 1u); break; } } } } while (0)

struct XcdBarrier {
    unsigned* bar; unsigned x;
    volatile LAS unsigned* st;
};

__device__ __forceinline__ XcdBarrier xcd_barrier_post(unsigned* bar, volatile LAS unsigned* st) {
    XcdBarrier b; b.bar = bar; b.x = xb_xcc_id(); b.st = st;
    if (threadIdx.x == 0) (void)xb_add(&bar[XB_XCNT(b.x)], 1u);
    return b;
}
__device__ __forceinline__ void xcd_barrier_complete(unsigned* bar, unsigned x, unsigned& nloc, unsigned& nx) {
    const unsigned G = gridDim.x * gridDim.y * gridDim.z;
    unsigned sum, cnt, mine, sp = 0u;
    for (;;) {
        sum = 0u; cnt = 0u; mine = 0u;
#pragma unroll
        for (unsigned j = 0; j < 16; ++j) { const unsigned c = xb_ld(&bar[XB_XCNT(j)]); sum += c; cnt += (c > 0u) ? 1u : 0u; mine = (j == x) ? c : mine; }
        if (sum == G) break;
        __builtin_amdgcn_s_sleep(1);
        if ((++sp & 255u) == 0u) { if (xb_ld(&bar[XB_TMO])) break; if (sp > XB_SPIN_CAP) { atomicAdd(&bar[XB_TMO], 1u); break; } }
    }
    nloc = mine > 0u ? mine : 1u; nx = cnt > 0u ? cnt : 1u;
}

__device__ __forceinline__ void xcd_barrier(const XcdBarrier& b) {
    asm volatile("s_waitcnt vmcnt(0)" ::: "memory");
    __syncthreads();
    if (threadIdx.x == 0) {
        unsigned* bar = b.bar;
        __builtin_amdgcn_s_waitcnt(0);
        unsigned nloc = b.st[0], nx = b.st[1];
        if (nloc == 0u) { xcd_barrier_complete(bar, b.x, nloc, nx); b.st[0] = nloc; b.st[1] = nx; }
        const unsigned old = xb_add(&bar[XB_XSUB(b.x)], 1u);
        const unsigned gen = old / nloc;
        if (old + 1u == (gen + 1u) * nloc) {
            __builtin_amdgcn_fence(__ATOMIC_RELEASE, "agent");
            asm volatile("s_waitcnt vmcnt(0)" ::: "memory");
            const unsigned og = xb_add(&bar[XB_TOP], 1u);
            const unsigned tg = og / nx;
            if (og + 1u == (tg + 1u) * nx) xb_add(&bar[XB_TOPGEN], 1u);
            else XB_SPIN(xb_ld(&bar[XB_TOPGEN]) == tg, bar);
            __builtin_amdgcn_fence(__ATOMIC_ACQUIRE, "agent");
            xb_add(&bar[XB_XGEN(b.x)], 1u);
            asm volatile("s_waitcnt vmcnt(0)" ::: "memory");
        } else {
            XB_SPIN(xb_ld(&bar[XB_XGEN(b.x)]) == gen, bar);
            __builtin_amdgcn_fence(__ATOMIC_ACQUIRE, "agent");
            asm volatile("s_waitcnt vmcnt(0)" ::: "memory");
        }
    }
    __syncthreads();
}
#define PHASE_BEGIN() do { int t_ = threadIdx.x; asm volatile("" : "+v"(t_)); C.tid = t_; C.lane = t_ & 63; C.wave = __builtin_amdgcn_readfirstlane(t_ >> 6); \
    int b_ = blockIdx.x; asm volatile("" : "+s"(b_)); C.bid = b_; unsigned char* w_ = args.ws; asm volatile("" : "+s"(w_)); C.ws = w_; ws = w_; \
    hb_c = (bf16_t*)(ws + (s ? B_HB1 : B_HB0)); hb_n = (bf16_t*)(ws + (s ? B_HB0 : B_HB1)); sq_c = (float*)(ws + (s ? B_SSQ1 : B_SSQ0)); sq_n = (float*)(ws + (s ? B_SSQ0 : B_SSQ1)); Ub = (bf16_t*)(ws + ARENA + A_U); MIXb = (bf16_t*)(ws + ARENA + A_MIX); \
    hch = args.out + (size_t)chunk * CH * DM; } while (0)
__global__ void __launch_bounds__(NT, 2) fwd_mega(Args args) {
    extern __shared__ __attribute__((aligned(16))) unsigned char lds_raw[];
    cg::grid_group grid = cg::this_grid();
    Ctx C; C.lds = (LAS unsigned char*)lds_raw; C.tid = threadIdx.x; C.lane = C.tid & 63; C.wave = __builtin_amdgcn_readfirstlane(C.tid >> 6);
    C.G = gridDim.x; C.bid = blockIdx.x; C.a = &args; C.ws = args.ws;
    unsigned char* ws = args.ws;
    bf16_t *hb_c, *hb_n; float *sq_c, *sq_n; bf16_t *Ub, *MIXb;
    if (blockIdx.x == 0) for (int i = threadIdx.x; i < XCD_BAR_WORDS; i += NT) ((unsigned*)args.ws)[i] = 0u;
    if (threadIdx.x < 2) ((volatile LAS unsigned*)(C.lds + LDS_BYTES - 256))[threadIdx.x] = 0u;
    weights_prologue(C);
    __syncthreads();
    grid.sync();
    XcdBarrier bar = xcd_barrier_post((unsigned*)args.ws, (volatile LAS unsigned*)(C.lds + LDS_BYTES - 256));
    float* hch;
#ifdef PROBE_A
    unsigned tacc[12];
#pragma unroll
    for (int i = 0; i < 12; ++i) tacc[i] = 0u;
    unsigned long long tprev = __builtin_amdgcn_s_memrealtime();
#define TICK(k) do { const unsigned long long now_ = __builtin_amdgcn_s_memrealtime(); tacc[k] += (unsigned)(now_ - tprev); tprev = now_; } while (0)
#else
#define TICK(k) do {} while (0)
#endif
#pragma nounroll
    for (int chunk = 0; chunk < NCHUNK; ++chunk) {
        const int T = chunk == 0 ? 4096 : 2048; int s = 0;
        PHASE_BEGIN();
        chunk_prologue(C, chunk, hb_c, sq_c);
        xcd_barrier(bar); TICK(10);
#pragma nounroll
        for (int l = 0; l < DEPTH; ++l) {
            const int even = (l & 1) == 0, li = l >> 1;
            Mix mx; mx.even = even; mx.li = li; mx.T = T; mx.DV = even ? 128 : 256; mx.ld = even ? EV_IN : OD_INP; mx.vcol = even ? 1536 : 1024; mx.gcol = 2048; mx.qscale = even ? 1.f : 0.08838834764831845f; mx.vf = nullptr;
            PHASE_BEGIN();
            {
                const int N = even ? EV_IN : OD_INP;
                const bf16_t* Wt = even ? (const bf16_t*)(ws + W_EVIN) + (size_t)li * EV_IN * DM : (const bf16_t*)(ws + W_ODIN) + (size_t)li * OD_INP * DM;
                pg8::Gemm g{hb_c, Wt, CH, N, DM, 256}; pg8::StaticOrder S; S.init(CH, N, C.G, C.bid);
                EpiScale E{Ub, N, sq_c};
                pg8::gemm_phase<EpiScale, pg8::StaticOrder, true, true>(C.lds, g, S, E);
            }
            xcd_barrier(bar); TICK(1);
            PHASE_BEGIN(); mx.vf = even ? (unsigned char*)hb_n : ws + ARENA + A_VFOD;
#ifndef NO_PREP
            prep_phase(C, mx);
#endif
            TICK(2);
            PHASE_BEGIN();
#ifndef NO_ATTN
            if (even) attn_phase(C, T);
#endif
            TICK(7);
            xcd_barrier(bar); TICK(0);
            PHASE_BEGIN(); mx.vf = even ? (unsigned char*)hb_n : ws + ARENA + A_VFOD;
#ifndef NO_SCAN
            scan_phase(C, mx);
#endif
            xcd_barrier(bar); TICK(3);
            PHASE_BEGIN();
#ifndef NO_FIN
            finalize_phase(C, mx);
#endif
            pb_convert(C, chunk, l);
            xcd_barrier(bar); TICK(4);
            PHASE_BEGIN();
            {
                const bf16_t* Wt = even ? (const bf16_t*)(ws + W_EVOUT) + (size_t)li * DM * DM : (const bf16_t*)(ws + W_ODOUT) + (size_t)li * DM * DM;
                pg8::Gemm g{MIXb, Wt, CH, DM, DM, 256}; pg8::StaticOrder S; S.init(CH, DM, C.G, C.bid);
                EpiResid<0> E{hch, hb_n, sq_n, nullptr, nullptr};
                pg8::gemm_phase<EpiResid<0>, pg8::StaticOrder, true, true>(C.lds, g, S, E);
                s ^= 1;
            }
            xcd_barrier(bar); TICK(5);
            PHASE_BEGIN();
            {
                pg8::Gemm g{hb_c - DM, (const bf16_t*)(ws + W_UP) + (size_t)l * 2 * DFF * DM, 65 * 256, 2 * DFF, DM, 254}; pg8::StaticOrder S; S.init(65 * 256, 2 * DFF, C.G, C.bid);
                EpiConv E{(bf16_t*)(ws + ARENA + A_ACT), sq_c, args.in[I_CW] + (size_t)l * 3 * 2 * DFF, args.in[I_CB] + (size_t)l * 2 * DFF, T, (LAS float*)(C.lds + 131072)};
                pg8::gemm_phase<EpiConv, pg8::StaticOrder, true, true>(C.lds, g, S, E);
            }
            {
                const int rem = (65 * 22) % C.G, c0 = rem, gs = rem ? C.G - rem : C.G;
                if (C.bid >= c0) {
                    PHASE_BEGIN();
                    pg8::Gemm g2{(const bf16_t*)(ws + B_PB), (const bf16_t*)(ws + W_PROJ) + (size_t)l * DM * PLE, CH, DM, PLE, 256}; pg8::StaticOrder S2; S2.init(CH, DM, gs, C.bid - c0);
                    EpiF32 E2{(bf16_t*)(ws + ARENA + A_PP), DM};
                    pg8::gemm_phase<EpiF32, pg8::StaticOrder, true, true>(C.lds, g2, S2, E2);
                }
            }
            xcd_barrier(bar); TICK(6);
            PHASE_BEGIN();
            {
                pg8::Gemm g{(const bf16_t*)(ws + ARENA + A_ACT), (const bf16_t*)(ws + W_DOWN) + (size_t)l * DM * DFF, CH, DM, DFF, 256}; pg8::StaticOrder S; S.init(CH, DM, C.G, C.bid);
                EpiResid<0> E{hch, hb_n, sq_n, nullptr, nullptr};
                pg8::gemm_phase<EpiResid<0>, pg8::StaticOrder, true, true>(C.lds, g, S, E);
                s ^= 1;
            }
            xcd_barrier(bar); TICK(8);
            PHASE_BEGIN();
            {
                pg8::Gemm g{hb_c, (const bf16_t*)(ws + W_GATE) + (size_t)l * DM * DM, CH, DM, DM, 256}; pg8::StaticOrder S; S.init(CH, DM, C.G, C.bid);
                EpiResid<1> E{hch, hb_n, sq_n, sq_c, (const bf16_t*)(ws + ARENA + A_PP)};
                pg8::gemm_phase<EpiResid<1>, pg8::StaticOrder, true, true>(C.lds, g, S, E);
                s ^= 1;
            }
            xcd_barrier(bar); TICK(9);
        }
        PHASE_BEGIN();
        final_norm(C, chunk);
        TICK(10);
    }
#ifdef PROBE_A
    xcd_barrier(bar); TICK(10);
    for (int i = 0; i < 100; ++i) xcd_barrier(bar);
    TICK(11);
    if (blockIdx.x == 0) {
        const float x1 = 8.f + (float)tacc[PROBE_A] * 1e-5f, t2 = 0.1f * (float)tacc[PROBE_B] * 1e-5f;
        float* o0 = args.out; float* o1 = args.out + (size_t)16384 * 1024;
        if (threadIdx.x == 0) { o0[0] += x1; o1[0] += x1; o1[1] += x1; }
        for (int i = threadIdx.x; i < 8192; i += NT) o0[1024 + i] += t2;
        for (int i = threadIdx.x; i < 16384; i += NT) o1[1024 + i] += t2;
    }
#endif
}
extern "C" void kernel_launch(void* const* d_in, const int* in_sizes, int n_in, void* d_out, int out_size, void* d_ws, size_t ws_size, hipStream_t stream) {
    static int grid = 0;
    if (grid == 0) {
        int dev = 0, cus = 0, per = 0;
        (void)hipGetDevice(&dev); (void)hipDeviceGetAttribute(&cus, hipDeviceAttributeMultiprocessorCount, dev);
        (void)hipFuncSetAttribute((const void*)fwd_mega, hipFuncAttributeMaxDynamicSharedMemorySize, LDS_BYTES);
        (void)hipOccupancyMaxActiveBlocksPerMultiprocessor(&per, (const void*)fwd_mega, NT, LDS_BYTES);
        if (per < 1) per = 1;
        grid = cus * per;
        fprintf(stderr, "kernel_launch: grid %d (cus %d x %d), ws %zu need %zu\n", grid, cus, per, ws_size, (size_t)WS_NEED);
        if (n_in != 23 || ws_size < WS_NEED) { fprintf(stderr, "kernel_launch: bad inputs / workspace too small\n"); grid = -1; }
    }
    if (grid < 0) return;
    Args a{};
    for (int i = 0; i < 23; ++i) a.in[i] = (const float*)d_in[i];
    a.out = (float*)d_out; a.ws = (unsigned char*)d_ws; a.ph_lo = 0; a.ph_hi = 0;
    void* kargs[] = {&a};
    hipError_t e = hipLaunchCooperativeKernel((const void*)fwd_mega, dim3(grid), dim3(NT), kargs, LDS_BYTES, stream);
    if (e != hipSuccess) fprintf(stderr, "kernel_launch: cooperative launch failed: %s\n", hipGetErrorString(e));
}
```

```cpp
#include <hip/hip_runtime.h>
#include <hip/hip_cooperative_groups.h>
#include <cstdio>
#include <cstdint>
namespace cg = cooperative_groups;
namespace pg8 {
#define PG8_LAS __attribute__((address_space(3)))
typedef unsigned short bf16_t;
typedef short bf16x8 __attribute__((ext_vector_type(8)));
typedef float f32x4 __attribute__((ext_vector_type(4)));
typedef unsigned u32x4 __attribute__((ext_vector_type(4)));
constexpr int BM = 256, BK = 64, HALF = 128, HTB = HALF * BK * 2  , STAGE_BYTES = 8 * HTB, NXCD = 8, WGM = 8;

__host__ __device__ __forceinline__ int lds_byte(int r, int c) { const int st = (r >> 4) * 2 + (c >> 5), rr = r & 15, cc = c & 31, ob = rr * 64 + cc * 2; return st * 1024 + (ob ^ (((ob >> 9) & 1) << 5)); }
__host__ __device__ __forceinline__ void stage_rc(int b, int& R, int& C) { const int st = b / 1024, sb = b % 1024, swz = sb ^ (((sb >> 9) & 1) << 5); R = (st >> 1) * 16 + swz / 64; C = (st & 1) * 32 + (swz % 64) / 2; }
__host__ __device__ __forceinline__ int perm32(int rho) { const int n = rho >> 4, i = rho & 15; return 8 * (i >> 2) + 4 * n + (i & 3); }

struct Unit { int pm, pn; };
struct Gemm { const bf16_t* A; const bf16_t* Bt; int M, N, K; int arows; };

struct StaticOrder {
    int nM, nN, nwg, G, c;
    __host__ __device__ void init(int M, int N, int G_, int c_) { nM = M / BM; nN = N / BM; nwg = nM * nN; G = G_; c = c_; }
    __host__ __device__ bool next(int i, Unit& u) const {
        const long L = (long)i * G + c; if (L >= nwg) return false;
        int wgid = (int)L; { const int q = nwg / NXCD, r = nwg % NXCD, xcd = wgid % NXCD, off = wgid / NXCD; wgid = (xcd < r ? xcd * (q + 1) : r * (q + 1) + (xcd - r) * q) + off; }
        const int nig = WGM * nN, gid = wgid / nig, fm = gid * WGM, gsz = (nM - fm) < WGM ? (nM - fm) : WGM;
        u.pm = fm + ((wgid % nig) % gsz); u.pn = (wgid % nig) / gsz; return true;
    }
    __device__ __forceinline__ void a_ready(const Unit&) const {}
    __device__ __forceinline__ void done(const Unit&) const {}
};

__device__ __forceinline__ unsigned cvt_pk_bf16(float lo, float hi) { unsigned r; asm volatile("v_cvt_pk_bf16_f32 %0, %1, %2" : "=v"(r) : "v"(lo), "v"(hi)); return r; }
typedef float f32x2 __attribute__((ext_vector_type(2)));
__device__ __forceinline__ f32x2 gelu_pk(f32x2 v) {
    const f32x2 av = __builtin_elementwise_abs(v), d = av * 0.2316418882f + 1.0f;
    f32x2 t; t.x = __builtin_amdgcn_rcpf(d.x); t.y = __builtin_amdgcn_rcpf(d.y);
    f32x2 q = t * 0.5307027145f + (-0.7265760135f); q = q * t + 0.7107068705f; q = q * t + (-0.142248368f); q = q * t + 0.127414796f; q = q * t;
    const f32x2 s = (v * v) * (-0.72134752044f);
    f32x2 e; e.x = __builtin_amdgcn_exp2f(s.x); e.y = __builtin_amdgcn_exp2f(s.y);
    const f32x2 m = v * (q * e), r = v - m;
    f32x2 o; o.x = v.x < 0.f ? m.x : r.x; o.y = v.y < 0.f ? m.y : r.y; return o;
}

template <int ACT  > struct EpiBf16 {
    static constexpr bool PERM = true, AFTER_DRAIN = false; static_assert(ACT == 0 || ACT == 1, "EpiBf16: ACT is 0 (none) or 1 (gelu_pk)");
    bf16_t* O; int ldc; const float* bias; int split_cols; size_t split_stride; float scale0;
    __device__ __forceinline__ void operator()(const f32x4 (&acc)[2][2][4][2], const Unit& u, int wr, int wc, int fr, int fq) const {
        const int row0 = u.pm * BM + wr * 64 + fr; int colt = u.pn * BM; bf16_t* base = O;
        float sc = 1.f; if (split_cols) { const int t = colt / split_cols; base += (size_t)t * split_stride; colt -= t * split_cols; if (t == 0) sc = scale0; }
        const int col0 = colt + wc * 32 + 8 * fq, bcol0 = u.pn * BM + wc * 32 + 8 * fq;
        f32x4 bv[2][2];
#pragma unroll
        for (int bj = 0; bj < 2; ++bj)
#pragma unroll
            for (int n = 0; n < 2; ++n) bv[bj][n] = bias ? *(const f32x4*)(bias + bcol0 + bj * HALF + 4 * n) : (f32x4){0.f, 0.f, 0.f, 0.f};
#pragma unroll
        for (int ai = 0; ai < 2; ++ai)
#pragma unroll
            for (int m = 0; m < 4; ++m) { bf16_t* rowp = base + (size_t)(row0 + ai * HALF + m * 16) * ldc + col0;
#pragma unroll
                for (int bj = 0; bj < 2; ++bj) { f32x4 v0 = acc[ai][bj][m][0] + bv[bj][0], v1 = acc[ai][bj][m][1] + bv[bj][1];
                    if (ACT == 1) { f32x2 a = gelu_pk((f32x2){v0[0], v0[1]}), b = gelu_pk((f32x2){v0[2], v0[3]}), c = gelu_pk((f32x2){v1[0], v1[1]}), d = gelu_pk((f32x2){v1[2], v1[3]});
                        v0 = (f32x4){a.x, a.y, b.x, b.y}; v1 = (f32x4){c.x, c.y, d.x, d.y}; }
                    v0 = v0 * sc; v1 = v1 * sc; u32x4 w; w.x = cvt_pk_bf16(v0[0], v0[1]); w.y = cvt_pk_bf16(v0[2], v0[3]); w.z = cvt_pk_bf16(v1[0], v1[1]); w.w = cvt_pk_bf16(v1[2], v1[3]);
                    *(u32x4*)(rowp + bj * HALF) = w; } }
    }
};
template <class Epi, class Sched, bool ALIGN_EPI = false, bool SP2 = false>
__device__ __forceinline__ void gemm_phase(PG8_LAS unsigned char* lds, const Gemm g, const Sched& S, const Epi& E) {
    int tid_ = threadIdx.x; asm volatile("" : "+v"(tid_)); const int tid = tid_, wid = __builtin_amdgcn_readfirstlane(tid >> 6), lane = tid & 63, wr = wid >> 2, wc = wid & 3, fr = lane & 15, fq = lane >> 4;
    int K_ = g.K; asm volatile("" : "+s"(K_)); const int K = K_, nt = K / BK;
    unsigned voffA[2], voffB[2];
#pragma unroll
    for (int i = 0; i < 2; ++i) { int R, C; stage_rc(tid * 16 + i * 8192, R, C); const int Rb = Epi::PERM ? ((R & ~31) + perm32(R & 31)) : R;
        voffA[i] = (unsigned)(R * K + C) * 2u; voffB[i] = (unsigned)(Rb * K + C) * 2u; }
    const size_t kstep = (size_t)(BK * 2);
    const size_t hstep = (size_t)HALF * K * 2;
    const size_t tstep = 2 * hstep; const size_t tstepA = (size_t)g.arows * K * 2;
    const unsigned ldsw = (unsigned)wid * 1024u;
    const int aoff = lds_byte(wr * 64 + fr, fq * 8), boff = lds_byte(wc * 32 + fr, fq * 8);
#define PG8_SA(b, h) (((b) * 2 + (h)) * HTB)
#define PG8_SB(b, h) ((4 + (b) * 2 + (h)) * HTB)
#define PG8_STAGE(bufoff, gbase, voff) do { _Pragma("unroll") for (int _i = 0; _i < 2; ++_i) \
        __builtin_amdgcn_global_load_lds((const unsigned*)((const char*)(gbase) + (voff)[_i]), (PG8_LAS unsigned*)(lds + (bufoff) + ldsw + _i * 8192), 16, 0, 0); } while (0)
#define PG8_LDA(dst, b, h) do { _Pragma("unroll") for (int m = 0; m < 4; ++m) _Pragma("unroll") for (int k = 0; k < 2; ++k) dst[m][k] = *(const PG8_LAS bf16x8*)(lds + PG8_SA(b, h) + aoff + m * 2048 + k * 1024); } while (0)
#define PG8_LDB(dst, b, h) do { _Pragma("unroll") for (int n = 0; n < 2; ++n) _Pragma("unroll") for (int k = 0; k < 2; ++k) dst[n][k] = *(const PG8_LAS bf16x8*)(lds + PG8_SB(b, h) + boff + n * 2048 + k * 1024); } while (0)
#define PG8_MMA(ai, bj, At, Bt) do { __builtin_amdgcn_s_setprio(1); _Pragma("unroll") for (int m = 0; m < 4; ++m) _Pragma("unroll") for (int n = 0; n < 2; ++n) _Pragma("unroll") for (int k = 0; k < 2; ++k) \
        acc[ai][bj][m][n] = __builtin_amdgcn_mfma_f32_16x16x32_bf16(Bt[n][k], At[m][k], acc[ai][bj][m][n], 0, 0, 0); __builtin_amdgcn_s_setprio(0); } while (0)
#define PG8_WAIT_V(n) asm volatile("s_waitcnt vmcnt(" #n ")" ::: "memory")
#define PG8_WAIT_L(n) asm volatile("s_waitcnt lgkmcnt(" #n ")" ::: "memory")
#define PG8_BAR __builtin_amdgcn_s_barrier()
#define PG8_SCHED __builtin_amdgcn_sched_barrier(0)
    Unit cur, nxt; int ui = 0;
    if (!S.next(0, cur)) return;
    f32x4 acc[2][2][4][2];
#pragma unroll
    for (int a = 0; a < 2; ++a)
#pragma unroll
        for (int b = 0; b < 2; ++b)
#pragma unroll
            for (int m = 0; m < 4; ++m)
#pragma unroll
                for (int n = 0; n < 2; ++n) acc[a][b][m][n] = (f32x4){0.f, 0.f, 0.f, 0.f};
    bf16x8 At[4][2], B0[2][2], B1[2][2];
    const char* cA = (const char*)g.A + (size_t)cur.pm * tstepA; const char* cB = (const char*)g.Bt + (size_t)cur.pn * tstep;
    S.a_ready(cur);
    if constexpr (SP2) {
        PG8_STAGE(PG8_SB(0, 0), cB, voffB); PG8_STAGE(PG8_SB(0, 1), cB + hstep, voffB); PG8_STAGE(PG8_SA(0, 0), cA, voffA); PG8_STAGE(PG8_SA(0, 1), cA + hstep, voffA);
        if (wr == 1) PG8_BAR;
        PG8_WAIT_V(2); PG8_BAR;
        PG8_STAGE(PG8_SB(1, 0), cB + kstep, voffB); PG8_STAGE(PG8_SA(1, 0), cA + kstep, voffA); PG8_STAGE(PG8_SB(1, 1), cB + hstep + kstep, voffB);
        PG8_WAIT_V(6); PG8_BAR;
    } else {
        PG8_STAGE(PG8_SB(0, 0), cB, voffB); PG8_STAGE(PG8_SA(0, 0), cA, voffA); PG8_STAGE(PG8_SB(0, 1), cB + hstep, voffB); PG8_STAGE(PG8_SA(0, 1), cA + hstep, voffA);
        if (wr == 1) PG8_BAR;
        PG8_WAIT_V(4); PG8_BAR;
        PG8_STAGE(PG8_SB(1, 0), cB + kstep, voffB); PG8_STAGE(PG8_SA(1, 0), cA + kstep, voffA); PG8_STAGE(PG8_SB(1, 1), cB + hstep + kstep, voffB);
        PG8_WAIT_V(6); PG8_BAR;
    }
    for (;;) {
        const bool has_next = S.next(ui + 1, nxt);
        const char* nA = has_next ? (const char*)g.A + (size_t)nxt.pm * tstepA : cA; const char* nB = has_next ? (const char*)g.Bt + (size_t)nxt.pn * tstep : cB;
        for (int t = 0; t < nt; t += 2) {
            const bool last = (t == nt - 2);
            const char* a1 = cA + (size_t)(t + 1) * kstep;
            const char* a2 = last ? nA : cA + (size_t)(t + 2) * kstep; const char* b2 = last ? nB : cB + (size_t)(t + 2) * kstep;
            const char* a3 = a2 + kstep; const char* b3 = b2 + kstep;
            if (last && has_next) S.a_ready(nxt);
            if constexpr (SP2) {
            PG8_LDB(B0, 0, 0); PG8_LDB(B1, 0, 1); PG8_SCHED; PG8_LDA(At, 0, 0); PG8_STAGE(PG8_SA(1, 1), a1 + hstep, voffA);
            PG8_WAIT_V(8); PG8_WAIT_L(0); PG8_BAR; PG8_MMA(0, 0, At, B0); PG8_MMA(0, 1, At, B1); PG8_BAR; PG8_SCHED;
            PG8_LDA(At, 0, 1); PG8_STAGE(PG8_SB(0, 0), b2, voffB); PG8_STAGE(PG8_SB(0, 1), b2 + hstep, voffB); PG8_STAGE(PG8_SA(0, 0), a2, voffA);
            PG8_WAIT_V(8); PG8_WAIT_L(0); PG8_BAR; PG8_MMA(1, 0, At, B0); PG8_MMA(1, 1, At, B1); PG8_BAR; PG8_SCHED;
            PG8_LDB(B0, 1, 0); PG8_LDB(B1, 1, 1); PG8_SCHED; PG8_LDA(At, 1, 0); PG8_STAGE(PG8_SA(0, 1), a2 + hstep, voffA);
            PG8_WAIT_V(8); PG8_WAIT_L(0); PG8_BAR; PG8_MMA(0, 0, At, B0); PG8_MMA(0, 1, At, B1); PG8_BAR; PG8_SCHED;
            PG8_LDA(At, 1, 1); PG8_STAGE(PG8_SB(1, 0), b3, voffB); PG8_STAGE(PG8_SB(1, 1), b3 + hstep, voffB); PG8_STAGE(PG8_SA(1, 0), a3, voffA);
            PG8_WAIT_V(8); PG8_WAIT_L(0); PG8_BAR; PG8_MMA(1, 0, At, B0); PG8_MMA(1, 1, At, B1); PG8_BAR; PG8_SCHED;
            } else {
            PG8_LDB(B0, 0, 0); PG8_SCHED; PG8_LDA(At, 0, 0); PG8_STAGE(PG8_SA(1, 1), a1 + hstep, voffA);
            PG8_WAIT_L(8); PG8_BAR; PG8_WAIT_L(0); PG8_MMA(0, 0, At, B0); PG8_BAR; PG8_SCHED;
            PG8_LDB(B1, 0, 1); PG8_STAGE(PG8_SB(0, 0), b2, voffB);
            PG8_BAR; PG8_WAIT_L(0); PG8_MMA(0, 1, At, B1); PG8_BAR;
            PG8_LDA(At, 0, 1); PG8_STAGE(PG8_SA(0, 0), a2, voffA);
            PG8_BAR; PG8_WAIT_L(0); PG8_MMA(1, 0, At, B0); PG8_BAR; PG8_SCHED;
            PG8_STAGE(PG8_SB(0, 1), b2 + hstep, voffB);
            PG8_WAIT_V(6); PG8_BAR; PG8_MMA(1, 1, At, B1); PG8_BAR;
            PG8_LDB(B0, 1, 0); PG8_SCHED; PG8_LDA(At, 1, 0); PG8_STAGE(PG8_SA(0, 1), a2 + hstep, voffA);
            PG8_WAIT_L(8); PG8_BAR; PG8_WAIT_L(0); PG8_MMA(0, 0, At, B0); PG8_BAR; PG8_SCHED;
            PG8_LDB(B1, 1, 1); PG8_STAGE(PG8_SB(1, 0), b3, voffB);
            PG8_BAR; PG8_WAIT_L(0); PG8_MMA(0, 1, At, B1); PG8_BAR;
            PG8_LDA(At, 1, 1); PG8_STAGE(PG8_SA(1, 0), a3, voffA);
            PG8_BAR; PG8_WAIT_L(0); PG8_MMA(1, 0, At, B0); PG8_BAR; PG8_SCHED;
            PG8_STAGE(PG8_SB(1, 1), b3 + hstep, voffB);
            PG8_WAIT_V(6); PG8_BAR; PG8_MMA(1, 1, At, B1); PG8_BAR;
            }
        }
        if constexpr (ALIGN_EPI) { if (wr == 0) PG8_BAR; }
        if constexpr (!Epi::AFTER_DRAIN) { E(acc, cur, wr, wc, fr, fq); S.done(cur); }
        if (!has_next) break;
#pragma unroll
        for (int a = 0; a < 2; ++a)
#pragma unroll
            for (int b = 0; b < 2; ++b)
#pragma unroll
                for (int m = 0; m < 4; ++m)
#pragma unroll
                    for (int n = 0; n < 2; ++n) acc[a][b][m][n] = (f32x4){0.f, 0.f, 0.f, 0.f};
        cur = nxt; cA = nA; cB = nB; ++ui;
        if constexpr (ALIGN_EPI) { if (wr == 1) PG8_BAR; }
    }
    PG8_WAIT_V(0);
    if constexpr (!ALIGN_EPI) { if (wr == 0) PG8_BAR; }
    PG8_BAR;
    if constexpr (Epi::AFTER_DRAIN) { E.fused(acc, cur, wr, wc, fr, fq, lds, wid, lane); S.done(cur); }
#undef PG8_SA
#undef PG8_SB
#undef PG8_STAGE
#undef PG8_LDA
#undef PG8_LDB
#undef PG8_MMA
#undef PG8_WAIT_V
#undef PG8_WAIT_L
#undef PG8_BAR
#undef PG8_SCHED
}
}
typedef unsigned short bf16_t;
typedef short bf16x8 __attribute__((ext_vector_type(8)));
typedef float f32x4 __attribute__((ext_vector_type(4)));
typedef float f32x2 __attribute__((ext_vector_type(2)));
typedef float f32x16 __attribute__((ext_vector_type(16)));
typedef unsigned u32x4 __attribute__((ext_vector_type(4)));
typedef unsigned u32x2 __attribute__((ext_vector_type(2)));
#define LAS __attribute__((address_space(3)))
constexpr int DM = 1024, CH = 16384, NCHUNK = 3, DEPTH = 4, PLE = 256, DFF = 2816;
constexpr int EV_IN = 7168, OD_IN = 3104, OD_INP = 3328;
constexpr float EPS = 1e-6f;
constexpr int NT = 512, NWV = 8;
constexpr int LDS_BYTES = 147456;
constexpr size_t al256(size_t x) { return (x + 255) & ~(size_t)255; }
constexpr size_t W_EVIN = 65536;
constexpr size_t W_EVOUT = W_EVIN + (size_t)2 * EV_IN * DM * 2;
constexpr size_t W_ODIN = W_EVOUT + (size_t)2 * DM * DM * 2;
constexpr size_t W_ODOUT = W_ODIN + (size_t)2 * OD_INP * DM * 2;
constexpr size_t W_UP = W_ODOUT + (size_t)2 * DM * DM * 2;
constexpr size_t W_DOWN = W_UP + (size_t)4 * 2 * DFF * DM * 2;
constexpr size_t W_GATE = W_DOWN + (size_t)4 * DM * DFF * 2;
constexpr size_t W_PROJ = W_GATE + (size_t)4 * DM * DM * 2;
constexpr size_t W_LB = W_PROJ + (size_t)4 * DM * PLE * 2;
constexpr size_t B_PB = W_LB + 8192;
constexpr size_t B_HB0 = B_PB + (size_t)CH * PLE * 2;
constexpr size_t B_HB1 = B_HB0 + (size_t)CH * DM * 2;
constexpr size_t B_SSQ0 = B_HB1 + (size_t)CH * DM * 2;
constexpr size_t B_SSQ1 = B_SSQ0 + (size_t)CH * 16 * 4;
constexpr size_t ARENA = B_SSQ1 + (size_t)CH * 16 * 4;
constexpr size_t A_U = 0;
constexpr size_t A_QT = (size_t)CH * EV_IN * 2;
constexpr size_t A_KT = A_QT + (size_t)2 * CH * 512 * 2;
constexpr size_t A_MIX = A_QT;
constexpr size_t A_OEV = A_KT + (size_t)2 * CH * 512 * 2;
constexpr size_t A_VFOD = (size_t)CH * OD_INP * 2;
constexpr size_t A_OOD = A_OEV;
constexpr size_t A_OG = A_OEV + (size_t)2 * CH * 512 * 4;
constexpr size_t A_LSE = A_OG + (size_t)3 * CH * 512 * 2;
constexpr size_t A_DEC = A_OOD + (size_t)2 * CH * 1024 * 4;
constexpr size_t ARENA_BYTES = A_DEC + (size_t)512 * 4 * 2 * 128 * 4;
constexpr size_t A_UF = 0;
constexpr size_t A_ACT = (size_t)CH * 2 * DFF * 2;
constexpr size_t A_PP = 0;
constexpr size_t WS_NEED = ARENA + ARENA_BYTES;
static_assert(A_LSE + (size_t)3 * CH * 4 * 4 <= A_DEC, "even bufs before DEC");
static_assert(A_VFOD + (size_t)CH * 1024 * 2 * 2 <= A_QT, "odd Vf fits before QT");
static_assert(A_ACT + (size_t)CH * DFF * 2 <= ARENA_BYTES, "act fits");

__device__ __forceinline__ float bf2f(unsigned short v) { return __uint_as_float(((unsigned)v) << 16); }
__device__ __forceinline__ unsigned pk2(float lo, float hi) { return pg8::cvt_pk_bf16(lo, hi); }
typedef float f32x2_cv __attribute__((ext_vector_type(2))); typedef __bf16 bf16x2_cv __attribute__((ext_vector_type(2)));
__device__ __forceinline__ unsigned pk2s(float lo, float hi) { const f32x2_cv v = {lo, hi}; const bf16x2_cv c = __builtin_convertvector(v, bf16x2_cv); return __builtin_bit_cast(unsigned, c); }
__device__ __forceinline__ float shfl_xor_l(float v, int lane, int m) { return __builtin_bit_cast(float, __builtin_amdgcn_ds_bpermute((lane ^ m) << 2, __builtin_bit_cast(int, v))); }
__device__ __forceinline__ float wave_sum(float v, int lane) {
#pragma unroll
    for (int o = 1; o < 64; o <<= 1) v += shfl_xor_l(v, lane, o);
    return v;
}
__device__ __forceinline__ float rstd_of(const float* ssq, int row) {
    const f32x4* p = (const f32x4*)(ssq + (size_t)row * 16);
    const f32x4 a = p[0], b = p[1], c = p[2], d = p[3];
    const float s = ((a.x + a.y) + (a.z + a.w)) + ((b.x + b.y) + (b.z + b.w)) + ((c.x + c.y) + (c.z + c.w)) + ((d.x + d.y) + (d.z + d.w));
    return rsqrtf(s * (1.0f / DM) + EPS);
}
struct EpiScale {
    static constexpr bool PERM = true, AFTER_DRAIN = false;
    bf16_t* O; int ldc; const float* ssq;
    __device__ __forceinline__ void operator()(const f32x4 (&acc)[2][2][4][2], const pg8::Unit& u, int wr, int wc, int fr, int fq) const {
        const int row0 = u.pm * 256 + wr * 64 + fr, col0 = u.pn * 256 + wc * 32 + 8 * fq;
#pragma unroll
        for (int ai = 0; ai < 2; ++ai)
#pragma unroll
            for (int m = 0; m < 4; ++m) {
                const int row = row0 + ai * 128 + m * 16; const float rs = rstd_of(ssq, row);
                bf16_t* rp = O + (size_t)row * ldc + col0;
#pragma unroll
                for (int bj = 0; bj < 2; ++bj) { const f32x4 v0 = acc[ai][bj][m][0] * rs, v1 = acc[ai][bj][m][1] * rs;
                    u32x4 w; w.x = pk2(v0[0], v0[1]); w.y = pk2(v0[2], v0[3]); w.z = pk2(v1[0], v1[1]); w.w = pk2(v1[2], v1[3]);
                    *(u32x4*)(rp + bj * 128) = w; }
            }
    }
};
struct EpiF32 {
    static constexpr bool PERM = true, AFTER_DRAIN = false;
    bf16_t* O; int ldc;
    __device__ __forceinline__ void operator()(const f32x4 (&acc)[2][2][4][2], const pg8::Unit& u, int wr, int wc, int fr, int fq) const {
        const int row0 = u.pm * 256 + wr * 64 + fr, col0 = u.pn * 256 + wc * 32 + 8 * fq;
#pragma unroll
        for (int ai = 0; ai < 2; ++ai)
#pragma unroll
            for (int m = 0; m < 4; ++m) { bf16_t* rp = O + (size_t)(row0 + ai * 128 + m * 16) * ldc + col0;
#pragma unroll
                for (int bj = 0; bj < 2; ++bj) { const f32x4 v0 = acc[ai][bj][m][0], v1 = acc[ai][bj][m][1];
                    u32x4 w; w.x = pk2s(v0[0], v0[1]); w.y = pk2s(v0[2], v0[3]); w.z = pk2s(v1[0], v1[1]); w.w = pk2s(v1[2], v1[3]);
                    *(u32x4*)(rp + bj * 128) = w; } }
    }
};
template <int MODE  > struct EpiResid {
    static constexpr bool PERM = true, AFTER_DRAIN = false;
    float* h; bf16_t* hb; float* ssq_out; const float* ssq_in; const bf16_t* pp;
    __device__ __forceinline__ void operator()(const f32x4 (&acc)[2][2][4][2], const pg8::Unit& u, int wr, int wc, int fr, int fq) const {
        const int row0 = u.pm * 256 + wr * 64 + fr, col0 = u.pn * 256 + wc * 32 + 8 * fq;
#pragma unroll
        for (int ai = 0; ai < 2; ++ai)
#pragma unroll
            for (int m = 0; m < 4; ++m) {
                const int row = row0 + ai * 128 + m * 16; float rs = 1.f; if (MODE == 1) rs = rstd_of(ssq_in, row);
                float* hp = h + (size_t)row * DM + col0; bf16_t* bp = hb + (size_t)row * DM + col0; float s = 0.f;
#pragma unroll
                for (int bj = 0; bj < 2; ++bj) {
                    f32x4 a0 = acc[ai][bj][m][0], a1 = acc[ai][bj][m][1];
                    if (MODE == 1) { const u32x4 pw = *(const u32x4*)(pp + (size_t)row * DM + col0 + bj * 128);
                        const f32x4 p0 = {__uint_as_float(pw.x << 16), __uint_as_float(pw.x & 0xffff0000u), __uint_as_float(pw.y << 16), __uint_as_float(pw.y & 0xffff0000u)};
                        const f32x4 p1 = {__uint_as_float(pw.z << 16), __uint_as_float(pw.z & 0xffff0000u), __uint_as_float(pw.w << 16), __uint_as_float(pw.w & 0xffff0000u)};
#pragma unroll
                        for (int e = 0; e < 4; ++e) { a0[e] = p0[e] / (1.f + __expf(-a0[e] * rs)); a1[e] = p1[e] / (1.f + __expf(-a1[e] * rs)); } }
                    const f32x4 h0 = *(const f32x4*)(hp + bj * 128) + a0, h1 = *(const f32x4*)(hp + bj * 128 + 4) + a1;
                    *(f32x4*)(hp + bj * 128) = h0; *(f32x4*)(hp + bj * 128 + 4) = h1;
                    u32x4 w; w.x = pk2(h0[0], h0[1]); w.y = pk2(h0[2], h0[3]); w.z = pk2(h1[0], h1[1]); w.w = pk2(h1[2], h1[3]);
                    *(u32x4*)(bp + bj * 128) = w;
                    s += (h0[0] * h0[0] + h0[1] * h0[1]) + (h0[2] * h0[2] + h0[3] * h0[3]) + (h1[0] * h1[0] + h1[1] * h1[1]) + (h1[2] * h1[2] + h1[3] * h1[3]);
                }
                { const int ln_ = fq * 16 + fr; s += shfl_xor_l(s, ln_, 16); s += shfl_xor_l(s, ln_, 32); }
                if (fq == 0) ssq_out[(size_t)row * 16 + u.pn * 4 + wc] = s;
            }
    }
};

struct EpiConv {
    static constexpr bool PERM = true, AFTER_DRAIN = false;
    bf16_t* act; const float* ssq; const float* cw; const float* cb; int T; LAS float* halo;
    __device__ __forceinline__ void operator()(f32x4 (&acc)[2][2][4][2], const pg8::Unit& u, int wr, int wc, int fr, int fq) const {
        const int g0 = 254 * u.pm - 1, lane = fq * 16 + fr;
#pragma unroll
        for (int ai = 0; ai < 2; ++ai)
#pragma unroll
            for (int m = 0; m < 4; ++m) { const float rs = rstd_of(ssq, g0 + ai * 128 + wr * 64 + m * 16 + fr);
#pragma unroll
                for (int bj = 0; bj < 2; ++bj) { acc[ai][bj][m][0] = acc[ai][bj][m][0] * rs; acc[ai][bj][m][1] = acc[ai][bj][m][1] * rs; } }
#pragma unroll
        for (int ai = 0; ai < 2; ++ai) { const int s = 2 * ai + wr;
            if (fr == 0) {
#pragma unroll
                for (int bj = 0; bj < 2; ++bj)
#pragma unroll
                    for (int n = 0; n < 2; ++n) *(LAS f32x4*)(halo + ((((wc * 4 + s) * 2 + 0) * 2 + bj) * 32) + 8 * fq + 4 * n) = acc[ai][bj][0][n]; }
            if (fr == 15) {
#pragma unroll
                for (int bj = 0; bj < 2; ++bj)
#pragma unroll
                    for (int n = 0; n < 2; ++n) *(LAS f32x4*)(halo + ((((wc * 4 + s) * 2 + 1) * 2 + bj) * 32) + 8 * fq + 4 * n) = acc[ai][bj][3][n]; } }
        asm volatile("s_waitcnt lgkmcnt(0)" ::: "memory"); __builtin_amdgcn_s_barrier(); asm volatile("" ::: "memory");
#pragma unroll
        for (int n = 0; n < 2; ++n) {
            const int ca = u.pn * 128 + wc * 32 + 8 * fq + 4 * n;
            f32x4 w0[2], w1[2], w2[2], bb[2];
#pragma unroll
            for (int bj = 0; bj < 2; ++bj) { const int c = bj * DFF + ca;
                w0[bj] = *(const f32x4*)(cw + c); w1[bj] = *(const f32x4*)(cw + 2 * DFF + c); w2[bj] = *(const f32x4*)(cw + 4 * DFF + c); bb[bj] = *(const f32x4*)(cb + c); }
#pragma unroll
            for (int ai = 0; ai < 2; ++ai) { const int s = 2 * ai + wr;
#pragma unroll
                for (int m = 0; m < 4; ++m) {
                    const int lr = ai * 128 + wr * 64 + m * 16 + fr, g = g0 + lr; const bool tp = (g & (T - 1)) != 0, tn = ((g + 1) & (T - 1)) != 0;
                    f32x4 ph[2] = {{0.f, 0.f, 0.f, 0.f}, {0.f, 0.f, 0.f, 0.f}}, nh[2] = {{0.f, 0.f, 0.f, 0.f}, {0.f, 0.f, 0.f, 0.f}};
                    if (m == 0 && s > 0) {
#pragma unroll
                        for (int bj = 0; bj < 2; ++bj) ph[bj] = *(const LAS f32x4*)(halo + ((((wc * 4 + s - 1) * 2 + 1) * 2 + bj) * 32) + 8 * fq + 4 * n); }
                    if (m == 3 && s < 3) {
#pragma unroll
                        for (int bj = 0; bj < 2; ++bj) nh[bj] = *(const LAS f32x4*)(halo + ((((wc * 4 + s + 1) * 2 + 0) * 2 + bj) * 32) + 8 * fq + 4 * n); }
                    float cv[2][4];
#pragma unroll
                    for (int bj = 0; bj < 2; ++bj)
#pragma unroll
                        for (int e = 0; e < 4; ++e) {
                            const float cur = acc[ai][bj][m][n][e];
                            const float sp_ = (fr == 15) ? (m > 0 ? acc[ai][bj][m > 0 ? m - 1 : 0][n][e] : ph[bj][e]) : cur;
                            const float sn_ = (fr == 0) ? (m < 3 ? acc[ai][bj][m < 3 ? m + 1 : 3][n][e] : nh[bj][e]) : cur;
                            const float pv = __builtin_bit_cast(float, __builtin_amdgcn_update_dpp(0, __builtin_bit_cast(int, sp_), 0x121, 0xf, 0xf, false));
                            const float nv = __builtin_bit_cast(float, __builtin_amdgcn_update_dpp(0, __builtin_bit_cast(int, sn_), 0x12F, 0xf, 0xf, false));
                            float t_ = fmaf(cur, w1[bj][e], bb[bj][e]); t_ = tp ? fmaf(pv, w0[bj][e], t_) : t_; t_ = tn ? fmaf(nv, w2[bj][e], t_) : t_; cv[bj][e] = t_;
                        }
                    const f32x2 g01 = pg8::gelu_pk((f32x2){cv[1][0], cv[1][1]}), g23 = pg8::gelu_pk((f32x2){cv[1][2], cv[1][3]});
                    if (lr >= 1 && lr <= 254 && g < CH) { u32x2 w; w.x = pk2(cv[0][0] * g01.x, cv[0][1] * g01.y); w.y = pk2(cv[0][2] * g23.x, cv[0][3] * g23.y);
                        *(u32x2*)(act + (size_t)g * DFF + ca) = w; }
                    __builtin_amdgcn_sched_barrier(0);
                }
            }
            asm volatile("" ::: "memory");
        }
    }
};
struct Args {
    const float* in[23]; float* out; unsigned char* ws; int ph_lo, ph_hi;
};
enum { I_XP = 0, I_XS, I_PP, I_PS, I_NMIX, I_EVIN, I_LBL, I_HNORM, I_EVOUT, I_ODIN, I_GUP, I_GB, I_GNORM, I_ODOUT, I_NFFN, I_FUP, I_CW, I_CB, I_FDOWN, I_NPLE, I_PGATE, I_PPROJ, I_NOUT };

struct Ctx {
    LAS unsigned char* lds; int tid, lane, wave, G, bid;
    const Args* a; unsigned char* ws;
};

__device__ __forceinline__ void transpose_item(const float* W, int K, int N, const float* gk, bf16_t* WT, LAS float* scr, int item, int lane, bool remap) {
    const int nblk = N / 32, kb = item / nblk, nb = item % nblk, k0 = 64 * kb, n0 = 32 * nb;
#pragma unroll 8
    for (int i = 0; i < 32; ++i) { const int kk = 2 * i + (lane >> 5); float v = W[(size_t)(k0 + kk) * N + n0 + (lane & 31)]; if (gk) v *= gk[k0 + kk]; scr[kk * 33 + (lane & 31)] = v; }
    asm volatile("s_waitcnt lgkmcnt(0)" ::: "memory");
    const int c = lane & 7;
#pragma unroll
    for (int j = 0; j < 4; ++j) { const int n = (lane >> 3) + 8 * j; const LAS float* s = scr + (8 * c) * 33 + n;
        u32x4 o; o.x = pk2(s[0 * 33], s[1 * 33]); o.y = pk2(s[2 * 33], s[3 * 33]); o.z = pk2(s[4 * 33], s[5 * 33]); o.w = pk2(s[6 * 33], s[7 * 33]);
        int nr = n0 + n; if (remap) nr = (nr < DFF) ? (((nr >> 7) << 8) + (nr & 127)) : ((((nr - DFF) >> 7) << 8) + 128 + ((nr - DFF) & 127));
        *(u32x4*)(WT + (size_t)nr * K + k0 + 8 * c) = o; }
    asm volatile("s_waitcnt lgkmcnt(0)" ::: "memory");
}
__device__ __forceinline__ void weights_prologue(const Ctx& C) {
    LAS float* scr = (LAS float*)(C.lds + C.wave * 8704);
    const int gw = C.bid * NWV + C.wave, NGW = C.G * NWV;
    const Args& a = *C.a;
    for (int mat = 0; mat < 24; ++mat) {
        const float* W; const float* g = nullptr; bf16_t* WT; int K, N;
        if (mat < 2)       { const int e = mat;      W = a.in[I_EVIN] + (size_t)e * DM * EV_IN;  K = DM; N = EV_IN; g = a.in[I_NMIX] + (2 * e) * DM;     WT = (bf16_t*)(C.ws + W_EVIN) + (size_t)e * EV_IN * DM; }
        else if (mat < 4)  { const int e = mat - 2;  W = a.in[I_EVOUT] + (size_t)e * DM * DM;    K = DM; N = DM;                                        WT = (bf16_t*)(C.ws + W_EVOUT) + (size_t)e * DM * DM; }
        else if (mat < 6)  { const int o = mat - 4;  W = a.in[I_ODIN] + (size_t)o * DM * OD_IN;  K = DM; N = OD_IN; g = a.in[I_NMIX] + (2 * o + 1) * DM; WT = (bf16_t*)(C.ws + W_ODIN) + (size_t)o * OD_INP * DM; }
        else if (mat < 8)  { const int o = mat - 6;  W = a.in[I_ODOUT] + (size_t)o * DM * DM;    K = DM; N = DM;                                        WT = (bf16_t*)(C.ws + W_ODOUT) + (size_t)o * DM * DM; }
        else if (mat < 12) { const int l = mat - 8;  W = a.in[I_FUP] + (size_t)l * DM * 2 * DFF; K = DM; N = 2 * DFF; g = a.in[I_NFFN] + l * DM;         WT = (bf16_t*)(C.ws + W_UP) + (size_t)l * 2 * DFF * DM; }
        else if (mat < 16) { const int l = mat - 12; W = a.in[I_FDOWN] + (size_t)l * DFF * DM;   K = DFF; N = DM;                                       WT = (bf16_t*)(C.ws + W_DOWN) + (size_t)l * DM * DFF; }
        else if (mat < 20) { const int l = mat - 16; W = a.in[I_PGATE] + (size_t)l * DM * DM;    K = DM; N = DM; g = a.in[I_NPLE] + l * DM;              WT = (bf16_t*)(C.ws + W_GATE) + (size_t)l * DM * DM; }
        else               { const int l = mat - 20; W = a.in[I_PPROJ] + (size_t)l * PLE * DM;   K = PLE; N = DM;                                       WT = (bf16_t*)(C.ws + W_PROJ) + (size_t)l * DM * PLE; }
        const int nitems = (K / 64) * (N / 32);
        for (int it = gw; it < nitems; it += NGW) transpose_item(W, K, N, g, WT, scr, it, C.lane, mat >= 8 && mat < 12);
    }
    { const int gt = C.bid * NT + C.tid, GT = C.G * NT; const int per = (OD_INP - OD_IN) * DM / 8;
      for (int i = gt; i < 2 * per; i += GT) { const int o = i / per, r = i % per; *(u32x4*)((bf16_t*)(C.ws + W_ODIN) + (size_t)o * OD_INP * DM + (size_t)OD_IN * DM + (size_t)r * 8) = (u32x4){0u, 0u, 0u, 0u}; } }
    { const int gt = C.bid * NT + C.tid; if (gt < 1024) { const int dir = gt >> 9, c = gt & 511; const float* L = a.in[I_LBL] + (size_t)dir * 2 * 512;
        float* lb = (float*)(C.ws + W_LB) + dir * 1024; lb[c] = 0.f; lb[512 + c] = 1.f / (1.f + __expf(L[c] - L[512 + c])); } }
}
__device__ __forceinline__ void chunk_prologue(const Ctx& C, int chunk, bf16_t* hb, float* ssq) {
    const int gw = C.bid * NWV + C.wave, NGW = C.G * NWV; const Args& a = *C.a;
    for (int r = gw; r < CH; r += NGW) {
        const size_t R = (size_t)chunk * CH + r;
        const float* xr = (R < 16384) ? a.in[I_XP] + R * DM : a.in[I_XS] + (R - 16384) * DM;
        float* hr = a.out + R * DM; f32x4 v[4]; float s = 0.f;
#pragma unroll
        for (int j = 0; j < 4; ++j) { v[j] = ((const f32x4*)xr)[C.lane + 64 * j]; s += (v[j].x * v[j].x + v[j].y * v[j].y) + (v[j].z * v[j].z + v[j].w * v[j].w); }
        s = wave_sum(s, C.lane);
#pragma unroll
        for (int j = 0; j < 4; ++j) { ((f32x4*)hr)[C.lane + 64 * j] = v[j]; u32x2 w; w.x = pk2(v[j].x, v[j].y); w.y = pk2(v[j].z, v[j].w); ((u32x2*)(hb + (size_t)r * DM))[C.lane + 64 * j] = w; }
        if (C.lane < 16) ssq[(size_t)r * 16 + C.lane] = (C.lane == 0) ? s : 0.f;
    }
}
__device__ __forceinline__ void final_norm(const Ctx& C, int chunk) {
    const int gw = C.bid * NWV + C.wave, NGW = C.G * NWV; const Args& a = *C.a; const float* g = a.in[I_NOUT];
    for (int r = gw; r < CH; r += NGW) {
        float* hr = a.out + ((size_t)chunk * CH + r) * DM; f32x4 v[4]; float s = 0.f;
#pragma unroll
        for (int j = 0; j < 4; ++j) { v[j] = ((const f32x4*)hr)[C.lane + 64 * j]; s += (v[j].x * v[j].x + v[j].y * v[j].y) + (v[j].z * v[j].z + v[j].w * v[j].w); }
        const float rs = rsqrtf(wave_sum(s, C.lane) * (1.f / DM) + EPS);
#pragma unroll
        for (int j = 0; j < 4; ++j) { const f32x4 gg = ((const f32x4*)g)[C.lane + 64 * j]; ((f32x4*)hr)[C.lane + 64 * j] = v[j] * rs * gg; }
    }
}
__device__ __forceinline__ void conv_phase(const Ctx& C, int chunk, int l, int T) {
    const Args& a = *C.a;
    const bf16_t* UF = (const bf16_t*)(C.ws + ARENA + A_UF); bf16_t* ACT = (bf16_t*)(C.ws + ARENA + A_ACT);
    const float* cw = a.in[I_CW] + (size_t)l * 3 * 2 * DFF; const float* cb = a.in[I_CB] + (size_t)l * 2 * DFF;
    {
        const int ry = C.tid >> 5, cx = C.tid & 31;
        for (int tile = C.bid; tile < (CH / 64) * 11; tile += C.G) {
            const int rt = tile / 11, ct = tile % 11; const int r0 = rt * 64 + ry * 4, c0 = ct * 256 + cx * 8;
            float wa0[8], wa1[8], wa2[8], wg0[8], wg1[8], wg2[8], ba[8], bg[8];
#pragma unroll
            for (int e = 0; e < 8; e += 4) { *(f32x4*)(wa0 + e) = *(const f32x4*)(cw + c0 + e); *(f32x4*)(wa1 + e) = *(const f32x4*)(cw + 2 * DFF + c0 + e); *(f32x4*)(wa2 + e) = *(const f32x4*)(cw + 4 * DFF + c0 + e);
                *(f32x4*)(wg0 + e) = *(const f32x4*)(cw + DFF + c0 + e); *(f32x4*)(wg1 + e) = *(const f32x4*)(cw + 3 * DFF + c0 + e); *(f32x4*)(wg2 + e) = *(const f32x4*)(cw + 5 * DFF + c0 + e);
                *(f32x4*)(ba + e) = *(const f32x4*)(cb + c0 + e); *(f32x4*)(bg + e) = *(const f32x4*)(cb + DFF + c0 + e); }
            bf16x8 ua[6], ug[6];
#pragma unroll
            for (int i = 0; i < 6; ++i) { const int r = r0 - 1 + i; const bool ok = (i == 0) ? ((r0 % T) != 0) : (i == 5 ? (((r0 + 4) % T) != 0) : true);
                if (ok) { ua[i] = *(const bf16x8*)(UF + (size_t)r * 2 * DFF + c0); ug[i] = *(const bf16x8*)(UF + (size_t)r * 2 * DFF + DFF + c0); }
                else { ua[i] = (bf16x8){0, 0, 0, 0, 0, 0, 0, 0}; ug[i] = ua[i]; } }
#pragma unroll
            for (int i = 0; i < 4; ++i) {
                float o[8];
#pragma unroll
                for (int e = 0; e < 8; ++e) {
                    const float av = bf2f((unsigned short)ua[i][e]) * wa0[e] + bf2f((unsigned short)ua[i + 1][e]) * wa1[e] + bf2f((unsigned short)ua[i + 2][e]) * wa2[e] + ba[e];
                    const float gv = bf2f((unsigned short)ug[i][e]) * wg0[e] + bf2f((unsigned short)ug[i + 1][e]) * wg1[e] + bf2f((unsigned short)ug[i + 2][e]) * wg2[e] + bg[e];
                    o[e] = av * (0.5f * gv * (1.f + erff(gv * 0.70710678118f)));
                }
                u32x4 w; w.x = pk2(o[0], o[1]); w.y = pk2(o[2], o[3]); w.z = pk2(o[4], o[5]); w.w = pk2(o[6], o[7]);
                *(u32x4*)(ACT + (size_t)(r0 + i) * DFF + c0) = w;
            }
        }
    }
}
__device__ __forceinline__ void pb_convert(const Ctx& C, int chunk, int l) {
    const Args& a = *C.a;
    { bf16_t* PB = (bf16_t*)(C.ws + B_PB); const int gt = C.bid * NT + C.tid, GT = C.G * NT;
      for (int i = gt; i < CH * PLE / 4; i += GT) { const int r = i / (PLE / 4), c4 = i % (PLE / 4); const size_t R = (size_t)chunk * CH + r;
          const float* src = (R < 16384) ? a.in[I_PP] + ((size_t)l * 16384 + R) * PLE : a.in[I_PS] + ((size_t)l * 32768 + (R - 16384)) * PLE;
          const f32x4 v = ((const f32x4*)src)[c4]; u32x2 w; w.x = pk2(v.x, v.y); w.y = pk2(v.z, v.w); ((u32x2*)(PB + (size_t)r * PLE))[c4] = w; } }
}
struct Mix { int even, li, T, DV, ld, vcol, gcol; float qscale; unsigned char* vf; };
#define MFMA32(a, b, c) __builtin_amdgcn_mfma_f32_32x32x16_bf16((a), (b), (c), 0, 0, 0)
#define QK_IDX(hd, dir, blk, k) (((((size_t)((hd) * 2 + (dir))) * 512 + (size_t)(blk)) * 8 + (k)) * 64)
#define V_IDX(hd, dir, ET, et, blk, sp) ((((((size_t)((hd) * 2 + (dir))) * (ET) + (et)) * 512 + (size_t)(blk)) * 2 + (sp)) * 64)
#define O_IDX(hd, dir, ET, et, blk, q) ((((((size_t)((hd) * 2 + (dir))) * (ET) + (et)) * 512 + (size_t)(blk)) * 4 + (q)) * 64)
#define OB_IDX(hd, dir, ET, et, blk, r) ((((((size_t)((hd) * 2 + (dir))) * (ET) + (et)) * 512 + (size_t)(blk)) * 2 + (r)) * 64)
#define DEC_IDX(hd, dir, blk) ((((size_t)((hd) * 2 + (dir))) * 512 + (size_t)(blk)) * 128)
#define LDSFENCE() asm volatile("s_waitcnt lgkmcnt(0)" ::: "memory")
__device__ __forceinline__ bf16x8 pack8(float a0, float a1, float a2, float a3, float a4, float a5, float a6, float a7) {
    u32x4 w; w.x = pk2(a0, a1); w.y = pk2(a2, a3); w.z = pk2(a4, a5); w.w = pk2(a6, a7); return __builtin_bit_cast(bf16x8, w);
}
__device__ __forceinline__ bf16x8 pack8s(float a0, float a1, float a2, float a3, float a4, float a5, float a6, float a7) {
    u32x4 w; w.x = pk2s(a0, a1); w.y = pk2s(a2, a3); w.z = pk2s(a4, a5); w.w = pk2s(a6, a7); return __builtin_bit_cast(bf16x8, w);
}
__device__ __forceinline__ f32x16 zero16() { f32x16 z;
#pragma unroll
    for (int i = 0; i < 16; ++i) z[i] = 0.f; return z; }

__device__ __forceinline__ void prep_phase(const Ctx& C, const Mix& mx) {
    const Args& a = *C.a;
    const bf16_t* U = (const bf16_t*)(C.ws + ARENA + A_U);
    u32x4* QTf = (u32x4*)(C.ws + ARENA + A_QT); u32x4* KTf = (u32x4*)(C.ws + ARENA + A_KT); u32x4* Vf = (u32x4*)mx.vf;
    f32x4* Of = (f32x4*)(C.ws + ARENA + A_OEV); float* DEC = (float*)(C.ws + ARENA + A_DEC);
    const float* LB = (const float*)(C.ws + W_LB);
    const int hd = C.wave & 3, dir = C.wave >> 2, lane = C.lane, ld = mx.ld, DV = mx.DV;
    LAS float* Bs = (LAS float*)(C.lds + C.wave * 16896);
    for (int b = C.bid; b < CH / 32; b += C.G) {
        int vz_ = 0; asm volatile("" : "+v"(vz_)); const int rb = 32 * b + vz_;
        {
            const int d0 = 2 * lane, col0 = hd * 128 + d0, dt0 = d0 >> 5, dp0 = d0 & 31;
            float bs0 = 0.f, bs1 = 0.f; unsigned zz[32];
            if (mx.even) {
                const f32x2 lb2 = *(const f32x2*)(LB + dir * 1024 + mx.li * 512 + col0); const float om0 = 1.f - lb2.x, om1 = 1.f - lb2.y;
                const bf16_t* zp = U + 512 + 512 * dir + col0;
#pragma unroll
                for (int t = 0; t < 32; ++t) { const int row = rb + (dir ? 31 - t : t);
                    const unsigned zw = *(const unsigned*)(zp + (size_t)row * ld); zz[t] = zw;
                    const float z0 = __uint_as_float(zw << 16), z1 = __uint_as_float(zw & 0xffff0000u);
                    bs0 += fmaxf(__logf(lb2.x + om0 / (1.f + __expf(-z0))), -30.f); bs1 += fmaxf(__logf(lb2.y + om1 / (1.f + __expf(-z1))), -30.f);
                    *(LAS f32x2*)(Bs + t * 132 + d0) = (f32x2){bs0, bs1}; }
                *(f32x2*)(DEC + DEC_IDX(hd, dir, b) + d0) = (f32x2){__expf(bs0), __expf(bs1)};
#pragma unroll
                for (int grp = 0; grp < 4; ++grp) { float k0[8], k1[8];
#pragma unroll
                    for (int j = 0; j < 8; ++j) { const int t = 16 * (grp >> 1) + 8 * (j >> 2) + 4 * (grp & 1) + (j & 3);
                        const float z0 = __uint_as_float(zz[t] << 16), z1 = __uint_as_float(zz[t] & 0xffff0000u); const f32x2 bt = *(const LAS f32x2*)(Bs + t * 132 + d0);
                        k0[j] = om0 / (1.f + __expf(z0)) * __expf(bs0 - bt.x); k1[j] = om1 / (1.f + __expf(z1)) * __expf(bs1 - bt.y); }
                    u32x4 w; w.x = pk2(k0[0], k0[1]); w.y = pk2(k0[2], k0[3]); w.z = pk2(k0[4], k0[5]); w.w = pk2(k0[6], k0[7]);
                    KTf[QK_IDX(hd, dir, b, (grp >> 1) * 4 + dt0) + 32 * (grp & 1) + dp0] = w;
                    w.x = pk2(k1[0], k1[1]); w.y = pk2(k1[2], k1[3]); w.z = pk2(k1[4], k1[5]); w.w = pk2(k1[6], k1[7]);
                    KTf[QK_IDX(hd, dir, b, (grp >> 1) * 4 + dt0) + 32 * (grp & 1) + dp0 + 1] = w; }
            } else {
                float Wg0[16], Wg1[16]; const float* wp = a.in[I_GUP] + ((size_t)(mx.li * 2 + dir) * 16) * 512 + col0;
#pragma unroll
                for (int r = 0; r < 16; ++r) { const f32x2 w2 = *(const f32x2*)(wp + r * 512); Wg0[r] = w2.x; Wg1[r] = w2.y; }
                const f32x2 bias = *(const f32x2*)(a.in[I_GB] + (mx.li * 2 + dir) * 512 + col0);
#pragma unroll
                for (int t = 0; t < 32; ++t) { const int row = rb + (dir ? 31 - t : t);
                    const u32x4 l0 = *(const u32x4*)(U + (size_t)row * ld + 3072 + 16 * dir), l1 = *(const u32x4*)(U + (size_t)row * ld + 3072 + 16 * dir + 8);
                    zz[t] = *(const unsigned*)(U + (size_t)row * ld + 512 + col0);
                    float x0 = bias.x, x1 = bias.y;
#pragma unroll
                    for (int w = 0; w < 4; ++w) { const float a0 = __uint_as_float(l0[w] << 16), a1 = __uint_as_float(l0[w] & 0xffff0000u), c0 = __uint_as_float(l1[w] << 16), c1 = __uint_as_float(l1[w] & 0xffff0000u);
                        x0 += a0 * Wg0[2 * w] + a1 * Wg0[2 * w + 1] + c0 * Wg0[8 + 2 * w] + c1 * Wg0[8 + 2 * w + 1];
                        x1 += a0 * Wg1[2 * w] + a1 * Wg1[2 * w + 1] + c0 * Wg1[8 + 2 * w] + c1 * Wg1[8 + 2 * w + 1]; }
                    bs0 += fmaxf((fminf(x0, 0.f) - log1pf(__expf(-fabsf(x0)))) * (1.f / 16.f), -30.f); bs1 += fmaxf((fminf(x1, 0.f) - log1pf(__expf(-fabsf(x1)))) * (1.f / 16.f), -30.f);
                    *(LAS f32x2*)(Bs + t * 132 + d0) = (f32x2){bs0, bs1}; }
                *(f32x2*)(DEC + DEC_IDX(hd, dir, b) + d0) = (f32x2){__expf(bs0), __expf(bs1)};
#pragma unroll
                for (int grp = 0; grp < 4; ++grp) { float k0[8], k1[8];
#pragma unroll
                    for (int j = 0; j < 8; ++j) { const int t = 16 * (grp >> 1) + 8 * (j >> 2) + 4 * (grp & 1) + (j & 3); const f32x2 bt = *(const LAS f32x2*)(Bs + t * 132 + d0);
                        k0[j] = __uint_as_float(zz[t] << 16) * __expf(bs0 - bt.x); k1[j] = __uint_as_float(zz[t] & 0xffff0000u) * __expf(bs1 - bt.y); }
                    u32x4 w; w.x = pk2(k0[0], k0[1]); w.y = pk2(k0[2], k0[3]); w.z = pk2(k0[4], k0[5]); w.w = pk2(k0[6], k0[7]);
                    KTf[QK_IDX(hd, dir, b, (grp >> 1) * 4 + dt0) + 32 * (grp & 1) + dp0] = w;
                    w.x = pk2(k1[0], k1[1]); w.y = pk2(k1[2], k1[3]); w.z = pk2(k1[4], k1[5]); w.w = pk2(k1[6], k1[7]);
                    KTf[QK_IDX(hd, dir, b, (grp >> 1) * 4 + dt0) + 32 * (grp & 1) + dp0 + 1] = w; }
            }
        }
        LDSFENCE();
        const int tau = lane & 31, h = lane >> 5, row = rb + (dir ? 31 - tau : tau);
        u32x4 vt[8];
#pragma unroll
        for (int it = 0; it < 8; ++it) { const int idx = lane + 64 * it, t = idx / (DV / 8), c8 = idx % (DV / 8); const int rj = rb + (dir ? 31 - t : t);
            vt[it] = *(const u32x4*)(U + (size_t)rj * ld + mx.vcol + hd * DV + c8 * 8); }
        bf16x8 Ak[8], Bq[8];
#pragma unroll
        for (int ks = 0; ks < 8; ++ks) {
            float qh[8], kh[8], qt[8];
#pragma unroll
            for (int q2 = 0; q2 < 2; ++q2) {
                const int d0 = 16 * ks + 8 * q2 + 4 * h;
                const f32x4 b4 = *(const LAS f32x4*)(Bs + tau * 132 + d0), r4 = *(const LAS f32x4*)(Bs + 15 * 132 + d0);
                const u32x2 qr = *(const u32x2*)(U + (size_t)row * ld + hd * 128 + d0);
                float q4[4] = {__uint_as_float(qr.x << 16), __uint_as_float(qr.x & 0xffff0000u), __uint_as_float(qr.y << 16), __uint_as_float(qr.y & 0xffff0000u)};
                float k4[4];
                if (mx.even) { const u32x2 zr = *(const u32x2*)(U + (size_t)row * ld + 512 + 512 * dir + hd * 128 + d0);
                    const f32x4 lb4 = *(const f32x4*)(LB + dir * 1024 + mx.li * 512 + hd * 128 + d0);
                    const float z4[4] = {__uint_as_float(zr.x << 16), __uint_as_float(zr.x & 0xffff0000u), __uint_as_float(zr.y << 16), __uint_as_float(zr.y & 0xffff0000u)};
#pragma unroll
                    for (int e = 0; e < 4; ++e) k4[e] = (1.f - lb4[e]) / (1.f + __expf(z4[e]));
                } else { const u32x2 kr = *(const u32x2*)(U + (size_t)row * ld + 512 + hd * 128 + d0);
                    k4[0] = __uint_as_float(kr.x << 16); k4[1] = __uint_as_float(kr.x & 0xffff0000u); k4[2] = __uint_as_float(kr.y << 16); k4[3] = __uint_as_float(kr.y & 0xffff0000u); }
#pragma unroll
                for (int e = 0; e < 4; ++e) { const float qq = q4[e] * mx.qscale; qt[4 * q2 + e] = qq * __expf(b4[e]);
                    qh[4 * q2 + e] = qq * __expf(fminf(b4[e] - r4[e], 80.f)); kh[4 * q2 + e] = k4[e] * __expf(fminf(r4[e] - b4[e], 80.f)); }
            }
            { u32x4 w; w.x = pk2(qt[0], qt[1]); w.y = pk2(qt[2], qt[3]); w.z = pk2(qt[4], qt[5]); w.w = pk2(qt[6], qt[7]); QTf[QK_IDX(hd, dir, b, ks) + lane] = w; }
            Bq[ks] = pack8(qh[0], qh[1], qh[2], qh[3], qh[4], qh[5], qh[6], qh[7]);
            Ak[ks] = pack8(kh[0], kh[1], kh[2], kh[3], kh[4], kh[5], kh[6], kh[7]);
        }
        f32x16 at = zero16();
#pragma unroll
        for (int ks = 0; ks < 8; ++ks) at = MFMA32(Ak[ks], Bq[ks], at);
#pragma unroll
        for (int i = 0; i < 16; ++i) { const int s = (i & 3) + 8 * (i >> 2) + 4 * h; if (s > tau) at[i] = 0.f; }
        bf16x8 Pa[2];
        Pa[0] = pack8(at[0], at[1], at[2], at[3], at[4], at[5], at[6], at[7]);
        Pa[1] = pack8(at[8], at[9], at[10], at[11], at[12], at[13], at[14], at[15]);
        const int ET = DV / 32;
        LDSFENCE();
        LAS unsigned char* Vs = (LAS unsigned char*)Bs; const int vpitch = 2 * DV + 16;
#pragma unroll
        for (int it = 0; it < 8; ++it) { const int idx = lane + 64 * it, t = idx / (DV / 8), c8 = idx % (DV / 8); *(LAS u32x4*)(Vs + t * vpitch + c8 * 16) = vt[it]; }
        for (int idx = lane + 512; idx < 32 * (DV / 8); idx += 64) { const int t = idx / (DV / 8), c8 = idx % (DV / 8); const int rj = rb + (dir ? 31 - t : t);
            *(LAS u32x4*)(Vs + t * vpitch + c8 * 16) = *(const u32x4*)(U + (size_t)rj * ld + mx.vcol + hd * DV + c8 * 8); }
        LDSFENCE();
        for (int et = 0; et < ET; ++et) {
            f32x16 acc = zero16();
#pragma unroll
            for (int sp = 0; sp < 2; ++sp) {
                unsigned short v[8];
#pragma unroll
                for (int j = 0; j < 8; ++j) { const int sj = 16 * sp + 8 * (j >> 2) + 4 * h + (j & 3); v[j] = *(const LAS unsigned short*)(Vs + sj * vpitch + (32 * et + (lane & 31)) * 2); }
                u32x4 w; w.x = v[0] | ((unsigned)v[1] << 16); w.y = v[2] | ((unsigned)v[3] << 16); w.z = v[4] | ((unsigned)v[5] << 16); w.w = v[6] | ((unsigned)v[7] << 16);
                Vf[V_IDX(hd, dir, ET, et, b, sp) + lane] = w;
                acc = MFMA32(Pa[sp], __builtin_bit_cast(bf16x8, w), acc);
            }
#pragma unroll
            for (int r = 0; r < 2; ++r) { u32x4 w; w.x = pk2s(acc[8 * r], acc[8 * r + 1]); w.y = pk2s(acc[8 * r + 2], acc[8 * r + 3]); w.z = pk2s(acc[8 * r + 4], acc[8 * r + 5]); w.w = pk2s(acc[8 * r + 6], acc[8 * r + 7]);
                ((u32x4*)Of)[OB_IDX(hd, dir, ET, et, b, r) + lane] = w; }
        }
        LDSFENCE();
    }
}
__device__ __forceinline__ void scan_phase(const Ctx& C, const Mix& mx) {
    const u32x4* QTf = (const u32x4*)(C.ws + ARENA + A_QT); const u32x4* KTf = (const u32x4*)(C.ws + ARENA + A_KT); const u32x4* Vf = (const u32x4*)mx.vf;
    u32x4* Of = (u32x4*)(C.ws + ARENA + A_OEV); const float* DEC = (const float*)(C.ws + ARENA + A_DEC);
    const int lane = C.lane, h = lane >> 5, DV = mx.DV, ET = DV / 32, T = mx.T, nb = T / 32;
    const int units = (CH / T) * 8 * ET;
    constexpr int SLOT = 23552, R = 5, NL = 4;
    LAS u32x4* SB = (LAS u32x4*)(C.lds + R * SLOT);
    for (int base = 0; base < units; base += C.G) {
        const bool loader = C.wave >= 2 && C.wave < 2 + NL;
        const int lr = C.wave - 2;
        const int u = base + C.bid;
        const bool valid = u < units;
        const int et = u % ET, x = u / ET, dir = x & 1, hd = (x >> 1) & 3, seq = x >> 3;
        LAS unsigned char* ring = C.lds;
#define SCAN_BAR() do { asm volatile("s_waitcnt lgkmcnt(0)" ::: "memory"); __builtin_amdgcn_s_barrier(); asm volatile("" ::: "memory"); } while (0)
#define GLDS16(gp, lp) __builtin_amdgcn_global_load_lds((const unsigned*)(gp), (LAS unsigned*)(lp), 16, 0, 0)
#define SCAN_ISSUE(j) do { const int blk_ = seq * nb + (dir ? nb - 1 - (j) : (j)); LAS unsigned char* sl_ = ring + ((j) % R) * SLOT; \
            _Pragma("unroll") for (int k = 0; k < 8; ++k) { GLDS16(QTf + QK_IDX(hd, dir, blk_, k) + lane, sl_ + k * 1024); GLDS16(KTf + QK_IDX(hd, dir, blk_, k) + lane, sl_ + (8 + k) * 1024); } \
            _Pragma("unroll") for (int sp = 0; sp < 2; ++sp) GLDS16(Vf + V_IDX(hd, dir, ET, et, blk_, sp) + lane, sl_ + (16 + sp) * 1024); \
            _Pragma("unroll") for (int r = 0; r < 2; ++r) GLDS16(Of + OB_IDX(hd, dir, ET, et, blk_, r) + lane, sl_ + (18 + r) * 1024); \
            if (lane < 32) GLDS16(DEC + DEC_IDX(hd, dir, blk_) + 4 * lane, sl_ + 22 * 1024); } while (0)
        if (C.wave == 0) {
            SCAN_BAR();
            for (int i = 0; i < nb; ++i) {
                if (valid) {
                    const LAS u32x4* sv = (const LAS u32x4*)(ring + (i % R) * SLOT) + lane; const LAS u32x4* sb = SB + (i & 1) * 512 + lane;
                    u32x4 qf[8], on[2], bs[8];
#pragma unroll
                    for (int r = 0; r < 2; ++r) on[r] = sv[(18 + r) * 64];
#pragma unroll
                    for (int k = 0; k < 8; ++k) { qf[k] = sv[k * 64]; bs[k] = sb[k * 64]; }
                    asm volatile("s_waitcnt lgkmcnt(0)" ::: "memory");
                    f32x16 acc;
#pragma unroll
                    for (int r = 0; r < 2; ++r) {
                        acc[8 * r + 0] = __uint_as_float(on[r].x << 16); acc[8 * r + 1] = __uint_as_float(on[r].x & 0xffff0000u); acc[8 * r + 2] = __uint_as_float(on[r].y << 16); acc[8 * r + 3] = __uint_as_float(on[r].y & 0xffff0000u);
                        acc[8 * r + 4] = __uint_as_float(on[r].z << 16); acc[8 * r + 5] = __uint_as_float(on[r].z & 0xffff0000u); acc[8 * r + 6] = __uint_as_float(on[r].w << 16); acc[8 * r + 7] = __uint_as_float(on[r].w & 0xffff0000u); }
#pragma unroll
                    for (int k = 0; k < 8; ++k) acc = MFMA32(__builtin_bit_cast(bf16x8, qf[k]), __builtin_bit_cast(bf16x8, bs[k]), acc);
                    const int blk = seq * nb + (dir ? nb - 1 - i : i);
#pragma unroll
                    for (int r = 0; r < 2; ++r) { u32x4 w; w.x = pk2s(acc[8 * r], acc[8 * r + 1]); w.y = pk2s(acc[8 * r + 2], acc[8 * r + 3]); w.z = pk2s(acc[8 * r + 4], acc[8 * r + 5]); w.w = pk2s(acc[8 * r + 6], acc[8 * r + 7]);
                        Of[OB_IDX(hd, dir, ET, et, blk, r) + lane] = w; }
                }
                SCAN_BAR();
            }
        } else if (C.wave == 1) {
            f32x16 S[4];
#pragma unroll
            for (int dt = 0; dt < 4; ++dt) S[dt] = zero16();
#pragma unroll
            for (int k = 0; k < 8; ++k) SB[k * 64 + lane] = (u32x4){0u, 0u, 0u, 0u};
            SCAN_BAR();
            for (int i = 0; i < nb; ++i) {
                if (valid) {
                    const LAS unsigned char* sl = ring + (i % R) * SLOT; const LAS u32x4* sv = (const LAS u32x4*)sl + lane;
                    u32x4 kf[8], vf[2]; f32x4 dq[16];
#pragma unroll
                    for (int k = 0; k < 8; ++k) kf[k] = sv[(8 + k) * 64];
#pragma unroll
                    for (int sp = 0; sp < 2; ++sp) vf[sp] = sv[(16 + sp) * 64];
                    const LAS float* dp = (const LAS float*)(sl + 22 * 1024) + 4 * h;
#pragma unroll
                    for (int k = 0; k < 16; ++k) dq[k] = *(const LAS f32x4*)(dp + 8 * k);
                    asm volatile("s_waitcnt lgkmcnt(0)" ::: "memory");
#pragma unroll
                    for (int dt = 0; dt < 4; ++dt)
#pragma unroll
                        for (int q = 0; q < 4; ++q) {
#pragma unroll
                            for (int e = 0; e < 4; ++e) S[dt][4 * q + e] *= dq[4 * dt + q][e]; }
#pragma unroll
                    for (int sp = 0; sp < 2; ++sp) {
#pragma unroll
                        for (int dt = 0; dt < 4; ++dt) S[dt] = MFMA32(__builtin_bit_cast(bf16x8, kf[sp * 4 + dt]), __builtin_bit_cast(bf16x8, vf[sp]), S[dt]); }
                    LAS u32x4* sbw = SB + ((i + 1) & 1) * 512 + lane;
#pragma unroll
                    for (int dt = 0; dt < 4; ++dt)
#pragma unroll
                        for (int sp = 0; sp < 2; ++sp)
                            sbw[(2 * dt + sp) * 64] = __builtin_bit_cast(u32x4, pack8s(S[dt][8 * sp + 0], S[dt][8 * sp + 1], S[dt][8 * sp + 2], S[dt][8 * sp + 3], S[dt][8 * sp + 4], S[dt][8 * sp + 5], S[dt][8 * sp + 6], S[dt][8 * sp + 7]));
                }
                SCAN_BAR();
            }
        } else {
            if (loader && valid && lr < nb) SCAN_ISSUE(lr);
            for (int i = -1; i < nb; ++i) {
                if (loader && valid) {
                    if (i >= 0 && lr == i % NL && i + NL < nb) SCAN_ISSUE(i + NL);
                    if (lr == (i + 1) % NL && i + 1 < nb) asm volatile("s_waitcnt vmcnt(0)" ::: "memory");
                }
                SCAN_BAR();
            }
        }
#undef SCAN_ISSUE
#undef GLDS16
#undef SCAN_BAR
    }
}
__device__ __forceinline__ void attn_phase(const Ctx& C, int T) {
    const bf16_t* U = (const bf16_t*)(C.ws + ARENA + A_U);
    bf16_t* OG = (bf16_t*)(C.ws + ARENA + A_OG); float* LSE = (float*)(C.ws + ARENA + A_LSE);
    const int lane = C.lane, h = lane >> 5, l31 = lane & 31, ld = EV_IN, tps = T / 32;
    for (int task = C.bid * NWV + C.wave; task < 3 * 4 * (CH / 32); task += C.G * NWV) {
        const int g = task / 2048, x = task % 2048, hd = x / 512, y = x % 512, seq = y / tps, z = y % tps;
        const int dil = 1 << (2 * g), L = T / dil, nqb = L / 32, r = z / nqb, qb = z % nqb, m0 = 32 * qb;
        const int qcol = 2560 + g * 1536 + hd * 128, kcol = qcol + 512, vcol = qcol + 1024;
        const float coef = exp2f(-8.0f * (float)(g * 4 + hd + 1) / 12.0f) * (float)dil, scale = 0.08838834764831845f;
        const size_t rbase = (size_t)seq * T + r;
        bf16x8 Bq[8];
        { const bf16_t* qp = U + (rbase + (size_t)(m0 + l31) * dil) * ld + qcol + 8 * h;
#pragma unroll
          for (int ks = 0; ks < 8; ++ks) Bq[ks] = *(const bf16x8*)(qp + 16 * ks); }
        f32x16 st[5];
        bf16x8 Kc[8], Kn[8];
        {   const int mkc0 = (m0 - 64) < 0 ? 0 : (m0 - 64);
            const bf16_t* kp = U + (rbase + (size_t)(mkc0 + l31) * dil) * ld + kcol + 8 * h;
#pragma unroll
            for (int ks = 0; ks < 8; ++ks) Kc[ks] = *(const bf16x8*)(kp + 16 * ks); }
#pragma unroll
        for (int kb = 0; kb < 5; ++kb) {
            const int mk0 = m0 - 64 + 32 * kb; const bool vb = (mk0 >= 0 && mk0 < L);
            if (kb < 4) { const int mk1 = mk0 + 32; const int mkc1 = mk1 < 0 ? 0 : (mk1 >= L ? L - 32 : mk1);
                const bf16_t* kp = U + (rbase + (size_t)(mkc1 + l31) * dil) * ld + kcol + 8 * h;
#pragma unroll
                for (int ks = 0; ks < 8; ++ks) Kn[ks] = *(const bf16x8*)(kp + 16 * ks); }
            f32x16 s = zero16();
#pragma unroll
            for (int ks = 0; ks < 8; ++ks) s = MFMA32(Kc[ks], Bq[ks], s);
#pragma unroll
            for (int i = 0; i < 16; ++i) { const int rel = (mk0 + (i & 3) + 8 * (i >> 2) + 4 * h) - (m0 + l31); const int ar = rel < 0 ? -rel : rel;
                s[i] = (vb && ar <= 64) ? s[i] * scale - coef * (float)ar : -1e30f; }
            st[kb] = s;
#pragma unroll
            for (int ks = 0; ks < 8; ++ks) Kc[ks] = Kn[ks];
        }
        float mxv = -1e30f;
#pragma unroll
        for (int kb = 0; kb < 5; ++kb)
#pragma unroll
            for (int i = 0; i < 16; ++i) mxv = fmaxf(mxv, st[kb][i]);
        mxv = fmaxf(mxv, shfl_xor_l(mxv, lane, 32));
        float den = 0.f;
#pragma unroll
        for (int kb = 0; kb < 5; ++kb)
#pragma unroll
            for (int i = 0; i < 16; ++i) { const float p = __expf(st[kb][i] - mxv); st[kb][i] = p; den += p; }
        den += shfl_xor_l(den, lane, 32);
        f32x16 ot[4];
#pragma unroll
        for (int dt = 0; dt < 4; ++dt) ot[dt] = zero16();
        LAS unsigned char* Vs = C.lds + C.wave * 16896;
#pragma unroll
        for (int kb = 0; kb < 5; ++kb) {
            const int mk0 = m0 - 64 + 32 * kb; const int mkc = mk0 < 0 ? 0 : (mk0 >= L ? L - 32 : mk0);
            u32x4 vr[8];
#pragma unroll
            for (int it = 0; it < 8; ++it) { const int idx = lane + 64 * it, t = idx >> 4, c8 = idx & 15; vr[it] = *(const u32x4*)(U + (rbase + (size_t)(mkc + t) * dil) * ld + vcol + c8 * 8); }
            LDSFENCE();
#pragma unroll
            for (int it = 0; it < 8; ++it) { const int idx = lane + 64 * it, t = idx >> 4, c8 = idx & 15; *(LAS u32x4*)(Vs + t * 272 + c8 * 16) = vr[it]; }
            LDSFENCE();
#pragma unroll
            for (int sp = 0; sp < 2; ++sp) {
                const bf16x8 Bp = pack8(st[kb][8 * sp + 0], st[kb][8 * sp + 1], st[kb][8 * sp + 2], st[kb][8 * sp + 3], st[kb][8 * sp + 4], st[kb][8 * sp + 5], st[kb][8 * sp + 6], st[kb][8 * sp + 7]);
#pragma unroll
                for (int dt = 0; dt < 4; ++dt) {
                    typedef short v4i16_t __attribute__((ext_vector_type(4)));
                    const LAS unsigned char* tp = Vs + (16 * sp + 4 * h + ((lane & 15) >> 2)) * 272 + (32 * dt + 16 * ((lane >> 4) & 1) + 4 * (lane & 3)) * 2;
                    const v4i16_t lo = __builtin_amdgcn_ds_read_tr16_b64_v4i16((LAS v4i16_t*)tp), hi = __builtin_amdgcn_ds_read_tr16_b64_v4i16((LAS v4i16_t*)(tp + 8 * 272));
                    bf16x8 w; w[0] = lo[0]; w[1] = lo[1]; w[2] = lo[2]; w[3] = lo[3]; w[4] = hi[0]; w[5] = hi[1]; w[6] = hi[2]; w[7] = hi[3];
                    ot[dt] = MFMA32(w, Bp, ot[dt]);
                }
            }
        }
        const float inv = 1.f / den; const size_t qrow = rbase + (size_t)(m0 + l31) * dil;
        bf16_t* op = OG + ((size_t)g * CH + qrow) * 512 + hd * 128 + 4 * h;
#pragma unroll
        for (int dt = 0; dt < 4; ++dt)
#pragma unroll
            for (int q = 0; q < 4; ++q) { u32x2 w; w.x = pk2(ot[dt][4 * q] * inv, ot[dt][4 * q + 1] * inv); w.y = pk2(ot[dt][4 * q + 2] * inv, ot[dt][4 * q + 3] * inv);
                *(u32x2*)(op + 32 * dt + 8 * q) = w; }
        if (h == 0) LSE[((size_t)g * CH + qrow) * 4 + hd] = mxv + __logf(den);
    }
}
__device__ __forceinline__ void finalize_phase(const Ctx& C, const Mix& mx) {
    const Args& a = *C.a;
    const bf16_t* __restrict__ U = (const bf16_t*)(C.ws + ARENA + A_U); bf16_t* __restrict__ MIX = (bf16_t*)(C.ws + ARENA + A_MIX);
    const f32x4* __restrict__ Of = (const f32x4*)(C.ws + ARENA + A_OEV);
    const int gw = C.bid * NWV + C.wave, NGW = C.G * NWV, lane = C.lane, ld = mx.ld, DV = mx.DV, ET = DV / 32, NE = DV / 64;
    const float* gn = mx.even ? a.in[I_HNORM] + mx.li * 512 : a.in[I_GNORM] + mx.li * 1024;
#pragma unroll 2
    for (int rg = gw; rg < CH / 4; rg += NGW) {
        const int r0 = 4 * rg, blk = r0 >> 5, t0 = r0 & 31;
        const int qf = t0 >> 3, hf = (t0 >> 2) & 1, tb = 28 - t0, qb = tb >> 3, hb2 = (tb >> 2) & 1;
#pragma unroll
        for (int hd = 0; hd < 4; ++hd) {
            float o[2][2][4]; float ss[4] = {0.f, 0.f, 0.f, 0.f};
            const u32x2* Ob2 = (const u32x2*)Of;
#pragma unroll
            for (int k = 0; k < 2; ++k) if (2 * k < NE) {
                const int e0 = 2 * lane + 128 * k, et = e0 >> 5;
#pragma unroll
                for (int p = 0; p < 2; ++p) {
                    const u32x2 vf_ = Ob2[(OB_IDX(hd, 0, ET, et, blk, qf >> 1) + 32 * hf + (e0 & 31) + p) * 2 + (qf & 1)], vb_ = Ob2[(OB_IDX(hd, 1, ET, et, blk, qb >> 1) + 32 * hb2 + (e0 & 31) + p) * 2 + (qb & 1)];
                    o[k][p][0] = __uint_as_float(vf_.x << 16) + __uint_as_float(vb_.y & 0xffff0000u); o[k][p][1] = __uint_as_float(vf_.x & 0xffff0000u) + __uint_as_float(vb_.y << 16);
                    o[k][p][2] = __uint_as_float(vf_.y << 16) + __uint_as_float(vb_.x & 0xffff0000u); o[k][p][3] = __uint_as_float(vf_.y & 0xffff0000u) + __uint_as_float(vb_.x << 16);
#pragma unroll
                    for (int j = 0; j < 4; ++j) ss[j] += o[k][p][j] * o[k][p][j];
                }
            }
#pragma unroll
            for (int j = 0; j < 4; ++j) ss[j] = rsqrtf(wave_sum(ss[j], lane) / (float)DV + EPS);
#pragma unroll
            for (int k = 0; k < 2; ++k) if (2 * k < NE) {
                const int c = hd * DV + 2 * lane + 128 * k; const f32x2 g2 = *(const f32x2*)(gn + c);
#pragma unroll
                for (int j = 0; j < 4; ++j) { const unsigned agw = *(const unsigned*)(U + (size_t)(r0 + j) * ld + 2048 + c);
                    const float a0 = __uint_as_float(agw << 16), a1 = __uint_as_float(agw & 0xffff0000u);
                    *(unsigned*)(MIX + (size_t)(r0 + j) * DM + c) = pk2(o[k][0][j] * ss[j] * g2.x * (a0 / (1.f + __expf(-a0))), o[k][1][j] * ss[j] * g2.y * (a1 / (1.f + __expf(-a1)))); }
            }
        }
        if (mx.even) {
            const bf16_t* __restrict__ OG = (const bf16_t*)(C.ws + ARENA + A_OG); const float* __restrict__ LSE = (const float*)(C.ws + ARENA + A_LSE);
            const int c8 = lane * 8, hd = lane >> 4;
#pragma unroll
            for (int j = 0; j < 4; ++j) { const int r = r0 + j;
                const float l0 = LSE[((size_t)0 * CH + r) * 4 + hd], l1 = LSE[((size_t)1 * CH + r) * 4 + hd], l2 = LSE[((size_t)2 * CH + r) * 4 + hd];
                const float m = fmaxf(l0, fmaxf(l1, l2)); float w0 = __expf(l0 - m), w1 = __expf(l1 - m), w2 = __expf(l2 - m); const float iw = 1.f / (w0 + w1 + w2);
                w0 *= iw; w1 *= iw; w2 *= iw;
                const u32x4 v0 = *(const u32x4*)(OG + ((size_t)0 * CH + r) * 512 + c8), v1 = *(const u32x4*)(OG + ((size_t)1 * CH + r) * 512 + c8), v2 = *(const u32x4*)(OG + ((size_t)2 * CH + r) * 512 + c8);
                u32x4 o;
#pragma unroll
                for (int k = 0; k < 4; ++k) {
                    const float bx = w0 * __uint_as_float(v0[k] << 16) + w1 * __uint_as_float(v1[k] << 16) + w2 * __uint_as_float(v2[k] << 16);
                    const float by = w0 * __uint_as_float(v0[k] & 0xffff0000u) + w1 * __uint_as_float(v1[k] & 0xffff0000u) + w2 * __uint_as_float(v2[k] & 0xffff0000u);
                    o[k] = pk2(bx, by); }
                *(u32x4*)(MIX + (size_t)r * DM + 512 + c8) = o;
            }
        }
    }
}
#define XB_TMO      128
#define XB_XCNT(j)  (256  + 64 * (j))
#define XB_XSUB(j)  (1280 + 64 * (j))
#define XB_XGEN(j)  (2304 + 64 * (j))
#define XB_TOP      3328
#define XB_TOPGEN   3392
#define XCD_BAR_WORDS 3456
#define XB_SPIN_CAP (1u << 18)

__device__ __forceinline__ unsigned xb_ld(unsigned* p)              { return __hip_atomic_load(p, __ATOMIC_RELAXED, __HIP_MEMORY_SCOPE_AGENT); }
__device__ __forceinline__ unsigned xb_add(unsigned* p, unsigned v) { return __hip_atomic_fetch_add(p, v, __ATOMIC_RELAXED, __HIP_MEMORY_SCOPE_AGENT); }
__device__ __forceinline__ unsigned xb_xcc_id() { return (unsigned)__builtin_amdgcn_s_getreg((3 << 11) | 20) & 0xFu; }
#define XB_SPIN(cond, bar) do { unsigned _sp = 0; while (cond) { __builtin_amdgcn_s_sleep(1); \
    if ((++_sp & 255u) == 0u) { if (xb_ld(&(bar)[XB_TMO])) break; if (_sp > XB_SPIN_CAP) { atomicAdd(&(bar)[XB_TMO], 1u); break; } } } } while (0)

struct XcdBarrier {
    unsigned* bar; unsigned x;
    volatile LAS unsigned* st;
};

__device__ __forceinline__ XcdBarrier xcd_barrier_post(unsigned* bar, volatile LAS unsigned* st) {
    XcdBarrier b; b.bar = bar; b.x = xb_xcc_id(); b.st = st;
    if (threadIdx.x == 0) (void)xb_add(&bar[XB_XCNT(b.x)], 1u);
    return b;
}
__device__ __forceinline__ void xcd_barrier_complete(unsigned* bar, unsigned x, unsigned& nloc, unsigned& nx) {
    const unsigned G = gridDim.x * gridDim.y * gridDim.z;
    unsigned sum, cnt, mine, sp = 0u;
    for (;;) {
        sum = 0u; cnt = 0u; mine = 0u;
#pragma unroll
        for (unsigned j = 0; j < 16; ++j) { const unsigned c = xb_ld(&bar[XB_XCNT(j)]); sum += c; cnt += (c > 0u) ? 1u : 0u; mine = (j == x) ? c : mine; }
        if (sum == G) break;
        __builtin_amdgcn_s_sleep(1);
        if ((++sp & 255u) == 0u) { if (xb_ld(&bar[XB_TMO])) break; if (sp > XB_SPIN_CAP) { atomicAdd(&bar[XB_TMO], 1u); break; } }
    }
    nloc = mine > 0u ? mine : 1u; nx = cnt > 0u ? cnt : 1u;
}

__device__ __forceinline__ void xcd_barrier(const XcdBarrier& b) {
    asm volatile("s_waitcnt vmcnt(0)" ::: "memory");
    __syncthreads();
    if (threadIdx.x == 0) {
        unsigned* bar = b.bar;
        __builtin_amdgcn_s_waitcnt(0);
        unsigned nloc = b.st[0], nx = b.st[1];
        if (nloc == 0u) { xcd_barrier_complete(bar, b.x, nloc, nx); b.st[0] = nloc; b.st[1] = nx; }
        const unsigned old = xb_add(&bar[XB_XSUB(b.x)], 1u);
        const unsigned gen = old / nloc;
        if (old + 1u == (gen + 1u) * nloc) {
            __builtin_amdgcn_fence(__ATOMIC_RELEASE, "agent");
            asm volatile("s_waitcnt vmcnt(0)" ::: "memory");
            const unsigned og = xb_add(&bar[XB_TOP], 1u);
            const unsigned tg = og / nx;
            if (og + 1u == (tg + 1u) * nx) xb_add(&bar[XB_TOPGEN], 1u);
            else XB_SPIN(xb_ld(&bar[XB_TOPGEN]) == tg, bar);
            __builtin_amdgcn_fence(__ATOMIC_ACQUIRE, "agent");
            xb_add(&bar[XB_XGEN(b.x)], 1u);
            asm volatile("s_waitcnt vmcnt(0)" ::: "memory");
        } else {
            XB_SPIN(xb_ld(&bar[XB_XGEN(b.x)]) == gen, bar);
            __builtin_amdgcn_fence(__ATOMIC_ACQUIRE, "agent");
            asm volatile("s_waitcnt vmcnt(0)" ::: "memory");
        }
    }
    __syncthreads();
}
#define PHASE_BEGIN() do { int t_ = threadIdx.x; asm volatile("" : "+v"(t_)); C.tid = t_; C.lane = t_ & 63; C.wave = __builtin_amdgcn_readfirstlane(t_ >> 6); \
    int b_ = blockIdx.x; asm volatile("" : "+s"(b_)); C.bid = b_; unsigned char* w_ = args.ws; asm volatile("" : "+s"(w_)); C.ws = w_; ws = w_; \
    hb_c = (bf16_t*)(ws + (s ? B_HB1 : B_HB0)); hb_n = (bf16_t*)(ws + (s ? B_HB0 : B_HB1)); sq_c = (float*)(ws + (s ? B_SSQ1 : B_SSQ0)); sq_n = (float*)(ws + (s ? B_SSQ0 : B_SSQ1)); Ub = (bf16_t*)(ws + ARENA + A_U); MIXb = (bf16_t*)(ws + ARENA + A_MIX); \
    hch = args.out + (size_t)chunk * CH * DM; } while (0)
__global__ void __launch_bounds__(NT, 2) fwd_mega(Args args) {
    extern __shared__ __attribute__((aligned(16))) unsigned char lds_raw[];
    cg::grid_group grid = cg::this_grid();
    Ctx C; C.lds = (LAS unsigned char*)lds_raw; C.tid = threadIdx.x; C.lane = C.tid & 63; C.wave = __builtin_amdgcn_readfirstlane(C.tid >> 6);
    C.G = gridDim.x; C.bid = blockIdx.x; C.a = &args; C.ws = args.ws;
    unsigned char* ws = args.ws;
    bf16_t *hb_c, *hb_n; float *sq_c, *sq_n; bf16_t *Ub, *MIXb;
    if (blockIdx.x == 0) for (int i = threadIdx.x; i < XCD_BAR_WORDS; i += NT) ((unsigned*)args.ws)[i] = 0u;
    if (threadIdx.x < 2) ((volatile LAS unsigned*)(C.lds + LDS_BYTES - 256))[threadIdx.x] = 0u;
    weights_prologue(C);
    __syncthreads();
    grid.sync();
    XcdBarrier bar = xcd_barrier_post((unsigned*)args.ws, (volatile LAS unsigned*)(C.lds + LDS_BYTES - 256));
    float* hch;
#ifdef PROBE_A
    unsigned tacc[12];
#pragma unroll
    for (int i = 0; i < 12; ++i) tacc[i] = 0u;
    unsigned long long tprev = __builtin_amdgcn_s_memrealtime();
#define TICK(k) do { const unsigned long long now_ = __builtin_amdgcn_s_memrealtime(); tacc[k] += (unsigned)(now_ - tprev); tprev = now_; } while (0)
#else
#define TICK(k) do {} while (0)
#endif
#pragma nounroll
    for (int chunk = 0; chunk < NCHUNK; ++chunk) {
        const int T = chunk == 0 ? 4096 : 2048; int s = 0;
        PHASE_BEGIN();
        chunk_prologue(C, chunk, hb_c, sq_c);
        xcd_barrier(bar); TICK(10);
#pragma nounroll
        for (int l = 0; l < DEPTH; ++l) {
            const int even = (l & 1) == 0, li = l >> 1;
            Mix mx; mx.even = even; mx.li = li; mx.T = T; mx.DV = even ? 128 : 256; mx.ld = even ? EV_IN : OD_INP; mx.vcol = even ? 1536 : 1024; mx.gcol = 2048; mx.qscale = even ? 1.f : 0.08838834764831845f; mx.vf = nullptr;
            PHASE_BEGIN();
            {
                const int N = even ? EV_IN : OD_INP;
                const bf16_t* Wt = even ? (const bf16_t*)(ws + W_EVIN) + (size_t)li * EV_IN * DM : (const bf16_t*)(ws + W_ODIN) + (size_t)li * OD_INP * DM;
                pg8::Gemm g{hb_c, Wt, CH, N, DM, 256}; pg8::StaticOrder S; S.init(CH, N, C.G, C.bid);
                EpiScale E{Ub, N, sq_c};
                pg8::gemm_phase<EpiScale, pg8::StaticOrder, true, true>(C.lds, g, S, E);
            }
            xcd_barrier(bar); TICK(1);
            PHASE_BEGIN(); mx.vf = even ? (unsigned char*)hb_n : ws + ARENA + A_VFOD;
#ifndef NO_PREP
            prep_phase(C, mx);
#endif
            TICK(2);
            PHASE_BEGIN();
#ifndef NO_ATTN
            if (even) attn_phase(C, T);
#endif
            TICK(7);
            xcd_barrier(bar); TICK(0);
            PHASE_BEGIN(); mx.vf = even ? (unsigned char*)hb_n : ws + ARENA + A_VFOD;
#ifndef NO_SCAN
            scan_phase(C, mx);
#endif
            xcd_barrier(bar); TICK(3);
            PHASE_BEGIN();
#ifndef NO_FIN
            finalize_phase(C, mx);
#endif
            pb_convert(C, chunk, l);
            xcd_barrier(bar); TICK(4);
            PHASE_BEGIN();
            {
                const bf16_t* Wt = even ? (const bf16_t*)(ws + W_EVOUT) + (size_t)li * DM * DM : (const bf16_t*)(ws + W_ODOUT) + (size_t)li * DM * DM;
                pg8::Gemm g{MIXb, Wt, CH, DM, DM, 256}; pg8::StaticOrder S; S.init(CH, DM, C.G, C.bid);
                EpiResid<0> E{hch, hb_n, sq_n, nullptr, nullptr};
                pg8::gemm_phase<EpiResid<0>, pg8::StaticOrder, true, true>(C.lds, g, S, E);
                s ^= 1;
            }
            xcd_barrier(bar); TICK(5);
            PHASE_BEGIN();
            {
                pg8::Gemm g{hb_c - DM, (const bf16_t*)(ws + W_UP) + (size_t)l * 2 * DFF * DM, 65 * 256, 2 * DFF, DM, 254}; pg8::StaticOrder S; S.init(65 * 256, 2 * DFF, C.G, C.bid);
                EpiConv E{(bf16_t*)(ws + ARENA + A_ACT), sq_c, args.in[I_CW] + (size_t)l * 3 * 2 * DFF, args.in[I_CB] + (size_t)l * 2 * DFF, T, (LAS float*)(C.lds + 131072)};
                pg8::gemm_phase<EpiConv, pg8::StaticOrder, true, true>(C.lds, g, S, E);
            }
            {
                const int rem = (65 * 22) % C.G, c0 = rem, gs = rem ? C.G - rem : C.G;
                if (C.bid >= c0) {
                    PHASE_BEGIN();
                    pg8::Gemm g2{(const bf16_t*)(ws + B_PB), (const bf16_t*)(ws + W_PROJ) + (size_t)l * DM * PLE, CH, DM, PLE, 256}; pg8::StaticOrder S2; S2.init(CH, DM, gs, C.bid - c0);
                    EpiF32 E2{(bf16_t*)(ws + ARENA + A_PP), DM};
                    pg8::gemm_phase<EpiF32, pg8::StaticOrder, true, true>(C.lds, g2, S2, E2);
                }
            }
            xcd_barrier(bar); TICK(6);
            PHASE_BEGIN();
            {
                pg8::Gemm g{(const bf16_t*)(ws + ARENA + A_ACT), (const bf16_t*)(ws + W_DOWN) + (size_t)l * DM * DFF, CH, DM, DFF, 256}; pg8::StaticOrder S; S.init(CH, DM, C.G, C.bid);
                EpiResid<0> E{hch, hb_n, sq_n, nullptr, nullptr};
                pg8::gemm_phase<EpiResid<0>, pg8::StaticOrder, true, true>(C.lds, g, S, E);
                s ^= 1;
            }
            xcd_barrier(bar); TICK(8);
            PHASE_BEGIN();
            {
                pg8::Gemm g{hb_c, (const bf16_t*)(ws + W_GATE) + (size_t)l * DM * DM, CH, DM, DM, 256}; pg8::StaticOrder S; S.init(CH, DM, C.G, C.bid);
                EpiResid<1> E{hch, hb_n, sq_n, sq_c, (const bf16_t*)(ws + ARENA + A_PP)};
                pg8::gemm_phase<EpiResid<1>, pg8::StaticOrder, true, true>(C.lds, g, S, E);
                s ^= 1;
            }
            xcd_barrier(bar); TICK(9);
        }
        PHASE_BEGIN();
        final_norm(C, chunk);
        TICK(10);
    }
#ifdef PROBE_A
    xcd_barrier(bar); TICK(10);
    for (int i = 0; i < 100; ++i) xcd_barrier(bar);
    TICK(11);
    if (blockIdx.x == 0) {
        const float x1 = 8.f + (float)tacc[PROBE_A] * 1e-5f, t2 = 0.1f * (float)tacc[PROBE_B] * 1e-5f;
        float* o0 = args.out; float* o1 = args.out + (size_t)16384 * 1024;
        if (threadIdx.x == 0) { o0[0] += x1; o1[0] += x1; o1[1] += x1; }
        for (int i = threadIdx.x; i < 8192; i += NT) o0[1024 + i] += t2;
        for (int i = threadIdx.x; i < 16384; i += NT) o1[1024 + i] += t2;
    }
#endif
}
extern "C" void kernel_launch(void* const* d_in, const int* in_sizes, int n_in, void* d_out, int out_size, void* d_ws, size_t ws_size, hipStream_t stream) {
    static int grid = 0;
    if (grid == 0) {
        int dev = 0, cus = 0, per = 0;
        (void)hipGetDevice(&dev); (void)hipDeviceGetAttribute(&cus, hipDeviceAttributeMultiprocessorCount, dev);
        (void)hipFuncSetAttribute((const void*)fwd_mega, hipFuncAttributeMaxDynamicSharedMemorySize, LDS_BYTES);
        (void)hipOccupancyMaxActiveBlocksPerMultiprocessor(&per, (const void*)fwd_mega, NT, LDS_BYTES);
        if (per < 1) per = 1;
        grid = cus * per;
        fprintf(stderr, "kernel_launch: grid %d (cus %d x %d), ws %zu need %zu\n", grid, cus, per, ws_size, (size_t)WS_NEED);
        if (n_in != 23 || ws_size < WS_NEED) { fprintf(stderr, "kernel_launch: bad inputs / workspace too small\n"); grid = -1; }
    }
    if (grid < 0) return;
    Args a{};
    for (int i = 0; i < 23; ++i) a.in[i] = (const float*)d_in[i];
    a.out = (float*)d_out; a.ws = (unsigned char*)d_ws; a.ph_lo = 0; a.ph_hi = 0;
    void* kargs[] = {&a};
    hipError_t e = hipLaunchCooperativeKernel((const void*)fwd_mega, dim3(grid), dim3(NT), kargs, LDS_BYTES, stream);
    if (e != hipSuccess) fprintf(stderr, "kernel_launch: cooperative launch failed: %s\n", hipGetErrorString(e));
}
```

```cpp
#include <hip/hip_runtime.h>
#include <hip/hip_cooperative_groups.h>
#include <cstdio>
#include <cstdint>
namespace cg = cooperative_groups;
namespace pg8 {
#define PG8_LAS __attribute__((address_space(3)))
typedef unsigned short bf16_t;
typedef short bf16x8 __attribute__((ext_vector_type(8)));
typedef float f32x4 __attribute__((ext_vector_type(4)));
typedef unsigned u32x4 __attribute__((ext_vector_type(4)));
constexpr int BM = 256, BK = 64, HALF = 128, HTB = HALF * BK * 2  , STAGE_BYTES = 8 * HTB, NXCD = 8, WGM = 8;

__host__ __device__ __forceinline__ int lds_byte(int r, int c) { const int st = (r >> 4) * 2 + (c >> 5), rr = r & 15, cc = c & 31, ob = rr * 64 + cc * 2; return st * 1024 + (ob ^ (((ob >> 9) & 1) << 5)); }
__host__ __device__ __forceinline__ void stage_rc(int b, int& R, int& C) { const int st = b / 1024, sb = b % 1024, swz = sb ^ (((sb >> 9) & 1) << 5); R = (st >> 1) * 16 + swz / 64; C = (st & 1) * 32 + (swz % 64) / 2; }
__host__ __device__ __forceinline__ int perm32(int rho) { const int n = rho >> 4, i = rho & 15; return 8 * (i >> 2) + 4 * n + (i & 3); }

struct Unit { int pm, pn; };
struct Gemm { const bf16_t* A; const bf16_t* Bt; int M, N, K; int arows; };

struct StaticOrder {
    int nM, nN, nwg, G, c;
    __host__ __device__ void init(int M, int N, int G_, int c_) { nM = M / BM; nN = N / BM; nwg = nM * nN; G = G_; c = c_; }
    __host__ __device__ bool next(int i, Unit& u) const {
        const long L = (long)i * G + c; if (L >= nwg) return false;
        int wgid = (int)L; { const int q = nwg / NXCD, r = nwg % NXCD, xcd = wgid % NXCD, off = wgid / NXCD; wgid = (xcd < r ? xcd * (q + 1) : r * (q + 1) + (xcd - r) * q) + off; }
        const int nig = WGM * nN, gid = wgid / nig, fm = gid * WGM, gsz = (nM - fm) < WGM ? (nM - fm) : WGM;
        u.pm = fm + ((wgid % nig) % gsz); u.pn = (wgid % nig) / gsz; return true;
    }
    __device__ __forceinline__ void a_ready(const Unit&) const {}
    __device__ __forceinline__ void done(const Unit&) const {}
};

__device__ __forceinline__ unsigned cvt_pk_bf16(float lo, float hi) { unsigned r; asm volatile("v_cvt_pk_bf16_f32 %0, %1, %2" : "=v"(r) : "v"(lo), "v"(hi)); return r; }
typedef float f32x2 __attribute__((ext_vector_type(2)));
__device__ __forceinline__ f32x2 gelu_pk(f32x2 v) {
    const f32x2 av = __builtin_elementwise_abs(v), d = av * 0.2316418882f + 1.0f;
    f32x2 t; t.x = __builtin_amdgcn_rcpf(d.x); t.y = __builtin_amdgcn_rcpf(d.y);
    f32x2 q = t * 0.5307027145f + (-0.7265760135f); q = q * t + 0.7107068705f; q = q * t + (-0.142248368f); q = q * t + 0.127414796f; q = q * t;
    const f32x2 s = (v * v) * (-0.72134752044f);
    f32x2 e; e.x = __builtin_amdgcn_exp2f(s.x); e.y = __builtin_amdgcn_exp2f(s.y);
    const f32x2 m = v * (q * e), r = v - m;
    f32x2 o; o.x = v.x < 0.f ? m.x : r.x; o.y = v.y < 0.f ? m.y : r.y; return o;
}

template <int ACT  > struct EpiBf16 {
    static constexpr bool PERM = true, AFTER_DRAIN = false; static_assert(ACT == 0 || ACT == 1, "EpiBf16: ACT is 0 (none) or 1 (gelu_pk)");
    bf16_t* O; int ldc; const float* bias; int split_cols; size_t split_stride; float scale0;
    __device__ __forceinline__ void operator()(const f32x4 (&acc)[2][2][4][2], const Unit& u, int wr, int wc, int fr, int fq) const {
        const int row0 = u.pm * BM + wr * 64 + fr; int colt = u.pn * BM; bf16_t* base = O;
        float sc = 1.f; if (split_cols) { const int t = colt / split_cols; base += (size_t)t * split_stride; colt -= t * split_cols; if (t == 0) sc = scale0; }
        const int col0 = colt + wc * 32 + 8 * fq, bcol0 = u.pn * BM + wc * 32 + 8 * fq;
        f32x4 bv[2][2];
#pragma unroll
        for (int bj = 0; bj < 2; ++bj)
#pragma unroll
            for (int n = 0; n < 2; ++n) bv[bj][n] = bias ? *(const f32x4*)(bias + bcol0 + bj * HALF + 4 * n) : (f32x4){0.f, 0.f, 0.f, 0.f};
#pragma unroll
        for (int ai = 0; ai < 2; ++ai)
#pragma unroll
            for (int m = 0; m < 4; ++m) { bf16_t* rowp = base + (size_t)(row0 + ai * HALF + m * 16) * ldc + col0;
#pragma unroll
                for (int bj = 0; bj < 2; ++bj) { f32x4 v0 = acc[ai][bj][m][0] + bv[bj][0], v1 = acc[ai][bj][m][1] + bv[bj][1];
                    if (ACT == 1) { f32x2 a = gelu_pk((f32x2){v0[0], v0[1]}), b = gelu_pk((f32x2){v0[2], v0[3]}), c = gelu_pk((f32x2){v1[0], v1[1]}), d = gelu_pk((f32x2){v1[2], v1[3]});
                        v0 = (f32x4){a.x, a.y, b.x, b.y}; v1 = (f32x4){c.x, c.y, d.x, d.y}; }
                    v0 = v0 * sc; v1 = v1 * sc; u32x4 w; w.x = cvt_pk_bf16(v0[0], v0[1]); w.y = cvt_pk_bf16(v0[2], v0[3]); w.z = cvt_pk_bf16(v1[0], v1[1]); w.w = cvt_pk_bf16(v1[2], v1[3]);
                    *(u32x4*)(rowp + bj * HALF) = w; } }
    }
};
template <class Epi, class Sched, bool ALIGN_EPI = false, bool SP2 = false>
__device__ __forceinline__ void gemm_phase(PG8_LAS unsigned char* lds, const Gemm g, const Sched& S, const Epi& E) {
    int tid_ = threadIdx.x; asm volatile("" : "+v"(tid_)); const int tid = tid_, wid = __builtin_amdgcn_readfirstlane(tid >> 6), lane = tid & 63, wr = wid >> 2, wc = wid & 3, fr = lane & 15, fq = lane >> 4;
    int K_ = g.K; asm volatile("" : "+s"(K_)); const int K = K_, nt = K / BK;
    unsigned voffA[2], voffB[2];
#pragma unroll
    for (int i = 0; i < 2; ++i) { int R, C; stage_rc(tid * 16 + i * 8192, R, C); const int Rb = Epi::PERM ? ((R & ~31) + perm32(R & 31)) : R;
        voffA[i] = (unsigned)(R * K + C) * 2u; voffB[i] = (unsigned)(Rb * K + C) * 2u; }
    const size_t kstep = (size_t)(BK * 2);
    const size_t hstep = (size_t)HALF * K * 2;
    const size_t tstep = 2 * hstep; const size_t tstepA = (size_t)g.arows * K * 2;
    const unsigned ldsw = (unsigned)wid * 1024u;
    const int aoff = lds_byte(wr * 64 + fr, fq * 8), boff = lds_byte(wc * 32 + fr, fq * 8);
#define PG8_SA(b, h) (((b) * 2 + (h)) * HTB)
#define PG8_SB(b, h) ((4 + (b) * 2 + (h)) * HTB)
#define PG8_STAGE(bufoff, gbase, voff) do { _Pragma("unroll") for (int _i = 0; _i < 2; ++_i) \
        __builtin_amdgcn_global_load_lds((const unsigned*)((const char*)(gbase) + (voff)[_i]), (PG8_LAS unsigned*)(lds + (bufoff) + ldsw + _i * 8192), 16, 0, 0); } while (0)
#define PG8_LDA(dst, b, h) do { _Pragma("unroll") for (int m = 0; m < 4; ++m) _Pragma("unroll") for (int k = 0; k < 2; ++k) dst[m][k] = *(const PG8_LAS bf16x8*)(lds + PG8_SA(b, h) + aoff + m * 2048 + k * 1024); } while (0)
#define PG8_LDB(dst, b, h) do { _Pragma("unroll") for (int n = 0; n < 2; ++n) _Pragma("unroll") for (int k = 0; k < 2; ++k) dst[n][k] = *(const PG8_LAS bf16x8*)(lds + PG8_SB(b, h) + boff + n * 2048 + k * 1024); } while (0)
#define PG8_MMA(ai, bj, At, Bt) do { __builtin_amdgcn_s_setprio(1); _Pragma("unroll") for (int m = 0; m < 4; ++m) _Pragma("unroll") for (int n = 0; n < 2; ++n) _Pragma("unroll") for (int k = 0; k < 2; ++k) \
        acc[ai][bj][m][n] = __builtin_amdgcn_mfma_f32_16x16x32_bf16(Bt[n][k], At[m][k], acc[ai][bj][m][n], 0, 0, 0); __builtin_amdgcn_s_setprio(0); } while (0)
#define PG8_WAIT_V(n) asm volatile("s_waitcnt vmcnt(" #n ")" ::: "memory")
#define PG8_WAIT_L(n) asm volatile("s_waitcnt lgkmcnt(" #n ")" ::: "memory")
#define PG8_BAR __builtin_amdgcn_s_barrier()
#define PG8_SCHED __builtin_amdgcn_sched_barrier(0)
    Unit cur, nxt; int ui = 0;
    if (!S.next(0, cur)) return;
    f32x4 acc[2][2][4][2];
#pragma unroll
    for (int a = 0; a < 2; ++a)
#pragma unroll
        for (int b = 0; b < 2; ++b)
#pragma unroll
            for (int m = 0; m < 4; ++m)
#pragma unroll
                for (int n = 0; n < 2; ++n) acc[a][b][m][n] = (f32x4){0.f, 0.f, 0.f, 0.f};
    bf16x8 At[4][2], B0[2][2], B1[2][2];
    const char* cA = (const char*)g.A + (size_t)cur.pm * tstepA; const char* cB = (const char*)g.Bt + (size_t)cur.pn * tstep;
    S.a_ready(cur);
    if constexpr (SP2) {
        PG8_STAGE(PG8_SB(0, 0), cB, voffB); PG8_STAGE(PG8_SB(0, 1), cB + hstep, voffB); PG8_STAGE(PG8_SA(0, 0), cA, voffA); PG8_STAGE(PG8_SA(0, 1), cA + hstep, voffA);
        if (wr == 1) PG8_BAR;
        PG8_WAIT_V(2); PG8_BAR;
        PG8_STAGE(PG8_SB(1, 0), cB + kstep, voffB); PG8_STAGE(PG8_SA(1, 0), cA + kstep, voffA); PG8_STAGE(PG8_SB(1, 1), cB + hstep + kstep, voffB);
        PG8_WAIT_V(6); PG8_BAR;
    } else {
        PG8_STAGE(PG8_SB(0, 0), cB, voffB); PG8_STAGE(PG8_SA(0, 0), cA, voffA); PG8_STAGE(PG8_SB(0, 1), cB + hstep, voffB); PG8_STAGE(PG8_SA(0, 1), cA + hstep, voffA);
        if (wr == 1) PG8_BAR;
        PG8_WAIT_V(4); PG8_BAR;
        PG8_STAGE(PG8_SB(1, 0), cB + kstep, voffB); PG8_STAGE(PG8_SA(1, 0), cA + kstep, voffA); PG8_STAGE(PG8_SB(1, 1), cB + hstep + kstep, voffB);
        PG8_WAIT_V(6); PG8_BAR;
    }
    for (;;) {
        const bool has_next = S.next(ui + 1, nxt);
        const char* nA = has_next ? (const char*)g.A + (size_t)nxt.pm * tstepA : cA; const char* nB = has_next ? (const char*)g.Bt + (size_t)nxt.pn * tstep : cB;
        for (int t = 0; t < nt; t += 2) {
            const bool last = (t == nt - 2);
            const char* a1 = cA + (size_t)(t + 1) * kstep;
            const char* a2 = last ? nA : cA + (size_t)(t + 2) * kstep; const char* b2 = last ? nB : cB + (size_t)(t + 2) * kstep;
            const char* a3 = a2 + kstep; const char* b3 = b2 + kstep;
            if (last && has_next) S.a_ready(nxt);
            if constexpr (SP2) {
            PG8_LDB(B0, 0, 0); PG8_LDB(B1, 0, 1); PG8_SCHED; PG8_LDA(At, 0, 0); PG8_STAGE(PG8_SA(1, 1), a1 + hstep, voffA);
            PG8_WAIT_V(8); PG8_WAIT_L(0); PG8_BAR; PG8_MMA(0, 0, At, B0); PG8_MMA(0, 1, At, B1); PG8_BAR; PG8_SCHED;
            PG8_LDA(At, 0, 1); PG8_STAGE(PG8_SB(0, 0), b2, voffB); PG8_STAGE(PG8_SB(0, 1), b2 + hstep, voffB); PG8_STAGE(PG8_SA(0, 0), a2, voffA);
            PG8_WAIT_V(8); PG8_WAIT_L(0); PG8_BAR; PG8_MMA(1, 0, At, B0); PG8_MMA(1, 1, At, B1); PG8_BAR; PG8_SCHED;
            PG8_LDB(B0, 1, 0); PG8_LDB(B1, 1, 1); PG8_SCHED; PG8_LDA(At, 1, 0); PG8_STAGE(PG8_SA(0, 1), a2 + hstep, voffA);
            PG8_WAIT_V(8); PG8_WAIT_L(0); PG8_BAR; PG8_MMA(0, 0, At, B0); PG8_MMA(0, 1, At, B1); PG8_BAR; PG8_SCHED;
            PG8_LDA(At, 1, 1); PG8_STAGE(PG8_SB(1, 0), b3, voffB); PG8_STAGE(PG8_SB(1, 1), b3 + hstep, voffB); PG8_STAGE(PG8_SA(1, 0), a3, voffA);
            PG8_WAIT_V(8); PG8_WAIT_L(0); PG8_BAR; PG8_MMA(1, 0, At, B0); PG8_MMA(1, 1, At, B1); PG8_BAR; PG8_SCHED;
            } else {
            PG8_LDB(B0, 0, 0); PG8_SCHED; PG8_LDA(At, 0, 0); PG8_STAGE(PG8_SA(1, 1), a1 + hstep, voffA);
            PG8_WAIT_L(8); PG8_BAR; PG8_WAIT_L(0); PG8_MMA(0, 0, At, B0); PG8_BAR; PG8_SCHED;
            PG8_LDB(B1, 0, 1); PG8_STAGE(PG8_SB(0, 0), b2, voffB);
            PG8_BAR; PG8_WAIT_L(0); PG8_MMA(0, 1, At, B1); PG8_BAR;
            PG8_LDA(At, 0, 1); PG8_STAGE(PG8_SA(0, 0), a2, voffA);
            PG8_BAR; PG8_WAIT_L(0); PG8_MMA(1, 0, At, B0); PG8_BAR; PG8_SCHED;
            PG8_STAGE(PG8_SB(0, 1), b2 + hstep, voffB);
            PG8_WAIT_V(6); PG8_BAR; PG8_MMA(1, 1, At, B1); PG8_BAR;
            PG8_LDB(B0, 1, 0); PG8_SCHED; PG8_LDA(At, 1, 0); PG8_STAGE(PG8_SA(0, 1), a2 + hstep, voffA);
            PG8_WAIT_L(8); PG8_BAR; PG8_WAIT_L(0); PG8_MMA(0, 0, At, B0); PG8_BAR; PG8_SCHED;
            PG8_LDB(B1, 1, 1); PG8_STAGE(PG8_SB(1, 0), b3, voffB);
            PG8_BAR; PG8_WAIT_L(0); PG8_MMA(0, 1, At, B1); PG8_BAR;
            PG8_LDA(At, 1, 1); PG8_STAGE(PG8_SA(1, 0), a3, voffA);
            PG8_BAR; PG8_WAIT_L(0); PG8_MMA(1, 0, At, B0); PG8_BAR; PG8_SCHED;
            PG8_STAGE(PG8_SB(1, 1), b3 + hstep, voffB);
            PG8_WAIT_V(6); PG8_BAR; PG8_MMA(1, 1, At, B1); PG8_BAR;
            }
        }
        if constexpr (ALIGN_EPI) { if (wr == 0) PG8_BAR; }
        if constexpr (!Epi::AFTER_DRAIN) { E(acc, cur, wr, wc, fr, fq); S.done(cur); }
        if (!has_next) break;
#pragma unroll
        for (int a = 0; a < 2; ++a)
#pragma unroll
            for (int b = 0; b < 2; ++b)
#pragma unroll
                for (int m = 0; m < 4; ++m)
#pragma unroll
                    for (int n = 0; n < 2; ++n) acc[a][b][m][n] = (f32x4){0.f, 0.f, 0.f, 0.f};
        cur = nxt; cA = nA; cB = nB; ++ui;
        if constexpr (ALIGN_EPI) { if (wr == 1) PG8_BAR; }
    }
    PG8_WAIT_V(0);
    if constexpr (!ALIGN_EPI) { if (wr == 0) PG8_BAR; }
    PG8_BAR;
    if constexpr (Epi::AFTER_DRAIN) { E.fused(acc, cur, wr, wc, fr, fq, lds, wid, lane); S.done(cur); }
#undef PG8_SA
#undef PG8_SB
#undef PG8_STAGE
#undef PG8_LDA
#undef PG8_LDB
#undef PG8_MMA
#undef PG8_WAIT_V
#undef PG8_WAIT_L
#undef PG8_BAR
#undef PG8_SCHED
}
}
typedef unsigned short bf16_t;
typedef short bf16x8 __attribute__((ext_vector_type(8)));
typedef float f32x4 __attribute__((ext_vector_type(4)));
typedef float f32x2 __attribute__((ext_vector_type(2)));
typedef float f32x16 __attribute__((ext_vector_type(16)));
typedef unsigned u32x4 __attribute__((ext_vector_type(4)));
typedef unsigned u32x2 __attribute__((ext_vector_type(2)));
#define LAS __attribute__((address_space(3)))
constexpr int DM = 1024, CH = 16384, NCHUNK = 3, DEPTH = 4, PLE = 256, DFF = 2816;
constexpr int EV_IN = 7168, OD_IN = 3104, OD_INP = 3328;
constexpr float EPS = 1e-6f;
constexpr int NT = 512, NWV = 8;
constexpr int LDS_BYTES = 147456;
constexpr size_t al256(size_t x) { return (x + 255) & ~(size_t)255; }
constexpr size_t W_EVIN = 65536;
constexpr size_t W_EVOUT = W_EVIN + (size_t)2 * EV_IN * DM * 2;
constexpr size_t W_ODIN = W_EVOUT + (size_t)2 * DM * DM * 2;
constexpr size_t W_ODOUT = W_ODIN + (size_t)2 * OD_INP * DM * 2;
constexpr size_t W_UP = W_ODOUT + (size_t)2 * DM * DM * 2;
constexpr size_t W_DOWN = W_UP + (size_t)4 * 2 * DFF * DM * 2;
constexpr size_t W_GATE = W_DOWN + (size_t)4 * DM * DFF * 2;
constexpr size_t W_PROJ = W_GATE + (size_t)4 * DM * DM * 2;
constexpr size_t W_LB = W_PROJ + (size_t)4 * DM * PLE * 2;
constexpr size_t B_PB = W_LB + 8192;
constexpr size_t B_HB0 = B_PB + (size_t)CH * PLE * 2;
constexpr size_t B_HB1 = B_HB0 + (size_t)CH * DM * 2;
constexpr size_t B_SSQ0 = B_HB1 + (size_t)CH * DM * 2;
constexpr size_t B_SSQ1 = B_SSQ0 + (size_t)CH * 16 * 4;
constexpr size_t ARENA = B_SSQ1 + (size_t)CH * 16 * 4;
constexpr size_t A_U = 0;
constexpr size_t A_QT = (size_t)CH * EV_IN * 2;
constexpr size_t A_KT = A_QT + (size_t)2 * CH * 512 * 2;
constexpr size_t A_MIX = A_QT;
constexpr size_t A_OEV = A_KT + (size_t)2 * CH * 512 * 2;
constexpr size_t A_VFOD = (size_t)CH * OD_INP * 2;
constexpr size_t A_OOD = A_OEV;
constexpr size_t A_OG = A_OEV + (size_t)2 * CH * 512 * 4;
constexpr size_t A_LSE = A_OG + (size_t)3 * CH * 512 * 2;
constexpr size_t A_DEC = A_OOD + (size_t)2 * CH * 1024 * 4;
constexpr size_t ARENA_BYTES = A_DEC + (size_t)512 * 4 * 2 * 128 * 4;
constexpr size_t A_UF = 0;
constexpr size_t A_ACT = (size_t)CH * 2 * DFF * 2;
constexpr size_t A_PP = 0;
constexpr size_t WS_NEED = ARENA + ARENA_BYTES;
static_assert(A_LSE + (size_t)3 * CH * 4 * 4 <= A_DEC, "even bufs before DEC");
static_assert(A_VFOD + (size_t)CH * 1024 * 2 * 2 <= A_QT, "odd Vf fits before QT");
static_assert(A_ACT + (size_t)CH * DFF * 2 <= ARENA_BYTES, "act fits");

__device__ __forceinline__ float bf2f(unsigned short v) { return __uint_as_float(((unsigned)v) << 16); }
__device__ __forceinline__ unsigned pk2(float lo, float hi) { return pg8::cvt_pk_bf16(lo, hi); }
typedef float f32x2_cv __attribute__((ext_vector_type(2))); typedef __bf16 bf16x2_cv __attribute__((ext_vector_type(2)));
__device__ __forceinline__ unsigned pk2s(float lo, float hi) { const f32x2_cv v = {lo, hi}; const bf16x2_cv c = __builtin_convertvector(v, bf16x2_cv); return __builtin_bit_cast(unsigned, c); }
__device__ __forceinline__ float shfl_xor_l(float v, int lane, int m) { return __builtin_bit_cast(float, __builtin_amdgcn_ds_bpermute((lane ^ m) << 2, __builtin_bit_cast(int, v))); }
__device__ __forceinline__ float wave_sum(float v, int lane) {
#pragma unroll
    for (int o = 1; o < 64; o <<= 1) v += shfl_xor_l(v, lane, o);
    return v;
}
__device__ __forceinline__ float rstd_of(const float* ssq, int row) {
    const f32x4* p = (const f32x4*)(ssq + (size_t)row * 16);
    const f32x4 a = p[0], b = p[1], c = p[2], d = p[3];
    const float s = ((a.x + a.y) + (a.z + a.w)) + ((b.x + b.y) + (b.z + b.w)) + ((c.x + c.y) + (c.z + c.w)) + ((d.x + d.y) + (d.z + d.w));
    return rsqrtf(s * (1.0f / DM) + EPS);
}
struct EpiScale {
    static constexpr bool PERM = true, AFTER_DRAIN = false;
    bf16_t* O; int ldc; const float* ssq;
    __device__ __forceinline__ void operator()(const f32x4 (&acc)[2][2][4][2], const pg8::Unit& u, int wr, int wc, int fr, int fq) const {
        const int row0 = u.pm * 256 + wr * 64 + fr, col0 = u.pn * 256 + wc * 32 + 8 * fq;
#pragma unroll
        for (int ai = 0; ai < 2; ++ai)
#pragma unroll
            for (int m = 0; m < 4; ++m) {
                const int row = row0 + ai * 128 + m * 16; const float rs = rstd_of(ssq, row);
                bf16_t* rp = O + (size_t)row * ldc + col0;
#pragma unroll
                for (int bj = 0; bj < 2; ++bj) { const f32x4 v0 = acc[ai][bj][m][0] * rs, v1 = acc[ai][bj][m][1] * rs;
                    u32x4 w; w.x = pk2(v0[0], v0[1]); w.y = pk2(v0[2], v0[3]); w.z = pk2(v1[0], v1[1]); w.w = pk2(v1[2], v1[3]);
                    *(u32x4*)(rp + bj * 128) = w; }
            }
    }
};
struct EpiF32 {
    static constexpr bool PERM = true, AFTER_DRAIN = false;
    bf16_t* O; int ldc;
    __device__ __forceinline__ void operator()(const f32x4 (&acc)[2][2][4][2], const pg8::Unit& u, int wr, int wc, int fr, int fq) const {
        const int row0 = u.pm * 256 + wr * 64 + fr, col0 = u.pn * 256 + wc * 32 + 8 * fq;
#pragma unroll
        for (int ai = 0; ai < 2; ++ai)
#pragma unroll
            for (int m = 0; m < 4; ++m) { bf16_t* rp = O + (size_t)(row0 + ai * 128 + m * 16) * ldc + col0;
#pragma unroll
                for (int bj = 0; bj < 2; ++bj) { const f32x4 v0 = acc[ai][bj][m][0], v1 = acc[ai][bj][m][1];
                    u32x4 w; w.x = pk2s(v0[0], v0[1]); w.y = pk2s(v0[2], v0[3]); w.z = pk2s(v1[0], v1[1]); w.w = pk2s(v1[2], v1[3]);
                    *(u32x4*)(rp + bj * 128) = w; } }
    }
};
template <int MODE  > struct EpiResid {
    static constexpr bool PERM = true, AFTER_DRAIN = false;
    float* h; bf16_t* hb; float* ssq_out; const float* ssq_in; const bf16_t* pp;
    __device__ __forceinline__ void operator()(const f32x4 (&acc)[2][2][4][2], const pg8::Unit& u, int wr, int wc, int fr, int fq) const {
        const int row0 = u.pm * 256 + wr * 64 + fr, col0 = u.pn * 256 + wc * 32 + 8 * fq;
#pragma unroll
        for (int ai = 0; ai < 2; ++ai)
#pragma unroll
            for (int m = 0; m < 4; ++m) {
                const int row = row0 + ai * 128 + m * 16; float rs = 1.f; if (MODE == 1) rs = rstd_of(ssq_in, row);
                float* hp = h + (size_t)row * DM + col0; bf16_t* bp = hb + (size_t)row * DM + col0; float s = 0.f;
#pragma unroll
                for (int bj = 0; bj < 2; ++bj) {
                    f32x4 a0 = acc[ai][bj][m][0], a1 = acc[ai][bj][m][1];
                    if (MODE == 1) { const u32x4 pw = *(const u32x4*)(pp + (size_t)row * DM + col0 + bj * 128);
                        const f32x4 p0 = {__uint_as_float(pw.x << 16), __uint_as_float(pw.x & 0xffff0000u), __uint_as_float(pw.y << 16), __uint_as_float(pw.y & 0xffff0000u)};
                        const f32x4 p1 = {__uint_as_float(pw.z << 16), __uint_as_float(pw.z & 0xffff0000u), __uint_as_float(pw.w << 16), __uint_as_float(pw.w & 0xffff0000u)};
#pragma unroll
                        for (int e = 0; e < 4; ++e) { a0[e] = p0[e] / (1.f + __expf(-a0[e] * rs)); a1[e] = p1[e] / (1.f + __expf(-a1[e] * rs)); } }
                    const f32x4 h0 = *(const f32x4*)(hp + bj * 128) + a0, h1 = *(const f32x4*)(hp + bj * 128 + 4) + a1;
                    *(f32x4*)(hp + bj * 128) = h0; *(f32x4*)(hp + bj * 128 + 4) = h1;
                    u32x4 w; w.x = pk2(h0[0], h0[1]); w.y = pk2(h0[2], h0[3]); w.z = pk2(h1[0], h1[1]); w.w = pk2(h1[2], h1[3]);
                    *(u32x4*)(bp + bj * 128) = w;
                    s += (h0[0] * h0[0] + h0[1] * h0[1]) + (h0[2] * h0[2] + h0[3] * h0[3]) + (h1[0] * h1[0] + h1[1] * h1[1]) + (h1[2] * h1[2] + h1[3] * h1[3]);
                }
                { const int ln_ = fq * 16 + fr; s += shfl_xor_l(s, ln_, 16); s += shfl_xor_l(s, ln_, 32); }
                if (fq == 0) ssq_out[(size_t)row * 16 + u.pn * 4 + wc] = s;
            }
    }
};

struct EpiConv {
    static constexpr bool PERM = true, AFTER_DRAIN = false;
    bf16_t* act; const float* ssq; const float* cw; const float* cb; int T; LAS float* halo;
    __device__ __forceinline__ void operator()(f32x4 (&acc)[2][2][4][2], const pg8::Unit& u, int wr, int wc, int fr, int fq) const {
        const int g0 = 254 * u.pm - 1, lane = fq * 16 + fr;
#pragma unroll
        for (int ai = 0; ai < 2; ++ai)
#pragma unroll
            for (int m = 0; m < 4; ++m) { const float rs = rstd_of(ssq, g0 + ai * 128 + wr * 64 + m * 16 + fr);
#pragma unroll
                for (int bj = 0; bj < 2; ++bj) { acc[ai][bj][m][0] = acc[ai][bj][m][0] * rs; acc[ai][bj][m][1] = acc[ai][bj][m][1] * rs; } }
#pragma unroll
        for (int ai = 0; ai < 2; ++ai) { const int s = 2 * ai + wr;
            if (fr == 0) {
#pragma unroll
                for (int bj = 0; bj < 2; ++bj)
#pragma unroll
                    for (int n = 0; n < 2; ++n) *(LAS f32x4*)(halo + ((((wc * 4 + s) * 2 + 0) * 2 + bj) * 32) + 8 * fq + 4 * n) = acc[ai][bj][0][n]; }
            if (fr == 15) {
#pragma unroll
                for (int bj = 0; bj < 2; ++bj)
#pragma unroll
                    for (int n = 0; n < 2; ++n) *(LAS f32x4*)(halo + ((((wc * 4 + s) * 2 + 1) * 2 + bj) * 32) + 8 * fq + 4 * n) = acc[ai][bj][3][n]; } }
        asm volatile("s_waitcnt lgkmcnt(0)" ::: "memory"); __builtin_amdgcn_s_barrier(); asm volatile("" ::: "memory");
#pragma unroll
        for (int n = 0; n < 2; ++n) {
            const int ca = u.pn * 128 + wc * 32 + 8 * fq + 4 * n;
            f32x4 w0[2], w1[2], w2[2], bb[2];
#pragma unroll
            for (int bj = 0; bj < 2; ++bj) { const int c = bj * DFF + ca;
                w0[bj] = *(const f32x4*)(cw + c); w1[bj] = *(const f32x4*)(cw + 2 * DFF + c); w2[bj] = *(const f32x4*)(cw + 4 * DFF + c); bb[bj] = *(const f32x4*)(cb + c); }
#pragma unroll
            for (int ai = 0; ai < 2; ++ai) { const int s = 2 * ai + wr;
#pragma unroll
                for (int m = 0; m < 4; ++m) {
                    const int lr = ai * 128 + wr * 64 + m * 16 + fr, g = g0 + lr; const bool tp = (g & (T - 1)) != 0, tn = ((g + 1) & (T - 1)) != 0;
                    f32x4 ph[2] = {{0.f, 0.f, 0.f, 0.f}, {0.f, 0.f, 0.f, 0.f}}, nh[2] = {{0.f, 0.f, 0.f, 0.f}, {0.f, 0.f, 0.f, 0.f}};
                    if (m == 0 && s > 0) {
#pragma unroll
                        for (int bj = 0; bj < 2; ++bj) ph[bj] = *(const LAS f32x4*)(halo + ((((wc * 4 + s - 1) * 2 + 1) * 2 + bj) * 32) + 8 * fq + 4 * n); }
                    if (m == 3 && s < 3) {
#pragma unroll
                        for (int bj = 0; bj < 2; ++bj) nh[bj] = *(const LAS f32x4*)(halo + ((((wc * 4 + s + 1) * 2 + 0) * 2 + bj) * 32) + 8 * fq + 4 * n); }
                    float cv[2][4];
#pragma unroll
                    for (int bj = 0; bj < 2; ++bj)
#pragma unroll
                        for (int e = 0; e < 4; ++e) {
                            const float cur = acc[ai][bj][m][n][e];
                            const float sp_ = (fr == 15) ? (m > 0 ? acc[ai][bj][m > 0 ? m - 1 : 0][n][e] : ph[bj][e]) : cur;
                            const float sn_ = (fr == 0) ? (m < 3 ? acc[ai][bj][m < 3 ? m + 1 : 3][n][e] : nh[bj][e]) : cur;
                            const float pv = __builtin_bit_cast(float, __builtin_amdgcn_update_dpp(0, __builtin_bit_cast(int, sp_), 0x121, 0xf, 0xf, false));
                            const float nv = __builtin_bit_cast(float, __builtin_amdgcn_update_dpp(0, __builtin_bit_cast(int, sn_), 0x12F, 0xf, 0xf, false));
                            float t_ = fmaf(cur, w1[bj][e], bb[bj][e]); t_ = tp ? fmaf(pv, w0[bj][e], t_) : t_; t_ = tn ? fmaf(nv, w2[bj][e], t_) : t_; cv[bj][e] = t_;
                        }
                    const f32x2 g01 = pg8::gelu_pk((f32x2){cv[1][0], cv[1][1]}), g23 = pg8::gelu_pk((f32x2){cv[1][2], cv[1][3]});
                    if (lr >= 1 && lr <= 254 && g < CH) { u32x2 w; w.x = pk2(cv[0][0] * g01.x, cv[0][1] * g01.y); w.y = pk2(cv[0][2] * g23.x, cv[0][3] * g23.y);
                        *(u32x2*)(act + (size_t)g * DFF + ca) = w; }
                    __builtin_amdgcn_sched_barrier(0);
                }
            }
            asm volatile("" ::: "memory");
        }
    }
};
struct Args {
    const float* in[23]; float* out; unsigned char* ws; int ph_lo, ph_hi;
};
enum { I_XP = 0, I_XS, I_PP, I_PS, I_NMIX, I_EVIN, I_LBL, I_HNORM, I_EVOUT, I_ODIN, I_GUP, I_GB, I_GNORM, I_ODOUT, I_NFFN, I_FUP, I_CW, I_CB, I_FDOWN, I_NPLE, I_PGATE, I_PPROJ, I_NOUT };

struct Ctx {
    LAS unsigned char* lds; int tid, lane, wave, G, bid;
    const Args* a; unsigned char* ws;
};

__device__ __forceinline__ void titem_load(const float* W, int K, int N, const float* gk, int item, int lane, float (&v)[32]) {
    const int nblk = N / 32, kb = item / nblk, nb = item % nblk, k0 = 64 * kb, n0 = 32 * nb;
#pragma unroll
    for (int i = 0; i < 32; ++i) { const int kk = 2 * i + (lane >> 5); v[i] = W[(size_t)(k0 + kk) * N + n0 + (lane & 31)]; }
    if (gk) {
#pragma unroll
        for (int i = 0; i < 32; ++i) v[i] *= gk[k0 + 2 * i + (lane >> 5)]; }
}
__device__ __forceinline__ void titem_store(int K, int N, bf16_t* WT, LAS float* scr, int item, int lane, bool remap, const float (&v)[32]) {
    const int nblk = N / 32, kb = item / nblk, nb = item % nblk, k0 = 64 * kb, n0 = 32 * nb;
#pragma unroll
    for (int i = 0; i < 32; ++i) scr[(2 * i + (lane >> 5)) * 33 + (lane & 31)] = v[i];
    asm volatile("s_waitcnt lgkmcnt(0)" ::: "memory");
    const int c = lane & 7;
#pragma unroll
    for (int j = 0; j < 4; ++j) { const int n = (lane >> 3) + 8 * j; const LAS float* s = scr + (8 * c) * 33 + n;
        u32x4 o; o.x = pk2(s[0 * 33], s[1 * 33]); o.y = pk2(s[2 * 33], s[3 * 33]); o.z = pk2(s[4 * 33], s[5 * 33]); o.w = pk2(s[6 * 33], s[7 * 33]);
        int nr = n0 + n; if (remap) nr = (nr < DFF) ? (((nr >> 7) << 8) + (nr & 127)) : ((((nr - DFF) >> 7) << 8) + 128 + ((nr - DFF) & 127));
        *(u32x4*)(WT + (size_t)nr * K + k0 + 8 * c) = o; }
    asm volatile("s_waitcnt lgkmcnt(0)" ::: "memory");
}
__device__ __forceinline__ void weights_prologue(const Ctx& C) {
    LAS float* scr = (LAS float*)(C.lds + C.wave * 8704);
    const int gw = C.bid * NWV + C.wave, NGW = C.G * NWV;
    const Args& a = *C.a;
    for (int mat = 0; mat < 24; ++mat) {
        const float* W; const float* g = nullptr; bf16_t* WT; int K, N;
        if (mat < 2)       { const int e = mat;      W = a.in[I_EVIN] + (size_t)e * DM * EV_IN;  K = DM; N = EV_IN; g = a.in[I_NMIX] + (2 * e) * DM;     WT = (bf16_t*)(C.ws + W_EVIN) + (size_t)e * EV_IN * DM; }
        else if (mat < 4)  { const int e = mat - 2;  W = a.in[I_EVOUT] + (size_t)e * DM * DM;    K = DM; N = DM;                                        WT = (bf16_t*)(C.ws + W_EVOUT) + (size_t)e * DM * DM; }
        else if (mat < 6)  { const int o = mat - 4;  W = a.in[I_ODIN] + (size_t)o * DM * OD_IN;  K = DM; N = OD_IN; g = a.in[I_NMIX] + (2 * o + 1) * DM; WT = (bf16_t*)(C.ws + W_ODIN) + (size_t)o * OD_INP * DM; }
        else if (mat < 8)  { const int o = mat - 6;  W = a.in[I_ODOUT] + (size_t)o * DM * DM;    K = DM; N = DM;                                        WT = (bf16_t*)(C.ws + W_ODOUT) + (size_t)o * DM * DM; }
        else if (mat < 12) { const int l = mat - 8;  W = a.in[I_FUP] + (size_t)l * DM * 2 * DFF; K = DM; N = 2 * DFF; g = a.in[I_NFFN] + l * DM;         WT = (bf16_t*)(C.ws + W_UP) + (size_t)l * 2 * DFF * DM; }
        else if (mat < 16) { const int l = mat - 12; W = a.in[I_FDOWN] + (size_t)l * DFF * DM;   K = DFF; N = DM;                                       WT = (bf16_t*)(C.ws + W_DOWN) + (size_t)l * DM * DFF; }
        else if (mat < 20) { const int l = mat - 16; W = a.in[I_PGATE] + (size_t)l * DM * DM;    K = DM; N = DM; g = a.in[I_NPLE] + l * DM;              WT = (bf16_t*)(C.ws + W_GATE) + (size_t)l * DM * DM; }
        else               { const int l = mat - 20; W = a.in[I_PPROJ] + (size_t)l * PLE * DM;   K = PLE; N = DM;                                       WT = (bf16_t*)(C.ws + W_PROJ) + (size_t)l * DM * PLE; }
        const int nitems = (K / 64) * (N / 32);
        float vc[32], vn[32];
        if (gw < nitems) titem_load(W, K, N, g, gw, C.lane, vc);
        for (int it = gw; it < nitems; it += NGW) {
            const bool more = it + NGW < nitems;
            if (more) titem_load(W, K, N, g, it + NGW, C.lane, vn);
            titem_store(K, N, WT, scr, it, C.lane, mat >= 8 && mat < 12, vc);
            if (more) {
#pragma unroll
                for (int i = 0; i < 32; ++i) vc[i] = vn[i]; }
        }
    }
    { const int gt = C.bid * NT + C.tid, GT = C.G * NT; const int per = (OD_INP - OD_IN) * DM / 8;
      for (int i = gt; i < 2 * per; i += GT) { const int o = i / per, r = i % per; *(u32x4*)((bf16_t*)(C.ws + W_ODIN) + (size_t)o * OD_INP * DM + (size_t)OD_IN * DM + (size_t)r * 8) = (u32x4){0u, 0u, 0u, 0u}; } }
    { const int gt = C.bid * NT + C.tid; if (gt < 1024) { const int dir = gt >> 9, c = gt & 511; const float* L = a.in[I_LBL] + (size_t)dir * 2 * 512;
        float* lb = (float*)(C.ws + W_LB) + dir * 1024; lb[c] = 0.f; lb[512 + c] = 1.f / (1.f + __expf(L[c] - L[512 + c])); } }
}
__device__ __forceinline__ void chunk_prologue(const Ctx& C, int chunk, bf16_t* hb, float* ssq) {
    const int gw = C.bid * NWV + C.wave, NGW = C.G * NWV; const Args& a = *C.a;
    for (int r = gw; r < CH; r += NGW) {
        const size_t R = (size_t)chunk * CH + r;
        const float* xr = (R < 16384) ? a.in[I_XP] + R * DM : a.in[I_XS] + (R - 16384) * DM;
        float* hr = a.out + R * DM; f32x4 v[4]; float s = 0.f;
#pragma unroll
        for (int j = 0; j < 4; ++j) { v[j] = ((const f32x4*)xr)[C.lane + 64 * j]; s += (v[j].x * v[j].x + v[j].y * v[j].y) + (v[j].z * v[j].z + v[j].w * v[j].w); }
        s = wave_sum(s, C.lane);
#pragma unroll
        for (int j = 0; j < 4; ++j) { ((f32x4*)hr)[C.lane + 64 * j] = v[j]; u32x2 w; w.x = pk2(v[j].x, v[j].y); w.y = pk2(v[j].z, v[j].w); ((u32x2*)(hb + (size_t)r * DM))[C.lane + 64 * j] = w; }
        if (C.lane < 16) ssq[(size_t)r * 16 + C.lane] = (C.lane == 0) ? s : 0.f;
    }
}
__device__ __forceinline__ void final_norm(const Ctx& C, int chunk) {
    const int gw = C.bid * NWV + C.wave, NGW = C.G * NWV; const Args& a = *C.a; const float* g = a.in[I_NOUT];
    for (int r = gw; r < CH; r += NGW) {
        float* hr = a.out + ((size_t)chunk * CH + r) * DM; f32x4 v[4]; float s = 0.f;
#pragma unroll
        for (int j = 0; j < 4; ++j) { v[j] = ((const f32x4*)hr)[C.lane + 64 * j]; s += (v[j].x * v[j].x + v[j].y * v[j].y) + (v[j].z * v[j].z + v[j].w * v[j].w); }
        const float rs = rsqrtf(wave_sum(s, C.lane) * (1.f / DM) + EPS);
#pragma unroll
        for (int j = 0; j < 4; ++j) { const f32x4 gg = ((const f32x4*)g)[C.lane + 64 * j]; ((f32x4*)hr)[C.lane + 64 * j] = v[j] * rs * gg; }
    }
}
__device__ __forceinline__ void conv_phase(const Ctx& C, int chunk, int l, int T) {
    const Args& a = *C.a;
    const bf16_t* UF = (const bf16_t*)(C.ws + ARENA + A_UF); bf16_t* ACT = (bf16_t*)(C.ws + ARENA + A_ACT);
    const float* cw = a.in[I_CW] + (size_t)l * 3 * 2 * DFF; const float* cb = a.in[I_CB] + (size_t)l * 2 * DFF;
    {
        const int ry = C.tid >> 5, cx = C.tid & 31;
        for (int tile = C.bid; tile < (CH / 64) * 11; tile += C.G) {
            const int rt = tile / 11, ct = tile % 11; const int r0 = rt * 64 + ry * 4, c0 = ct * 256 + cx * 8;
            float wa0[8], wa1[8], wa2[8], wg0[8], wg1[8], wg2[8], ba[8], bg[8];
#pragma unroll
            for (int e = 0; e < 8; e += 4) { *(f32x4*)(wa0 + e) = *(const f32x4*)(cw + c0 + e); *(f32x4*)(wa1 + e) = *(const f32x4*)(cw + 2 * DFF + c0 + e); *(f32x4*)(wa2 + e) = *(const f32x4*)(cw + 4 * DFF + c0 + e);
                *(f32x4*)(wg0 + e) = *(const f32x4*)(cw + DFF + c0 + e); *(f32x4*)(wg1 + e) = *(const f32x4*)(cw + 3 * DFF + c0 + e); *(f32x4*)(wg2 + e) = *(const f32x4*)(cw + 5 * DFF + c0 + e);
                *(f32x4*)(ba + e) = *(const f32x4*)(cb + c0 + e); *(f32x4*)(bg + e) = *(const f32x4*)(cb + DFF + c0 + e); }
            bf16x8 ua[6], ug[6];
#pragma unroll
            for (int i = 0; i < 6; ++i) { const int r = r0 - 1 + i; const bool ok = (i == 0) ? ((r0 % T) != 0) : (i == 5 ? (((r0 + 4) % T) != 0) : true);
                if (ok) { ua[i] = *(const bf16x8*)(UF + (size_t)r * 2 * DFF + c0); ug[i] = *(const bf16x8*)(UF + (size_t)r * 2 * DFF + DFF + c0); }
                else { ua[i] = (bf16x8){0, 0, 0, 0, 0, 0, 0, 0}; ug[i] = ua[i]; } }
#pragma unroll
            for (int i = 0; i < 4; ++i) {
                float o[8];
#pragma unroll
                for (int e = 0; e < 8; ++e) {
                    const float av = bf2f((unsigned short)ua[i][e]) * wa0[e] + bf2f((unsigned short)ua[i + 1][e]) * wa1[e] + bf2f((unsigned short)ua[i + 2][e]) * wa2[e] + ba[e];
                    const float gv = bf2f((unsigned short)ug[i][e]) * wg0[e] + bf2f((unsigned short)ug[i + 1][e]) * wg1[e] + bf2f((unsigned short)ug[i + 2][e]) * wg2[e] + bg[e];
                    o[e] = av * (0.5f * gv * (1.f + erff(gv * 0.70710678118f)));
                }
                u32x4 w; w.x = pk2(o[0], o[1]); w.y = pk2(o[2], o[3]); w.z = pk2(o[4], o[5]); w.w = pk2(o[6], o[7]);
                *(u32x4*)(ACT + (size_t)(r0 + i) * DFF + c0) = w;
            }
        }
    }
}
__device__ __forceinline__ void pb_convert(const Ctx& C, int chunk, int l) {
    const Args& a = *C.a;
    { bf16_t* PB = (bf16_t*)(C.ws + B_PB); const int gt = C.bid * NT + C.tid, GT = C.G * NT;
      for (int i = gt; i < CH * PLE / 4; i += GT) { const int r = i / (PLE / 4), c4 = i % (PLE / 4); const size_t R = (size_t)chunk * CH + r;
          const float* src = (R < 16384) ? a.in[I_PP] + ((size_t)l * 16384 + R) * PLE : a.in[I_PS] + ((size_t)l * 32768 + (R - 16384)) * PLE;
          const f32x4 v = ((const f32x4*)src)[c4]; u32x2 w; w.x = pk2(v.x, v.y); w.y = pk2(v.z, v.w); ((u32x2*)(PB + (size_t)r * PLE))[c4] = w; } }
}
struct Mix { int even, li, T, DV, ld, vcol, gcol; float qscale; unsigned char* vf; };
#define MFMA32(a, b, c) __builtin_amdgcn_mfma_f32_32x32x16_bf16((a), (b), (c), 0, 0, 0)
#define QK_IDX(hd, dir, blk, k) (((((size_t)((hd) * 2 + (dir))) * 512 + (size_t)(blk)) * 8 + (k)) * 64)
#define V_IDX(hd, dir, ET, et, blk, sp) ((((((size_t)((hd) * 2 + (dir))) * (ET) + (et)) * 512 + (size_t)(blk)) * 2 + (sp)) * 64)
#define O_IDX(hd, dir, ET, et, blk, q) ((((((size_t)((hd) * 2 + (dir))) * (ET) + (et)) * 512 + (size_t)(blk)) * 4 + (q)) * 64)
#define OB_IDX(hd, dir, ET, et, blk, r) ((((((size_t)((hd) * 2 + (dir))) * (ET) + (et)) * 512 + (size_t)(blk)) * 2 + (r)) * 64)
#define DEC_IDX(hd, dir, blk) ((((size_t)((hd) * 2 + (dir))) * 512 + (size_t)(blk)) * 128)
#define LDSFENCE() asm volatile("s_waitcnt lgkmcnt(0)" ::: "memory")
__device__ __forceinline__ bf16x8 pack8(float a0, float a1, float a2, float a3, float a4, float a5, float a6, float a7) {
    u32x4 w; w.x = pk2(a0, a1); w.y = pk2(a2, a3); w.z = pk2(a4, a5); w.w = pk2(a6, a7); return __builtin_bit_cast(bf16x8, w);
}
__device__ __forceinline__ bf16x8 pack8s(float a0, float a1, float a2, float a3, float a4, float a5, float a6, float a7) {
    u32x4 w; w.x = pk2s(a0, a1); w.y = pk2s(a2, a3); w.z = pk2s(a4, a5); w.w = pk2s(a6, a7); return __builtin_bit_cast(bf16x8, w);
}
__device__ __forceinline__ f32x16 zero16() { f32x16 z;
#pragma unroll
    for (int i = 0; i < 16; ++i) z[i] = 0.f; return z; }

__device__ __forceinline__ void prep_phase(const Ctx& C, const Mix& mx) {
    const Args& a = *C.a;
    const bf16_t* U = (const bf16_t*)(C.ws + ARENA + A_U);
    u32x4* QTf = (u32x4*)(C.ws + ARENA + A_QT); u32x4* KTf = (u32x4*)(C.ws + ARENA + A_KT); u32x4* Vf = (u32x4*)mx.vf;
    f32x4* Of = (f32x4*)(C.ws + ARENA + A_OEV); float* DEC = (float*)(C.ws + ARENA + A_DEC);
    const float* LB = (const float*)(C.ws + W_LB);
    const int hd = C.wave & 3, dir = C.wave >> 2, lane = C.lane, ld = mx.ld, DV = mx.DV;
    LAS float* Bs = (LAS float*)(C.lds + C.wave * 16896);
    for (int b = C.bid; b < CH / 32; b += C.G) {
        int vz_ = 0; asm volatile("" : "+v"(vz_)); const int rb = 32 * b + vz_;
        {
            const int d0 = 2 * lane, col0 = hd * 128 + d0, dt0 = d0 >> 5, dp0 = d0 & 31;
            float bs0 = 0.f, bs1 = 0.f; unsigned zz[32];
            if (mx.even) {
                const f32x2 lb2 = *(const f32x2*)(LB + dir * 1024 + mx.li * 512 + col0); const float om0 = 1.f - lb2.x, om1 = 1.f - lb2.y;
                const bf16_t* zp = U + 512 + 512 * dir + col0;
#pragma unroll
                for (int t = 0; t < 32; ++t) { const int row = rb + (dir ? 31 - t : t);
                    const unsigned zw = *(const unsigned*)(zp + (size_t)row * ld); zz[t] = zw;
                    const float z0 = __uint_as_float(zw << 16), z1 = __uint_as_float(zw & 0xffff0000u);
                    bs0 += fmaxf(__logf(lb2.x + om0 / (1.f + __expf(-z0))), -30.f); bs1 += fmaxf(__logf(lb2.y + om1 / (1.f + __expf(-z1))), -30.f);
                    *(LAS f32x2*)(Bs + t * 132 + d0) = (f32x2){bs0, bs1}; }
                *(f32x2*)(DEC + DEC_IDX(hd, dir, b) + d0) = (f32x2){__expf(bs0), __expf(bs1)};
#pragma unroll
                for (int grp = 0; grp < 4; ++grp) { float k0[8], k1[8];
#pragma unroll
                    for (int j = 0; j < 8; ++j) { const int t = 16 * (grp >> 1) + 8 * (j >> 2) + 4 * (grp & 1) + (j & 3);
                        const float z0 = __uint_as_float(zz[t] << 16), z1 = __uint_as_float(zz[t] & 0xffff0000u); const f32x2 bt = *(const LAS f32x2*)(Bs + t * 132 + d0);
                        k0[j] = om0 / (1.f + __expf(z0)) * __expf(bs0 - bt.x); k1[j] = om1 / (1.f + __expf(z1)) * __expf(bs1 - bt.y); }
                    u32x4 w; w.x = pk2(k0[0], k0[1]); w.y = pk2(k0[2], k0[3]); w.z = pk2(k0[4], k0[5]); w.w = pk2(k0[6], k0[7]);
                    KTf[QK_IDX(hd, dir, b, (grp >> 1) * 4 + dt0) + 32 * (grp & 1) + dp0] = w;
                    w.x = pk2(k1[0], k1[1]); w.y = pk2(k1[2], k1[3]); w.z = pk2(k1[4], k1[5]); w.w = pk2(k1[6], k1[7]);
                    KTf[QK_IDX(hd, dir, b, (grp >> 1) * 4 + dt0) + 32 * (grp & 1) + dp0 + 1] = w; }
            } else {
                float Wg0[16], Wg1[16]; const float* wp = a.in[I_GUP] + ((size_t)(mx.li * 2 + dir) * 16) * 512 + col0;
#pragma unroll
                for (int r = 0; r < 16; ++r) { const f32x2 w2 = *(const f32x2*)(wp + r * 512); Wg0[r] = w2.x; Wg1[r] = w2.y; }
                const f32x2 bias = *(const f32x2*)(a.in[I_GB] + (mx.li * 2 + dir) * 512 + col0);
#pragma unroll
                for (int t = 0; t < 32; ++t) { const int row = rb + (dir ? 31 - t : t);
                    const u32x4 l0 = *(const u32x4*)(U + (size_t)row * ld + 3072 + 16 * dir), l1 = *(const u32x4*)(U + (size_t)row * ld + 3072 + 16 * dir + 8);
                    zz[t] = *(const unsigned*)(U + (size_t)row * ld + 512 + col0);
                    float x0 = bias.x, x1 = bias.y;
#pragma unroll
                    for (int w = 0; w < 4; ++w) { const float a0 = __uint_as_float(l0[w] << 16), a1 = __uint_as_float(l0[w] & 0xffff0000u), c0 = __uint_as_float(l1[w] << 16), c1 = __uint_as_float(l1[w] & 0xffff0000u);
                        x0 += a0 * Wg0[2 * w] + a1 * Wg0[2 * w + 1] + c0 * Wg0[8 + 2 * w] + c1 * Wg0[8 + 2 * w + 1];
                        x1 += a0 * Wg1[2 * w] + a1 * Wg1[2 * w + 1] + c0 * Wg1[8 + 2 * w] + c1 * Wg1[8 + 2 * w + 1]; }
                    bs0 += fmaxf((fminf(x0, 0.f) - log1pf(__expf(-fabsf(x0)))) * (1.f / 16.f), -30.f); bs1 += fmaxf((fminf(x1, 0.f) - log1pf(__expf(-fabsf(x1)))) * (1.f / 16.f), -30.f);
                    *(LAS f32x2*)(Bs + t * 132 + d0) = (f32x2){bs0, bs1}; }
                *(f32x2*)(DEC + DEC_IDX(hd, dir, b) + d0) = (f32x2){__expf(bs0), __expf(bs1)};
#pragma unroll
                for (int grp = 0; grp < 4; ++grp) { float k0[8], k1[8];
#pragma unroll
                    for (int j = 0; j < 8; ++j) { const int t = 16 * (grp >> 1) + 8 * (j >> 2) + 4 * (grp & 1) + (j & 3); const f32x2 bt = *(const LAS f32x2*)(Bs + t * 132 + d0);
                        k0[j] = __uint_as_float(zz[t] << 16) * __expf(bs0 - bt.x); k1[j] = __uint_as_float(zz[t] & 0xffff0000u) * __expf(bs1 - bt.y); }
                    u32x4 w; w.x = pk2(k0[0], k0[1]); w.y = pk2(k0[2], k0[3]); w.z = pk2(k0[4], k0[5]); w.w = pk2(k0[6], k0[7]);
                    KTf[QK_IDX(hd, dir, b, (grp >> 1) * 4 + dt0) + 32 * (grp & 1) + dp0] = w;
                    w.x = pk2(k1[0], k1[1]); w.y = pk2(k1[2], k1[3]); w.z = pk2(k1[4], k1[5]); w.w = pk2(k1[6], k1[7]);
                    KTf[QK_IDX(hd, dir, b, (grp >> 1) * 4 + dt0) + 32 * (grp & 1) + dp0 + 1] = w; }
            }
        }
        LDSFENCE();
        const int tau = lane & 31, h = lane >> 5, row = rb + (dir ? 31 - tau : tau);
        u32x4 vt[8];
#pragma unroll
        for (int it = 0; it < 8; ++it) { const int idx = lane + 64 * it, t = idx / (DV / 8), c8 = idx % (DV / 8); const int rj = rb + (dir ? 31 - t : t);
            vt[it] = *(const u32x4*)(U + (size_t)rj * ld + mx.vcol + hd * DV + c8 * 8); }
        bf16x8 Ak[8], Bq[8];
#pragma unroll
        for (int ks = 0; ks < 8; ++ks) {
            float qh[8], kh[8], qt[8];
#pragma unroll
            for (int q2 = 0; q2 < 2; ++q2) {
                const int d0 = 16 * ks + 8 * q2 + 4 * h;
                const f32x4 b4 = *(const LAS f32x4*)(Bs + tau * 132 + d0), r4 = *(const LAS f32x4*)(Bs + 15 * 132 + d0);
                const u32x2 qr = *(const u32x2*)(U + (size_t)row * ld + hd * 128 + d0);
                float q4[4] = {__uint_as_float(qr.x << 16), __uint_as_float(qr.x & 0xffff0000u), __uint_as_float(qr.y << 16), __uint_as_float(qr.y & 0xffff0000u)};
                float k4[4];
                if (mx.even) { const u32x2 zr = *(const u32x2*)(U + (size_t)row * ld + 512 + 512 * dir + hd * 128 + d0);
                    const f32x4 lb4 = *(const f32x4*)(LB + dir * 1024 + mx.li * 512 + hd * 128 + d0);
                    const float z4[4] = {__uint_as_float(zr.x << 16), __uint_as_float(zr.x & 0xffff0000u), __uint_as_float(zr.y << 16), __uint_as_float(zr.y & 0xffff0000u)};
#pragma unroll
                    for (int e = 0; e < 4; ++e) k4[e] = (1.f - lb4[e]) / (1.f + __expf(z4[e]));
                } else { const u32x2 kr = *(const u32x2*)(U + (size_t)row * ld + 512 + hd * 128 + d0);
                    k4[0] = __uint_as_float(kr.x << 16); k4[1] = __uint_as_float(kr.x & 0xffff0000u); k4[2] = __uint_as_float(kr.y << 16); k4[3] = __uint_as_float(kr.y & 0xffff0000u); }
#pragma unroll
                for (int e = 0; e < 4; ++e) { const float qq = q4[e] * mx.qscale; qt[4 * q2 + e] = qq * __expf(b4[e]);
                    qh[4 * q2 + e] = qq * __expf(fminf(b4[e] - r4[e], 80.f)); kh[4 * q2 + e] = k4[e] * __expf(fminf(r4[e] - b4[e], 80.f)); }
            }
            { u32x4 w; w.x = pk2(qt[0], qt[1]); w.y = pk2(qt[2], qt[3]); w.z = pk2(qt[4], qt[5]); w.w = pk2(qt[6], qt[7]); QTf[QK_IDX(hd, dir, b, ks) + lane] = w; }
            Bq[ks] = pack8(qh[0], qh[1], qh[2], qh[3], qh[4], qh[5], qh[6], qh[7]);
            Ak[ks] = pack8(kh[0], kh[1], kh[2], kh[3], kh[4], kh[5], kh[6], kh[7]);
        }
        f32x16 at = zero16();
#pragma unroll
        for (int ks = 0; ks < 8; ++ks) at = MFMA32(Ak[ks], Bq[ks], at);
#pragma unroll
        for (int i = 0; i < 16; ++i) { const int s = (i & 3) + 8 * (i >> 2) + 4 * h; if (s > tau) at[i] = 0.f; }
        bf16x8 Pa[2];
        Pa[0] = pack8(at[0], at[1], at[2], at[3], at[4], at[5], at[6], at[7]);
        Pa[1] = pack8(at[8], at[9], at[10], at[11], at[12], at[13], at[14], at[15]);
        const int ET = DV / 32;
        LDSFENCE();
        LAS unsigned char* Vs = (LAS unsigned char*)Bs; const int vpitch = 2 * DV + 16;
#pragma unroll
        for (int it = 0; it < 8; ++it) { const int idx = lane + 64 * it, t = idx / (DV / 8), c8 = idx % (DV / 8); *(LAS u32x4*)(Vs + t * vpitch + c8 * 16) = vt[it]; }
        for (int idx = lane + 512; idx < 32 * (DV / 8); idx += 64) { const int t = idx / (DV / 8), c8 = idx % (DV / 8); const int rj = rb + (dir ? 31 - t : t);
            *(LAS u32x4*)(Vs + t * vpitch + c8 * 16) = *(const u32x4*)(U + (size_t)rj * ld + mx.vcol + hd * DV + c8 * 8); }
        LDSFENCE();
        for (int et = 0; et < ET; ++et) {
            f32x16 acc = zero16();
#pragma unroll
            for (int sp = 0; sp < 2; ++sp) {
                unsigned short v[8];
#pragma unroll
                for (int j = 0; j < 8; ++j) { const int sj = 16 * sp + 8 * (j >> 2) + 4 * h + (j & 3); v[j] = *(const LAS unsigned short*)(Vs + sj * vpitch + (32 * et + (lane & 31)) * 2); }
                u32x4 w; w.x = v[0] | ((unsigned)v[1] << 16); w.y = v[2] | ((unsigned)v[3] << 16); w.z = v[4] | ((unsigned)v[5] << 16); w.w = v[6] | ((unsigned)v[7] << 16);
                Vf[V_IDX(hd, dir, ET, et, b, sp) + lane] = w;
                acc = MFMA32(Pa[sp], __builtin_bit_cast(bf16x8, w), acc);
            }
#pragma unroll
            for (int r = 0; r < 2; ++r) { u32x4 w; w.x = pk2s(acc[8 * r], acc[8 * r + 1]); w.y = pk2s(acc[8 * r + 2], acc[8 * r + 3]); w.z = pk2s(acc[8 * r + 4], acc[8 * r + 5]); w.w = pk2s(acc[8 * r + 6], acc[8 * r + 7]);
                ((u32x4*)Of)[OB_IDX(hd, dir, ET, et, b, r) + lane] = w; }
        }
        LDSFENCE();
    }
}
__device__ __forceinline__ void scan_phase(const Ctx& C, const Mix& mx) {
    const u32x4* QTf = (const u32x4*)(C.ws + ARENA + A_QT); const u32x4* KTf = (const u32x4*)(C.ws + ARENA + A_KT); const u32x4* Vf = (const u32x4*)mx.vf;
    u32x4* Of = (u32x4*)(C.ws + ARENA + A_OEV); const float* DEC = (const float*)(C.ws + ARENA + A_DEC);
    const int lane = C.lane, h = lane >> 5, DV = mx.DV, ET = DV / 32, T = mx.T, nb = T / 32;
    const int units = (CH / T) * 8 * ET;
    constexpr int SLOT = 23552, R = 5, NL = 4;
    LAS u32x4* SB = (LAS u32x4*)(C.lds + R * SLOT);
    for (int base = 0; base < units; base += C.G) {
        const bool loader = C.wave >= 2 && C.wave < 2 + NL;
        const int lr = C.wave - 2;
        const int u = base + C.bid;
        const bool valid = u < units;
        const int et = u % ET, x = u / ET, dir = x & 1, hd = (x >> 1) & 3, seq = x >> 3;
        LAS unsigned char* ring = C.lds;
#define SCAN_BAR() do { asm volatile("s_waitcnt lgkmcnt(0)" ::: "memory"); __builtin_amdgcn_s_barrier(); asm volatile("" ::: "memory"); } while (0)
#define GLDS16(gp, lp) __builtin_amdgcn_global_load_lds((const unsigned*)(gp), (LAS unsigned*)(lp), 16, 0, 0)
#define SCAN_ISSUE(j) do { const int blk_ = seq * nb + (dir ? nb - 1 - (j) : (j)); LAS unsigned char* sl_ = ring + ((j) % R) * SLOT; \
            _Pragma("unroll") for (int k = 0; k < 8; ++k) { GLDS16(QTf + QK_IDX(hd, dir, blk_, k) + lane, sl_ + k * 1024); GLDS16(KTf + QK_IDX(hd, dir, blk_, k) + lane, sl_ + (8 + k) * 1024); } \
            _Pragma("unroll") for (int sp = 0; sp < 2; ++sp) GLDS16(Vf + V_IDX(hd, dir, ET, et, blk_, sp) + lane, sl_ + (16 + sp) * 1024); \
            _Pragma("unroll") for (int r = 0; r < 2; ++r) GLDS16(Of + OB_IDX(hd, dir, ET, et, blk_, r) + lane, sl_ + (18 + r) * 1024); \
            if (lane < 32) GLDS16(DEC + DEC_IDX(hd, dir, blk_) + 4 * lane, sl_ + 22 * 1024); } while (0)
        if (C.wave == 0) {
            SCAN_BAR();
            for (int i = 0; i < nb; ++i) {
                if (valid) {
                    const LAS u32x4* sv = (const LAS u32x4*)(ring + (i % R) * SLOT) + lane; const LAS u32x4* sb = SB + (i & 1) * 512 + lane;
                    u32x4 qf[8], on[2], bs[8];
#pragma unroll
                    for (int r = 0; r < 2; ++r) on[r] = sv[(18 + r) * 64];
#pragma unroll
                    for (int k = 0; k < 8; ++k) { qf[k] = sv[k * 64]; bs[k] = sb[k * 64]; }
                    asm volatile("s_waitcnt lgkmcnt(0)" ::: "memory");
                    f32x16 acc;
#pragma unroll
                    for (int r = 0; r < 2; ++r) {
                        acc[8 * r + 0] = __uint_as_float(on[r].x << 16); acc[8 * r + 1] = __uint_as_float(on[r].x & 0xffff0000u); acc[8 * r + 2] = __uint_as_float(on[r].y << 16); acc[8 * r + 3] = __uint_as_float(on[r].y & 0xffff0000u);
                        acc[8 * r + 4] = __uint_as_float(on[r].z << 16); acc[8 * r + 5] = __uint_as_float(on[r].z & 0xffff0000u); acc[8 * r + 6] = __uint_as_float(on[r].w << 16); acc[8 * r + 7] = __uint_as_float(on[r].w & 0xffff0000u); }
#pragma unroll
                    for (int k = 0; k < 8; ++k) acc = MFMA32(__builtin_bit_cast(bf16x8, qf[k]), __builtin_bit_cast(bf16x8, bs[k]), acc);
                    const int blk = seq * nb + (dir ? nb - 1 - i : i);
#pragma unroll
                    for (int r = 0; r < 2; ++r) { u32x4 w; w.x = pk2s(acc[8 * r], acc[8 * r + 1]); w.y = pk2s(acc[8 * r + 2], acc[8 * r + 3]); w.z = pk2s(acc[8 * r + 4], acc[8 * r + 5]); w.w = pk2s(acc[8 * r + 6], acc[8 * r + 7]);
                        Of[OB_IDX(hd, dir, ET, et, blk, r) + lane] = w; }
                }
                SCAN_BAR();
            }
        } else if (C.wave == 1) {
            f32x16 S[4];
#pragma unroll
            for (int dt = 0; dt < 4; ++dt) S[dt] = zero16();
#pragma unroll
            for (int k = 0; k < 8; ++k) SB[k * 64 + lane] = (u32x4){0u, 0u, 0u, 0u};
            SCAN_BAR();
            for (int i = 0; i < nb; ++i) {
                if (valid) {
                    const LAS unsigned char* sl = ring + (i % R) * SLOT; const LAS u32x4* sv = (const LAS u32x4*)sl + lane;
                    u32x4 kf[8], vf[2]; f32x4 dq[16];
#pragma unroll
                    for (int k = 0; k < 8; ++k) kf[k] = sv[(8 + k) * 64];
#pragma unroll
                    for (int sp = 0; sp < 2; ++sp) vf[sp] = sv[(16 + sp) * 64];
                    const LAS float* dp = (const LAS float*)(sl + 22 * 1024) + 4 * h;
#pragma unroll
                    for (int k = 0; k < 16; ++k) dq[k] = *(const LAS f32x4*)(dp + 8 * k);
                    asm volatile("s_waitcnt lgkmcnt(0)" ::: "memory");
#pragma unroll
                    for (int dt = 0; dt < 4; ++dt)
#pragma unroll
                        for (int q = 0; q < 4; ++q) {
#pragma unroll
                            for (int e = 0; e < 4; ++e) S[dt][4 * q + e] *= dq[4 * dt + q][e]; }
#pragma unroll
                    for (int sp = 0; sp < 2; ++sp) {
#pragma unroll
                        for (int dt = 0; dt < 4; ++dt) S[dt] = MFMA32(__builtin_bit_cast(bf16x8, kf[sp * 4 + dt]), __builtin_bit_cast(bf16x8, vf[sp]), S[dt]); }
                    LAS u32x4* sbw = SB + ((i + 1) & 1) * 512 + lane;
#pragma unroll
                    for (int dt = 0; dt < 4; ++dt)
#pragma unroll
                        for (int sp = 0; sp < 2; ++sp)
                            sbw[(2 * dt + sp) * 64] = __builtin_bit_cast(u32x4, pack8s(S[dt][8 * sp + 0], S[dt][8 * sp + 1], S[dt][8 * sp + 2], S[dt][8 * sp + 3], S[dt][8 * sp + 4], S[dt][8 * sp + 5], S[dt][8 * sp + 6], S[dt][8 * sp + 7]));
                }
                SCAN_BAR();
            }
        } else {
            if (loader && valid && lr < nb) SCAN_ISSUE(lr);
            for (int i = -1; i < nb; ++i) {
                if (loader && valid) {
                    if (i >= 0 && lr == i % NL && i + NL < nb) SCAN_ISSUE(i + NL);
                    if (lr == (i + 1) % NL && i + 1 < nb) asm volatile("s_waitcnt vmcnt(0)" ::: "memory");
                }
                SCAN_BAR();
            }
        }
#undef SCAN_ISSUE
#undef GLDS16
#undef SCAN_BAR
    }
}
__device__ __forceinline__ void attn_phase(const Ctx& C, int T) {
    const bf16_t* U = (const bf16_t*)(C.ws + ARENA + A_U);
    bf16_t* OG = (bf16_t*)(C.ws + ARENA + A_OG); float* LSE = (float*)(C.ws + ARENA + A_LSE);
    const int lane = C.lane, h = lane >> 5, l31 = lane & 31, ld = EV_IN, tps = T / 32;
    for (int task = C.bid * NWV + C.wave; task < 3 * 4 * (CH / 32); task += C.G * NWV) {
        const int g = task / 2048, x = task % 2048, hd = x / 512, y = x % 512, seq = y / tps, z = y % tps;
        const int dil = 1 << (2 * g), L = T / dil, nqb = L / 32, r = z / nqb, qb = z % nqb, m0 = 32 * qb;
        const int qcol = 2560 + g * 1536 + hd * 128, kcol = qcol + 512, vcol = qcol + 1024;
        const float coef = exp2f(-8.0f * (float)(g * 4 + hd + 1) / 12.0f) * (float)dil, scale = 0.08838834764831845f;
        const size_t rbase = (size_t)seq * T + r;
        bf16x8 Bq[8];
        { const bf16_t* qp = U + (rbase + (size_t)(m0 + l31) * dil) * ld + qcol + 8 * h;
#pragma unroll
          for (int ks = 0; ks < 8; ++ks) Bq[ks] = *(const bf16x8*)(qp + 16 * ks); }
        f32x16 st[5];
        bf16x8 Kc[8], Kn[8];
        {   const int mkc0 = (m0 - 64) < 0 ? 0 : (m0 - 64);
            const bf16_t* kp = U + (rbase + (size_t)(mkc0 + l31) * dil) * ld + kcol + 8 * h;
#pragma unroll
            for (int ks = 0; ks < 8; ++ks) Kc[ks] = *(const bf16x8*)(kp + 16 * ks); }
#pragma unroll
        for (int kb = 0; kb < 5; ++kb) {
            const int mk0 = m0 - 64 + 32 * kb; const bool vb = (mk0 >= 0 && mk0 < L);
            if (kb < 4) { const int mk1 = mk0 + 32; const int mkc1 = mk1 < 0 ? 0 : (mk1 >= L ? L - 32 : mk1);
                const bf16_t* kp = U + (rbase + (size_t)(mkc1 + l31) * dil) * ld + kcol + 8 * h;
#pragma unroll
                for (int ks = 0; ks < 8; ++ks) Kn[ks] = *(const bf16x8*)(kp + 16 * ks); }
            f32x16 s = zero16();
#pragma unroll
            for (int ks = 0; ks < 8; ++ks) s = MFMA32(Kc[ks], Bq[ks], s);
#pragma unroll
            for (int i = 0; i < 16; ++i) { const int rel = (mk0 + (i & 3) + 8 * (i >> 2) + 4 * h) - (m0 + l31); const int ar = rel < 0 ? -rel : rel;
                s[i] = (vb && ar <= 64) ? s[i] * scale - coef * (float)ar : -1e30f; }
            st[kb] = s;
#pragma unroll
            for (int ks = 0; ks < 8; ++ks) Kc[ks] = Kn[ks];
        }
        float mxv = -1e30f;
#pragma unroll
        for (int kb = 0; kb < 5; ++kb)
#pragma unroll
            for (int i = 0; i < 16; ++i) mxv = fmaxf(mxv, st[kb][i]);
        mxv = fmaxf(mxv, shfl_xor_l(mxv, lane, 32));
        float den = 0.f;
#pragma unroll
        for (int kb = 0; kb < 5; ++kb)
#pragma unroll
            for (int i = 0; i < 16; ++i) { const float p = __expf(st[kb][i] - mxv); st[kb][i] = p; den += p; }
        den += shfl_xor_l(den, lane, 32);
        f32x16 ot[4];
#pragma unroll
        for (int dt = 0; dt < 4; ++dt) ot[dt] = zero16();
        LAS unsigned char* Vs = C.lds + C.wave * 16896;
#pragma unroll
        for (int kb = 0; kb < 5; ++kb) {
            const int mk0 = m0 - 64 + 32 * kb; const int mkc = mk0 < 0 ? 0 : (mk0 >= L ? L - 32 : mk0);
            u32x4 vr[8];
#pragma unroll
            for (int it = 0; it < 8; ++it) { const int idx = lane + 64 * it, t = idx >> 4, c8 = idx & 15; vr[it] = *(const u32x4*)(U + (rbase + (size_t)(mkc + t) * dil) * ld + vcol + c8 * 8); }
            LDSFENCE();
#pragma unroll
            for (int it = 0; it < 8; ++it) { const int idx = lane + 64 * it, t = idx >> 4, c8 = idx & 15; *(LAS u32x4*)(Vs + t * 272 + c8 * 16) = vr[it]; }
            LDSFENCE();
#pragma unroll
            for (int sp = 0; sp < 2; ++sp) {
                const bf16x8 Bp = pack8(st[kb][8 * sp + 0], st[kb][8 * sp + 1], st[kb][8 * sp + 2], st[kb][8 * sp + 3], st[kb][8 * sp + 4], st[kb][8 * sp + 5], st[kb][8 * sp + 6], st[kb][8 * sp + 7]);
#pragma unroll
                for (int dt = 0; dt < 4; ++dt) {
                    typedef short v4i16_t __attribute__((ext_vector_type(4)));
                    const LAS unsigned char* tp = Vs + (16 * sp + 4 * h + ((lane & 15) >> 2)) * 272 + (32 * dt + 16 * ((lane >> 4) & 1) + 4 * (lane & 3)) * 2;
                    const v4i16_t lo = __builtin_amdgcn_ds_read_tr16_b64_v4i16((LAS v4i16_t*)tp), hi = __builtin_amdgcn_ds_read_tr16_b64_v4i16((LAS v4i16_t*)(tp + 8 * 272));
                    bf16x8 w; w[0] = lo[0]; w[1] = lo[1]; w[2] = lo[2]; w[3] = lo[3]; w[4] = hi[0]; w[5] = hi[1]; w[6] = hi[2]; w[7] = hi[3];
                    ot[dt] = MFMA32(w, Bp, ot[dt]);
                }
            }
        }
        const float inv = 1.f / den; const size_t qrow = rbase + (size_t)(m0 + l31) * dil;
        bf16_t* op = OG + ((size_t)g * CH + qrow) * 512 + hd * 128 + 4 * h;
#pragma unroll
        for (int dt = 0; dt < 4; ++dt)
#pragma unroll
            for (int q = 0; q < 4; ++q) { u32x2 w; w.x = pk2(ot[dt][4 * q] * inv, ot[dt][4 * q + 1] * inv); w.y = pk2(ot[dt][4 * q + 2] * inv, ot[dt][4 * q + 3] * inv);
                *(u32x2*)(op + 32 * dt + 8 * q) = w; }
        if (h == 0) LSE[((size_t)g * CH + qrow) * 4 + hd] = mxv + __logf(den);
    }
}
__device__ __forceinline__ void finalize_phase(const Ctx& C, const Mix& mx) {
    const Args& a = *C.a;
    const bf16_t* __restrict__ U = (const bf16_t*)(C.ws + ARENA + A_U); bf16_t* __restrict__ MIX = (bf16_t*)(C.ws + ARENA + A_MIX);
    const f32x4* __restrict__ Of = (const f32x4*)(C.ws + ARENA + A_OEV);
    const int gw = C.bid * NWV + C.wave, NGW = C.G * NWV, lane = C.lane, ld = mx.ld, DV = mx.DV, ET = DV / 32, NE = DV / 64;
    const float* gn = mx.even ? a.in[I_HNORM] + mx.li * 512 : a.in[I_GNORM] + mx.li * 1024;
#pragma unroll 2
    for (int rg = gw; rg < CH / 4; rg += NGW) {
        const int r0 = 4 * rg, blk = r0 >> 5, t0 = r0 & 31;
        const int qf = t0 >> 3, hf = (t0 >> 2) & 1, tb = 28 - t0, qb = tb >> 3, hb2 = (tb >> 2) & 1;
#pragma unroll
        for (int hd = 0; hd < 4; ++hd) {
            float o[2][2][4]; float ss[4] = {0.f, 0.f, 0.f, 0.f};
            const u32x2* Ob2 = (const u32x2*)Of;
#pragma unroll
            for (int k = 0; k < 2; ++k) if (2 * k < NE) {
                const int e0 = 2 * lane + 128 * k, et = e0 >> 5;
#pragma unroll
                for (int p = 0; p < 2; ++p) {
                    const u32x2 vf_ = Ob2[(OB_IDX(hd, 0, ET, et, blk, qf >> 1) + 32 * hf + (e0 & 31) + p) * 2 + (qf & 1)], vb_ = Ob2[(OB_IDX(hd, 1, ET, et, blk, qb >> 1) + 32 * hb2 + (e0 & 31) + p) * 2 + (qb & 1)];
                    o[k][p][0] = __uint_as_float(vf_.x << 16) + __uint_as_float(vb_.y & 0xffff0000u); o[k][p][1] = __uint_as_float(vf_.x & 0xffff0000u) + __uint_as_float(vb_.y << 16);
                    o[k][p][2] = __uint_as_float(vf_.y << 16) + __uint_as_float(vb_.x & 0xffff0000u); o[k][p][3] = __uint_as_float(vf_.y & 0xffff0000u) + __uint_as_float(vb_.x << 16);
#pragma unroll
                    for (int j = 0; j < 4; ++j) ss[j] += o[k][p][j] * o[k][p][j];
                }
            }
#pragma unroll
            for (int j = 0; j < 4; ++j) ss[j] = rsqrtf(wave_sum(ss[j], lane) / (float)DV + EPS);
#pragma unroll
            for (int k = 0; k < 2; ++k) if (2 * k < NE) {
                const int c = hd * DV + 2 * lane + 128 * k; const f32x2 g2 = *(const f32x2*)(gn + c);
#pragma unroll
                for (int j = 0; j < 4; ++j) { const unsigned agw = *(const unsigned*)(U + (size_t)(r0 + j) * ld + 2048 + c);
                    const float a0 = __uint_as_float(agw << 16), a1 = __uint_as_float(agw & 0xffff0000u);
                    *(unsigned*)(MIX + (size_t)(r0 + j) * DM + c) = pk2(o[k][0][j] * ss[j] * g2.x * (a0 / (1.f + __expf(-a0))), o[k][1][j] * ss[j] * g2.y * (a1 / (1.f + __expf(-a1)))); }
            }
        }
        if (mx.even) {
            const bf16_t* __restrict__ OG = (const bf16_t*)(C.ws + ARENA + A_OG); const float* __restrict__ LSE = (const float*)(C.ws + ARENA + A_LSE);
            const int c8 = lane * 8, hd = lane >> 4;
#pragma unroll
            for (int j = 0; j < 4; ++j) { const int r = r0 + j;
                const float l0 = LSE[((size_t)0 * CH + r) * 4 + hd], l1 = LSE[((size_t)1 * CH + r) * 4 + hd], l2 = LSE[((size_t)2 * CH + r) * 4 + hd];
                const float m = fmaxf(l0, fmaxf(l1, l2)); float w0 = __expf(l0 - m), w1 = __expf(l1 - m), w2 = __expf(l2 - m); const float iw = 1.f / (w0 + w1 + w2);
                w0 *= iw; w1 *= iw; w2 *= iw;
                const u32x4 v0 = *(const u32x4*)(OG + ((size_t)0 * CH + r) * 512 + c8), v1 = *(const u32x4*)(OG + ((size_t)1 * CH + r) * 512 + c8), v2 = *(const u32x4*)(OG + ((size_t)2 * CH + r) * 512 + c8);
                u32x4 o;
#pragma unroll
                for (int k = 0; k < 4; ++k) {
                    const float bx = w0 * __uint_as_float(v0[k] << 16) + w1 * __uint_as_float(v1[k] << 16) + w2 * __uint_as_float(v2[k] << 16);
                    const float by = w0 * __uint_as_float(v0[k] & 0xffff0000u) + w1 * __uint_as_float(v1[k] & 0xffff0000u) + w2 * __uint_as_float(v2[k] & 0xffff0000u);
                    o[k] = pk2(bx, by); }
                *(u32x4*)(MIX + (size_t)r * DM + 512 + c8) = o;
            }
        }
    }
}
#define XB_TMO      128
#define XB_XCNT(j)  (256  + 64 * (j))
#define XB_XSUB(j)  (1280 + 64 * (j))
#define XB_XGEN(j)  (2304 + 64 * (j))
#define XB_TOP      3328
#define XB_TOPGEN   3392
#define XCD_BAR_WORDS 3456
#define XB_SPIN_CAP (1u << 18)

__device__ __forceinline__ unsigned xb_ld(unsigned* p)              { return __hip_atomic_load(p, __ATOMIC_RELAXED, __HIP_MEMORY_SCOPE_AGENT); }
__device__ __forceinline__ unsigned xb_add(unsigned* p, unsigned v) { return __hip_atomic_fetch_add(p, v, __ATOMIC_RELAXED, __HIP_MEMORY_SCOPE_AGENT); }
__device__ __forceinline__ unsigned xb_xcc_id() { return (unsigned)__builtin_amdgcn_s_getreg((3 << 11) | 20) & 0xFu; }
#define XB_SPIN(cond, bar) do { unsigned _sp = 0; while (cond) { __builtin_amdgcn_s_sleep(1); \
    if ((++_sp & 255u) == 0u) { if (xb_ld(&(bar)[XB_TMO])) break; if (_sp > XB_SPIN_CAP) { atomicAdd(&(bar)[XB_TMO], 1u); break; } } } } while (0)

struct XcdBarrier {
    unsigned* bar; unsigned x;
    volatile LAS unsigned* st;
};

__device__ __forceinline__ XcdBarrier xcd_barrier_post(unsigned* bar, volatile LAS unsigned* st) {
    XcdBarrier b; b.bar = bar; b.x = xb_xcc_id(); b.st = st;
    if (threadIdx.x == 0) (void)xb_add(&bar[XB_XCNT(b.x)], 1u);
    return b;
}
__device__ __forceinline__ void xcd_barrier_complete(unsigned* bar, unsigned x, unsigned& nloc, unsigned& nx) {
    const unsigned G = gridDim.x * gridDim.y * gridDim.z;
    unsigned sum, cnt, mine, sp = 0u;
    for (;;) {
        sum = 0u; cnt = 0u; mine = 0u;
#pragma unroll
        for (unsigned j = 0; j < 16; ++j) { const unsigned c = xb_ld(&bar[XB_XCNT(j)]); sum += c; cnt += (c > 0u) ? 1u : 0u; mine = (j == x) ? c : mine; }
        if (sum == G) break;
        __builtin_amdgcn_s_sleep(1);
        if ((++sp & 255u) == 0u) { if (xb_ld(&bar[XB_TMO])) break; if (sp > XB_SPIN_CAP) { atomicAdd(&bar[XB_TMO], 1u); break; } }
    }
    nloc = mine > 0u ? mine : 1u; nx = cnt > 0u ? cnt : 1u;
}

__device__ __forceinline__ void xcd_barrier(const XcdBarrier& b) {
    asm volatile("s_waitcnt vmcnt(0)" ::: "memory");
    __syncthreads();
    if (threadIdx.x == 0) {
        unsigned* bar = b.bar;
        __builtin_amdgcn_s_waitcnt(0);
        unsigned nloc = b.st[0], nx = b.st[1];
        if (nloc == 0u) { xcd_barrier_complete(bar, b.x, nloc, nx); b.st[0] = nloc; b.st[1] = nx; }
        const unsigned old = xb_add(&bar[XB_XSUB(b.x)], 1u);
        const unsigned gen = old / nloc;
        if (old + 1u == (gen + 1u) * nloc) {
            __builtin_amdgcn_fence(__ATOMIC_RELEASE, "agent");
            asm volatile("s_waitcnt vmcnt(0)" ::: "memory");
            const unsigned og = xb_add(&bar[XB_TOP], 1u);
            const unsigned tg = og / nx;
            if (og + 1u == (tg + 1u) * nx) xb_add(&bar[XB_TOPGEN], 1u);
            else XB_SPIN(xb_ld(&bar[XB_TOPGEN]) == tg, bar);
            __builtin_amdgcn_fence(__ATOMIC_ACQUIRE, "agent");
            xb_add(&bar[XB_XGEN(b.x)], 1u);
            asm volatile("s_waitcnt vmcnt(0)" ::: "memory");
        } else {
            XB_SPIN(xb_ld(&bar[XB_XGEN(b.x)]) == gen, bar);
            __builtin_amdgcn_fence(__ATOMIC_ACQUIRE, "agent");
            asm volatile("s_waitcnt vmcnt(0)" ::: "memory");
        }
    }
    __syncthreads();
}
#define PHASE_BEGIN() do { int t_ = threadIdx.x; asm volatile("" : "+v"(t_)); C.tid = t_; C.lane = t_ & 63; C.wave = __builtin_amdgcn_readfirstlane(t_ >> 6); \
    int b_ = blockIdx.x; asm volatile("" : "+s"(b_)); C.bid = b_; unsigned char* w_ = args.ws; asm volatile("" : "+s"(w_)); C.ws = w_; ws = w_; \
    hb_c = (bf16_t*)(ws + (s ? B_HB1 : B_HB0)); hb_n = (bf16_t*)(ws + (s ? B_HB0 : B_HB1)); sq_c = (float*)(ws + (s ? B_SSQ1 : B_SSQ0)); sq_n = (float*)(ws + (s ? B_SSQ0 : B_SSQ1)); Ub = (bf16_t*)(ws + ARENA + A_U); MIXb = (bf16_t*)(ws + ARENA + A_MIX); \
    hch = args.out + (size_t)chunk * CH * DM; } while (0)
__global__ void __launch_bounds__(NT, 2) fwd_mega(Args args) {
    extern __shared__ __attribute__((aligned(16))) unsigned char lds_raw[];
    cg::grid_group grid = cg::this_grid();
    Ctx C; C.lds = (LAS unsigned char*)lds_raw; C.tid = threadIdx.x; C.lane = C.tid & 63; C.wave = __builtin_amdgcn_readfirstlane(C.tid >> 6);
    C.G = gridDim.x; C.bid = blockIdx.x; C.a = &args; C.ws = args.ws;
    unsigned char* ws = args.ws;
    bf16_t *hb_c, *hb_n; float *sq_c, *sq_n; bf16_t *Ub, *MIXb;
    if (blockIdx.x == 0) for (int i = threadIdx.x; i < XCD_BAR_WORDS; i += NT) ((unsigned*)args.ws)[i] = 0u;
    if (threadIdx.x < 2) ((volatile LAS unsigned*)(C.lds + LDS_BYTES - 256))[threadIdx.x] = 0u;
    weights_prologue(C);
    __syncthreads();
    grid.sync();
    XcdBarrier bar = xcd_barrier_post((unsigned*)args.ws, (volatile LAS unsigned*)(C.lds + LDS_BYTES - 256));
    float* hch;
#ifdef PROBE_A
    unsigned tacc[12];
#pragma unroll
    for (int i = 0; i < 12; ++i) tacc[i] = 0u;
    unsigned long long tprev = __builtin_amdgcn_s_memrealtime();
#define TICK(k) do { const unsigned long long now_ = __builtin_amdgcn_s_memrealtime(); tacc[k] += (unsigned)(now_ - tprev); tprev = now_; } while (0)
#else
#define TICK(k) do {} while (0)
#endif
#pragma nounroll
    for (int chunk = 0; chunk < NCHUNK; ++chunk) {
        const int T = chunk == 0 ? 4096 : 2048; int s = 0;
        PHASE_BEGIN();
        chunk_prologue(C, chunk, hb_c, sq_c);
        xcd_barrier(bar); TICK(10);
#pragma nounroll
        for (int l = 0; l < DEPTH; ++l) {
            const int even = (l & 1) == 0, li = l >> 1;
            Mix mx; mx.even = even; mx.li = li; mx.T = T; mx.DV = even ? 128 : 256; mx.ld = even ? EV_IN : OD_INP; mx.vcol = even ? 1536 : 1024; mx.gcol = 2048; mx.qscale = even ? 1.f : 0.08838834764831845f; mx.vf = nullptr;
            PHASE_BEGIN();
            {
                const int N = even ? EV_IN : OD_INP;
                const bf16_t* Wt = even ? (const bf16_t*)(ws + W_EVIN) + (size_t)li * EV_IN * DM : (const bf16_t*)(ws + W_ODIN) + (size_t)li * OD_INP * DM;
                pg8::Gemm g{hb_c, Wt, CH, N, DM, 256}; pg8::StaticOrder S; S.init(CH, N, C.G, C.bid);
                EpiScale E{Ub, N, sq_c};
                pg8::gemm_phase<EpiScale, pg8::StaticOrder, true, true>(C.lds, g, S, E);
            }
            xcd_barrier(bar); TICK(1);
            PHASE_BEGIN(); mx.vf = even ? (unsigned char*)hb_n : ws + ARENA + A_VFOD;
#ifndef NO_PREP
            prep_phase(C, mx);
#endif
            TICK(2);
            PHASE_BEGIN();
#ifndef NO_ATTN
            if (even) attn_phase(C, T);
#endif
            TICK(7);
            xcd_barrier(bar); TICK(0);
            PHASE_BEGIN(); mx.vf = even ? (unsigned char*)hb_n : ws + ARENA + A_VFOD;
#ifndef NO_SCAN
            scan_phase(C, mx);
#endif
            xcd_barrier(bar); TICK(3);
            PHASE_BEGIN();
#ifndef NO_FIN
            finalize_phase(C, mx);
#endif
            pb_convert(C, chunk, l);
            xcd_barrier(bar); TICK(4);
            PHASE_BEGIN();
            {
                const bf16_t* Wt = even ? (const bf16_t*)(ws + W_EVOUT) + (size_t)li * DM * DM : (const bf16_t*)(ws + W_ODOUT) + (size_t)li * DM * DM;
                pg8::Gemm g{MIXb, Wt, CH, DM, DM, 256}; pg8::StaticOrder S; S.init(CH, DM, C.G, C.bid);
                EpiResid<0> E{hch, hb_n, sq_n, nullptr, nullptr};
                pg8::gemm_phase<EpiResid<0>, pg8::StaticOrder, true, true>(C.lds, g, S, E);
                s ^= 1;
            }
            xcd_barrier(bar); TICK(5);
            PHASE_BEGIN();
            {
                pg8::Gemm g{hb_c - DM, (const bf16_t*)(ws + W_UP) + (size_t)l * 2 * DFF * DM, 65 * 256, 2 * DFF, DM, 254}; pg8::StaticOrder S; S.init(65 * 256, 2 * DFF, C.G, C.bid);
                EpiConv E{(bf16_t*)(ws + ARENA + A_ACT), sq_c, args.in[I_CW] + (size_t)l * 3 * 2 * DFF, args.in[I_CB] + (size_t)l * 2 * DFF, T, (LAS float*)(C.lds + 131072)};
                pg8::gemm_phase<EpiConv, pg8::StaticOrder, true, true>(C.lds, g, S, E);
            }
            {
                const int rem = (65 * 22) % C.G, c0 = rem, gs = rem ? C.G - rem : C.G;
                if (C.bid >= c0) {
                    PHASE_BEGIN();
                    pg8::Gemm g2{(const bf16_t*)(ws + B_PB), (const bf16_t*)(ws + W_PROJ) + (size_t)l * DM * PLE, CH, DM, PLE, 256}; pg8::StaticOrder S2; S2.init(CH, DM, gs, C.bid - c0);
                    EpiF32 E2{(bf16_t*)(ws + ARENA + A_PP), DM};
                    pg8::gemm_phase<EpiF32, pg8::StaticOrder, true, true>(C.lds, g2, S2, E2);
                }
            }
            xcd_barrier(bar); TICK(6);
            PHASE_BEGIN();
            {
                pg8::Gemm g{(const bf16_t*)(ws + ARENA + A_ACT), (const bf16_t*)(ws + W_DOWN) + (size_t)l * DM * DFF, CH, DM, DFF, 256}; pg8::StaticOrder S; S.init(CH, DM, C.G, C.bid);
                EpiResid<0> E{hch, hb_n, sq_n, nullptr, nullptr};
                pg8::gemm_phase<EpiResid<0>, pg8::StaticOrder, true, true>(C.lds, g, S, E);
                s ^= 1;
            }
            xcd_barrier(bar); TICK(8);
            PHASE_BEGIN();
            {
                pg8::Gemm g{hb_c, (const bf16_t*)(ws + W_GATE) + (size_t)l * DM * DM, CH, DM, DM, 256}; pg8::StaticOrder S; S.init(CH, DM, C.G, C.bid);
                EpiResid<1> E{hch, hb_n, sq_n, sq_c, (const bf16_t*)(ws + ARENA + A_PP)};
                pg8::gemm_phase<EpiResid<1>, pg8::StaticOrder, true, true>(C.lds, g, S, E);
                s ^= 1;
            }
            xcd_barrier(bar); TICK(9);
        }
        PHASE_BEGIN();
        final_norm(C, chunk);
        TICK(10);
    }
#ifdef PROBE_A
    xcd_barrier(bar); TICK(10);
    for (int i = 0; i < 100; ++i) xcd_barrier(bar);
    TICK(11);
    if (blockIdx.x == 0) {
        const float x1 = 8.f + (float)tacc[PROBE_A] * 1e-5f, t2 = 0.1f * (float)tacc[PROBE_B] * 1e-5f;
        float* o0 = args.out; float* o1 = args.out + (size_t)16384 * 1024;
        if (threadIdx.x == 0) { o0[0] += x1; o1[0] += x1; o1[1] += x1; }
        for (int i = threadIdx.x; i < 8192; i += NT) o0[1024 + i] += t2;
        for (int i = threadIdx.x; i < 16384; i += NT) o1[1024 + i] += t2;
    }
#endif
}
extern "C" void kernel_launch(void* const* d_in, const int* in_sizes, int n_in, void* d_out, int out_size, void* d_ws, size_t ws_size, hipStream_t stream) {
    static int grid = 0;
    if (grid == 0) {
        int dev = 0, cus = 0, per = 0;
        (void)hipGetDevice(&dev); (void)hipDeviceGetAttribute(&cus, hipDeviceAttributeMultiprocessorCount, dev);
        (void)hipFuncSetAttribute((const void*)fwd_mega, hipFuncAttributeMaxDynamicSharedMemorySize, LDS_BYTES);
        (void)hipOccupancyMaxActiveBlocksPerMultiprocessor(&per, (const void*)fwd_mega, NT, LDS_BYTES);
        if (per < 1) per = 1;
        grid = cus * per;
        fprintf(stderr, "kernel_launch: grid %d (cus %d x %d), ws %zu need %zu\n", grid, cus, per, ws_size, (size_t)WS_NEED);
        if (n_in != 23 || ws_size < WS_NEED) { fprintf(stderr, "kernel_launch: bad inputs / workspace too small\n"); grid = -1; }
    }
    if (grid < 0) return;
    Args a{};
    for (int i = 0; i < 23; ++i) a.in[i] = (const float*)d_in[i];
    a.out = (float*)d_out; a.ws = (unsigned char*)d_ws; a.ph_lo = 0; a.ph_hi = 0;
    void* kargs[] = {&a};
    hipError_t e = hipLaunchCooperativeKernel((const void*)fwd_mega, dim3(grid), dim3(NT), kargs, LDS_BYTES, stream);
    if (e != hipSuccess) fprintf(stderr, "kernel_launch: cooperative launch failed: %s\n", hipGetErrorString(e));
}
```

```cpp
#include <hip/hip_runtime.h>
#include <hip/hip_cooperative_groups.h>
#include <cstdio>
#include <cstdint>
namespace cg = cooperative_groups;
namespace pg8 {
#define PG8_LAS __attribute__((address_space(3)))
typedef unsigned short bf16_t;
typedef short bf16x8 __attribute__((ext_vector_type(8)));
typedef float f32x4 __attribute__((ext_vector_type(4)));
typedef unsigned u32x4 __attribute__((ext_vector_type(4)));
constexpr int BM = 256, BK = 64, HALF = 128, HTB = HALF * BK * 2  , STAGE_BYTES = 8 * HTB, NXCD = 8, WGM = 8;

__host__ __device__ __forceinline__ int lds_byte(int r, int c) { const int st = (r >> 4) * 2 + (c >> 5), rr = r & 15, cc = c & 31, ob = rr * 64 + cc * 2; return st * 1024 + (ob ^ (((ob >> 9) & 1) << 5)); }
__host__ __device__ __forceinline__ void stage_rc(int b, int& R, int& C) { const int st = b / 1024, sb = b % 1024, swz = sb ^ (((sb >> 9) & 1) << 5); R = (st >> 1) * 16 + swz / 64; C = (st & 1) * 32 + (swz % 64) / 2; }
__host__ __device__ __forceinline__ int perm32(int rho) { const int n = rho >> 4, i = rho & 15; return 8 * (i >> 2) + 4 * n + (i & 3); }

struct Unit { int pm, pn; };
struct Gemm { const bf16_t* A; const bf16_t* Bt; int M, N, K; int arows; };

struct StaticOrder {
    int nM, nN, nwg, G, c;
    __host__ __device__ void init(int M, int N, int G_, int c_) { nM = M / BM; nN = N / BM; nwg = nM * nN; G = G_; c = c_; }
    __host__ __device__ bool next(int i, Unit& u) const {
        const long L = (long)i * G + c; if (L >= nwg) return false;
        int wgid = (int)L; { const int q = nwg / NXCD, r = nwg % NXCD, xcd = wgid % NXCD, off = wgid / NXCD; wgid = (xcd < r ? xcd * (q + 1) : r * (q + 1) + (xcd - r) * q) + off; }
        const int nig = WGM * nN, gid = wgid / nig, fm = gid * WGM, gsz = (nM - fm) < WGM ? (nM - fm) : WGM;
        u.pm = fm + ((wgid % nig) % gsz); u.pn = (wgid % nig) / gsz; return true;
    }
    __device__ __forceinline__ void a_ready(const Unit&) const {}
    __device__ __forceinline__ void done(const Unit&) const {}
};

__device__ __forceinline__ unsigned cvt_pk_bf16(float lo, float hi) { unsigned r; asm volatile("v_cvt_pk_bf16_f32 %0, %1, %2" : "=v"(r) : "v"(lo), "v"(hi)); return r; }
typedef float f32x2 __attribute__((ext_vector_type(2)));
__device__ __forceinline__ f32x2 gelu_pk(f32x2 v) {
    const f32x2 av = __builtin_elementwise_abs(v), d = av * 0.2316418882f + 1.0f;
    f32x2 t; t.x = __builtin_amdgcn_rcpf(d.x); t.y = __builtin_amdgcn_rcpf(d.y);
    f32x2 q = t * 0.5307027145f + (-0.7265760135f); q = q * t + 0.7107068705f; q = q * t + (-0.142248368f); q = q * t + 0.127414796f; q = q * t;
    const f32x2 s = (v * v) * (-0.72134752044f);
    f32x2 e; e.x = __builtin_amdgcn_exp2f(s.x); e.y = __builtin_amdgcn_exp2f(s.y);
    const f32x2 m = v * (q * e), r = v - m;
    f32x2 o; o.x = v.x < 0.f ? m.x : r.x; o.y = v.y < 0.f ? m.y : r.y; return o;
}

template <int ACT  > struct EpiBf16 {
    static constexpr bool PERM = true, AFTER_DRAIN = false; static_assert(ACT == 0 || ACT == 1, "EpiBf16: ACT is 0 (none) or 1 (gelu_pk)");
    bf16_t* O; int ldc; const float* bias; int split_cols; size_t split_stride; float scale0;
    __device__ __forceinline__ void operator()(const f32x4 (&acc)[2][2][4][2], const Unit& u, int wr, int wc, int fr, int fq) const {
        const int row0 = u.pm * BM + wr * 64 + fr; int colt = u.pn * BM; bf16_t* base = O;
        float sc = 1.f; if (split_cols) { const int t = colt / split_cols; base += (size_t)t * split_stride; colt -= t * split_cols; if (t == 0) sc = scale0; }
        const int col0 = colt + wc * 32 + 8 * fq, bcol0 = u.pn * BM + wc * 32 + 8 * fq;
        f32x4 bv[2][2];
#pragma unroll
        for (int bj = 0; bj < 2; ++bj)
#pragma unroll
            for (int n = 0; n < 2; ++n) bv[bj][n] = bias ? *(const f32x4*)(bias + bcol0 + bj * HALF + 4 * n) : (f32x4){0.f, 0.f, 0.f, 0.f};
#pragma unroll
        for (int ai = 0; ai < 2; ++ai)
#pragma unroll
            for (int m = 0; m < 4; ++m) { bf16_t* rowp = base + (size_t)(row0 + ai * HALF + m * 16) * ldc + col0;
#pragma unroll
                for (int bj = 0; bj < 2; ++bj) { f32x4 v0 = acc[ai][bj][m][0] + bv[bj][0], v1 = acc[ai][bj][m][1] + bv[bj][1];
                    if (ACT == 1) { f32x2 a = gelu_pk((f32x2){v0[0], v0[1]}), b = gelu_pk((f32x2){v0[2], v0[3]}), c = gelu_pk((f32x2){v1[0], v1[1]}), d = gelu_pk((f32x2){v1[2], v1[3]});
                        v0 = (f32x4){a.x, a.y, b.x, b.y}; v1 = (f32x4){c.x, c.y, d.x, d.y}; }
                    v0 = v0 * sc; v1 = v1 * sc; u32x4 w; w.x = cvt_pk_bf16(v0[0], v0[1]); w.y = cvt_pk_bf16(v0[2], v0[3]); w.z = cvt_pk_bf16(v1[0], v1[1]); w.w = cvt_pk_bf16(v1[2], v1[3]);
                    *(u32x4*)(rowp + bj * HALF) = w; } }
    }
};
template <class Epi, class Sched, bool ALIGN_EPI = false, bool SP2 = false>
__device__ __forceinline__ void gemm_phase(PG8_LAS unsigned char* lds, const Gemm g, const Sched& S, const Epi& E) {
    int tid_ = threadIdx.x; asm volatile("" : "+v"(tid_)); const int tid = tid_, wid = __builtin_amdgcn_readfirstlane(tid >> 6), lane = tid & 63, wr = wid >> 2, wc = wid & 3, fr = lane & 15, fq = lane >> 4;
    int K_ = g.K; asm volatile("" : "+s"(K_)); const int K = K_, nt = K / BK;
    unsigned voffA[2], voffB[2];
#pragma unroll
    for (int i = 0; i < 2; ++i) { int R, C; stage_rc(tid * 16 + i * 8192, R, C); const int Rb = Epi::PERM ? ((R & ~31) + perm32(R & 31)) : R;
        voffA[i] = (unsigned)(R * K + C) * 2u; voffB[i] = (unsigned)(Rb * K + C) * 2u; }
    const size_t kstep = (size_t)(BK * 2);
    const size_t hstep = (size_t)HALF * K * 2;
    const size_t tstep = 2 * hstep; const size_t tstepA = (size_t)g.arows * K * 2;
    const unsigned ldsw = (unsigned)wid * 1024u;
    const int aoff = lds_byte(wr * 64 + fr, fq * 8), boff = lds_byte(wc * 32 + fr, fq * 8);
#define PG8_SA(b, h) (((b) * 2 + (h)) * HTB)
#define PG8_SB(b, h) ((4 + (b) * 2 + (h)) * HTB)
#define PG8_STAGE(bufoff, gbase, voff) do { _Pragma("unroll") for (int _i = 0; _i < 2; ++_i) \
        __builtin_amdgcn_global_load_lds((const unsigned*)((const char*)(gbase) + (voff)[_i]), (PG8_LAS unsigned*)(lds + (bufoff) + ldsw + _i * 8192), 16, 0, 0); } while (0)
#define PG8_LDA(dst, b, h) do { _Pragma("unroll") for (int m = 0; m < 4; ++m) _Pragma("unroll") for (int k = 0; k < 2; ++k) dst[m][k] = *(const PG8_LAS bf16x8*)(lds + PG8_SA(b, h) + aoff + m * 2048 + k * 1024); } while (0)
#define PG8_LDB(dst, b, h) do { _Pragma("unroll") for (int n = 0; n < 2; ++n) _Pragma("unroll") for (int k = 0; k < 2; ++k) dst[n][k] = *(const PG8_LAS bf16x8*)(lds + PG8_SB(b, h) + boff + n * 2048 + k * 1024); } while (0)
#define PG8_MMA(ai, bj, At, Bt) do { __builtin_amdgcn_s_setprio(1); _Pragma("unroll") for (int m = 0; m < 4; ++m) _Pragma("unroll") for (int n = 0; n < 2; ++n) _Pragma("unroll") for (int k = 0; k < 2; ++k) \
        acc[ai][bj][m][n] = __builtin_amdgcn_mfma_f32_16x16x32_bf16(Bt[n][k], At[m][k], acc[ai][bj][m][n], 0, 0, 0); __builtin_amdgcn_s_setprio(0); } while (0)
#define PG8_WAIT_V(n) asm volatile("s_waitcnt vmcnt(" #n ")" ::: "memory")
#define PG8_WAIT_L(n) asm volatile("s_waitcnt lgkmcnt(" #n ")" ::: "memory")
#define PG8_BAR __builtin_amdgcn_s_barrier()
#define PG8_SCHED __builtin_amdgcn_sched_barrier(0)
    Unit cur, nxt; int ui = 0;
    if (!S.next(0, cur)) return;
    f32x4 acc[2][2][4][2];
#pragma unroll
    for (int a = 0; a < 2; ++a)
#pragma unroll
        for (int b = 0; b < 2; ++b)
#pragma unroll
            for (int m = 0; m < 4; ++m)
#pragma unroll
                for (int n = 0; n < 2; ++n) acc[a][b][m][n] = (f32x4){0.f, 0.f, 0.f, 0.f};
    bf16x8 At[4][2], B0[2][2], B1[2][2];
    const char* cA = (const char*)g.A + (size_t)cur.pm * tstepA; const char* cB = (const char*)g.Bt + (size_t)cur.pn * tstep;
    S.a_ready(cur);
    if constexpr (SP2) {
        PG8_STAGE(PG8_SB(0, 0), cB, voffB); PG8_STAGE(PG8_SB(0, 1), cB + hstep, voffB); PG8_STAGE(PG8_SA(0, 0), cA, voffA); PG8_STAGE(PG8_SA(0, 1), cA + hstep, voffA);
        if (wr == 1) PG8_BAR;
        PG8_WAIT_V(2); PG8_BAR;
        PG8_STAGE(PG8_SB(1, 0), cB + kstep, voffB); PG8_STAGE(PG8_SA(1, 0), cA + kstep, voffA); PG8_STAGE(PG8_SB(1, 1), cB + hstep + kstep, voffB);
        PG8_WAIT_V(6); PG8_BAR;
    } else {
        PG8_STAGE(PG8_SB(0, 0), cB, voffB); PG8_STAGE(PG8_SA(0, 0), cA, voffA); PG8_STAGE(PG8_SB(0, 1), cB + hstep, voffB); PG8_STAGE(PG8_SA(0, 1), cA + hstep, voffA);
        if (wr == 1) PG8_BAR;
        PG8_WAIT_V(4); PG8_BAR;
        PG8_STAGE(PG8_SB(1, 0), cB + kstep, voffB); PG8_STAGE(PG8_SA(1, 0), cA + kstep, voffA); PG8_STAGE(PG8_SB(1, 1), cB + hstep + kstep, voffB);
        PG8_WAIT_V(6); PG8_BAR;
    }
    for (;;) {
        const bool has_next = S.next(ui + 1, nxt);
        const char* nA = has_next ? (const char*)g.A + (size_t)nxt.pm * tstepA : cA; const char* nB = has_next ? (const char*)g.Bt + (size_t)nxt.pn * tstep : cB;
        for (int t = 0; t < nt; t += 2) {
            const bool last = (t == nt - 2);
            const char* a1 = cA + (size_t)(t + 1) * kstep;
            const char* a2 = last ? nA : cA + (size_t)(t + 2) * kstep; const char* b2 = last ? nB : cB + (size_t)(t + 2) * kstep;
            const char* a3 = a2 + kstep; const char* b3 = b2 + kstep;
            if (last && has_next) S.a_ready(nxt);
            if constexpr (SP2) {
            PG8_LDB(B0, 0, 0); PG8_LDB(B1, 0, 1); PG8_SCHED; PG8_LDA(At, 0, 0); PG8_STAGE(PG8_SA(1, 1), a1 + hstep, voffA);
            PG8_WAIT_V(8); PG8_WAIT_L(0); PG8_BAR; PG8_MMA(0, 0, At, B0); PG8_MMA(0, 1, At, B1); PG8_BAR; PG8_SCHED;
            PG8_LDA(At, 0, 1); PG8_STAGE(PG8_SB(0, 0), b2, voffB); PG8_STAGE(PG8_SB(0, 1), b2 + hstep, voffB); PG8_STAGE(PG8_SA(0, 0), a2, voffA);
            PG8_WAIT_V(8); PG8_WAIT_L(0); PG8_BAR; PG8_MMA(1, 0, At, B0); PG8_MMA(1, 1, At, B1); PG8_BAR; PG8_SCHED;
            PG8_LDB(B0, 1, 0); PG8_LDB(B1, 1, 1); PG8_SCHED; PG8_LDA(At, 1, 0); PG8_STAGE(PG8_SA(0, 1), a2 + hstep, voffA);
            PG8_WAIT_V(8); PG8_WAIT_L(0); PG8_BAR; PG8_MMA(0, 0, At, B0); PG8_MMA(0, 1, At, B1); PG8_BAR; PG8_SCHED;
            PG8_LDA(At, 1, 1); PG8_STAGE(PG8_SB(1, 0), b3, voffB); PG8_STAGE(PG8_SB(1, 1), b3 + hstep, voffB); PG8_STAGE(PG8_SA(1, 0), a3, voffA);
            PG8_WAIT_V(8); PG8_WAIT_L(0); PG8_BAR; PG8_MMA(1, 0, At, B0); PG8_MMA(1, 1, At, B1); PG8_BAR; PG8_SCHED;
            } else {
            PG8_LDB(B0, 0, 0); PG8_SCHED; PG8_LDA(At, 0, 0); PG8_STAGE(PG8_SA(1, 1), a1 + hstep, voffA);
            PG8_WAIT_L(8); PG8_BAR; PG8_WAIT_L(0); PG8_MMA(0, 0, At, B0); PG8_BAR; PG8_SCHED;
            PG8_LDB(B1, 0, 1); PG8_STAGE(PG8_SB(0, 0), b2, voffB);
            PG8_BAR; PG8_WAIT_L(0); PG8_MMA(0, 1, At, B1); PG8_BAR;
            PG8_LDA(At, 0, 1); PG8_STAGE(PG8_SA(0, 0), a2, voffA);
            PG8_BAR; PG8_WAIT_L(0); PG8_MMA(1, 0, At, B0); PG8_BAR; PG8_SCHED;
            PG8_STAGE(PG8_SB(0, 1), b2 + hstep, voffB);
            PG8_WAIT_V(6); PG8_BAR; PG8_MMA(1, 1, At, B1); PG8_BAR;
            PG8_LDB(B0, 1, 0); PG8_SCHED; PG8_LDA(At, 1, 0); PG8_STAGE(PG8_SA(0, 1), a2 + hstep, voffA);
            PG8_WAIT_L(8); PG8_BAR; PG8_WAIT_L(0); PG8_MMA(0, 0, At, B0); PG8_BAR; PG8_SCHED;
            PG8_LDB(B1, 1, 1); PG8_STAGE(PG8_SB(1, 0), b3, voffB);
            PG8_BAR; PG8_WAIT_L(0); PG8_MMA(0, 1, At, B1); PG8_BAR;
            PG8_LDA(At, 1, 1); PG8_STAGE(PG8_SA(1, 0), a3, voffA);
            PG8_BAR; PG8_WAIT_L(0); PG8_MMA(1, 0, At, B0); PG8_BAR; PG8_SCHED;
            PG8_STAGE(PG8_SB(1, 1), b3 + hstep, voffB);
            PG8_WAIT_V(6); PG8_BAR; PG8_MMA(1, 1, At, B1); PG8_BAR;
            }
        }
        if constexpr (ALIGN_EPI) { if (wr == 0) PG8_BAR; }
        if constexpr (!Epi::AFTER_DRAIN) { E(acc, cur, wr, wc, fr, fq); S.done(cur); }
        if (!has_next) break;
#pragma unroll
        for (int a = 0; a < 2; ++a)
#pragma unroll
            for (int b = 0; b < 2; ++b)
#pragma unroll
                for (int m = 0; m < 4; ++m)
#pragma unroll
                    for (int n = 0; n < 2; ++n) acc[a][b][m][n] = (f32x4){0.f, 0.f, 0.f, 0.f};
        cur = nxt; cA = nA; cB = nB; ++ui;
        if constexpr (ALIGN_EPI) { if (wr == 1) PG8_BAR; }
    }
    PG8_WAIT_V(0);
    if constexpr (!ALIGN_EPI) { if (wr == 0) PG8_BAR; }
    PG8_BAR;
    if constexpr (Epi::AFTER_DRAIN) { E.fused(acc, cur, wr, wc, fr, fq, lds, wid, lane); S.done(cur); }
#undef PG8_SA
#undef PG8_SB
#undef PG8_STAGE
#undef PG8_LDA
#undef PG8_LDB
#undef PG8_MMA
#undef PG8_WAIT_V
#undef PG8_WAIT_L
#undef PG8_BAR
#undef PG8_SCHED
}
}
typedef unsigned short bf16_t;
typedef short bf16x8 __attribute__((ext_vector_type(8)));
typedef float f32x4 __attribute__((ext_vector_type(4)));
typedef float f32x2 __attribute__((ext_vector_type(2)));
typedef float f32x16 __attribute__((ext_vector_type(16)));
typedef unsigned u32x4 __attribute__((ext_vector_type(4)));
typedef unsigned u32x2 __attribute__((ext_vector_type(2)));
#define LAS __attribute__((address_space(3)))
constexpr int DM = 1024, CH = 16384, NCHUNK = 3, DEPTH = 4, PLE = 256, DFF = 2816;
constexpr int EV_IN = 7168, OD_IN = 3104, OD_INP = 3328;
constexpr float EPS = 1e-6f;
constexpr int NT = 512, NWV = 8;
constexpr int LDS_BYTES = 147456;
constexpr size_t al256(size_t x) { return (x + 255) & ~(size_t)255; }
constexpr size_t W_EVIN = 65536;
constexpr size_t W_EVOUT = W_EVIN + (size_t)2 * EV_IN * DM * 2;
constexpr size_t W_ODIN = W_EVOUT + (size_t)2 * DM * DM * 2;
constexpr size_t W_ODOUT = W_ODIN + (size_t)2 * OD_INP * DM * 2;
constexpr size_t W_UP = W_ODOUT + (size_t)2 * DM * DM * 2;
constexpr size_t W_DOWN = W_UP + (size_t)4 * 2 * DFF * DM * 2;
constexpr size_t W_GATE = W_DOWN + (size_t)4 * DM * DFF * 2;
constexpr size_t W_PROJ = W_GATE + (size_t)4 * DM * DM * 2;
constexpr size_t W_LB = W_PROJ + (size_t)4 * DM * PLE * 2;
constexpr size_t B_PB = W_LB + 8192;
constexpr size_t B_HB0 = B_PB + (size_t)CH * PLE * 2;
constexpr size_t B_HB1 = B_HB0 + (size_t)CH * DM * 2;
constexpr size_t B_SSQ0 = B_HB1 + (size_t)CH * DM * 2;
constexpr size_t B_SSQ1 = B_SSQ0 + (size_t)CH * 16 * 4;
constexpr size_t ARENA = B_SSQ1 + (size_t)CH * 16 * 4;
constexpr size_t A_U = 0;
constexpr size_t A_QT = (size_t)CH * EV_IN * 2;
constexpr size_t A_KT = A_QT + (size_t)2 * CH * 512 * 2;
constexpr size_t A_MIX = A_QT;
constexpr size_t A_OEV = A_KT + (size_t)2 * CH * 512 * 2;
constexpr size_t A_VFOD = (size_t)CH * OD_INP * 2;
constexpr size_t A_OOD = A_OEV;
constexpr size_t A_OG = A_OEV + (size_t)2 * CH * 512 * 4;
constexpr size_t A_LSE = A_OG + (size_t)3 * CH * 512 * 2;
constexpr size_t A_DEC = A_OOD + (size_t)2 * CH * 1024 * 4;
constexpr size_t ARENA_BYTES = A_DEC + (size_t)512 * 4 * 2 * 128 * 4;
constexpr size_t A_UF = 0;
constexpr size_t A_ACT = (size_t)CH * 2 * DFF * 2;
constexpr size_t A_PP = 0;
constexpr size_t WS_NEED = ARENA + ARENA_BYTES;
static_assert(A_LSE + (size_t)3 * CH * 4 * 4 <= A_DEC, "even bufs before DEC");
static_assert(A_VFOD + (size_t)CH * 1024 * 2 * 2 <= A_QT, "odd Vf fits before QT");
static_assert(A_ACT + (size_t)CH * DFF * 2 <= ARENA_BYTES, "act fits");

__device__ __forceinline__ float bf2f(unsigned short v) { return __uint_as_float(((unsigned)v) << 16); }
__device__ __forceinline__ unsigned pk2(float lo, float hi) { return pg8::cvt_pk_bf16(lo, hi); }
typedef float f32x2_cv __attribute__((ext_vector_type(2))); typedef __bf16 bf16x2_cv __attribute__((ext_vector_type(2)));
__device__ __forceinline__ unsigned pk2s(float lo, float hi) { const f32x2_cv v = {lo, hi}; const bf16x2_cv c = __builtin_convertvector(v, bf16x2_cv); return __builtin_bit_cast(unsigned, c); }
__device__ __forceinline__ float shfl_xor_l(float v, int lane, int m) { return __builtin_bit_cast(float, __builtin_amdgcn_ds_bpermute((lane ^ m) << 2, __builtin_bit_cast(int, v))); }
__device__ __forceinline__ float wave_sum(float v, int lane) {
#pragma unroll
    for (int o = 1; o < 64; o <<= 1) v += shfl_xor_l(v, lane, o);
    return v;
}
__device__ __forceinline__ float rstd_of(const float* ssq, int row) {
    const f32x4* p = (const f32x4*)(ssq + (size_t)row * 16);
    const f32x4 a = p[0], b = p[1], c = p[2], d = p[3];
    const float s = ((a.x + a.y) + (a.z + a.w)) + ((b.x + b.y) + (b.z + b.w)) + ((c.x + c.y) + (c.z + c.w)) + ((d.x + d.y) + (d.z + d.w));
    return rsqrtf(s * (1.0f / DM) + EPS);
}
struct EpiScale {
    static constexpr bool PERM = true, AFTER_DRAIN = false;
    bf16_t* O; int ldc; const float* ssq;
    __device__ __forceinline__ void operator()(const f32x4 (&acc)[2][2][4][2], const pg8::Unit& u, int wr, int wc, int fr, int fq) const {
        const int row0 = u.pm * 256 + wr * 64 + fr, col0 = u.pn * 256 + wc * 32 + 8 * fq;
#pragma unroll
        for (int ai = 0; ai < 2; ++ai)
#pragma unroll
            for (int m = 0; m < 4; ++m) {
                const int row = row0 + ai * 128 + m * 16; const float rs = rstd_of(ssq, row);
                bf16_t* rp = O + (size_t)row * ldc + col0;
#pragma unroll
                for (int bj = 0; bj < 2; ++bj) { const f32x4 v0 = acc[ai][bj][m][0] * rs, v1 = acc[ai][bj][m][1] * rs;
                    u32x4 w; w.x = pk2(v0[0], v0[1]); w.y = pk2(v0[2], v0[3]); w.z = pk2(v1[0], v1[1]); w.w = pk2(v1[2], v1[3]);
                    *(u32x4*)(rp + bj * 128) = w; }
            }
    }
};
struct EpiF32 {
    static constexpr bool PERM = true, AFTER_DRAIN = false;
    bf16_t* O; int ldc;
    __device__ __forceinline__ void operator()(const f32x4 (&acc)[2][2][4][2], const pg8::Unit& u, int wr, int wc, int fr, int fq) const {
        const int row0 = u.pm * 256 + wr * 64 + fr, col0 = u.pn * 256 + wc * 32 + 8 * fq;
#pragma unroll
        for (int ai = 0; ai < 2; ++ai)
#pragma unroll
            for (int m = 0; m < 4; ++m) { bf16_t* rp = O + (size_t)(row0 + ai * 128 + m * 16) * ldc + col0;
#pragma unroll
                for (int bj = 0; bj < 2; ++bj) { const f32x4 v0 = acc[ai][bj][m][0], v1 = acc[ai][bj][m][1];
                    u32x4 w; w.x = pk2s(v0[0], v0[1]); w.y = pk2s(v0[2], v0[3]); w.z = pk2s(v1[0], v1[1]); w.w = pk2s(v1[2], v1[3]);
                    *(u32x4*)(rp + bj * 128) = w; } }
    }
};
template <int MODE  > struct EpiResid {
    static constexpr bool PERM = true, AFTER_DRAIN = false;
    float* h; bf16_t* hb; float* ssq_out; const float* ssq_in; const bf16_t* pp;
    __device__ __forceinline__ void operator()(const f32x4 (&acc)[2][2][4][2], const pg8::Unit& u, int wr, int wc, int fr, int fq) const {
        const int row0 = u.pm * 256 + wr * 64 + fr, col0 = u.pn * 256 + wc * 32 + 8 * fq;
#pragma unroll
        for (int ai = 0; ai < 2; ++ai)
#pragma unroll
            for (int m = 0; m < 4; ++m) {
                const int row = row0 + ai * 128 + m * 16; float rs = 1.f; if (MODE == 1) rs = rstd_of(ssq_in, row);
                float* hp = h + (size_t)row * DM + col0; bf16_t* bp = hb + (size_t)row * DM + col0; float s = 0.f;
#pragma unroll
                for (int bj = 0; bj < 2; ++bj) {
                    f32x4 a0 = acc[ai][bj][m][0], a1 = acc[ai][bj][m][1];
                    if (MODE == 1) { const u32x4 pw = *(const u32x4*)(pp + (size_t)row * DM + col0 + bj * 128);
                        const f32x4 p0 = {__uint_as_float(pw.x << 16), __uint_as_float(pw.x & 0xffff0000u), __uint_as_float(pw.y << 16), __uint_as_float(pw.y & 0xffff0000u)};
                        const f32x4 p1 = {__uint_as_float(pw.z << 16), __uint_as_float(pw.z & 0xffff0000u), __uint_as_float(pw.w << 16), __uint_as_float(pw.w & 0xffff0000u)};
#pragma unroll
                        for (int e = 0; e < 4; ++e) { a0[e] = p0[e] / (1.f + __expf(-a0[e] * rs)); a1[e] = p1[e] / (1.f + __expf(-a1[e] * rs)); } }
                    const f32x4 h0 = *(const f32x4*)(hp + bj * 128) + a0, h1 = *(const f32x4*)(hp + bj * 128 + 4) + a1;
                    *(f32x4*)(hp + bj * 128) = h0; *(f32x4*)(hp + bj * 128 + 4) = h1;
                    u32x4 w; w.x = pk2(h0[0], h0[1]); w.y = pk2(h0[2], h0[3]); w.z = pk2(h1[0], h1[1]); w.w = pk2(h1[2], h1[3]);
                    *(u32x4*)(bp + bj * 128) = w;
                    s += (h0[0] * h0[0] + h0[1] * h0[1]) + (h0[2] * h0[2] + h0[3] * h0[3]) + (h1[0] * h1[0] + h1[1] * h1[1]) + (h1[2] * h1[2] + h1[3] * h1[3]);
                }
                { const int ln_ = fq * 16 + fr; s += shfl_xor_l(s, ln_, 16); s += shfl_xor_l(s, ln_, 32); }
                if (fq == 0) ssq_out[(size_t)row * 16 + u.pn * 4 + wc] = s;
            }
    }
};

struct EpiConv {
    static constexpr bool PERM = true, AFTER_DRAIN = false;
    bf16_t* act; const float* ssq; const float* cw; const float* cb; int T; LAS float* halo;
    __device__ __forceinline__ void operator()(f32x4 (&acc)[2][2][4][2], const pg8::Unit& u, int wr, int wc, int fr, int fq) const {
        const int g0 = 254 * u.pm - 1, lane = fq * 16 + fr;
#pragma unroll
        for (int ai = 0; ai < 2; ++ai)
#pragma unroll
            for (int m = 0; m < 4; ++m) { const float rs = rstd_of(ssq, g0 + ai * 128 + wr * 64 + m * 16 + fr);
#pragma unroll
                for (int bj = 0; bj < 2; ++bj) { acc[ai][bj][m][0] = acc[ai][bj][m][0] * rs; acc[ai][bj][m][1] = acc[ai][bj][m][1] * rs; } }
#pragma unroll
        for (int ai = 0; ai < 2; ++ai) { const int s = 2 * ai + wr;
            if (fr == 0) {
#pragma unroll
                for (int bj = 0; bj < 2; ++bj)
#pragma unroll
                    for (int n = 0; n < 2; ++n) *(LAS f32x4*)(halo + ((((wc * 4 + s) * 2 + 0) * 2 + bj) * 32) + 8 * fq + 4 * n) = acc[ai][bj][0][n]; }
            if (fr == 15) {
#pragma unroll
                for (int bj = 0; bj < 2; ++bj)
#pragma unroll
                    for (int n = 0; n < 2; ++n) *(LAS f32x4*)(halo + ((((wc * 4 + s) * 2 + 1) * 2 + bj) * 32) + 8 * fq + 4 * n) = acc[ai][bj][3][n]; } }
        asm volatile("s_waitcnt lgkmcnt(0)" ::: "memory"); __builtin_amdgcn_s_barrier(); asm volatile("" ::: "memory");
#pragma unroll
        for (int n = 0; n < 2; ++n) {
            const int ca = u.pn * 128 + wc * 32 + 8 * fq + 4 * n;
            f32x4 w0[2], w1[2], w2[2], bb[2];
#pragma unroll
            for (int bj = 0; bj < 2; ++bj) { const int c = bj * DFF + ca;
                w0[bj] = *(const f32x4*)(cw + c); w1[bj] = *(const f32x4*)(cw + 2 * DFF + c); w2[bj] = *(const f32x4*)(cw + 4 * DFF + c); bb[bj] = *(const f32x4*)(cb + c); }
#pragma unroll
            for (int ai = 0; ai < 2; ++ai) { const int s = 2 * ai + wr;
#pragma unroll
                for (int m = 0; m < 4; ++m) {
                    const int lr = ai * 128 + wr * 64 + m * 16 + fr, g = g0 + lr; const bool tp = (g & (T - 1)) != 0, tn = ((g + 1) & (T - 1)) != 0;
                    f32x4 ph[2] = {{0.f, 0.f, 0.f, 0.f}, {0.f, 0.f, 0.f, 0.f}}, nh[2] = {{0.f, 0.f, 0.f, 0.f}, {0.f, 0.f, 0.f, 0.f}};
                    if (m == 0 && s > 0) {
#pragma unroll
                        for (int bj = 0; bj < 2; ++bj) ph[bj] = *(const LAS f32x4*)(halo + ((((wc * 4 + s - 1) * 2 + 1) * 2 + bj) * 32) + 8 * fq + 4 * n); }
                    if (m == 3 && s < 3) {
#pragma unroll
                        for (int bj = 0; bj < 2; ++bj) nh[bj] = *(const LAS f32x4*)(halo + ((((wc * 4 + s + 1) * 2 + 0) * 2 + bj) * 32) + 8 * fq + 4 * n); }
                    float cv[2][4];
#pragma unroll
                    for (int bj = 0; bj < 2; ++bj)
#pragma unroll
                        for (int e = 0; e < 4; ++e) {
                            const float cur = acc[ai][bj][m][n][e];
                            const float sp_ = (fr == 15) ? (m > 0 ? acc[ai][bj][m > 0 ? m - 1 : 0][n][e] : ph[bj][e]) : cur;
                            const float sn_ = (fr == 0) ? (m < 3 ? acc[ai][bj][m < 3 ? m + 1 : 3][n][e] : nh[bj][e]) : cur;
                            const float pv = __builtin_bit_cast(float, __builtin_amdgcn_update_dpp(0, __builtin_bit_cast(int, sp_), 0x121, 0xf, 0xf, false));
                            const float nv = __builtin_bit_cast(float, __builtin_amdgcn_update_dpp(0, __builtin_bit_cast(int, sn_), 0x12F, 0xf, 0xf, false));
                            float t_ = fmaf(cur, w1[bj][e], bb[bj][e]); t_ = tp ? fmaf(pv, w0[bj][e], t_) : t_; t_ = tn ? fmaf(nv, w2[bj][e], t_) : t_; cv[bj][e] = t_;
                        }
                    const f32x2 g01 = pg8::gelu_pk((f32x2){cv[1][0], cv[1][1]}), g23 = pg8::gelu_pk((f32x2){cv[1][2], cv[1][3]});
                    if (lr >= 1 && lr <= 254 && g < CH) { u32x2 w; w.x = pk2(cv[0][0] * g01.x, cv[0][1] * g01.y); w.y = pk2(cv[0][2] * g23.x, cv[0][3] * g23.y);
                        *(u32x2*)(act + (size_t)g * DFF + ca) = w; }
                    __builtin_amdgcn_sched_barrier(0);
                }
            }
            asm volatile("" ::: "memory");
        }
    }
};
struct Args {
    const float* in[23]; float* out; unsigned char* ws; int ph_lo, ph_hi;
};
enum { I_XP = 0, I_XS, I_PP, I_PS, I_NMIX, I_EVIN, I_LBL, I_HNORM, I_EVOUT, I_ODIN, I_GUP, I_GB, I_GNORM, I_ODOUT, I_NFFN, I_FUP, I_CW, I_CB, I_FDOWN, I_NPLE, I_PGATE, I_PPROJ, I_NOUT };

struct Ctx {
    LAS unsigned char* lds; int tid, lane, wave, G, bid;
    const Args* a; unsigned char* ws;
};

__device__ __forceinline__ void titem_load(const float* W, int K, int N, const float* gk, int item, int lane, float (&v)[32]) {
    const int nblk = N / 32, kb = item / nblk, nb = item % nblk, k0 = 64 * kb, n0 = 32 * nb;
#pragma unroll
    for (int i = 0; i < 32; ++i) { const int kk = 2 * i + (lane >> 5); v[i] = W[(size_t)(k0 + kk) * N + n0 + (lane & 31)]; }
    if (gk) {
#pragma unroll
        for (int i = 0; i < 32; ++i) v[i] *= gk[k0 + 2 * i + (lane >> 5)]; }
}
__device__ __forceinline__ void titem_store(int K, int N, bf16_t* WT, LAS float* scr, int item, int lane, bool remap, const float (&v)[32]) {
    const int nblk = N / 32, kb = item / nblk, nb = item % nblk, k0 = 64 * kb, n0 = 32 * nb;
#pragma unroll
    for (int i = 0; i < 32; ++i) scr[(2 * i + (lane >> 5)) * 33 + (lane & 31)] = v[i];
    asm volatile("s_waitcnt lgkmcnt(0)" ::: "memory");
    const int c = lane & 7;
#pragma unroll
    for (int j = 0; j < 4; ++j) { const int n = (lane >> 3) + 8 * j; const LAS float* s = scr + (8 * c) * 33 + n;
        u32x4 o; o.x = pk2(s[0 * 33], s[1 * 33]); o.y = pk2(s[2 * 33], s[3 * 33]); o.z = pk2(s[4 * 33], s[5 * 33]); o.w = pk2(s[6 * 33], s[7 * 33]);
        int nr = n0 + n; if (remap) nr = (nr < DFF) ? (((nr >> 7) << 8) + (nr & 127)) : ((((nr - DFF) >> 7) << 8) + 128 + ((nr - DFF) & 127));
        *(u32x4*)(WT + (size_t)nr * K + k0 + 8 * c) = o; }
    asm volatile("s_waitcnt lgkmcnt(0)" ::: "memory");
}
__device__ __forceinline__ void weights_prologue(const Ctx& C) {
    LAS float* scr = (LAS float*)(C.lds + C.wave * 8704);
    const int gw = C.bid * NWV + C.wave, NGW = C.G * NWV;
    const Args& a = *C.a;
    for (int mat = 0; mat < 24; ++mat) {
        const float* W; const float* g = nullptr; bf16_t* WT; int K, N;
        if (mat < 2)       { const int e = mat;      W = a.in[I_EVIN] + (size_t)e * DM * EV_IN;  K = DM; N = EV_IN; g = a.in[I_NMIX] + (2 * e) * DM;     WT = (bf16_t*)(C.ws + W_EVIN) + (size_t)e * EV_IN * DM; }
        else if (mat < 4)  { const int e = mat - 2;  W = a.in[I_EVOUT] + (size_t)e * DM * DM;    K = DM; N = DM;                                        WT = (bf16_t*)(C.ws + W_EVOUT) + (size_t)e * DM * DM; }
        else if (mat < 6)  { const int o = mat - 4;  W = a.in[I_ODIN] + (size_t)o * DM * OD_IN;  K = DM; N = OD_IN; g = a.in[I_NMIX] + (2 * o + 1) * DM; WT = (bf16_t*)(C.ws + W_ODIN) + (size_t)o * OD_INP * DM; }
        else if (mat < 8)  { const int o = mat - 6;  W = a.in[I_ODOUT] + (size_t)o * DM * DM;    K = DM; N = DM;                                        WT = (bf16_t*)(C.ws + W_ODOUT) + (size_t)o * DM * DM; }
        else if (mat < 12) { const int l = mat - 8;  W = a.in[I_FUP] + (size_t)l * DM * 2 * DFF; K = DM; N = 2 * DFF; g = a.in[I_NFFN] + l * DM;         WT = (bf16_t*)(C.ws + W_UP) + (size_t)l * 2 * DFF * DM; }
        else if (mat < 16) { const int l = mat - 12; W = a.in[I_FDOWN] + (size_t)l * DFF * DM;   K = DFF; N = DM;                                       WT = (bf16_t*)(C.ws + W_DOWN) + (size_t)l * DM * DFF; }
        else if (mat < 20) { const int l = mat - 16; W = a.in[I_PGATE] + (size_t)l * DM * DM;    K = DM; N = DM; g = a.in[I_NPLE] + l * DM;              WT = (bf16_t*)(C.ws + W_GATE) + (size_t)l * DM * DM; }
        else               { const int l = mat - 20; W = a.in[I_PPROJ] + (size_t)l * PLE * DM;   K = PLE; N = DM;                                       WT = (bf16_t*)(C.ws + W_PROJ) + (size_t)l * DM * PLE; }
        const int nitems = (K / 64) * (N / 32);
        float vc[32], vn[32];
        if (gw < nitems) titem_load(W, K, N, g, gw, C.lane, vc);
        for (int it = gw; it < nitems; it += NGW) {
            const bool more = it + NGW < nitems;
            if (more) titem_load(W, K, N, g, it + NGW, C.lane, vn);
            titem_store(K, N, WT, scr, it, C.lane, mat >= 8 && mat < 12, vc);
            if (more) {
#pragma unroll
                for (int i = 0; i < 32; ++i) vc[i] = vn[i]; }
        }
    }
    { const int gt = C.bid * NT + C.tid, GT = C.G * NT; const int per = (OD_INP - OD_IN) * DM / 8;
      for (int i = gt; i < 2 * per; i += GT) { const int o = i / per, r = i % per; *(u32x4*)((bf16_t*)(C.ws + W_ODIN) + (size_t)o * OD_INP * DM + (size_t)OD_IN * DM + (size_t)r * 8) = (u32x4){0u, 0u, 0u, 0u}; } }
    { const int gt = C.bid * NT + C.tid; if (gt < 1024) { const int dir = gt >> 9, c = gt & 511; const float* L = a.in[I_LBL] + (size_t)dir * 2 * 512;
        float* lb = (float*)(C.ws + W_LB) + dir * 1024; lb[c] = 0.f; lb[512 + c] = 1.f / (1.f + __expf(L[c] - L[512 + c])); } }
}
__device__ __forceinline__ void chunk_prologue(const Ctx& C, int chunk, bf16_t* hb, float* ssq) {
    const int gw = C.bid * NWV + C.wave, NGW = C.G * NWV; const Args& a = *C.a;
    for (int r = gw; r < CH; r += NGW) {
        const size_t R = (size_t)chunk * CH + r;
        const float* xr = (R < 16384) ? a.in[I_XP] + R * DM : a.in[I_XS] + (R - 16384) * DM;
        float* hr = a.out + R * DM; f32x4 v[4]; float s = 0.f;
#pragma unroll
        for (int j = 0; j < 4; ++j) { v[j] = ((const f32x4*)xr)[C.lane + 64 * j]; s += (v[j].x * v[j].x + v[j].y * v[j].y) + (v[j].z * v[j].z + v[j].w * v[j].w); }
        s = wave_sum(s, C.lane);
#pragma unroll
        for (int j = 0; j < 4; ++j) { ((f32x4*)hr)[C.lane + 64 * j] = v[j]; u32x2 w; w.x = pk2(v[j].x, v[j].y); w.y = pk2(v[j].z, v[j].w); ((u32x2*)(hb + (size_t)r * DM))[C.lane + 64 * j] = w; }
        if (C.lane < 16) ssq[(size_t)r * 16 + C.lane] = (C.lane == 0) ? s : 0.f;
    }
}
__device__ __forceinline__ void final_norm(const Ctx& C, int chunk) {
    const int gw = C.bid * NWV + C.wave, NGW = C.G * NWV; const Args& a = *C.a; const float* g = a.in[I_NOUT];
    for (int r = gw; r < CH; r += NGW) {
        float* hr = a.out + ((size_t)chunk * CH + r) * DM; f32x4 v[4]; float s = 0.f;
#pragma unroll
        for (int j = 0; j < 4; ++j) { v[j] = ((const f32x4*)hr)[C.lane + 64 * j]; s += (v[j].x * v[j].x + v[j].y * v[j].y) + (v[j].z * v[j].z + v[j].w * v[j].w); }
        const float rs = rsqrtf(wave_sum(s, C.lane) * (1.f / DM) + EPS);
#pragma unroll
        for (int j = 0; j < 4; ++j) { const f32x4 gg = ((const f32x4*)g)[C.lane + 64 * j]; ((f32x4*)hr)[C.lane + 64 * j] = v[j] * rs * gg; }
    }
}
__device__ __forceinline__ void conv_phase(const Ctx& C, int chunk, int l, int T) {
    const Args& a = *C.a;
    const bf16_t* UF = (const bf16_t*)(C.ws + ARENA + A_UF); bf16_t* ACT = (bf16_t*)(C.ws + ARENA + A_ACT);
    const float* cw = a.in[I_CW] + (size_t)l * 3 * 2 * DFF; const float* cb = a.in[I_CB] + (size_t)l * 2 * DFF;
    {
        const int ry = C.tid >> 5, cx = C.tid & 31;
        for (int tile = C.bid; tile < (CH / 64) * 11; tile += C.G) {
            const int rt = tile / 11, ct = tile % 11; const int r0 = rt * 64 + ry * 4, c0 = ct * 256 + cx * 8;
            float wa0[8], wa1[8], wa2[8], wg0[8], wg1[8], wg2[8], ba[8], bg[8];
#pragma unroll
            for (int e = 0; e < 8; e += 4) { *(f32x4*)(wa0 + e) = *(const f32x4*)(cw + c0 + e); *(f32x4*)(wa1 + e) = *(const f32x4*)(cw + 2 * DFF + c0 + e); *(f32x4*)(wa2 + e) = *(const f32x4*)(cw + 4 * DFF + c0 + e);
                *(f32x4*)(wg0 + e) = *(const f32x4*)(cw + DFF + c0 + e); *(f32x4*)(wg1 + e) = *(const f32x4*)(cw + 3 * DFF + c0 + e); *(f32x4*)(wg2 + e) = *(const f32x4*)(cw + 5 * DFF + c0 + e);
                *(f32x4*)(ba + e) = *(const f32x4*)(cb + c0 + e); *(f32x4*)(bg + e) = *(const f32x4*)(cb + DFF + c0 + e); }
            bf16x8 ua[6], ug[6];
#pragma unroll
            for (int i = 0; i < 6; ++i) { const int r = r0 - 1 + i; const bool ok = (i == 0) ? ((r0 % T) != 0) : (i == 5 ? (((r0 + 4) % T) != 0) : true);
                if (ok) { ua[i] = *(const bf16x8*)(UF + (size_t)r * 2 * DFF + c0); ug[i] = *(const bf16x8*)(UF + (size_t)r * 2 * DFF + DFF + c0); }
                else { ua[i] = (bf16x8){0, 0, 0, 0, 0, 0, 0, 0}; ug[i] = ua[i]; } }
#pragma unroll
            for (int i = 0; i < 4; ++i) {
                float o[8];
#pragma unroll
                for (int e = 0; e < 8; ++e) {
                    const float av = bf2f((unsigned short)ua[i][e]) * wa0[e] + bf2f((unsigned short)ua[i + 1][e]) * wa1[e] + bf2f((unsigned short)ua[i + 2][e]) * wa2[e] + ba[e];
                    const float gv = bf2f((unsigned short)ug[i][e]) * wg0[e] + bf2f((unsigned short)ug[i + 1][e]) * wg1[e] + bf2f((unsigned short)ug[i + 2][e]) * wg2[e] + bg[e];
                    o[e] = av * (0.5f * gv * (1.f + erff(gv * 0.70710678118f)));
                }
                u32x4 w; w.x = pk2(o[0], o[1]); w.y = pk2(o[2], o[3]); w.z = pk2(o[4], o[5]); w.w = pk2(o[6], o[7]);
                *(u32x4*)(ACT + (size_t)(r0 + i) * DFF + c0) = w;
            }
        }
    }
}
__device__ __forceinline__ void pb_convert(const Ctx& C, int chunk, int l) {
    const Args& a = *C.a;
    { bf16_t* PB = (bf16_t*)(C.ws + B_PB); const int gt = C.bid * NT + C.tid, GT = C.G * NT;
      for (int i = gt; i < CH * PLE / 4; i += GT) { const int r = i / (PLE / 4), c4 = i % (PLE / 4); const size_t R = (size_t)chunk * CH + r;
          const float* src = (R < 16384) ? a.in[I_PP] + ((size_t)l * 16384 + R) * PLE : a.in[I_PS] + ((size_t)l * 32768 + (R - 16384)) * PLE;
          const f32x4 v = ((const f32x4*)src)[c4]; u32x2 w; w.x = pk2(v.x, v.y); w.y = pk2(v.z, v.w); ((u32x2*)(PB + (size_t)r * PLE))[c4] = w; } }
}
struct Mix { int even, li, T, DV, ld, vcol, gcol; float qscale; unsigned char* vf; };
#define MFMA32(a, b, c) __builtin_amdgcn_mfma_f32_32x32x16_bf16((a), (b), (c), 0, 0, 0)
#define QK_IDX(hd, dir, blk, k) (((((size_t)((hd) * 2 + (dir))) * 512 + (size_t)(blk)) * 8 + (k)) * 64)
#define V_IDX(hd, dir, ET, et, blk, sp) ((((((size_t)((hd) * 2 + (dir))) * (ET) + (et)) * 512 + (size_t)(blk)) * 2 + (sp)) * 64)
#define O_IDX(hd, dir, ET, et, blk, q) ((((((size_t)((hd) * 2 + (dir))) * (ET) + (et)) * 512 + (size_t)(blk)) * 4 + (q)) * 64)
#define OB_IDX(hd, dir, ET, et, blk, r) ((((((size_t)((hd) * 2 + (dir))) * (ET) + (et)) * 512 + (size_t)(blk)) * 2 + (r)) * 64)
#define DEC_IDX(hd, dir, blk) ((((size_t)((hd) * 2 + (dir))) * 512 + (size_t)(blk)) * 128)
#define LDSFENCE() asm volatile("s_waitcnt lgkmcnt(0)" ::: "memory")
__device__ __forceinline__ bf16x8 pack8(float a0, float a1, float a2, float a3, float a4, float a5, float a6, float a7) {
    u32x4 w; w.x = pk2(a0, a1); w.y = pk2(a2, a3); w.z = pk2(a4, a5); w.w = pk2(a6, a7); return __builtin_bit_cast(bf16x8, w);
}
__device__ __forceinline__ bf16x8 pack8s(float a0, float a1, float a2, float a3, float a4, float a5, float a6, float a7) {
    u32x4 w; w.x = pk2s(a0, a1); w.y = pk2s(a2, a3); w.z = pk2s(a4, a5); w.w = pk2s(a6, a7); return __builtin_bit_cast(bf16x8, w);
}
__device__ __forceinline__ f32x16 zero16() { f32x16 z;
#pragma unroll
    for (int i = 0; i < 16; ++i) z[i] = 0.f; return z; }

__device__ __forceinline__ void prep_phase(const Ctx& C, const Mix& mx) {
    const Args& a = *C.a;
    const bf16_t* U = (const bf16_t*)(C.ws + ARENA + A_U);
    u32x4* QTf = (u32x4*)(C.ws + ARENA + A_QT); u32x4* KTf = (u32x4*)(C.ws + ARENA + A_KT); u32x4* Vf = (u32x4*)mx.vf;
    f32x4* Of = (f32x4*)(C.ws + ARENA + A_OEV); float* DEC = (float*)(C.ws + ARENA + A_DEC);
    const float* LB = (const float*)(C.ws + W_LB);
    const int hd = C.wave & 3, dir = C.wave >> 2, lane = C.lane, ld = mx.ld, DV = mx.DV;
    LAS float* Bs = (LAS float*)(C.lds + C.wave * 16896);
    for (int b = C.bid; b < CH / 32; b += C.G) {
        int vz_ = 0; asm volatile("" : "+v"(vz_)); const int rb = 32 * b + vz_;
        {
            const int d0 = 2 * lane, col0 = hd * 128 + d0, dt0 = d0 >> 5, dp0 = d0 & 31;
            float bs0 = 0.f, bs1 = 0.f; unsigned zz[32];
            if (mx.even) {
                const f32x2 lb2 = *(const f32x2*)(LB + dir * 1024 + mx.li * 512 + col0); const float om0 = 1.f - lb2.x, om1 = 1.f - lb2.y;
                const bf16_t* zp = U + 512 + 512 * dir + col0;
#pragma unroll
                for (int t = 0; t < 32; ++t) { const int row = rb + (dir ? 31 - t : t);
                    const unsigned zw = *(const unsigned*)(zp + (size_t)row * ld); zz[t] = zw;
                    const float z0 = __uint_as_float(zw << 16), z1 = __uint_as_float(zw & 0xffff0000u);
                    bs0 += fmaxf(__logf(lb2.x + om0 / (1.f + __expf(-z0))), -30.f); bs1 += fmaxf(__logf(lb2.y + om1 / (1.f + __expf(-z1))), -30.f);
                    *(LAS f32x2*)(Bs + t * 132 + d0) = (f32x2){bs0, bs1}; }
                *(f32x2*)(DEC + DEC_IDX(hd, dir, b) + d0) = (f32x2){__expf(bs0), __expf(bs1)};
#pragma unroll
                for (int grp = 0; grp < 4; ++grp) { float k0[8], k1[8];
#pragma unroll
                    for (int j = 0; j < 8; ++j) { const int t = 16 * (grp >> 1) + 8 * (j >> 2) + 4 * (grp & 1) + (j & 3);
                        const float z0 = __uint_as_float(zz[t] << 16), z1 = __uint_as_float(zz[t] & 0xffff0000u); const f32x2 bt = *(const LAS f32x2*)(Bs + t * 132 + d0);
                        k0[j] = om0 / (1.f + __expf(z0)) * __expf(bs0 - bt.x); k1[j] = om1 / (1.f + __expf(z1)) * __expf(bs1 - bt.y); }
                    u32x4 w; w.x = pk2(k0[0], k0[1]); w.y = pk2(k0[2], k0[3]); w.z = pk2(k0[4], k0[5]); w.w = pk2(k0[6], k0[7]);
                    KTf[QK_IDX(hd, dir, b, (grp >> 1) * 4 + dt0) + 32 * (grp & 1) + dp0] = w;
                    w.x = pk2(k1[0], k1[1]); w.y = pk2(k1[2], k1[3]); w.z = pk2(k1[4], k1[5]); w.w = pk2(k1[6], k1[7]);
                    KTf[QK_IDX(hd, dir, b, (grp >> 1) * 4 + dt0) + 32 * (grp & 1) + dp0 + 1] = w; }
            } else {
                float Wg0[16], Wg1[16]; const float* wp = a.in[I_GUP] + ((size_t)(mx.li * 2 + dir) * 16) * 512 + col0;
#pragma unroll
                for (int r = 0; r < 16; ++r) { const f32x2 w2 = *(const f32x2*)(wp + r * 512); Wg0[r] = w2.x; Wg1[r] = w2.y; }
                const f32x2 bias = *(const f32x2*)(a.in[I_GB] + (mx.li * 2 + dir) * 512 + col0);
#pragma unroll
                for (int t = 0; t < 32; ++t) { const int row = rb + (dir ? 31 - t : t);
                    const u32x4 l0 = *(const u32x4*)(U + (size_t)row * ld + 3072 + 16 * dir), l1 = *(const u32x4*)(U + (size_t)row * ld + 3072 + 16 * dir + 8);
                    zz[t] = *(const unsigned*)(U + (size_t)row * ld + 512 + col0);
                    float x0 = bias.x, x1 = bias.y;
#pragma unroll
                    for (int w = 0; w < 4; ++w) { const float a0 = __uint_as_float(l0[w] << 16), a1 = __uint_as_float(l0[w] & 0xffff0000u), c0 = __uint_as_float(l1[w] << 16), c1 = __uint_as_float(l1[w] & 0xffff0000u);
                        x0 += a0 * Wg0[2 * w] + a1 * Wg0[2 * w + 1] + c0 * Wg0[8 + 2 * w] + c1 * Wg0[8 + 2 * w + 1];
                        x1 += a0 * Wg1[2 * w] + a1 * Wg1[2 * w + 1] + c0 * Wg1[8 + 2 * w] + c1 * Wg1[8 + 2 * w + 1]; }
                    bs0 += fmaxf((fminf(x0, 0.f) - log1pf(__expf(-fabsf(x0)))) * (1.f / 16.f), -30.f); bs1 += fmaxf((fminf(x1, 0.f) - log1pf(__expf(-fabsf(x1)))) * (1.f / 16.f), -30.f);
                    *(LAS f32x2*)(Bs + t * 132 + d0) = (f32x2){bs0, bs1}; }
                *(f32x2*)(DEC + DEC_IDX(hd, dir, b) + d0) = (f32x2){__expf(bs0), __expf(bs1)};
#pragma unroll
                for (int grp = 0; grp < 4; ++grp) { float k0[8], k1[8];
#pragma unroll
                    for (int j = 0; j < 8; ++j) { const int t = 16 * (grp >> 1) + 8 * (j >> 2) + 4 * (grp & 1) + (j & 3); const f32x2 bt = *(const LAS f32x2*)(Bs + t * 132 + d0);
                        k0[j] = __uint_as_float(zz[t] << 16) * __expf(bs0 - bt.x); k1[j] = __uint_as_float(zz[t] & 0xffff0000u) * __expf(bs1 - bt.y); }
                    u32x4 w; w.x = pk2(k0[0], k0[1]); w.y = pk2(k0[2], k0[3]); w.z = pk2(k0[4], k0[5]); w.w = pk2(k0[6], k0[7]);
                    KTf[QK_IDX(hd, dir, b, (grp >> 1) * 4 + dt0) + 32 * (grp & 1) + dp0] = w;
                    w.x = pk2(k1[0], k1[1]); w.y = pk2(k1[2], k1[3]); w.z = pk2(k1[4], k1[5]); w.w = pk2(k1[6], k1[7]);
                    KTf[QK_IDX(hd, dir, b, (grp >> 1) * 4 + dt0) + 32 * (grp & 1) + dp0 + 1] = w; }
            }
        }
        LDSFENCE();
        const int tau = lane & 31, h = lane >> 5, row = rb + (dir ? 31 - tau : tau);
        u32x4 vt[8];
#pragma unroll
        for (int it = 0; it < 8; ++it) { const int idx = lane + 64 * it, t = idx / (DV / 8), c8 = idx % (DV / 8); const int rj = rb + (dir ? 31 - t : t);
            vt[it] = *(const u32x4*)(U + (size_t)rj * ld + mx.vcol + hd * DV + c8 * 8); }
        bf16x8 Ak[8], Bq[8];
#pragma unroll
        for (int ks = 0; ks < 8; ++ks) {
            float qh[8], kh[8], qt[8];
#pragma unroll
            for (int q2 = 0; q2 < 2; ++q2) {
                const int d0 = 16 * ks + 8 * q2 + 4 * h;
                const f32x4 b4 = *(const LAS f32x4*)(Bs + tau * 132 + d0), r4 = *(const LAS f32x4*)(Bs + 15 * 132 + d0);
                const u32x2 qr = *(const u32x2*)(U + (size_t)row * ld + hd * 128 + d0);
                float q4[4] = {__uint_as_float(qr.x << 16), __uint_as_float(qr.x & 0xffff0000u), __uint_as_float(qr.y << 16), __uint_as_float(qr.y & 0xffff0000u)};
                float k4[4];
                if (mx.even) { const u32x2 zr = *(const u32x2*)(U + (size_t)row * ld + 512 + 512 * dir + hd * 128 + d0);
                    const f32x4 lb4 = *(const f32x4*)(LB + dir * 1024 + mx.li * 512 + hd * 128 + d0);
                    const float z4[4] = {__uint_as_float(zr.x << 16), __uint_as_float(zr.x & 0xffff0000u), __uint_as_float(zr.y << 16), __uint_as_float(zr.y & 0xffff0000u)};
#pragma unroll
                    for (int e = 0; e < 4; ++e) k4[e] = (1.f - lb4[e]) / (1.f + __expf(z4[e]));
                } else { const u32x2 kr = *(const u32x2*)(U + (size_t)row * ld + 512 + hd * 128 + d0);
                    k4[0] = __uint_as_float(kr.x << 16); k4[1] = __uint_as_float(kr.x & 0xffff0000u); k4[2] = __uint_as_float(kr.y << 16); k4[3] = __uint_as_float(kr.y & 0xffff0000u); }
#pragma unroll
                for (int e = 0; e < 4; ++e) { const float qq = q4[e] * mx.qscale; qt[4 * q2 + e] = qq * __expf(b4[e]);
                    qh[4 * q2 + e] = qq * __expf(fminf(b4[e] - r4[e], 80.f)); kh[4 * q2 + e] = k4[e] * __expf(fminf(r4[e] - b4[e], 80.f)); }
            }
            { u32x4 w; w.x = pk2(qt[0], qt[1]); w.y = pk2(qt[2], qt[3]); w.z = pk2(qt[4], qt[5]); w.w = pk2(qt[6], qt[7]); QTf[QK_IDX(hd, dir, b, ks) + lane] = w; }
            Bq[ks] = pack8(qh[0], qh[1], qh[2], qh[3], qh[4], qh[5], qh[6], qh[7]);
            Ak[ks] = pack8(kh[0], kh[1], kh[2], kh[3], kh[4], kh[5], kh[6], kh[7]);
        }
        f32x16 at = zero16();
#pragma unroll
        for (int ks = 0; ks < 8; ++ks) at = MFMA32(Ak[ks], Bq[ks], at);
#pragma unroll
        for (int i = 0; i < 16; ++i) { const int s = (i & 3) + 8 * (i >> 2) + 4 * h; if (s > tau) at[i] = 0.f; }
        bf16x8 Pa[2];
        Pa[0] = pack8(at[0], at[1], at[2], at[3], at[4], at[5], at[6], at[7]);
        Pa[1] = pack8(at[8], at[9], at[10], at[11], at[12], at[13], at[14], at[15]);
        const int ET = DV / 32;
        LDSFENCE();
        LAS unsigned char* Vs = (LAS unsigned char*)Bs; const int vpitch = 2 * DV + 16;
#pragma unroll
        for (int it = 0; it < 8; ++it) { const int idx = lane + 64 * it, t = idx / (DV / 8), c8 = idx % (DV / 8); *(LAS u32x4*)(Vs + t * vpitch + c8 * 16) = vt[it]; }
        for (int idx = lane + 512; idx < 32 * (DV / 8); idx += 64) { const int t = idx / (DV / 8), c8 = idx % (DV / 8); const int rj = rb + (dir ? 31 - t : t);
            *(LAS u32x4*)(Vs + t * vpitch + c8 * 16) = *(const u32x4*)(U + (size_t)rj * ld + mx.vcol + hd * DV + c8 * 8); }
        LDSFENCE();
        for (int et = 0; et < ET; ++et) {
            f32x16 acc = zero16();
#pragma unroll
            for (int sp = 0; sp < 2; ++sp) {
                unsigned short v[8];
#pragma unroll
                for (int j = 0; j < 8; ++j) { const int sj = 16 * sp + 8 * (j >> 2) + 4 * h + (j & 3); v[j] = *(const LAS unsigned short*)(Vs + sj * vpitch + (32 * et + (lane & 31)) * 2); }
                u32x4 w; w.x = v[0] | ((unsigned)v[1] << 16); w.y = v[2] | ((unsigned)v[3] << 16); w.z = v[4] | ((unsigned)v[5] << 16); w.w = v[6] | ((unsigned)v[7] << 16);
                Vf[V_IDX(hd, dir, ET, et, b, sp) + lane] = w;
                acc = MFMA32(Pa[sp], __builtin_bit_cast(bf16x8, w), acc);
            }
#pragma unroll
            for (int r = 0; r < 2; ++r) { u32x4 w; w.x = pk2s(acc[8 * r], acc[8 * r + 1]); w.y = pk2s(acc[8 * r + 2], acc[8 * r + 3]); w.z = pk2s(acc[8 * r + 4], acc[8 * r + 5]); w.w = pk2s(acc[8 * r + 6], acc[8 * r + 7]);
                ((u32x4*)Of)[OB_IDX(hd, dir, ET, et, b, r) + lane] = w; }
        }
        LDSFENCE();
    }
}
__device__ __forceinline__ void scan_phase(const Ctx& C, const Mix& mx) {
    const u32x4* QTf = (const u32x4*)(C.ws + ARENA + A_QT); const u32x4* KTf = (const u32x4*)(C.ws + ARENA + A_KT); const u32x4* Vf = (const u32x4*)mx.vf;
    u32x4* Of = (u32x4*)(C.ws + ARENA + A_OEV); const float* DEC = (const float*)(C.ws + ARENA + A_DEC);
    const int lane = C.lane, h = lane >> 5, DV = mx.DV, ET = DV / 32, T = mx.T, nb = T / 32;
    const int units = (CH / T) * 8 * ET;
    constexpr int SLOT = 23552, R = 5, NL = 4;
    LAS u32x4* SB = (LAS u32x4*)(C.lds + R * SLOT);
    for (int base = 0; base < units; base += C.G) {
        const bool loader = C.wave >= 2 && C.wave < 2 + NL;
        const int lr = C.wave - 2;
        const int vcu = (C.G % 8 == 0) ? (C.bid % 8) * (C.G / 8) + C.bid / 8 : C.bid;
        const int u = base + vcu;
        const bool valid = u < units;
        const int et = u % ET, x = u / ET, dir = x & 1, hd = (x >> 1) & 3, seq = x >> 3;
        LAS unsigned char* ring = C.lds;
#define SCAN_BAR() do { asm volatile("s_waitcnt lgkmcnt(0)" ::: "memory"); __builtin_amdgcn_s_barrier(); asm volatile("" ::: "memory"); } while (0)
#define GLDS16(gp, lp) __builtin_amdgcn_global_load_lds((const unsigned*)(gp), (LAS unsigned*)(lp), 16, 0, 0)
#define SCAN_ISSUE(j) do { const int blk_ = seq * nb + (dir ? nb - 1 - (j) : (j)); LAS unsigned char* sl_ = ring + ((j) % R) * SLOT; \
            _Pragma("unroll") for (int k = 0; k < 8; ++k) { GLDS16(QTf + QK_IDX(hd, dir, blk_, k) + lane, sl_ + k * 1024); GLDS16(KTf + QK_IDX(hd, dir, blk_, k) + lane, sl_ + (8 + k) * 1024); } \
            _Pragma("unroll") for (int sp = 0; sp < 2; ++sp) GLDS16(Vf + V_IDX(hd, dir, ET, et, blk_, sp) + lane, sl_ + (16 + sp) * 1024); \
            _Pragma("unroll") for (int r = 0; r < 2; ++r) GLDS16(Of + OB_IDX(hd, dir, ET, et, blk_, r) + lane, sl_ + (18 + r) * 1024); \
            if (lane < 32) GLDS16(DEC + DEC_IDX(hd, dir, blk_) + 4 * lane, sl_ + 22 * 1024); } while (0)
        if (C.wave == 0) {
            SCAN_BAR();
            for (int i = 0; i < nb; ++i) {
                if (valid) {
                    const LAS u32x4* sv = (const LAS u32x4*)(ring + (i % R) * SLOT) + lane; const LAS u32x4* sb = SB + (i & 1) * 512 + lane;
                    u32x4 qf[8], on[2], bs[8];
#pragma unroll
                    for (int r = 0; r < 2; ++r) on[r] = sv[(18 + r) * 64];
#pragma unroll
                    for (int k = 0; k < 8; ++k) { qf[k] = sv[k * 64]; bs[k] = sb[k * 64]; }
                    asm volatile("s_waitcnt lgkmcnt(0)" ::: "memory");
                    f32x16 acc;
#pragma unroll
                    for (int r = 0; r < 2; ++r) {
                        acc[8 * r + 0] = __uint_as_float(on[r].x << 16); acc[8 * r + 1] = __uint_as_float(on[r].x & 0xffff0000u); acc[8 * r + 2] = __uint_as_float(on[r].y << 16); acc[8 * r + 3] = __uint_as_float(on[r].y & 0xffff0000u);
                        acc[8 * r + 4] = __uint_as_float(on[r].z << 16); acc[8 * r + 5] = __uint_as_float(on[r].z & 0xffff0000u); acc[8 * r + 6] = __uint_as_float(on[r].w << 16); acc[8 * r + 7] = __uint_as_float(on[r].w & 0xffff0000u); }
#pragma unroll
                    for (int k = 0; k < 8; ++k) acc = MFMA32(__builtin_bit_cast(bf16x8, qf[k]), __builtin_bit_cast(bf16x8, bs[k]), acc);
                    const int blk = seq * nb + (dir ? nb - 1 - i : i);
#pragma unroll
                    for (int r = 0; r < 2; ++r) { u32x4 w; w.x = pk2s(acc[8 * r], acc[8 * r + 1]); w.y = pk2s(acc[8 * r + 2], acc[8 * r + 3]); w.z = pk2s(acc[8 * r + 4], acc[8 * r + 5]); w.w = pk2s(acc[8 * r + 6], acc[8 * r + 7]);
                        Of[OB_IDX(hd, dir, ET, et, blk, r) + lane] = w; }
                }
                SCAN_BAR();
            }
        } else if (C.wave == 1) {
            f32x16 S[4];
#pragma unroll
            for (int dt = 0; dt < 4; ++dt) S[dt] = zero16();
#pragma unroll
            for (int k = 0; k < 8; ++k) SB[k * 64 + lane] = (u32x4){0u, 0u, 0u, 0u};
            SCAN_BAR();
            for (int i = 0; i < nb; ++i) {
                if (valid) {
                    const LAS unsigned char* sl = ring + (i % R) * SLOT; const LAS u32x4* sv = (const LAS u32x4*)sl + lane;
                    u32x4 kf[8], vf[2]; f32x4 dq[16];
#pragma unroll
                    for (int k = 0; k < 8; ++k) kf[k] = sv[(8 + k) * 64];
#pragma unroll
                    for (int sp = 0; sp < 2; ++sp) vf[sp] = sv[(16 + sp) * 64];
                    const LAS float* dp = (const LAS float*)(sl + 22 * 1024) + 4 * h;
#pragma unroll
                    for (int k = 0; k < 16; ++k) dq[k] = *(const LAS f32x4*)(dp + 8 * k);
                    asm volatile("s_waitcnt lgkmcnt(0)" ::: "memory");
#pragma unroll
                    for (int dt = 0; dt < 4; ++dt)
#pragma unroll
                        for (int q = 0; q < 4; ++q) {
#pragma unroll
                            for (int e = 0; e < 4; ++e) S[dt][4 * q + e] *= dq[4 * dt + q][e]; }
#pragma unroll
                    for (int sp = 0; sp < 2; ++sp) {
#pragma unroll
                        for (int dt = 0; dt < 4; ++dt) S[dt] = MFMA32(__builtin_bit_cast(bf16x8, kf[sp * 4 + dt]), __builtin_bit_cast(bf16x8, vf[sp]), S[dt]); }
                    LAS u32x4* sbw = SB + ((i + 1) & 1) * 512 + lane;
#pragma unroll
                    for (int dt = 0; dt < 4; ++dt)
#pragma unroll
                        for (int sp = 0; sp < 2; ++sp)
                            sbw[(2 * dt + sp) * 64] = __builtin_bit_cast(u32x4, pack8s(S[dt][8 * sp + 0], S[dt][8 * sp + 1], S[dt][8 * sp + 2], S[dt][8 * sp + 3], S[dt][8 * sp + 4], S[dt][8 * sp + 5], S[dt][8 * sp + 6], S[dt][8 * sp + 7]));
                }
                SCAN_BAR();
            }
        } else {
            if (loader && valid && lr < nb) SCAN_ISSUE(lr);
            for (int i = -1; i < nb; ++i) {
                if (loader && valid) {
                    if (i >= 0 && lr == i % NL && i + NL < nb) SCAN_ISSUE(i + NL);
                    if (lr == (i + 1) % NL && i + 1 < nb) asm volatile("s_waitcnt vmcnt(0)" ::: "memory");
                }
                SCAN_BAR();
            }
        }
#undef SCAN_ISSUE
#undef GLDS16
#undef SCAN_BAR
    }
}
__device__ __forceinline__ void attn_phase(const Ctx& C, int T) {
    const bf16_t* U = (const bf16_t*)(C.ws + ARENA + A_U);
    bf16_t* OG = (bf16_t*)(C.ws + ARENA + A_OG); float* LSE = (float*)(C.ws + ARENA + A_LSE);
    const int lane = C.lane, h = lane >> 5, l31 = lane & 31, ld = EV_IN, tps = T / 32;
    for (int task = C.bid * NWV + C.wave; task < 3 * 4 * (CH / 32); task += C.G * NWV) {
        const int g = task / 2048, x = task % 2048, hd = x / 512, y = x % 512, seq = y / tps, z = y % tps;
        const int dil = 1 << (2 * g), L = T / dil, nqb = L / 32, r = z / nqb, qb = z % nqb, m0 = 32 * qb;
        const int qcol = 2560 + g * 1536 + hd * 128, kcol = qcol + 512, vcol = qcol + 1024;
        const float coef = exp2f(-8.0f * (float)(g * 4 + hd + 1) / 12.0f) * (float)dil, scale = 0.08838834764831845f;
        const size_t rbase = (size_t)seq * T + r;
        bf16x8 Bq[8];
        { const bf16_t* qp = U + (rbase + (size_t)(m0 + l31) * dil) * ld + qcol + 8 * h;
#pragma unroll
          for (int ks = 0; ks < 8; ++ks) Bq[ks] = *(const bf16x8*)(qp + 16 * ks); }
        f32x16 st[5];
        bf16x8 Kc[8], Kn[8];
        {   const int mkc0 = (m0 - 64) < 0 ? 0 : (m0 - 64);
            const bf16_t* kp = U + (rbase + (size_t)(mkc0 + l31) * dil) * ld + kcol + 8 * h;
#pragma unroll
            for (int ks = 0; ks < 8; ++ks) Kc[ks] = *(const bf16x8*)(kp + 16 * ks); }
#pragma unroll
        for (int kb = 0; kb < 5; ++kb) {
            const int mk0 = m0 - 64 + 32 * kb; const bool vb = (mk0 >= 0 && mk0 < L);
            if (kb < 4) { const int mk1 = mk0 + 32; const int mkc1 = mk1 < 0 ? 0 : (mk1 >= L ? L - 32 : mk1);
                const bf16_t* kp = U + (rbase + (size_t)(mkc1 + l31) * dil) * ld + kcol + 8 * h;
#pragma unroll
                for (int ks = 0; ks < 8; ++ks) Kn[ks] = *(const bf16x8*)(kp + 16 * ks); }
            f32x16 s = zero16();
#pragma unroll
            for (int ks = 0; ks < 8; ++ks) s = MFMA32(Kc[ks], Bq[ks], s);
#pragma unroll
            for (int i = 0; i < 16; ++i) { const int rel = (mk0 + (i & 3) + 8 * (i >> 2) + 4 * h) - (m0 + l31); const int ar = rel < 0 ? -rel : rel;
                s[i] = (vb && ar <= 64) ? s[i] * scale - coef * (float)ar : -1e30f; }
            st[kb] = s;
#pragma unroll
            for (int ks = 0; ks < 8; ++ks) Kc[ks] = Kn[ks];
        }
        float mxv = -1e30f;
#pragma unroll
        for (int kb = 0; kb < 5; ++kb)
#pragma unroll
            for (int i = 0; i < 16; ++i) mxv = fmaxf(mxv, st[kb][i]);
        mxv = fmaxf(mxv, shfl_xor_l(mxv, lane, 32));
        float den = 0.f;
#pragma unroll
        for (int kb = 0; kb < 5; ++kb)
#pragma unroll
            for (int i = 0; i < 16; ++i) { const float p = __expf(st[kb][i] - mxv); st[kb][i] = p; den += p; }
        den += shfl_xor_l(den, lane, 32);
        f32x16 ot[4];
#pragma unroll
        for (int dt = 0; dt < 4; ++dt) ot[dt] = zero16();
        LAS unsigned char* Vs = C.lds + C.wave * 16896;
#pragma unroll
        for (int kb = 0; kb < 5; ++kb) {
            const int mk0 = m0 - 64 + 32 * kb; const int mkc = mk0 < 0 ? 0 : (mk0 >= L ? L - 32 : mk0);
            u32x4 vr[8];
#pragma unroll
            for (int it = 0; it < 8; ++it) { const int idx = lane + 64 * it, t = idx >> 4, c8 = idx & 15; vr[it] = *(const u32x4*)(U + (rbase + (size_t)(mkc + t) * dil) * ld + vcol + c8 * 8); }
            LDSFENCE();
#pragma unroll
            for (int it = 0; it < 8; ++it) { const int idx = lane + 64 * it, t = idx >> 4, c8 = idx & 15; *(LAS u32x4*)(Vs + t * 272 + c8 * 16) = vr[it]; }
            LDSFENCE();
#pragma unroll
            for (int sp = 0; sp < 2; ++sp) {
                const bf16x8 Bp = pack8(st[kb][8 * sp + 0], st[kb][8 * sp + 1], st[kb][8 * sp + 2], st[kb][8 * sp + 3], st[kb][8 * sp + 4], st[kb][8 * sp + 5], st[kb][8 * sp + 6], st[kb][8 * sp + 7]);
#pragma unroll
                for (int dt = 0; dt < 4; ++dt) {
                    typedef short v4i16_t __attribute__((ext_vector_type(4)));
                    const LAS unsigned char* tp = Vs + (16 * sp + 4 * h + ((lane & 15) >> 2)) * 272 + (32 * dt + 16 * ((lane >> 4) & 1) + 4 * (lane & 3)) * 2;
                    const v4i16_t lo = __builtin_amdgcn_ds_read_tr16_b64_v4i16((LAS v4i16_t*)tp), hi = __builtin_amdgcn_ds_read_tr16_b64_v4i16((LAS v4i16_t*)(tp + 8 * 272));
                    bf16x8 w; w[0] = lo[0]; w[1] = lo[1]; w[2] = lo[2]; w[3] = lo[3]; w[4] = hi[0]; w[5] = hi[1]; w[6] = hi[2]; w[7] = hi[3];
                    ot[dt] = MFMA32(w, Bp, ot[dt]);
                }
            }
        }
        const float inv = 1.f / den; const size_t qrow = rbase + (size_t)(m0 + l31) * dil;
        bf16_t* op = OG + ((size_t)g * CH + qrow) * 512 + hd * 128 + 4 * h;
#pragma unroll
        for (int dt = 0; dt < 4; ++dt)
#pragma unroll
            for (int q = 0; q < 4; ++q) { u32x2 w; w.x = pk2(ot[dt][4 * q] * inv, ot[dt][4 * q + 1] * inv); w.y = pk2(ot[dt][4 * q + 2] * inv, ot[dt][4 * q + 3] * inv);
                *(u32x2*)(op + 32 * dt + 8 * q) = w; }
        if (h == 0) LSE[((size_t)g * CH + qrow) * 4 + hd] = mxv + __logf(den);
    }
}
__device__ __forceinline__ void finalize_phase(const Ctx& C, const Mix& mx) {
    const Args& a = *C.a;
    const bf16_t* __restrict__ U = (const bf16_t*)(C.ws + ARENA + A_U); bf16_t* __restrict__ MIX = (bf16_t*)(C.ws + ARENA + A_MIX);
    const f32x4* __restrict__ Of = (const f32x4*)(C.ws + ARENA + A_OEV);
    const int gw = C.bid * NWV + C.wave, NGW = C.G * NWV, lane = C.lane, ld = mx.ld, DV = mx.DV, ET = DV / 32, NE = DV / 64;
    const float* gn = mx.even ? a.in[I_HNORM] + mx.li * 512 : a.in[I_GNORM] + mx.li * 1024;
#pragma unroll 2
    for (int rg = gw; rg < CH / 4; rg += NGW) {
        const int r0 = 4 * rg, blk = r0 >> 5, t0 = r0 & 31;
        const int qf = t0 >> 3, hf = (t0 >> 2) & 1, tb = 28 - t0, qb = tb >> 3, hb2 = (tb >> 2) & 1;
#pragma unroll
        for (int hd = 0; hd < 4; ++hd) {
            float o[2][2][4]; float ss[4] = {0.f, 0.f, 0.f, 0.f};
            const u32x2* Ob2 = (const u32x2*)Of;
#pragma unroll
            for (int k = 0; k < 2; ++k) if (2 * k < NE) {
                const int e0 = 2 * lane + 128 * k, et = e0 >> 5;
#pragma unroll
                for (int p = 0; p < 2; ++p) {
                    const u32x2 vf_ = Ob2[(OB_IDX(hd, 0, ET, et, blk, qf >> 1) + 32 * hf + (e0 & 31) + p) * 2 + (qf & 1)], vb_ = Ob2[(OB_IDX(hd, 1, ET, et, blk, qb >> 1) + 32 * hb2 + (e0 & 31) + p) * 2 + (qb & 1)];
                    o[k][p][0] = __uint_as_float(vf_.x << 16) + __uint_as_float(vb_.y & 0xffff0000u); o[k][p][1] = __uint_as_float(vf_.x & 0xffff0000u) + __uint_as_float(vb_.y << 16);
                    o[k][p][2] = __uint_as_float(vf_.y << 16) + __uint_as_float(vb_.x & 0xffff0000u); o[k][p][3] = __uint_as_float(vf_.y & 0xffff0000u) + __uint_as_float(vb_.x << 16);
#pragma unroll
                    for (int j = 0; j < 4; ++j) ss[j] += o[k][p][j] * o[k][p][j];
                }
            }
#pragma unroll
            for (int j = 0; j < 4; ++j) ss[j] = rsqrtf(wave_sum(ss[j], lane) / (float)DV + EPS);
#pragma unroll
            for (int k = 0; k < 2; ++k) if (2 * k < NE) {
                const int c = hd * DV + 2 * lane + 128 * k; const f32x2 g2 = *(const f32x2*)(gn + c);
#pragma unroll
                for (int j = 0; j < 4; ++j) { const unsigned agw = *(const unsigned*)(U + (size_t)(r0 + j) * ld + 2048 + c);
                    const float a0 = __uint_as_float(agw << 16), a1 = __uint_as_float(agw & 0xffff0000u);
                    *(unsigned*)(MIX + (size_t)(r0 + j) * DM + c) = pk2(o[k][0][j] * ss[j] * g2.x * (a0 / (1.f + __expf(-a0))), o[k][1][j] * ss[j] * g2.y * (a1 / (1.f + __expf(-a1)))); }
            }
        }
        if (mx.even) {
            const bf16_t* __restrict__ OG = (const bf16_t*)(C.ws + ARENA + A_OG); const float* __restrict__ LSE = (const float*)(C.ws + ARENA + A_LSE);
            const int c8 = lane * 8, hd = lane >> 4;
#pragma unroll
            for (int j = 0; j < 4; ++j) { const int r = r0 + j;
                const float l0 = LSE[((size_t)0 * CH + r) * 4 + hd], l1 = LSE[((size_t)1 * CH + r) * 4 + hd], l2 = LSE[((size_t)2 * CH + r) * 4 + hd];
                const float m = fmaxf(l0, fmaxf(l1, l2)); float w0 = __expf(l0 - m), w1 = __expf(l1 - m), w2 = __expf(l2 - m); const float iw = 1.f / (w0 + w1 + w2);
                w0 *= iw; w1 *= iw; w2 *= iw;
                const u32x4 v0 = *(const u32x4*)(OG + ((size_t)0 * CH + r) * 512 + c8), v1 = *(const u32x4*)(OG + ((size_t)1 * CH + r) * 512 + c8), v2 = *(const u32x4*)(OG + ((size_t)2 * CH + r) * 512 + c8);
                u32x4 o;
#pragma unroll
                for (int k = 0; k < 4; ++k) {
                    const float bx = w0 * __uint_as_float(v0[k] << 16) + w1 * __uint_as_float(v1[k] << 16) + w2 * __uint_as_float(v2[k] << 16);
                    const float by = w0 * __uint_as_float(v0[k] & 0xffff0000u) + w1 * __uint_as_float(v1[k] & 0xffff0000u) + w2 * __uint_as_float(v2[k] & 0xffff0000u);
                    o[k] = pk2(bx, by); }
                *(u32x4*)(MIX + (size_t)r * DM + 512 + c8) = o;
            }
        }
    }
}
#define XB_TMO      128
#define XB_XCNT(j)  (256  + 64 * (j))
#define XB_XSUB(j)  (1280 + 64 * (j))
#define XB_XGEN(j)  (2304 + 64 * (j))
#define XB_TOP      3328
#define XB_TOPGEN   3392
#define XCD_BAR_WORDS 3456
#define XB_SPIN_CAP (1u << 18)

__device__ __forceinline__ unsigned xb_ld(unsigned* p)              { return __hip_atomic_load(p, __ATOMIC_RELAXED, __HIP_MEMORY_SCOPE_AGENT); }
__device__ __forceinline__ unsigned xb_add(unsigned* p, unsigned v) { return __hip_atomic_fetch_add(p, v, __ATOMIC_RELAXED, __HIP_MEMORY_SCOPE_AGENT); }
__device__ __forceinline__ unsigned xb_xcc_id() { return (unsigned)__builtin_amdgcn_s_getreg((3 << 11) | 20) & 0xFu; }
#define XB_SPIN(cond, bar) do { unsigned _sp = 0; while (cond) { __builtin_amdgcn_s_sleep(1); \
    if ((++_sp & 255u) == 0u) { if (xb_ld(&(bar)[XB_TMO])) break; if (_sp > XB_SPIN_CAP) { atomicAdd(&(bar)[XB_TMO], 1u); break; } } } } while (0)

struct XcdBarrier {
    unsigned* bar; unsigned x;
    volatile LAS unsigned* st;
};

__device__ __forceinline__ XcdBarrier xcd_barrier_post(unsigned* bar, volatile LAS unsigned* st) {
    XcdBarrier b; b.bar = bar; b.x = xb_xcc_id(); b.st = st;
    if (threadIdx.x == 0) (void)xb_add(&bar[XB_XCNT(b.x)], 1u);
    return b;
}
__device__ __forceinline__ void xcd_barrier_complete(unsigned* bar, unsigned x, unsigned& nloc, unsigned& nx) {
    const unsigned G = gridDim.x * gridDim.y * gridDim.z;
    unsigned sum, cnt, mine, sp = 0u;
    for (;;) {
        sum = 0u; cnt = 0u; mine = 0u;
#pragma unroll
        for (unsigned j = 0; j < 16; ++j) { const unsigned c = xb_ld(&bar[XB_XCNT(j)]); sum += c; cnt += (c > 0u) ? 1u : 0u; mine = (j == x) ? c : mine; }
        if (sum == G) break;
        __builtin_amdgcn_s_sleep(1);
        if ((++sp & 255u) == 0u) { if (xb_ld(&bar[XB_TMO])) break; if (sp > XB_SPIN_CAP) { atomicAdd(&bar[XB_TMO], 1u); break; } }
    }
    nloc = mine > 0u ? mine : 1u; nx = cnt > 0u ? cnt : 1u;
}

__device__ __forceinline__ void xcd_barrier(const XcdBarrier& b) {
    asm volatile("s_waitcnt vmcnt(0)" ::: "memory");
    __syncthreads();
    if (threadIdx.x == 0) {
        unsigned* bar = b.bar;
        __builtin_amdgcn_s_waitcnt(0);
        unsigned nloc = b.st[0], nx = b.st[1];
        if (nloc == 0u) { xcd_barrier_complete(bar, b.x, nloc, nx); b.st[0] = nloc; b.st[1] = nx; }
        const unsigned old = xb_add(&bar[XB_XSUB(b.x)], 1u);
        const unsigned gen = old / nloc;
        if (old + 1u == (gen + 1u) * nloc) {
            __builtin_amdgcn_fence(__ATOMIC_RELEASE, "agent");
            asm volatile("s_waitcnt vmcnt(0)" ::: "memory");
            const unsigned og = xb_add(&bar[XB_TOP], 1u);
            const unsigned tg = og / nx;
            if (og + 1u == (tg + 1u) * nx) xb_add(&bar[XB_TOPGEN], 1u);
            else XB_SPIN(xb_ld(&bar[XB_TOPGEN]) == tg, bar);
            __builtin_amdgcn_fence(__ATOMIC_ACQUIRE, "agent");
            xb_add(&bar[XB_XGEN(b.x)], 1u);
            asm volatile("s_waitcnt vmcnt(0)" ::: "memory");
        } else {
            XB_SPIN(xb_ld(&bar[XB_XGEN(b.x)]) == gen, bar);
            __builtin_amdgcn_fence(__ATOMIC_ACQUIRE, "agent");
            asm volatile("s_waitcnt vmcnt(0)" ::: "memory");
        }
    }
    __syncthreads();
}
#define PHASE_BEGIN() do { int t_ = threadIdx.x; asm volatile("" : "+v"(t_)); C.tid = t_; C.lane = t_ & 63; C.wave = __builtin_amdgcn_readfirstlane(t_ >> 6); \
    int b_ = blockIdx.x; asm volatile("" : "+s"(b_)); C.bid = b_; unsigned char* w_ = args.ws; asm volatile("" : "+s"(w_)); C.ws = w_; ws = w_; \
    hb_c = (bf16_t*)(ws + (s ? B_HB1 : B_HB0)); hb_n = (bf16_t*)(ws + (s ? B_HB0 : B_HB1)); sq_c = (float*)(ws + (s ? B_SSQ1 : B_SSQ0)); sq_n = (float*)(ws + (s ? B_SSQ0 : B_SSQ1)); Ub = (bf16_t*)(ws + ARENA + A_U); MIXb = (bf16_t*)(ws + ARENA + A_MIX); \
    hch = args.out + (size_t)chunk * CH * DM; } while (0)
__global__ void __launch_bounds__(NT, 2) fwd_mega(Args args) {
    extern __shared__ __attribute__((aligned(16))) unsigned char lds_raw[];
    cg::grid_group grid = cg::this_grid();
    Ctx C; C.lds = (LAS unsigned char*)lds_raw; C.tid = threadIdx.x; C.lane = C.tid & 63; C.wave = __builtin_amdgcn_readfirstlane(C.tid >> 6);
    C.G = gridDim.x; C.bid = blockIdx.x; C.a = &args; C.ws = args.ws;
    unsigned char* ws = args.ws;
    bf16_t *hb_c, *hb_n; float *sq_c, *sq_n; bf16_t *Ub, *MIXb;
    if (blockIdx.x == 0) for (int i = threadIdx.x; i < XCD_BAR_WORDS; i += NT) ((unsigned*)args.ws)[i] = 0u;
    if (threadIdx.x < 2) ((volatile LAS unsigned*)(C.lds + LDS_BYTES - 256))[threadIdx.x] = 0u;
    weights_prologue(C);
    __syncthreads();
    grid.sync();
    XcdBarrier bar = xcd_barrier_post((unsigned*)args.ws, (volatile LAS unsigned*)(C.lds + LDS_BYTES - 256));
    float* hch;
#ifdef PROBE_A
    unsigned tacc[12];
#pragma unroll
    for (int i = 0; i < 12; ++i) tacc[i] = 0u;
    unsigned long long tprev = __builtin_amdgcn_s_memrealtime();
#define TICK(k) do { const unsigned long long now_ = __builtin_amdgcn_s_memrealtime(); tacc[k] += (unsigned)(now_ - tprev); tprev = now_; } while (0)
#else
#define TICK(k) do {} while (0)
#endif
#pragma nounroll
    for (int chunk = 0; chunk < NCHUNK; ++chunk) {
        const int T = chunk == 0 ? 4096 : 2048; int s = 0;
        PHASE_BEGIN();
        chunk_prologue(C, chunk, hb_c, sq_c);
        xcd_barrier(bar); TICK(10);
#pragma nounroll
        for (int l = 0; l < DEPTH; ++l) {
            const int even = (l & 1) == 0, li = l >> 1;
            Mix mx; mx.even = even; mx.li = li; mx.T = T; mx.DV = even ? 128 : 256; mx.ld = even ? EV_IN : OD_INP; mx.vcol = even ? 1536 : 1024; mx.gcol = 2048; mx.qscale = even ? 1.f : 0.08838834764831845f; mx.vf = nullptr;
            PHASE_BEGIN();
            {
                const int N = even ? EV_IN : OD_INP;
                const bf16_t* Wt = even ? (const bf16_t*)(ws + W_EVIN) + (size_t)li * EV_IN * DM : (const bf16_t*)(ws + W_ODIN) + (size_t)li * OD_INP * DM;
                pg8::Gemm g{hb_c, Wt, CH, N, DM, 256}; pg8::StaticOrder S; S.init(CH, N, C.G, C.bid);
                EpiScale E{Ub, N, sq_c};
                pg8::gemm_phase<EpiScale, pg8::StaticOrder, true, true>(C.lds, g, S, E);
            }
            xcd_barrier(bar); TICK(1);
            PHASE_BEGIN(); mx.vf = even ? (unsigned char*)hb_n : ws + ARENA + A_VFOD;
#ifndef NO_PREP
            prep_phase(C, mx);
#endif
            TICK(2);
            PHASE_BEGIN();
#ifndef NO_ATTN
            if (even) attn_phase(C, T);
#endif
            TICK(7);
            xcd_barrier(bar); TICK(0);
            PHASE_BEGIN(); mx.vf = even ? (unsigned char*)hb_n : ws + ARENA + A_VFOD;
#ifndef NO_SCAN
            scan_phase(C, mx);
#endif
            xcd_barrier(bar); TICK(3);
            PHASE_BEGIN();
#ifndef NO_FIN
            finalize_phase(C, mx);
#endif
            pb_convert(C, chunk, l);
            xcd_barrier(bar); TICK(4);
            PHASE_BEGIN();
            {
                const bf16_t* Wt = even ? (const bf16_t*)(ws + W_EVOUT) + (size_t)li * DM * DM : (const bf16_t*)(ws + W_ODOUT) + (size_t)li * DM * DM;
                pg8::Gemm g{MIXb, Wt, CH, DM, DM, 256}; pg8::StaticOrder S; S.init(CH, DM, C.G, C.bid);
                EpiResid<0> E{hch, hb_n, sq_n, nullptr, nullptr};
                pg8::gemm_phase<EpiResid<0>, pg8::StaticOrder, true, true>(C.lds, g, S, E);
                s ^= 1;
            }
            xcd_barrier(bar); TICK(5);
            PHASE_BEGIN();
            {
                pg8::Gemm g{hb_c - DM, (const bf16_t*)(ws + W_UP) + (size_t)l * 2 * DFF * DM, 65 * 256, 2 * DFF, DM, 254}; pg8::StaticOrder S; S.init(65 * 256, 2 * DFF, C.G, C.bid);
                EpiConv E{(bf16_t*)(ws + ARENA + A_ACT), sq_c, args.in[I_CW] + (size_t)l * 3 * 2 * DFF, args.in[I_CB] + (size_t)l * 2 * DFF, T, (LAS float*)(C.lds + 131072)};
                pg8::gemm_phase<EpiConv, pg8::StaticOrder, true, true>(C.lds, g, S, E);
            }
            {
                const int rem = (65 * 22) % C.G, c0 = rem, gs = rem ? C.G - rem : C.G;
                if (C.bid >= c0) {
                    PHASE_BEGIN();
                    pg8::Gemm g2{(const bf16_t*)(ws + B_PB), (const bf16_t*)(ws + W_PROJ) + (size_t)l * DM * PLE, CH, DM, PLE, 256}; pg8::StaticOrder S2; S2.init(CH, DM, gs, C.bid - c0);
                    EpiF32 E2{(bf16_t*)(ws + ARENA + A_PP), DM};
                    pg8::gemm_phase<EpiF32, pg8::StaticOrder, true, true>(C.lds, g2, S2, E2);
                }
            }
            xcd_barrier(bar); TICK(6);
            PHASE_BEGIN();
            {
                pg8::Gemm g{(const bf16_t*)(ws + ARENA + A_ACT), (const bf16_t*)(ws + W_DOWN) + (size_t)l * DM * DFF, CH, DM, DFF, 256}; pg8::StaticOrder S; S.init(CH, DM, C.G, C.bid);
                EpiResid<0> E{hch, hb_n, sq_n, nullptr, nullptr};
                pg8::gemm_phase<EpiResid<0>, pg8::StaticOrder, true, true>(C.lds, g, S, E);
                s ^= 1;
            }
            xcd_barrier(bar); TICK(8);
            PHASE_BEGIN();
            {
                pg8::Gemm g{hb_c, (const bf16_t*)(ws + W_GATE) + (size_t)l * DM * DM, CH, DM, DM, 256}; pg8::StaticOrder S; S.init(CH, DM, C.G, C.bid);
                EpiResid<1> E{hch, hb_n, sq_n, sq_c, (const bf16_t*)(ws + ARENA + A_PP)};
                pg8::gemm_phase<EpiResid<1>, pg8::StaticOrder, true, true>(C.lds, g, S, E);
                s ^= 1;
            }
            xcd_barrier(bar); TICK(9);
        }
        PHASE_BEGIN();
        final_norm(C, chunk);
        TICK(10);
    }
#ifdef PROBE_A
    xcd_barrier(bar); TICK(10);
    for (int i = 0; i < 100; ++i) xcd_barrier(bar);
    TICK(11);
    if (blockIdx.x == 0) {
        const float x1 = 8.f + (float)tacc[PROBE_A] * 1e-5f, t2 = 0.1f * (float)tacc[PROBE_B] * 1e-5f;
        float* o0 = args.out; float* o1 = args.out + (size_t)16384 * 1024;
        if (threadIdx.x == 0) { o0[0] += x1; o1[0] += x1; o1[1] += x1; }
        for (int i = threadIdx.x; i < 8192; i += NT) o0[1024 + i] += t2;
        for (int i = threadIdx.x; i < 16384; i += NT) o1[1024 + i] += t2;
    }
#endif
}
extern "C" void kernel_launch(void* const* d_in, const int* in_sizes, int n_in, void* d_out, int out_size, void* d_ws, size_t ws_size, hipStream_t stream) {
    static int grid = 0;
    if (grid == 0) {
        int dev = 0, cus = 0, per = 0;
        (void)hipGetDevice(&dev); (void)hipDeviceGetAttribute(&cus, hipDeviceAttributeMultiprocessorCount, dev);
        (void)hipFuncSetAttribute((const void*)fwd_mega, hipFuncAttributeMaxDynamicSharedMemorySize, LDS_BYTES);
        (void)hipOccupancyMaxActiveBlocksPerMultiprocessor(&per, (const void*)fwd_mega, NT, LDS_BYTES);
        if (per < 1) per = 1;
        grid = cus * per;
        fprintf(stderr, "kernel_launch: grid %d (cus %d x %d), ws %zu need %zu\n", grid, cus, per, ws_size, (size_t)WS_NEED);
        if (n_in != 23 || ws_size < WS_NEED) { fprintf(stderr, "kernel_launch: bad inputs / workspace too small\n"); grid = -1; }
    }
    if (grid < 0) return;
    Args a{};
    for (int i = 0; i < 23; ++i) a.in[i] = (const float*)d_in[i];
    a.out = (float*)d_out; a.ws = (unsigned char*)d_ws; a.ph_lo = 0; a.ph_hi = 0;
    void* kargs[] = {&a};
    hipError_t e = hipLaunchCooperativeKernel((const void*)fwd_mega, dim3(grid), dim3(NT), kargs, LDS_BYTES, stream);
    if (e != hipSuccess) fprintf(stderr, "kernel_launch: cooperative launch failed: %s\n", hipGetErrorString(e));
}
```

```cpp
#include <hip/hip_runtime.h>
#include <hip/hip_cooperative_groups.h>
#include <cstdio>
#include <cstdint>
namespace cg = cooperative_groups;
namespace pg8 {
#define PG8_LAS __attribute__((address_space(3)))
typedef unsigned short bf16_t;
typedef short bf16x8 __attribute__((ext_vector_type(8)));
typedef float f32x4 __attribute__((ext_vector_type(4)));
typedef unsigned u32x4 __attribute__((ext_vector_type(4)));
constexpr int BM = 256, BK = 64, HALF = 128, HTB = HALF * BK * 2  , STAGE_BYTES = 8 * HTB, NXCD = 8, WGM = 8;

__host__ __device__ __forceinline__ int lds_byte(int r, int c) { const int st = (r >> 4) * 2 + (c >> 5), rr = r & 15, cc = c & 31, ob = rr * 64 + cc * 2; return st * 1024 + (ob ^ (((ob >> 9) & 1) << 5)); }
__host__ __device__ __forceinline__ void stage_rc(int b, int& R, int& C) { const int st = b / 1024, sb = b % 1024, swz = sb ^ (((sb >> 9) & 1) << 5); R = (st >> 1) * 16 + swz / 64; C = (st & 1) * 32 + (swz % 64) / 2; }
__host__ __device__ __forceinline__ int perm32(int rho) { const int n = rho >> 4, i = rho & 15; return 8 * (i >> 2) + 4 * n + (i & 3); }

struct Unit { int pm, pn; };
struct Gemm { const bf16_t* A; const bf16_t* Bt; int M, N, K; int arows; };

struct StaticOrder {
    int nM, nN, nwg, G, c;
    __host__ __device__ void init(int M, int N, int G_, int c_) { nM = M / BM; nN = N / BM; nwg = nM * nN; G = G_; c = c_; }
    __host__ __device__ bool next(int i, Unit& u) const {
        const long L = (long)i * G + c; if (L >= nwg) return false;
        int wgid = (int)L; { const int q = nwg / NXCD, r = nwg % NXCD, xcd = wgid % NXCD, off = wgid / NXCD; wgid = (xcd < r ? xcd * (q + 1) : r * (q + 1) + (xcd - r) * q) + off; }
        const int nig = WGM * nN, gid = wgid / nig, fm = gid * WGM, gsz = (nM - fm) < WGM ? (nM - fm) : WGM;
        u.pm = fm + ((wgid % nig) % gsz); u.pn = (wgid % nig) / gsz; return true;
    }
    __device__ __forceinline__ void a_ready(const Unit&) const {}
    __device__ __forceinline__ void done(const Unit&) const {}
};

__device__ __forceinline__ unsigned cvt_pk_bf16(float lo, float hi) { unsigned r; asm volatile("v_cvt_pk_bf16_f32 %0, %1, %2" : "=v"(r) : "v"(lo), "v"(hi)); return r; }
typedef float f32x2 __attribute__((ext_vector_type(2)));
__device__ __forceinline__ f32x2 gelu_pk(f32x2 v) {
    const f32x2 av = __builtin_elementwise_abs(v), d = av * 0.2316418882f + 1.0f;
    f32x2 t; t.x = __builtin_amdgcn_rcpf(d.x); t.y = __builtin_amdgcn_rcpf(d.y);
    f32x2 q = t * 0.5307027145f + (-0.7265760135f); q = q * t + 0.7107068705f; q = q * t + (-0.142248368f); q = q * t + 0.127414796f; q = q * t;
    const f32x2 s = (v * v) * (-0.72134752044f);
    f32x2 e; e.x = __builtin_amdgcn_exp2f(s.x); e.y = __builtin_amdgcn_exp2f(s.y);
    const f32x2 m = v * (q * e), r = v - m;
    f32x2 o; o.x = v.x < 0.f ? m.x : r.x; o.y = v.y < 0.f ? m.y : r.y; return o;
}

template <int ACT  > struct EpiBf16 {
    static constexpr bool PERM = true, AFTER_DRAIN = false; static_assert(ACT == 0 || ACT == 1, "EpiBf16: ACT is 0 (none) or 1 (gelu_pk)");
    bf16_t* O; int ldc; const float* bias; int split_cols; size_t split_stride; float scale0;
    __device__ __forceinline__ void operator()(const f32x4 (&acc)[2][2][4][2], const Unit& u, int wr, int wc, int fr, int fq) const {
        const int row0 = u.pm * BM + wr * 64 + fr; int colt = u.pn * BM; bf16_t* base = O;
        float sc = 1.f; if (split_cols) { const int t = colt / split_cols; base += (size_t)t * split_stride; colt -= t * split_cols; if (t == 0) sc = scale0; }
        const int col0 = colt + wc * 32 + 8 * fq, bcol0 = u.pn * BM + wc * 32 + 8 * fq;
        f32x4 bv[2][2];
#pragma unroll
        for (int bj = 0; bj < 2; ++bj)
#pragma unroll
            for (int n = 0; n < 2; ++n) bv[bj][n] = bias ? *(const f32x4*)(bias + bcol0 + bj * HALF + 4 * n) : (f32x4){0.f, 0.f, 0.f, 0.f};
#pragma unroll
        for (int ai = 0; ai < 2; ++ai)
#pragma unroll
            for (int m = 0; m < 4; ++m) { bf16_t* rowp = base + (size_t)(row0 + ai * HALF + m * 16) * ldc + col0;
#pragma unroll
                for (int bj = 0; bj < 2; ++bj) { f32x4 v0 = acc[ai][bj][m][0] + bv[bj][0], v1 = acc[ai][bj][m][1] + bv[bj][1];
                    if (ACT == 1) { f32x2 a = gelu_pk((f32x2){v0[0], v0[1]}), b = gelu_pk((f32x2){v0[2], v0[3]}), c = gelu_pk((f32x2){v1[0], v1[1]}), d = gelu_pk((f32x2){v1[2], v1[3]});
                        v0 = (f32x4){a.x, a.y, b.x, b.y}; v1 = (f32x4){c.x, c.y, d.x, d.y}; }
                    v0 = v0 * sc; v1 = v1 * sc; u32x4 w; w.x = cvt_pk_bf16(v0[0], v0[1]); w.y = cvt_pk_bf16(v0[2], v0[3]); w.z = cvt_pk_bf16(v1[0], v1[1]); w.w = cvt_pk_bf16(v1[2], v1[3]);
                    *(u32x4*)(rowp + bj * HALF) = w; } }
    }
};
template <class Epi, class Sched, bool ALIGN_EPI = false, bool SP2 = false>
__device__ __forceinline__ void gemm_phase(PG8_LAS unsigned char* lds, const Gemm g, const Sched& S, const Epi& E) {
    int tid_ = threadIdx.x; asm volatile("" : "+v"(tid_)); const int tid = tid_, wid = __builtin_amdgcn_readfirstlane(tid >> 6), lane = tid & 63, wr = wid >> 2, wc = wid & 3, fr = lane & 15, fq = lane >> 4;
    int K_ = g.K; asm volatile("" : "+s"(K_)); const int K = K_, nt = K / BK;
    unsigned voffA[2], voffB[2];
#pragma unroll
    for (int i = 0; i < 2; ++i) { int R, C; stage_rc(tid * 16 + i * 8192, R, C); const int Rb = Epi::PERM ? ((R & ~31) + perm32(R & 31)) : R;
        voffA[i] = (unsigned)(R * K + C) * 2u; voffB[i] = (unsigned)(Rb * K + C) * 2u; }
    const size_t kstep = (size_t)(BK * 2);
    const size_t hstep = (size_t)HALF * K * 2;
    const size_t tstep = 2 * hstep; const size_t tstepA = (size_t)g.arows * K * 2;
    const unsigned ldsw = (unsigned)wid * 1024u;
    const int aoff = lds_byte(wr * 64 + fr, fq * 8), boff = lds_byte(wc * 32 + fr, fq * 8);
#define PG8_SA(b, h) (((b) * 2 + (h)) * HTB)
#define PG8_SB(b, h) ((4 + (b) * 2 + (h)) * HTB)
#define PG8_STAGE(bufoff, gbase, voff) do { _Pragma("unroll") for (int _i = 0; _i < 2; ++_i) \
        __builtin_amdgcn_global_load_lds((const unsigned*)((const char*)(gbase) + (voff)[_i]), (PG8_LAS unsigned*)(lds + (bufoff) + ldsw + _i * 8192), 16, 0, 0); } while (0)
#define PG8_LDA(dst, b, h) do { _Pragma("unroll") for (int m = 0; m < 4; ++m) _Pragma("unroll") for (int k = 0; k < 2; ++k) dst[m][k] = *(const PG8_LAS bf16x8*)(lds + PG8_SA(b, h) + aoff + m * 2048 + k * 1024); } while (0)
#define PG8_LDB(dst, b, h) do { _Pragma("unroll") for (int n = 0; n < 2; ++n) _Pragma("unroll") for (int k = 0; k < 2; ++k) dst[n][k] = *(const PG8_LAS bf16x8*)(lds + PG8_SB(b, h) + boff + n * 2048 + k * 1024); } while (0)
#define PG8_MMA(ai, bj, At, Bt) do { __builtin_amdgcn_s_setprio(1); _Pragma("unroll") for (int m = 0; m < 4; ++m) _Pragma("unroll") for (int n = 0; n < 2; ++n) _Pragma("unroll") for (int k = 0; k < 2; ++k) \
        acc[ai][bj][m][n] = __builtin_amdgcn_mfma_f32_16x16x32_bf16(Bt[n][k], At[m][k], acc[ai][bj][m][n], 0, 0, 0); __builtin_amdgcn_s_setprio(0); } while (0)
#define PG8_WAIT_V(n) asm volatile("s_waitcnt vmcnt(" #n ")" ::: "memory")
#define PG8_WAIT_L(n) asm volatile("s_waitcnt lgkmcnt(" #n ")" ::: "memory")
#define PG8_BAR __builtin_amdgcn_s_barrier()
#define PG8_SCHED __builtin_amdgcn_sched_barrier(0)
    Unit cur, nxt; int ui = 0;
    if (!S.next(0, cur)) return;
    f32x4 acc[2][2][4][2];
#pragma unroll
    for (int a = 0; a < 2; ++a)
#pragma unroll
        for (int b = 0; b < 2; ++b)
#pragma unroll
            for (int m = 0; m < 4; ++m)
#pragma unroll
                for (int n = 0; n < 2; ++n) acc[a][b][m][n] = (f32x4){0.f, 0.f, 0.f, 0.f};
    bf16x8 At[4][2], B0[2][2], B1[2][2];
    const char* cA = (const char*)g.A + (size_t)cur.pm * tstepA; const char* cB = (const char*)g.Bt + (size_t)cur.pn * tstep;
    S.a_ready(cur);
    if constexpr (SP2) {
        PG8_STAGE(PG8_SB(0, 0), cB, voffB); PG8_STAGE(PG8_SB(0, 1), cB + hstep, voffB); PG8_STAGE(PG8_SA(0, 0), cA, voffA); PG8_STAGE(PG8_SA(0, 1), cA + hstep, voffA);
        if (wr == 1) PG8_BAR;
        PG8_WAIT_V(2); PG8_BAR;
        PG8_STAGE(PG8_SB(1, 0), cB + kstep, voffB); PG8_STAGE(PG8_SA(1, 0), cA + kstep, voffA); PG8_STAGE(PG8_SB(1, 1), cB + hstep + kstep, voffB);
        PG8_WAIT_V(6); PG8_BAR;
    } else {
        PG8_STAGE(PG8_SB(0, 0), cB, voffB); PG8_STAGE(PG8_SA(0, 0), cA, voffA); PG8_STAGE(PG8_SB(0, 1), cB + hstep, voffB); PG8_STAGE(PG8_SA(0, 1), cA + hstep, voffA);
        if (wr == 1) PG8_BAR;
        PG8_WAIT_V(4); PG8_BAR;
        PG8_STAGE(PG8_SB(1, 0), cB + kstep, voffB); PG8_STAGE(PG8_SA(1, 0), cA + kstep, voffA); PG8_STAGE(PG8_SB(1, 1), cB + hstep + kstep, voffB);
        PG8_WAIT_V(6); PG8_BAR;
    }
    for (;;) {
        const bool has_next = S.next(ui + 1, nxt);
        const char* nA = has_next ? (const char*)g.A + (size_t)nxt.pm * tstepA : cA; const char* nB = has_next ? (const char*)g.Bt + (size_t)nxt.pn * tstep : cB;
        for (int t = 0; t < nt; t += 2) {
            const bool last = (t == nt - 2);
            const char* a1 = cA + (size_t)(t + 1) * kstep;
            const char* a2 = last ? nA : cA + (size_t)(t + 2) * kstep; const char* b2 = last ? nB : cB + (size_t)(t + 2) * kstep;
            const char* a3 = a2 + kstep; const char* b3 = b2 + kstep;
            if (last && has_next) S.a_ready(nxt);
            if constexpr (SP2) {
            PG8_LDB(B0, 0, 0); PG8_LDB(B1, 0, 1); PG8_SCHED; PG8_LDA(At, 0, 0); PG8_STAGE(PG8_SA(1, 1), a1 + hstep, voffA);
            PG8_WAIT_V(8); PG8_WAIT_L(0); PG8_BAR; PG8_MMA(0, 0, At, B0); PG8_MMA(0, 1, At, B1); PG8_BAR; PG8_SCHED;
            PG8_LDA(At, 0, 1); PG8_STAGE(PG8_SB(0, 0), b2, voffB); PG8_STAGE(PG8_SB(0, 1), b2 + hstep, voffB); PG8_STAGE(PG8_SA(0, 0), a2, voffA);
            PG8_WAIT_V(8); PG8_WAIT_L(0); PG8_BAR; PG8_MMA(1, 0, At, B0); PG8_MMA(1, 1, At, B1); PG8_BAR; PG8_SCHED;
            PG8_LDB(B0, 1, 0); PG8_LDB(B1, 1, 1); PG8_SCHED; PG8_LDA(At, 1, 0); PG8_STAGE(PG8_SA(0, 1), a2 + hstep, voffA);
            PG8_WAIT_V(8); PG8_WAIT_L(0); PG8_BAR; PG8_MMA(0, 0, At, B0); PG8_MMA(0, 1, At, B1); PG8_BAR; PG8_SCHED;
            PG8_LDA(At, 1, 1); PG8_STAGE(PG8_SB(1, 0), b3, voffB); PG8_STAGE(PG8_SB(1, 1), b3 + hstep, voffB); PG8_STAGE(PG8_SA(1, 0), a3, voffA);
            PG8_WAIT_V(8); PG8_WAIT_L(0); PG8_BAR; PG8_MMA(1, 0, At, B0); PG8_MMA(1, 1, At, B1); PG8_BAR; PG8_SCHED;
            } else {
            PG8_LDB(B0, 0, 0); PG8_SCHED; PG8_LDA(At, 0, 0); PG8_STAGE(PG8_SA(1, 1), a1 + hstep, voffA);
            PG8_WAIT_L(8); PG8_BAR; PG8_WAIT_L(0); PG8_MMA(0, 0, At, B0); PG8_BAR; PG8_SCHED;
            PG8_LDB(B1, 0, 1); PG8_STAGE(PG8_SB(0, 0), b2, voffB);
            PG8_BAR; PG8_WAIT_L(0); PG8_MMA(0, 1, At, B1); PG8_BAR;
            PG8_LDA(At, 0, 1); PG8_STAGE(PG8_SA(0, 0), a2, voffA);
            PG8_BAR; PG8_WAIT_L(0); PG8_MMA(1, 0, At, B0); PG8_BAR; PG8_SCHED;
            PG8_STAGE(PG8_SB(0, 1), b2 + hstep, voffB);
            PG8_WAIT_V(6); PG8_BAR; PG8_MMA(1, 1, At, B1); PG8_BAR;
            PG8_LDB(B0, 1, 0); PG8_SCHED; PG8_LDA(At, 1, 0); PG8_STAGE(PG8_SA(0, 1), a2 + hstep, voffA);
            PG8_WAIT_L(8); PG8_BAR; PG8_WAIT_L(0); PG8_MMA(0, 0, At, B0); PG8_BAR; PG8_SCHED;
            PG8_LDB(B1, 1, 1); PG8_STAGE(PG8_SB(1, 0), b3, voffB);
            PG8_BAR; PG8_WAIT_L(0); PG8_MMA(0, 1, At, B1); PG8_BAR;
            PG8_LDA(At, 1, 1); PG8_STAGE(PG8_SA(1, 0), a3, voffA);
            PG8_BAR; PG8_WAIT_L(0); PG8_MMA(1, 0, At, B0); PG8_BAR; PG8_SCHED;
            PG8_STAGE(PG8_SB(1, 1), b3 + hstep, voffB);
            PG8_WAIT_V(6); PG8_BAR; PG8_MMA(1, 1, At, B1); PG8_BAR;
            }
        }
        if constexpr (ALIGN_EPI) { if (wr == 0) PG8_BAR; }
        if constexpr (!Epi::AFTER_DRAIN) { E(acc, cur, wr, wc, fr, fq); S.done(cur); }
        if (!has_next) break;
#pragma unroll
        for (int a = 0; a < 2; ++a)
#pragma unroll
            for (int b = 0; b < 2; ++b)
#pragma unroll
                for (int m = 0; m < 4; ++m)
#pragma unroll
                    for (int n = 0; n < 2; ++n) acc[a][b][m][n] = (f32x4){0.f, 0.f, 0.f, 0.f};
        cur = nxt; cA = nA; cB = nB; ++ui;
        if constexpr (ALIGN_EPI) { if (wr == 1) PG8_BAR; }
    }
    PG8_WAIT_V(0);
    if constexpr (!ALIGN_EPI) { if (wr == 0) PG8_BAR; }
    PG8_BAR;
    if constexpr (Epi::AFTER_DRAIN) { E.fused(acc, cur, wr, wc, fr, fq, lds, wid, lane); S.done(cur); }
#undef PG8_SA
#undef PG8_SB
#undef PG8_STAGE
#undef PG8_LDA
#undef PG8_LDB
#undef PG8_MMA
#undef PG8_WAIT_V
#undef PG8_WAIT_L
#undef PG8_BAR
#undef PG8_SCHED
}
}
typedef unsigned short bf16_t;
typedef short bf16x8 __attribute__((ext_vector_type(8)));
typedef float f32x4 __attribute__((ext_vector_type(4)));
typedef float f32x2 __attribute__((ext_vector_type(2)));
typedef float f32x16 __attribute__((ext_vector_type(16)));
typedef unsigned u32x4 __attribute__((ext_vector_type(4)));
typedef unsigned u32x2 __attribute__((ext_vector_type(2)));
#define LAS __attribute__((address_space(3)))
constexpr int DM = 1024, CH = 16384, NCHUNK = 3, DEPTH = 4, PLE = 256, DFF = 2816;
constexpr int EV_IN = 7168, OD_IN = 3104, OD_INP = 3328;
constexpr float EPS = 1e-6f;
constexpr int NT = 512, NWV = 8;
constexpr int LDS_BYTES = 147456;
constexpr size_t al256(size_t x) { return (x + 255) & ~(size_t)255; }
constexpr size_t W_EVIN = 65536;
constexpr size_t W_EVOUT = W_EVIN + (size_t)2 * EV_IN * DM * 2;
constexpr size_t W_ODIN = W_EVOUT + (size_t)2 * DM * DM * 2;
constexpr size_t W_ODOUT = W_ODIN + (size_t)2 * OD_INP * DM * 2;
constexpr size_t W_UP = W_ODOUT + (size_t)2 * DM * DM * 2;
constexpr size_t W_DOWN = W_UP + (size_t)4 * 2 * DFF * DM * 2;
constexpr size_t W_GATE = W_DOWN + (size_t)4 * DM * DFF * 2;
constexpr size_t W_PROJ = W_GATE + (size_t)4 * DM * DM * 2;
constexpr size_t W_LB = W_PROJ + (size_t)4 * DM * PLE * 2;
constexpr size_t B_PB = W_LB + 8192;
constexpr size_t B_HB0 = B_PB + (size_t)CH * PLE * 2;
constexpr size_t B_HB1 = B_HB0 + (size_t)CH * DM * 2;
constexpr size_t B_SSQ0 = B_HB1 + (size_t)CH * DM * 2;
constexpr size_t B_SSQ1 = B_SSQ0 + (size_t)CH * 16 * 4;
constexpr size_t ARENA = B_SSQ1 + (size_t)CH * 16 * 4;
constexpr size_t A_U = 0;
constexpr size_t A_QT = (size_t)CH * EV_IN * 2;
constexpr size_t A_KT = A_QT + (size_t)2 * CH * 512 * 2;
constexpr size_t A_MIX = A_QT;
constexpr size_t A_OEV = A_KT + (size_t)2 * CH * 512 * 2;
constexpr size_t A_VFOD = (size_t)CH * OD_INP * 2;
constexpr size_t A_OOD = A_OEV;
constexpr size_t A_OG = A_OEV + (size_t)2 * CH * 512 * 4;
constexpr size_t A_LSE = A_OG + (size_t)3 * CH * 512 * 2;
constexpr size_t A_DEC = A_OOD + (size_t)2 * CH * 1024 * 4;
constexpr size_t ARENA_BYTES = A_DEC + (size_t)512 * 4 * 2 * 128 * 4;
constexpr size_t A_UF = 0;
constexpr size_t A_ACT = (size_t)CH * 2 * DFF * 2;
constexpr size_t A_PP = 0;
constexpr size_t WS_NEED = ARENA + ARENA_BYTES;
static_assert(A_LSE + (size_t)3 * CH * 4 * 4 <= A_DEC, "even bufs before DEC");
static_assert(A_VFOD + (size_t)CH * 1024 * 2 * 2 <= A_QT, "odd Vf fits before QT");
static_assert(A_ACT + (size_t)CH * DFF * 2 <= ARENA_BYTES, "act fits");

__device__ __forceinline__ float bf2f(unsigned short v) { return __uint_as_float(((unsigned)v) << 16); }
__device__ __forceinline__ unsigned pk2(float lo, float hi) { return pg8::cvt_pk_bf16(lo, hi); }
typedef float f32x2_cv __attribute__((ext_vector_type(2))); typedef __bf16 bf16x2_cv __attribute__((ext_vector_type(2)));
__device__ __forceinline__ unsigned pk2s(float lo, float hi) { const f32x2_cv v = {lo, hi}; const bf16x2_cv c = __builtin_convertvector(v, bf16x2_cv); return __builtin_bit_cast(unsigned, c); }
__device__ __forceinline__ float shfl_xor_l(float v, int lane, int m) { return __builtin_bit_cast(float, __builtin_amdgcn_ds_bpermute((lane ^ m) << 2, __builtin_bit_cast(int, v))); }
__device__ __forceinline__ float wave_sum(float v, int lane) {
#pragma unroll
    for (int o = 1; o < 64; o <<= 1) v += shfl_xor_l(v, lane, o);
    return v;
}
__device__ __forceinline__ float rstd_of(const float* ssq, int row) {
    const f32x4* p = (const f32x4*)(ssq + (size_t)row * 16);
    const f32x4 a = p[0], b = p[1], c = p[2], d = p[3];
    const float s = ((a.x + a.y) + (a.z + a.w)) + ((b.x + b.y) + (b.z + b.w)) + ((c.x + c.y) + (c.z + c.w)) + ((d.x + d.y) + (d.z + d.w));
    return rsqrtf(s * (1.0f / DM) + EPS);
}
struct EpiScale {
    static constexpr bool PERM = true, AFTER_DRAIN = false;
    bf16_t* O; int ldc; const float* ssq;
    __device__ __forceinline__ void operator()(const f32x4 (&acc)[2][2][4][2], const pg8::Unit& u, int wr, int wc, int fr, int fq) const {
        const int row0 = u.pm * 256 + wr * 64 + fr, col0 = u.pn * 256 + wc * 32 + 8 * fq;
#pragma unroll
        for (int ai = 0; ai < 2; ++ai)
#pragma unroll
            for (int m = 0; m < 4; ++m) {
                const int row = row0 + ai * 128 + m * 16; const float rs = rstd_of(ssq, row);
                bf16_t* rp = O + (size_t)row * ldc + col0;
#pragma unroll
                for (int bj = 0; bj < 2; ++bj) { const f32x4 v0 = acc[ai][bj][m][0] * rs, v1 = acc[ai][bj][m][1] * rs;
                    u32x4 w; w.x = pk2(v0[0], v0[1]); w.y = pk2(v0[2], v0[3]); w.z = pk2(v1[0], v1[1]); w.w = pk2(v1[2], v1[3]);
                    *(u32x4*)(rp + bj * 128) = w; }
            }
    }
};
struct EpiF32 {
    static constexpr bool PERM = true, AFTER_DRAIN = false;
    bf16_t* O; int ldc;
    __device__ __forceinline__ void operator()(const f32x4 (&acc)[2][2][4][2], const pg8::Unit& u, int wr, int wc, int fr, int fq) const {
        const int row0 = u.pm * 256 + wr * 64 + fr, col0 = u.pn * 256 + wc * 32 + 8 * fq;
#pragma unroll
        for (int ai = 0; ai < 2; ++ai)
#pragma unroll
            for (int m = 0; m < 4; ++m) { bf16_t* rp = O + (size_t)(row0 + ai * 128 + m * 16) * ldc + col0;
#pragma unroll
                for (int bj = 0; bj < 2; ++bj) { const f32x4 v0 = acc[ai][bj][m][0], v1 = acc[ai][bj][m][1];
                    u32x4 w; w.x = pk2s(v0[0], v0[1]); w.y = pk2s(v0[2], v0[3]); w.z = pk2s(v1[0], v1[1]); w.w = pk2s(v1[2], v1[3]);
                    *(u32x4*)(rp + bj * 128) = w; } }
    }
};
template <int MODE  > struct EpiResid {
    static constexpr bool PERM = true, AFTER_DRAIN = false;
    float* h; bf16_t* hb; float* ssq_out; const float* ssq_in; const bf16_t* pp;
    __device__ __forceinline__ void operator()(const f32x4 (&acc)[2][2][4][2], const pg8::Unit& u, int wr, int wc, int fr, int fq) const {
        const int row0 = u.pm * 256 + wr * 64 + fr, col0 = u.pn * 256 + wc * 32 + 8 * fq;
#pragma unroll
        for (int ai = 0; ai < 2; ++ai)
#pragma unroll
            for (int m = 0; m < 4; ++m) {
                const int row = row0 + ai * 128 + m * 16; float rs = 1.f; if (MODE == 1) rs = rstd_of(ssq_in, row);
                float* hp = h + (size_t)row * DM + col0; bf16_t* bp = hb + (size_t)row * DM + col0; float s = 0.f;
#pragma unroll
                for (int bj = 0; bj < 2; ++bj) {
                    f32x4 a0 = acc[ai][bj][m][0], a1 = acc[ai][bj][m][1];
                    if (MODE == 1) { const u32x4 pw = *(const u32x4*)(pp + (size_t)row * DM + col0 + bj * 128);
                        const f32x4 p0 = {__uint_as_float(pw.x << 16), __uint_as_float(pw.x & 0xffff0000u), __uint_as_float(pw.y << 16), __uint_as_float(pw.y & 0xffff0000u)};
                        const f32x4 p1 = {__uint_as_float(pw.z << 16), __uint_as_float(pw.z & 0xffff0000u), __uint_as_float(pw.w << 16), __uint_as_float(pw.w & 0xffff0000u)};
#pragma unroll
                        for (int e = 0; e < 4; ++e) { a0[e] = p0[e] / (1.f + __expf(-a0[e] * rs)); a1[e] = p1[e] / (1.f + __expf(-a1[e] * rs)); } }
                    const f32x4 h0 = *(const f32x4*)(hp + bj * 128) + a0, h1 = *(const f32x4*)(hp + bj * 128 + 4) + a1;
                    *(f32x4*)(hp + bj * 128) = h0; *(f32x4*)(hp + bj * 128 + 4) = h1;
                    u32x4 w; w.x = pk2(h0[0], h0[1]); w.y = pk2(h0[2], h0[3]); w.z = pk2(h1[0], h1[1]); w.w = pk2(h1[2], h1[3]);
                    *(u32x4*)(bp + bj * 128) = w;
                    s += (h0[0] * h0[0] + h0[1] * h0[1]) + (h0[2] * h0[2] + h0[3] * h0[3]) + (h1[0] * h1[0] + h1[1] * h1[1]) + (h1[2] * h1[2] + h1[3] * h1[3]);
                }
                { const int ln_ = fq * 16 + fr; s += shfl_xor_l(s, ln_, 16); s += shfl_xor_l(s, ln_, 32); }
                if (fq == 0) ssq_out[(size_t)row * 16 + u.pn * 4 + wc] = s;
            }
    }
};

struct EpiConv {
    static constexpr bool PERM = true, AFTER_DRAIN = false;
    bf16_t* act; const float* ssq; const float* cw; const float* cb; int T; LAS float* halo;
    __device__ __forceinline__ void operator()(f32x4 (&acc)[2][2][4][2], const pg8::Unit& u, int wr, int wc, int fr, int fq) const {
        const int g0 = 254 * u.pm - 1, lane = fq * 16 + fr;
#pragma unroll
        for (int ai = 0; ai < 2; ++ai)
#pragma unroll
            for (int m = 0; m < 4; ++m) { const float rs = rstd_of(ssq, g0 + ai * 128 + wr * 64 + m * 16 + fr);
#pragma unroll
                for (int bj = 0; bj < 2; ++bj) { acc[ai][bj][m][0] = acc[ai][bj][m][0] * rs; acc[ai][bj][m][1] = acc[ai][bj][m][1] * rs; } }
#pragma unroll
        for (int ai = 0; ai < 2; ++ai) { const int s = 2 * ai + wr;
            if (fr == 0) {
#pragma unroll
                for (int bj = 0; bj < 2; ++bj)
#pragma unroll
                    for (int n = 0; n < 2; ++n) *(LAS f32x4*)(halo + ((((wc * 4 + s) * 2 + 0) * 2 + bj) * 32) + 8 * fq + 4 * n) = acc[ai][bj][0][n]; }
            if (fr == 15) {
#pragma unroll
                for (int bj = 0; bj < 2; ++bj)
#pragma unroll
                    for (int n = 0; n < 2; ++n) *(LAS f32x4*)(halo + ((((wc * 4 + s) * 2 + 1) * 2 + bj) * 32) + 8 * fq + 4 * n) = acc[ai][bj][3][n]; } }
        asm volatile("s_waitcnt lgkmcnt(0)" ::: "memory"); __builtin_amdgcn_s_barrier(); asm volatile("" ::: "memory");
#pragma unroll
        for (int n = 0; n < 2; ++n) {
            const int ca = u.pn * 128 + wc * 32 + 8 * fq + 4 * n;
            f32x4 w0[2], w1[2], w2[2], bb[2];
#pragma unroll
            for (int bj = 0; bj < 2; ++bj) { const int c = bj * DFF + ca;
                w0[bj] = *(const f32x4*)(cw + c); w1[bj] = *(const f32x4*)(cw + 2 * DFF + c); w2[bj] = *(const f32x4*)(cw + 4 * DFF + c); bb[bj] = *(const f32x4*)(cb + c); }
#pragma unroll
            for (int ai = 0; ai < 2; ++ai) { const int s = 2 * ai + wr;
#pragma unroll
                for (int m = 0; m < 4; ++m) {
                    const int lr = ai * 128 + wr * 64 + m * 16 + fr, g = g0 + lr; const bool tp = (g & (T - 1)) != 0, tn = ((g + 1) & (T - 1)) != 0;
                    f32x4 ph[2] = {{0.f, 0.f, 0.f, 0.f}, {0.f, 0.f, 0.f, 0.f}}, nh[2] = {{0.f, 0.f, 0.f, 0.f}, {0.f, 0.f, 0.f, 0.f}};
                    if (m == 0 && s > 0) {
#pragma unroll
                        for (int bj = 0; bj < 2; ++bj) ph[bj] = *(const LAS f32x4*)(halo + ((((wc * 4 + s - 1) * 2 + 1) * 2 + bj) * 32) + 8 * fq + 4 * n); }
                    if (m == 3 && s < 3) {
#pragma unroll
                        for (int bj = 0; bj < 2; ++bj) nh[bj] = *(const LAS f32x4*)(halo + ((((wc * 4 + s + 1) * 2 + 0) * 2 + bj) * 32) + 8 * fq + 4 * n); }
                    float cv[2][4];
#pragma unroll
                    for (int bj = 0; bj < 2; ++bj)
#pragma unroll
                        for (int e = 0; e < 4; ++e) {
                            const float cur = acc[ai][bj][m][n][e];
                            const float sp_ = (fr == 15) ? (m > 0 ? acc[ai][bj][m > 0 ? m - 1 : 0][n][e] : ph[bj][e]) : cur;
                            const float sn_ = (fr == 0) ? (m < 3 ? acc[ai][bj][m < 3 ? m + 1 : 3][n][e] : nh[bj][e]) : cur;
                            const float pv = __builtin_bit_cast(float, __builtin_amdgcn_update_dpp(0, __builtin_bit_cast(int, sp_), 0x121, 0xf, 0xf, false));
                            const float nv = __builtin_bit_cast(float, __builtin_amdgcn_update_dpp(0, __builtin_bit_cast(int, sn_), 0x12F, 0xf, 0xf, false));
                            float t_ = fmaf(cur, w1[bj][e], bb[bj][e]); t_ = tp ? fmaf(pv, w0[bj][e], t_) : t_; t_ = tn ? fmaf(nv, w2[bj][e], t_) : t_; cv[bj][e] = t_;
                        }
                    const f32x2 g01 = pg8::gelu_pk((f32x2){cv[1][0], cv[1][1]}), g23 = pg8::gelu_pk((f32x2){cv[1][2], cv[1][3]});
                    if (lr >= 1 && lr <= 254 && g < CH) { u32x2 w; w.x = pk2(cv[0][0] * g01.x, cv[0][1] * g01.y); w.y = pk2(cv[0][2] * g23.x, cv[0][3] * g23.y);
                        *(u32x2*)(act + (size_t)g * DFF + ca) = w; }
                    __builtin_amdgcn_sched_barrier(0);
                }
            }
            asm volatile("" ::: "memory");
        }
    }
};
struct Args {
    const float* in[23]; float* out; unsigned char* ws; int ph_lo, ph_hi;
};
enum { I_XP = 0, I_XS, I_PP, I_PS, I_NMIX, I_EVIN, I_LBL, I_HNORM, I_EVOUT, I_ODIN, I_GUP, I_GB, I_GNORM, I_ODOUT, I_NFFN, I_FUP, I_CW, I_CB, I_FDOWN, I_NPLE, I_PGATE, I_PPROJ, I_NOUT };

struct Ctx {
    LAS unsigned char* lds; int tid, lane, wave, G, bid;
    const Args* a; unsigned char* ws;
};

__device__ __forceinline__ void titem_load(const float* W, int K, int N, const float* gk, int item, int lane, float (&v)[32]) {
    const int nblk = N / 32, kb = item / nblk, nb = item % nblk, k0 = 64 * kb, n0 = 32 * nb;
#pragma unroll
    for (int i = 0; i < 32; ++i) { const int kk = 2 * i + (lane >> 5); v[i] = W[(size_t)(k0 + kk) * N + n0 + (lane & 31)]; }
    if (gk) {
#pragma unroll
        for (int i = 0; i < 32; ++i) v[i] *= gk[k0 + 2 * i + (lane >> 5)]; }
}
__device__ __forceinline__ void titem_store(int K, int N, bf16_t* WT, LAS float* scr, int item, int lane, bool remap, const float (&v)[32]) {
    const int nblk = N / 32, kb = item / nblk, nb = item % nblk, k0 = 64 * kb, n0 = 32 * nb;
#pragma unroll
    for (int i = 0; i < 32; ++i) scr[(2 * i + (lane >> 5)) * 33 + (lane & 31)] = v[i];
    asm volatile("s_waitcnt lgkmcnt(0)" ::: "memory");
    const int c = lane & 7;
#pragma unroll
    for (int j = 0; j < 4; ++j) { const int n = (lane >> 3) + 8 * j; const LAS float* s = scr + (8 * c) * 33 + n;
        u32x4 o; o.x = pk2(s[0 * 33], s[1 * 33]); o.y = pk2(s[2 * 33], s[3 * 33]); o.z = pk2(s[4 * 33], s[5 * 33]); o.w = pk2(s[6 * 33], s[7 * 33]);
        int nr = n0 + n; if (remap) nr = (nr < DFF) ? (((nr >> 7) << 8) + (nr & 127)) : ((((nr - DFF) >> 7) << 8) + 128 + ((nr - DFF) & 127));
        *(u32x4*)(WT + (size_t)nr * K + k0 + 8 * c) = o; }
    asm volatile("s_waitcnt lgkmcnt(0)" ::: "memory");
}
__device__ __forceinline__ void weights_prologue(const Ctx& C) {
    LAS float* scr = (LAS float*)(C.lds + C.wave * 8704);
    const int gw = C.bid * NWV + C.wave, NGW = C.G * NWV;
    const Args& a = *C.a;
    for (int mat = 0; mat < 24; ++mat) {
        const float* W; const float* g = nullptr; bf16_t* WT; int K, N;
        if (mat < 2)       { const int e = mat;      W = a.in[I_EVIN] + (size_t)e * DM * EV_IN;  K = DM; N = EV_IN; g = a.in[I_NMIX] + (2 * e) * DM;     WT = (bf16_t*)(C.ws + W_EVIN) + (size_t)e * EV_IN * DM; }
        else if (mat < 4)  { const int e = mat - 2;  W = a.in[I_EVOUT] + (size_t)e * DM * DM;    K = DM; N = DM;                                        WT = (bf16_t*)(C.ws + W_EVOUT) + (size_t)e * DM * DM; }
        else if (mat < 6)  { const int o = mat - 4;  W = a.in[I_ODIN] + (size_t)o * DM * OD_IN;  K = DM; N = OD_IN; g = a.in[I_NMIX] + (2 * o + 1) * DM; WT = (bf16_t*)(C.ws + W_ODIN) + (size_t)o * OD_INP * DM; }
        else if (mat < 8)  { const int o = mat - 6;  W = a.in[I_ODOUT] + (size_t)o * DM * DM;    K = DM; N = DM;                                        WT = (bf16_t*)(C.ws + W_ODOUT) + (size_t)o * DM * DM; }
        else if (mat < 12) { const int l = mat - 8;  W = a.in[I_FUP] + (size_t)l * DM * 2 * DFF; K = DM; N = 2 * DFF; g = a.in[I_NFFN] + l * DM;         WT = (bf16_t*)(C.ws + W_UP) + (size_t)l * 2 * DFF * DM; }
        else if (mat < 16) { const int l = mat - 12; W = a.in[I_FDOWN] + (size_t)l * DFF * DM;   K = DFF; N = DM;                                       WT = (bf16_t*)(C.ws + W_DOWN) + (size_t)l * DM * DFF; }
        else if (mat < 20) { const int l = mat - 16; W = a.in[I_PGATE] + (size_t)l * DM * DM;    K = DM; N = DM; g = a.in[I_NPLE] + l * DM;              WT = (bf16_t*)(C.ws + W_GATE) + (size_t)l * DM * DM; }
        else               { const int l = mat - 20; W = a.in[I_PPROJ] + (size_t)l * PLE * DM;   K = PLE; N = DM;                                       WT = (bf16_t*)(C.ws + W_PROJ) + (size_t)l * DM * PLE; }
        const int nitems = (K / 64) * (N / 32);
        float vc[32], vn[32];
        if (gw < nitems) titem_load(W, K, N, g, gw, C.lane, vc);
        for (int it = gw; it < nitems; it += NGW) {
            const bool more = it + NGW < nitems;
            if (more) titem_load(W, K, N, g, it + NGW, C.lane, vn);
            titem_store(K, N, WT, scr, it, C.lane, mat >= 8 && mat < 12, vc);
            if (more) {
#pragma unroll
                for (int i = 0; i < 32; ++i) vc[i] = vn[i]; }
        }
    }
    { const int gt = C.bid * NT + C.tid, GT = C.G * NT; const int per = (OD_INP - OD_IN) * DM / 8;
      for (int i = gt; i < 2 * per; i += GT) { const int o = i / per, r = i % per; *(u32x4*)((bf16_t*)(C.ws + W_ODIN) + (size_t)o * OD_INP * DM + (size_t)OD_IN * DM + (size_t)r * 8) = (u32x4){0u, 0u, 0u, 0u}; } }
    { const int gt = C.bid * NT + C.tid; if (gt < 1024) { const int dir = gt >> 9, c = gt & 511; const float* L = a.in[I_LBL] + (size_t)dir * 2 * 512;
        float* lb = (float*)(C.ws + W_LB) + dir * 1024; lb[c] = 0.f; lb[512 + c] = 1.f / (1.f + __expf(L[c] - L[512 + c])); } }
}
__device__ __forceinline__ void chunk_prologue(const Ctx& C, int chunk, bf16_t* hb, float* ssq) {
    const int gw = C.bid * NWV + C.wave, NGW = C.G * NWV; const Args& a = *C.a;
    for (int r = gw; r < CH; r += NGW) {
        const size_t R = (size_t)chunk * CH + r;
        const float* xr = (R < 16384) ? a.in[I_XP] + R * DM : a.in[I_XS] + (R - 16384) * DM;
        float* hr = a.out + R * DM; f32x4 v[4]; float s = 0.f;
#pragma unroll
        for (int j = 0; j < 4; ++j) { v[j] = ((const f32x4*)xr)[C.lane + 64 * j]; s += (v[j].x * v[j].x + v[j].y * v[j].y) + (v[j].z * v[j].z + v[j].w * v[j].w); }
        s = wave_sum(s, C.lane);
#pragma unroll
        for (int j = 0; j < 4; ++j) { ((f32x4*)hr)[C.lane + 64 * j] = v[j]; u32x2 w; w.x = pk2(v[j].x, v[j].y); w.y = pk2(v[j].z, v[j].w); ((u32x2*)(hb + (size_t)r * DM))[C.lane + 64 * j] = w; }
        if (C.lane < 16) ssq[(size_t)r * 16 + C.lane] = (C.lane == 0) ? s : 0.f;
    }
}
__device__ __forceinline__ void final_norm(const Ctx& C, int chunk) {
    const int gw = C.bid * NWV + C.wave, NGW = C.G * NWV; const Args& a = *C.a; const float* g = a.in[I_NOUT];
    for (int r = gw; r < CH; r += NGW) {
        float* hr = a.out + ((size_t)chunk * CH + r) * DM; f32x4 v[4]; float s = 0.f;
#pragma unroll
        for (int j = 0; j < 4; ++j) { v[j] = ((const f32x4*)hr)[C.lane + 64 * j]; s += (v[j].x * v[j].x + v[j].y * v[j].y) + (v[j].z * v[j].z + v[j].w * v[j].w); }
        const float rs = rsqrtf(wave_sum(s, C.lane) * (1.f / DM) + EPS);
#pragma unroll
        for (int j = 0; j < 4; ++j) { const f32x4 gg = ((const f32x4*)g)[C.lane + 64 * j]; ((f32x4*)hr)[C.lane + 64 * j] = v[j] * rs * gg; }
    }
}
__device__ __forceinline__ void conv_phase(const Ctx& C, int chunk, int l, int T) {
    const Args& a = *C.a;
    const bf16_t* UF = (const bf16_t*)(C.ws + ARENA + A_UF); bf16_t* ACT = (bf16_t*)(C.ws + ARENA + A_ACT);
    const float* cw = a.in[I_CW] + (size_t)l * 3 * 2 * DFF; const float* cb = a.in[I_CB] + (size_t)l * 2 * DFF;
    {
        const int ry = C.tid >> 5, cx = C.tid & 31;
        for (int tile = C.bid; tile < (CH / 64) * 11; tile += C.G) {
            const int rt = tile / 11, ct = tile % 11; const int r0 = rt * 64 + ry * 4, c0 = ct * 256 + cx * 8;
            float wa0[8], wa1[8], wa2[8], wg0[8], wg1[8], wg2[8], ba[8], bg[8];
#pragma unroll
            for (int e = 0; e < 8; e += 4) { *(f32x4*)(wa0 + e) = *(const f32x4*)(cw + c0 + e); *(f32x4*)(wa1 + e) = *(const f32x4*)(cw + 2 * DFF + c0 + e); *(f32x4*)(wa2 + e) = *(const f32x4*)(cw + 4 * DFF + c0 + e);
                *(f32x4*)(wg0 + e) = *(const f32x4*)(cw + DFF + c0 + e); *(f32x4*)(wg1 + e) = *(const f32x4*)(cw + 3 * DFF + c0 + e); *(f32x4*)(wg2 + e) = *(const f32x4*)(cw + 5 * DFF + c0 + e);
                *(f32x4*)(ba + e) = *(const f32x4*)(cb + c0 + e); *(f32x4*)(bg + e) = *(const f32x4*)(cb + DFF + c0 + e); }
            bf16x8 ua[6], ug[6];
#pragma unroll
            for (int i = 0; i < 6; ++i) { const int r = r0 - 1 + i; const bool ok = (i == 0) ? ((r0 % T) != 0) : (i == 5 ? (((r0 + 4) % T) != 0) : true);
                if (ok) { ua[i] = *(const bf16x8*)(UF + (size_t)r * 2 * DFF + c0); ug[i] = *(const bf16x8*)(UF + (size_t)r * 2 * DFF + DFF + c0); }
                else { ua[i] = (bf16x8){0, 0, 0, 0, 0, 0, 0, 0}; ug[i] = ua[i]; } }
#pragma unroll
            for (int i = 0; i < 4; ++i) {
                float o[8];
#pragma unroll
                for (int e = 0; e < 8; ++e) {
                    const float av = bf2f((unsigned short)ua[i][e]) * wa0[e] + bf2f((unsigned short)ua[i + 1][e]) * wa1[e] + bf2f((unsigned short)ua[i + 2][e]) * wa2[e] + ba[e];
                    const float gv = bf2f((unsigned short)ug[i][e]) * wg0[e] + bf2f((unsigned short)ug[i + 1][e]) * wg1[e] + bf2f((unsigned short)ug[i + 2][e]) * wg2[e] + bg[e];
                    o[e] = av * (0.5f * gv * (1.f + erff(gv * 0.70710678118f)));
                }
                u32x4 w; w.x = pk2(o[0], o[1]); w.y = pk2(o[2], o[3]); w.z = pk2(o[4], o[5]); w.w = pk2(o[6], o[7]);
                *(u32x4*)(ACT + (size_t)(r0 + i) * DFF + c0) = w;
            }
        }
    }
}
__device__ __forceinline__ void pb_convert(const Ctx& C, int chunk, int l) {
    const Args& a = *C.a;
    { bf16_t* PB = (bf16_t*)(C.ws + B_PB); const int gt = C.bid * NT + C.tid, GT = C.G * NT;
      for (int i = gt; i < CH * PLE / 4; i += GT) { const int r = i / (PLE / 4), c4 = i % (PLE / 4); const size_t R = (size_t)chunk * CH + r;
          const float* src = (R < 16384) ? a.in[I_PP] + ((size_t)l * 16384 + R) * PLE : a.in[I_PS] + ((size_t)l * 32768 + (R - 16384)) * PLE;
          const f32x4 v = ((const f32x4*)src)[c4]; u32x2 w; w.x = pk2(v.x, v.y); w.y = pk2(v.z, v.w); ((u32x2*)(PB + (size_t)r * PLE))[c4] = w; } }
}
struct Mix { int even, li, T, DV, ld, vcol, gcol; float qscale; unsigned char* vf; };
#define MFMA32(a, b, c) __builtin_amdgcn_mfma_f32_32x32x16_bf16((a), (b), (c), 0, 0, 0)
#define QK_IDX(hd, dir, blk, k) (((((size_t)((hd) * 2 + (dir))) * 512 + (size_t)(blk)) * 8 + (k)) * 64)
#define V_IDX(hd, dir, ET, et, blk, sp) ((((((size_t)((hd) * 2 + (dir))) * (ET) + (et)) * 512 + (size_t)(blk)) * 2 + (sp)) * 64)
#define O_IDX(hd, dir, ET, et, blk, q) ((((((size_t)((hd) * 2 + (dir))) * (ET) + (et)) * 512 + (size_t)(blk)) * 4 + (q)) * 64)
#define OB_IDX(hd, dir, ET, et, blk, r) ((((((size_t)((hd) * 2 + (dir))) * (ET) + (et)) * 512 + (size_t)(blk)) * 2 + (r)) * 64)
#define DEC_IDX(hd, dir, blk) ((((size_t)((hd) * 2 + (dir))) * 512 + (size_t)(blk)) * 128)
#define LDSFENCE() asm volatile("s_waitcnt lgkmcnt(0)" ::: "memory")
__device__ __forceinline__ bf16x8 pack8(float a0, float a1, float a2, float a3, float a4, float a5, float a6, float a7) {
    u32x4 w; w.x = pk2(a0, a1); w.y = pk2(a2, a3); w.z = pk2(a4, a5); w.w = pk2(a6, a7); return __builtin_bit_cast(bf16x8, w);
}
__device__ __forceinline__ bf16x8 pack8s(float a0, float a1, float a2, float a3, float a4, float a5, float a6, float a7) {
    u32x4 w; w.x = pk2s(a0, a1); w.y = pk2s(a2, a3); w.z = pk2s(a4, a5); w.w = pk2s(a6, a7); return __builtin_bit_cast(bf16x8, w);
}
__device__ __forceinline__ f32x16 zero16() { f32x16 z;
#pragma unroll
    for (int i = 0; i < 16; ++i) z[i] = 0.f; return z; }

__device__ __forceinline__ void prep_phase(const Ctx& C, const Mix& mx) {
    const Args& a = *C.a;
    const bf16_t* U = (const bf16_t*)(C.ws + ARENA + A_U);
    u32x4* QTf = (u32x4*)(C.ws + ARENA + A_QT); u32x4* KTf = (u32x4*)(C.ws + ARENA + A_KT); u32x4* Vf = (u32x4*)mx.vf;
    f32x4* Of = (f32x4*)(C.ws + ARENA + A_OEV); float* DEC = (float*)(C.ws + ARENA + A_DEC);
    const float* LB = (const float*)(C.ws + W_LB);
    const int hd = C.wave & 3, dir = C.wave >> 2, lane = C.lane, ld = mx.ld, DV = mx.DV;
    LAS float* Bs = (LAS float*)(C.lds + C.wave * 16896);
    for (int b = C.bid; b < CH / 32; b += C.G) {
        int vz_ = 0; asm volatile("" : "+v"(vz_)); const int rb = 32 * b + vz_;
        {
            const int d0 = 2 * lane, col0 = hd * 128 + d0, dt0 = d0 >> 5, dp0 = d0 & 31;
            float bs0 = 0.f, bs1 = 0.f; unsigned zz[32];
            if (mx.even) {
                const f32x2 lb2 = *(const f32x2*)(LB + dir * 1024 + mx.li * 512 + col0); const float om0 = 1.f - lb2.x, om1 = 1.f - lb2.y;
                const bf16_t* zp = U + 512 + 512 * dir + col0;
#pragma unroll
                for (int t = 0; t < 32; ++t) { const int row = rb + (dir ? 31 - t : t);
                    const unsigned zw = *(const unsigned*)(zp + (size_t)row * ld); zz[t] = zw;
                    const float z0 = __uint_as_float(zw << 16), z1 = __uint_as_float(zw & 0xffff0000u);
                    bs0 += fmaxf(__logf(lb2.x + om0 / (1.f + __expf(-z0))), -30.f); bs1 += fmaxf(__logf(lb2.y + om1 / (1.f + __expf(-z1))), -30.f);
                    *(LAS f32x2*)(Bs + t * 132 + d0) = (f32x2){bs0, bs1}; }
                *(f32x2*)(DEC + DEC_IDX(hd, dir, b) + d0) = (f32x2){__expf(bs0), __expf(bs1)};
#pragma unroll
                for (int grp = 0; grp < 4; ++grp) { float k0[8], k1[8];
#pragma unroll
                    for (int j = 0; j < 8; ++j) { const int t = 16 * (grp >> 1) + 8 * (j >> 2) + 4 * (grp & 1) + (j & 3);
                        const float z0 = __uint_as_float(zz[t] << 16), z1 = __uint_as_float(zz[t] & 0xffff0000u); const f32x2 bt = *(const LAS f32x2*)(Bs + t * 132 + d0);
                        k0[j] = om0 / (1.f + __expf(z0)) * __expf(bs0 - bt.x); k1[j] = om1 / (1.f + __expf(z1)) * __expf(bs1 - bt.y); }
                    u32x4 w; w.x = pk2(k0[0], k0[1]); w.y = pk2(k0[2], k0[3]); w.z = pk2(k0[4], k0[5]); w.w = pk2(k0[6], k0[7]);
                    KTf[QK_IDX(hd, dir, b, (grp >> 1) * 4 + dt0) + 32 * (grp & 1) + dp0] = w;
                    w.x = pk2(k1[0], k1[1]); w.y = pk2(k1[2], k1[3]); w.z = pk2(k1[4], k1[5]); w.w = pk2(k1[6], k1[7]);
                    KTf[QK_IDX(hd, dir, b, (grp >> 1) * 4 + dt0) + 32 * (grp & 1) + dp0 + 1] = w; }
            } else {
                float Wg0[16], Wg1[16]; const float* wp = a.in[I_GUP] + ((size_t)(mx.li * 2 + dir) * 16) * 512 + col0;
#pragma unroll
                for (int r = 0; r < 16; ++r) { const f32x2 w2 = *(const f32x2*)(wp + r * 512); Wg0[r] = w2.x; Wg1[r] = w2.y; }
                const f32x2 bias = *(const f32x2*)(a.in[I_GB] + (mx.li * 2 + dir) * 512 + col0);
#pragma unroll
                for (int t = 0; t < 32; ++t) { const int row = rb + (dir ? 31 - t : t);
                    const u32x4 l0 = *(const u32x4*)(U + (size_t)row * ld + 3072 + 16 * dir), l1 = *(const u32x4*)(U + (size_t)row * ld + 3072 + 16 * dir + 8);
                    zz[t] = *(const unsigned*)(U + (size_t)row * ld + 512 + col0);
                    float x0 = bias.x, x1 = bias.y;
#pragma unroll
                    for (int w = 0; w < 4; ++w) { const float a0 = __uint_as_float(l0[w] << 16), a1 = __uint_as_float(l0[w] & 0xffff0000u), c0 = __uint_as_float(l1[w] << 16), c1 = __uint_as_float(l1[w] & 0xffff0000u);
                        x0 += a0 * Wg0[2 * w] + a1 * Wg0[2 * w + 1] + c0 * Wg0[8 + 2 * w] + c1 * Wg0[8 + 2 * w + 1];
                        x1 += a0 * Wg1[2 * w] + a1 * Wg1[2 * w + 1] + c0 * Wg1[8 + 2 * w] + c1 * Wg1[8 + 2 * w + 1]; }
                    bs0 += fmaxf((fminf(x0, 0.f) - log1pf(__expf(-fabsf(x0)))) * (1.f / 16.f), -30.f); bs1 += fmaxf((fminf(x1, 0.f) - log1pf(__expf(-fabsf(x1)))) * (1.f / 16.f), -30.f);
                    *(LAS f32x2*)(Bs + t * 132 + d0) = (f32x2){bs0, bs1}; }
                *(f32x2*)(DEC + DEC_IDX(hd, dir, b) + d0) = (f32x2){__expf(bs0), __expf(bs1)};
#pragma unroll
                for (int grp = 0; grp < 4; ++grp) { float k0[8], k1[8];
#pragma unroll
                    for (int j = 0; j < 8; ++j) { const int t = 16 * (grp >> 1) + 8 * (j >> 2) + 4 * (grp & 1) + (j & 3); const f32x2 bt = *(const LAS f32x2*)(Bs + t * 132 + d0);
                        k0[j] = __uint_as_float(zz[t] << 16) * __expf(bs0 - bt.x); k1[j] = __uint_as_float(zz[t] & 0xffff0000u) * __expf(bs1 - bt.y); }
                    u32x4 w; w.x = pk2(k0[0], k0[1]); w.y = pk2(k0[2], k0[3]); w.z = pk2(k0[4], k0[5]); w.w = pk2(k0[6], k0[7]);
                    KTf[QK_IDX(hd, dir, b, (grp >> 1) * 4 + dt0) + 32 * (grp & 1) + dp0] = w;
                    w.x = pk2(k1[0], k1[1]); w.y = pk2(k1[2], k1[3]); w.z = pk2(k1[4], k1[5]); w.w = pk2(k1[6], k1[7]);
                    KTf[QK_IDX(hd, dir, b, (grp >> 1) * 4 + dt0) + 32 * (grp & 1) + dp0 + 1] = w; }
            }
        }
        LDSFENCE();
        const int tau = lane & 31, h = lane >> 5, row = rb + (dir ? 31 - tau : tau);
        u32x4 vt[8];
#pragma unroll
        for (int it = 0; it < 8; ++it) { const int idx = lane + 64 * it, t = idx / (DV / 8), c8 = idx % (DV / 8); const int rj = rb + (dir ? 31 - t : t);
            vt[it] = *(const u32x4*)(U + (size_t)rj * ld + mx.vcol + hd * DV + c8 * 8); }
        bf16x8 Ak[8], Bq[8];
#pragma unroll
        for (int ks = 0; ks < 8; ++ks) {
            float qh[8], kh[8], qt[8];
#pragma unroll
            for (int q2 = 0; q2 < 2; ++q2) {
                const int d0 = 16 * ks + 8 * q2 + 4 * h;
                const f32x4 b4 = *(const LAS f32x4*)(Bs + tau * 132 + d0), r4 = *(const LAS f32x4*)(Bs + 15 * 132 + d0);
                const u32x2 qr = *(const u32x2*)(U + (size_t)row * ld + hd * 128 + d0);
                float q4[4] = {__uint_as_float(qr.x << 16), __uint_as_float(qr.x & 0xffff0000u), __uint_as_float(qr.y << 16), __uint_as_float(qr.y & 0xffff0000u)};
                float k4[4];
                if (mx.even) { const u32x2 zr = *(const u32x2*)(U + (size_t)row * ld + 512 + 512 * dir + hd * 128 + d0);
                    const f32x4 lb4 = *(const f32x4*)(LB + dir * 1024 + mx.li * 512 + hd * 128 + d0);
                    const float z4[4] = {__uint_as_float(zr.x << 16), __uint_as_float(zr.x & 0xffff0000u), __uint_as_float(zr.y << 16), __uint_as_float(zr.y & 0xffff0000u)};
#pragma unroll
                    for (int e = 0; e < 4; ++e) k4[e] = (1.f - lb4[e]) / (1.f + __expf(z4[e]));
                } else { const u32x2 kr = *(const u32x2*)(U + (size_t)row * ld + 512 + hd * 128 + d0);
                    k4[0] = __uint_as_float(kr.x << 16); k4[1] = __uint_as_float(kr.x & 0xffff0000u); k4[2] = __uint_as_float(kr.y << 16); k4[3] = __uint_as_float(kr.y & 0xffff0000u); }
#pragma unroll
                for (int e = 0; e < 4; ++e) { const float qq = q4[e] * mx.qscale; qt[4 * q2 + e] = qq * __expf(b4[e]);
                    qh[4 * q2 + e] = qq * __expf(fminf(b4[e] - r4[e], 80.f)); kh[4 * q2 + e] = k4[e] * __expf(fminf(r4[e] - b4[e], 80.f)); }
            }
            { u32x4 w; w.x = pk2(qt[0], qt[1]); w.y = pk2(qt[2], qt[3]); w.z = pk2(qt[4], qt[5]); w.w = pk2(qt[6], qt[7]); QTf[QK_IDX(hd, dir, b, ks) + lane] = w; }
            Bq[ks] = pack8(qh[0], qh[1], qh[2], qh[3], qh[4], qh[5], qh[6], qh[7]);
            Ak[ks] = pack8(kh[0], kh[1], kh[2], kh[3], kh[4], kh[5], kh[6], kh[7]);
        }
        f32x16 at = zero16();
#pragma unroll
        for (int ks = 0; ks < 8; ++ks) at = MFMA32(Ak[ks], Bq[ks], at);
#pragma unroll
        for (int i = 0; i < 16; ++i) { const int s = (i & 3) + 8 * (i >> 2) + 4 * h; if (s > tau) at[i] = 0.f; }
        bf16x8 Pa[2];
        Pa[0] = pack8(at[0], at[1], at[2], at[3], at[4], at[5], at[6], at[7]);
        Pa[1] = pack8(at[8], at[9], at[10], at[11], at[12], at[13], at[14], at[15]);
        const int ET = DV / 32;
        LDSFENCE();
        LAS unsigned char* Vs = (LAS unsigned char*)Bs; const int vpitch = 2 * DV + 16;
#pragma unroll
        for (int it = 0; it < 8; ++it) { const int idx = lane + 64 * it, t = idx / (DV / 8), c8 = idx % (DV / 8); *(LAS u32x4*)(Vs + t * vpitch + c8 * 16) = vt[it]; }
        for (int idx = lane + 512; idx < 32 * (DV / 8); idx += 64) { const int t = idx / (DV / 8), c8 = idx % (DV / 8); const int rj = rb + (dir ? 31 - t : t);
            *(LAS u32x4*)(Vs + t * vpitch + c8 * 16) = *(const u32x4*)(U + (size_t)rj * ld + mx.vcol + hd * DV + c8 * 8); }
        LDSFENCE();
        for (int et = 0; et < ET; ++et) {
            f32x16 acc = zero16();
#pragma unroll
            for (int sp = 0; sp < 2; ++sp) {
                unsigned short v[8];
#pragma unroll
                for (int j = 0; j < 8; ++j) { const int sj = 16 * sp + 8 * (j >> 2) + 4 * h + (j & 3); v[j] = *(const LAS unsigned short*)(Vs + sj * vpitch + (32 * et + (lane & 31)) * 2); }
                u32x4 w; w.x = v[0] | ((unsigned)v[1] << 16); w.y = v[2] | ((unsigned)v[3] << 16); w.z = v[4] | ((unsigned)v[5] << 16); w.w = v[6] | ((unsigned)v[7] << 16);
                Vf[V_IDX(hd, dir, ET, et, b, sp) + lane] = w;
                acc = MFMA32(Pa[sp], __builtin_bit_cast(bf16x8, w), acc);
            }
#pragma unroll
            for (int r = 0; r < 2; ++r) { u32x4 w; w.x = pk2s(acc[8 * r], acc[8 * r + 1]); w.y = pk2s(acc[8 * r + 2], acc[8 * r + 3]); w.z = pk2s(acc[8 * r + 4], acc[8 * r + 5]); w.w = pk2s(acc[8 * r + 6], acc[8 * r + 7]);
                ((u32x4*)Of)[OB_IDX(hd, dir, ET, et, b, r) + lane] = w; }
        }
        LDSFENCE();
    }
}
__device__ __forceinline__ void scan_phase(const Ctx& C, const Mix& mx) {
    const u32x4* QTf = (const u32x4*)(C.ws + ARENA + A_QT); const u32x4* KTf = (const u32x4*)(C.ws + ARENA + A_KT); const u32x4* Vf = (const u32x4*)mx.vf;
    u32x4* Of = (u32x4*)(C.ws + ARENA + A_OEV); const float* DEC = (const float*)(C.ws + ARENA + A_DEC);
    const int lane = C.lane, h = lane >> 5, DV = mx.DV, ET = DV / 32, T = mx.T, nb = T / 32;
    const int units = (CH / T) * 8 * ET;
    constexpr int SLOT = 23552, R = 5, NL = 4;
    LAS u32x4* SB = (LAS u32x4*)(C.lds + R * SLOT);
    for (int base = 0; base < units; base += C.G) {
        const bool loader = C.wave >= 2 && C.wave < 2 + NL;
        const int lr = C.wave - 2;
        const int vcu = (C.G % 8 == 0) ? (C.bid % 8) * (C.G / 8) + C.bid / 8 : C.bid;
        const int u = base + vcu;
        const bool valid = u < units;
        const int et = u % ET, x = u / ET, dir = x & 1, hd = (x >> 1) & 3, seq = x >> 3;
        LAS unsigned char* ring = C.lds;
#define SCAN_BAR() do { asm volatile("s_waitcnt lgkmcnt(0)" ::: "memory"); __builtin_amdgcn_s_barrier(); asm volatile("" ::: "memory"); } while (0)
#define GLDS16(gp, lp) __builtin_amdgcn_global_load_lds((const unsigned*)(gp), (LAS unsigned*)(lp), 16, 0, 0)
#define SCAN_ISSUE(j) do { const int blk_ = seq * nb + (dir ? nb - 1 - (j) : (j)); LAS unsigned char* sl_ = ring + ((j) % R) * SLOT; \
            _Pragma("unroll") for (int k = 0; k < 8; ++k) { GLDS16(QTf + QK_IDX(hd, dir, blk_, k) + lane, sl_ + k * 1024); GLDS16(KTf + QK_IDX(hd, dir, blk_, k) + lane, sl_ + (8 + k) * 1024); } \
            _Pragma("unroll") for (int sp = 0; sp < 2; ++sp) GLDS16(Vf + V_IDX(hd, dir, ET, et, blk_, sp) + lane, sl_ + (16 + sp) * 1024); \
            _Pragma("unroll") for (int r = 0; r < 2; ++r) GLDS16(Of + OB_IDX(hd, dir, ET, et, blk_, r) + lane, sl_ + (18 + r) * 1024); \
            if (lane < 32) GLDS16(DEC + DEC_IDX(hd, dir, blk_) + 4 * lane, sl_ + 22 * 1024); } while (0)
        if (C.wave == 0) {
            SCAN_BAR();
            for (int i = 0; i < nb; ++i) {
                if (valid) {
                    const LAS u32x4* sv = (const LAS u32x4*)(ring + (i % R) * SLOT) + lane; const LAS u32x4* sb = SB + (i & 1) * 512 + lane;
                    u32x4 qf[8], on[2], bs[8];
#pragma unroll
                    for (int r = 0; r < 2; ++r) on[r] = sv[(18 + r) * 64];
#pragma unroll
                    for (int k = 0; k < 8; ++k) { qf[k] = sv[k * 64]; bs[k] = sb[k * 64]; }
                    asm volatile("s_waitcnt lgkmcnt(0)" ::: "memory");
                    f32x16 acc;
#pragma unroll
                    for (int r = 0; r < 2; ++r) {
                        acc[8 * r + 0] = __uint_as_float(on[r].x << 16); acc[8 * r + 1] = __uint_as_float(on[r].x & 0xffff0000u); acc[8 * r + 2] = __uint_as_float(on[r].y << 16); acc[8 * r + 3] = __uint_as_float(on[r].y & 0xffff0000u);
                        acc[8 * r + 4] = __uint_as_float(on[r].z << 16); acc[8 * r + 5] = __uint_as_float(on[r].z & 0xffff0000u); acc[8 * r + 6] = __uint_as_float(on[r].w << 16); acc[8 * r + 7] = __uint_as_float(on[r].w & 0xffff0000u); }
#pragma unroll
                    for (int k = 0; k < 8; ++k) acc = MFMA32(__builtin_bit_cast(bf16x8, qf[k]), __builtin_bit_cast(bf16x8, bs[k]), acc);
                    const int blk = seq * nb + (dir ? nb - 1 - i : i);
#pragma unroll
                    for (int r = 0; r < 2; ++r) { u32x4 w; w.x = pk2s(acc[8 * r], acc[8 * r + 1]); w.y = pk2s(acc[8 * r + 2], acc[8 * r + 3]); w.z = pk2s(acc[8 * r + 4], acc[8 * r + 5]); w.w = pk2s(acc[8 * r + 6], acc[8 * r + 7]);
                        Of[OB_IDX(hd, dir, ET, et, blk, r) + lane] = w; }
                }
                SCAN_BAR();
            }
        } else if (C.wave == 1) {
            f32x16 S[4];
#pragma unroll
            for (int dt = 0; dt < 4; ++dt) S[dt] = zero16();
#pragma unroll
            for (int k = 0; k < 8; ++k) SB[k * 64 + lane] = (u32x4){0u, 0u, 0u, 0u};
            SCAN_BAR();
            for (int i = 0; i < nb; ++i) {
                if (valid) {
                    const LAS unsigned char* sl = ring + (i % R) * SLOT; const LAS u32x4* sv = (const LAS u32x4*)sl + lane;
                    u32x4 kf[8], vf[2]; f32x4 dq[16];
#pragma unroll
                    for (int k = 0; k < 8; ++k) kf[k] = sv[(8 + k) * 64];
#pragma unroll
                    for (int sp = 0; sp < 2; ++sp) vf[sp] = sv[(16 + sp) * 64];
                    const LAS float* dp = (const LAS float*)(sl + 22 * 1024) + 4 * h;
#pragma unroll
                    for (int k = 0; k < 16; ++k) dq[k] = *(const LAS f32x4*)(dp + 8 * k);
                    asm volatile("s_waitcnt lgkmcnt(0)" ::: "memory");
#pragma unroll
                    for (int dt = 0; dt < 4; ++dt)
#pragma unroll
                        for (int q = 0; q < 4; ++q) {
#pragma unroll
                            for (int e = 0; e < 4; ++e) S[dt][4 * q + e] *= dq[4 * dt + q][e]; }
#pragma unroll
                    for (int sp = 0; sp < 2; ++sp) {
#pragma unroll
                        for (int dt = 0; dt < 4; ++dt) S[dt] = MFMA32(__builtin_bit_cast(bf16x8, kf[sp * 4 + dt]), __builtin_bit_cast(bf16x8, vf[sp]), S[dt]); }
                    LAS u32x4* sbw = SB + ((i + 1) & 1) * 512 + lane;
#pragma unroll
                    for (int dt = 0; dt < 4; ++dt)
#pragma unroll
                        for (int sp = 0; sp < 2; ++sp)
                            sbw[(2 * dt + sp) * 64] = __builtin_bit_cast(u32x4, pack8s(S[dt][8 * sp + 0], S[dt][8 * sp + 1], S[dt][8 * sp + 2], S[dt][8 * sp + 3], S[dt][8 * sp + 4], S[dt][8 * sp + 5], S[dt][8 * sp + 6], S[dt][8 * sp + 7]));
                }
                SCAN_BAR();
            }
        } else {
            if (loader && valid && lr < nb) SCAN_ISSUE(lr);
            for (int i = -1; i < nb; ++i) {
                if (loader && valid) {
                    if (i >= 0 && lr == i % NL && i + NL < nb) SCAN_ISSUE(i + NL);
                    if (lr == (i + 1) % NL && i + 1 < nb) asm volatile("s_waitcnt vmcnt(0)" ::: "memory");
                }
                SCAN_BAR();
            }
        }
#undef SCAN_ISSUE
#undef GLDS16
#undef SCAN_BAR
    }
}
__device__ __forceinline__ void attn_phase(const Ctx& C, int T) {
    const bf16_t* U = (const bf16_t*)(C.ws + ARENA + A_U);
    bf16_t* OG = (bf16_t*)(C.ws + ARENA + A_OG); float* LSE = (float*)(C.ws + ARENA + A_LSE);
    const int lane = C.lane, h = lane >> 5, l31 = lane & 31, ld = EV_IN, tps = T / 32;
    for (int task = C.bid * NWV + C.wave; task < 3 * 4 * (CH / 32); task += C.G * NWV) {
        const int g = task / 2048, x = task % 2048, hd = x / 512, y = x % 512, seq = y / tps, z = y % tps;
        const int dil = 1 << (2 * g), L = T / dil, nqb = L / 32, r = z / nqb, qb = z % nqb, m0 = 32 * qb;
        const int qcol = 2560 + g * 1536 + hd * 128, kcol = qcol + 512, vcol = qcol + 1024;
        const float coef = exp2f(-8.0f * (float)(g * 4 + hd + 1) / 12.0f) * (float)dil, scale = 0.08838834764831845f;
        const size_t rbase = (size_t)seq * T + r;
        bf16x8 Bq[8];
        { const bf16_t* qp = U + (rbase + (size_t)(m0 + l31) * dil) * ld + qcol + 8 * h;
#pragma unroll
          for (int ks = 0; ks < 8; ++ks) Bq[ks] = *(const bf16x8*)(qp + 16 * ks); }
        f32x16 st[5];
        bf16x8 Kc[8], Kn[8];
        {   const int mkc0 = (m0 - 64) < 0 ? 0 : (m0 - 64);
            const bf16_t* kp = U + (rbase + (size_t)(mkc0 + l31) * dil) * ld + kcol + 8 * h;
#pragma unroll
            for (int ks = 0; ks < 8; ++ks) Kc[ks] = *(const bf16x8*)(kp + 16 * ks); }
#pragma unroll
        for (int kb = 0; kb < 5; ++kb) {
            const int mk0 = m0 - 64 + 32 * kb; const bool vb = (mk0 >= 0 && mk0 < L);
            if (kb < 4) { const int mk1 = mk0 + 32; const int mkc1 = mk1 < 0 ? 0 : (mk1 >= L ? L - 32 : mk1);
                const bf16_t* kp = U + (rbase + (size_t)(mkc1 + l31) * dil) * ld + kcol + 8 * h;
#pragma unroll
                for (int ks = 0; ks < 8; ++ks) Kn[ks] = *(const bf16x8*)(kp + 16 * ks); }
            f32x16 s = zero16();
#pragma unroll
            for (int ks = 0; ks < 8; ++ks) s = MFMA32(Kc[ks], Bq[ks], s);
#pragma unroll
            for (int i = 0; i < 16; ++i) { const int rel = (mk0 + (i & 3) + 8 * (i >> 2) + 4 * h) - (m0 + l31); const int ar = rel < 0 ? -rel : rel;
                s[i] = (vb && ar <= 64) ? s[i] * scale - coef * (float)ar : -1e30f; }
            st[kb] = s;
#pragma unroll
            for (int ks = 0; ks < 8; ++ks) Kc[ks] = Kn[ks];
        }
        float mxv = -1e30f;
#pragma unroll
        for (int kb = 0; kb < 5; ++kb)
#pragma unroll
            for (int i = 0; i < 16; ++i) mxv = fmaxf(mxv, st[kb][i]);
        mxv = fmaxf(mxv, shfl_xor_l(mxv, lane, 32));
        float den = 0.f;
#pragma unroll
        for (int kb = 0; kb < 5; ++kb)
#pragma unroll
            for (int i = 0; i < 16; ++i) { const float p = __expf(st[kb][i] - mxv); st[kb][i] = p; den += p; }
        den += shfl_xor_l(den, lane, 32);
        f32x16 ot[4];
#pragma unroll
        for (int dt = 0; dt < 4; ++dt) ot[dt] = zero16();
        LAS unsigned char* Vs = C.lds + C.wave * 16896;
#pragma unroll
        for (int kb = 0; kb < 5; ++kb) {
            const int mk0 = m0 - 64 + 32 * kb; const int mkc = mk0 < 0 ? 0 : (mk0 >= L ? L - 32 : mk0);
            u32x4 vr[8];
#pragma unroll
            for (int it = 0; it < 8; ++it) { const int idx = lane + 64 * it, t = idx >> 4, c8 = idx & 15; vr[it] = *(const u32x4*)(U + (rbase + (size_t)(mkc + t) * dil) * ld + vcol + c8 * 8); }
            LDSFENCE();
#pragma unroll
            for (int it = 0; it < 8; ++it) { const int idx = lane + 64 * it, t = idx >> 4, c8 = idx & 15; *(LAS u32x4*)(Vs + t * 272 + c8 * 16) = vr[it]; }
            LDSFENCE();
#pragma unroll
            for (int sp = 0; sp < 2; ++sp) {
                const bf16x8 Bp = pack8(st[kb][8 * sp + 0], st[kb][8 * sp + 1], st[kb][8 * sp + 2], st[kb][8 * sp + 3], st[kb][8 * sp + 4], st[kb][8 * sp + 5], st[kb][8 * sp + 6], st[kb][8 * sp + 7]);
#pragma unroll
                for (int dt = 0; dt < 4; ++dt) {
                    typedef short v4i16_t __attribute__((ext_vector_type(4)));
                    const LAS unsigned char* tp = Vs + (16 * sp + 4 * h + ((lane & 15) >> 2)) * 272 + (32 * dt + 16 * ((lane >> 4) & 1) + 4 * (lane & 3)) * 2;
                    const v4i16_t lo = __builtin_amdgcn_ds_read_tr16_b64_v4i16((LAS v4i16_t*)tp), hi = __builtin_amdgcn_ds_read_tr16_b64_v4i16((LAS v4i16_t*)(tp + 8 * 272));
                    bf16x8 w; w[0] = lo[0]; w[1] = lo[1]; w[2] = lo[2]; w[3] = lo[3]; w[4] = hi[0]; w[5] = hi[1]; w[6] = hi[2]; w[7] = hi[3];
                    ot[dt] = MFMA32(w, Bp, ot[dt]);
                }
            }
        }
        const float inv = 1.f / den; const size_t qrow = rbase + (size_t)(m0 + l31) * dil;
        bf16_t* op = OG + ((size_t)g * CH + qrow) * 512 + hd * 128 + 4 * h;
#pragma unroll
        for (int dt = 0; dt < 4; ++dt)
#pragma unroll
            for (int q = 0; q < 4; ++q) { u32x2 w; w.x = pk2(ot[dt][4 * q] * inv, ot[dt][4 * q + 1] * inv); w.y = pk2(ot[dt][4 * q + 2] * inv, ot[dt][4 * q + 3] * inv);
                *(u32x2*)(op + 32 * dt + 8 * q) = w; }
        if (h == 0) LSE[((size_t)g * CH + qrow) * 4 + hd] = mxv + __logf(den);
    }
}
__device__ __forceinline__ void finalize_phase(const Ctx& C, const Mix& mx) {
    const Args& a = *C.a;
    const bf16_t* __restrict__ U = (const bf16_t*)(C.ws + ARENA + A_U); bf16_t* __restrict__ MIX = (bf16_t*)(C.ws + ARENA + A_MIX);
    const f32x4* __restrict__ Of = (const f32x4*)(C.ws + ARENA + A_OEV);
    const int gw = C.bid * NWV + C.wave, NGW = C.G * NWV, lane = C.lane, ld = mx.ld, DV = mx.DV, ET = DV / 32, NE = DV / 64;
    const float* gn = mx.even ? a.in[I_HNORM] + mx.li * 512 : a.in[I_GNORM] + mx.li * 1024;
    const bool xmap = (C.G == 256); const int xcd_ = C.bid & 7, xi_ = C.bid >> 3;
#pragma unroll 2
    for (int it_ = 0; it_ < 2 || !xmap; ++it_) {
        const int rg = xmap ? xcd_ * 512 + it_ * 256 + xi_ * 8 + C.wave : gw + it_ * NGW;
        if (rg >= CH / 4) break;
        const int r0 = 4 * rg, blk = r0 >> 5, t0 = r0 & 31;
        const int qf = t0 >> 3, hf = (t0 >> 2) & 1, tb = 28 - t0, qb = tb >> 3, hb2 = (tb >> 2) & 1;
#pragma unroll
        for (int hd = 0; hd < 4; ++hd) {
            float o[2][2][4]; float ss[4] = {0.f, 0.f, 0.f, 0.f};
            const u32x2* Ob2 = (const u32x2*)Of;
#pragma unroll
            for (int k = 0; k < 2; ++k) if (2 * k < NE) {
                const int e0 = 2 * lane + 128 * k, et = e0 >> 5;
#pragma unroll
                for (int p = 0; p < 2; ++p) {
                    const u32x2 vf_ = Ob2[(OB_IDX(hd, 0, ET, et, blk, qf >> 1) + 32 * hf + (e0 & 31) + p) * 2 + (qf & 1)], vb_ = Ob2[(OB_IDX(hd, 1, ET, et, blk, qb >> 1) + 32 * hb2 + (e0 & 31) + p) * 2 + (qb & 1)];
                    o[k][p][0] = __uint_as_float(vf_.x << 16) + __uint_as_float(vb_.y & 0xffff0000u); o[k][p][1] = __uint_as_float(vf_.x & 0xffff0000u) + __uint_as_float(vb_.y << 16);
                    o[k][p][2] = __uint_as_float(vf_.y << 16) + __uint_as_float(vb_.x & 0xffff0000u); o[k][p][3] = __uint_as_float(vf_.y & 0xffff0000u) + __uint_as_float(vb_.x << 16);
#pragma unroll
                    for (int j = 0; j < 4; ++j) ss[j] += o[k][p][j] * o[k][p][j];
                }
            }
#pragma unroll
            for (int j = 0; j < 4; ++j) ss[j] = rsqrtf(wave_sum(ss[j], lane) / (float)DV + EPS);
#pragma unroll
            for (int k = 0; k < 2; ++k) if (2 * k < NE) {
                const int c = hd * DV + 2 * lane + 128 * k; const f32x2 g2 = *(const f32x2*)(gn + c);
#pragma unroll
                for (int j = 0; j < 4; ++j) { const unsigned agw = *(const unsigned*)(U + (size_t)(r0 + j) * ld + 2048 + c);
                    const float a0 = __uint_as_float(agw << 16), a1 = __uint_as_float(agw & 0xffff0000u);
                    *(unsigned*)(MIX + (size_t)(r0 + j) * DM + c) = pk2(o[k][0][j] * ss[j] * g2.x * (a0 / (1.f + __expf(-a0))), o[k][1][j] * ss[j] * g2.y * (a1 / (1.f + __expf(-a1)))); }
            }
        }
        if (mx.even) {
            const bf16_t* __restrict__ OG = (const bf16_t*)(C.ws + ARENA + A_OG); const float* __restrict__ LSE = (const float*)(C.ws + ARENA + A_LSE);
            const int c8 = lane * 8, hd = lane >> 4;
#pragma unroll
            for (int j = 0; j < 4; ++j) { const int r = r0 + j;
                const float l0 = LSE[((size_t)0 * CH + r) * 4 + hd], l1 = LSE[((size_t)1 * CH + r) * 4 + hd], l2 = LSE[((size_t)2 * CH + r) * 4 + hd];
                const float m = fmaxf(l0, fmaxf(l1, l2)); float w0 = __expf(l0 - m), w1 = __expf(l1 - m), w2 = __expf(l2 - m); const float iw = 1.f / (w0 + w1 + w2);
                w0 *= iw; w1 *= iw; w2 *= iw;
                const u32x4 v0 = *(const u32x4*)(OG + ((size_t)0 * CH + r) * 512 + c8), v1 = *(const u32x4*)(OG + ((size_t)1 * CH + r) * 512 + c8), v2 = *(const u32x4*)(OG + ((size_t)2 * CH + r) * 512 + c8);
                u32x4 o;
#pragma unroll
                for (int k = 0; k < 4; ++k) {
                    const float bx = w0 * __uint_as_float(v0[k] << 16) + w1 * __uint_as_float(v1[k] << 16) + w2 * __uint_as_float(v2[k] << 16);
                    const float by = w0 * __uint_as_float(v0[k] & 0xffff0000u) + w1 * __uint_as_float(v1[k] & 0xffff0000u) + w2 * __uint_as_float(v2[k] & 0xffff0000u);
                    o[k] = pk2(bx, by); }
                *(u32x4*)(MIX + (size_t)r * DM + 512 + c8) = o;
            }
        }
    }
}
#define XB_TMO      128
#define XB_XCNT(j)  (256  + 64 * (j))
#define XB_XSUB(j)  (1280 + 64 * (j))
#define XB_XGEN(j)  (2304 + 64 * (j))
#define XB_TOP      3328
#define XB_TOPGEN   3392
#define XCD_BAR_WORDS 3456
#define XB_SPIN_CAP (1u << 18)

__device__ __forceinline__ unsigned xb_ld(unsigned* p)              { return __hip_atomic_load(p, __ATOMIC_RELAXED, __HIP_MEMORY_SCOPE_AGENT); }
__device__ __forceinline__ unsigned xb_add(unsigned* p, unsigned v) { return __hip_atomic_fetch_add(p, v, __ATOMIC_RELAXED, __HIP_MEMORY_SCOPE_AGENT); }
__device__ __forceinline__ unsigned xb_xcc_id() { return (unsigned)__builtin_amdgcn_s_getreg((3 << 11) | 20) & 0xFu; }
#define XB_SPIN(cond, bar) do { unsigned _sp = 0; while (cond) { __builtin_amdgcn_s_sleep(1); \
    if ((++_sp & 255u) == 0u) { if (xb_ld(&(bar)[XB_TMO])) break; if (_sp > XB_SPIN_CAP) { atomicAdd(&(bar)[XB_TMO], 1u); break; } } } } while (0)

struct XcdBarrier {
    unsigned* bar; unsigned x;
    volatile LAS unsigned* st;
};

__device__ __forceinline__ XcdBarrier xcd_barrier_post(unsigned* bar, volatile LAS unsigned* st) {
    XcdBarrier b; b.bar = bar; b.x = xb_xcc_id(); b.st = st;
    if (threadIdx.x == 0) (void)xb_add(&bar[XB_XCNT(b.x)], 1u);
    return b;
}
__device__ __forceinline__ void xcd_barrier_complete(unsigned* bar, unsigned x, unsigned& nloc, unsigned& nx) {
    const unsigned G = gridDim.x * gridDim.y * gridDim.z;
    unsigned sum, cnt, mine, sp = 0u;
    for (;;) {
        sum = 0u; cnt = 0u; mine = 0u;
#pragma unroll
        for (unsigned j = 0; j < 16; ++j) { const unsigned c = xb_ld(&bar[XB_XCNT(j)]); sum += c; cnt += (c > 0u) ? 1u : 0u; mine = (j == x) ? c : mine; }
        if (sum == G) break;
        __builtin_amdgcn_s_sleep(1);
        if ((++sp & 255u) == 0u) { if (xb_ld(&bar[XB_TMO])) break; if (sp > XB_SPIN_CAP) { atomicAdd(&bar[XB_TMO], 1u); break; } }
    }
    nloc = mine > 0u ? mine : 1u; nx = cnt > 0u ? cnt : 1u;
}

__device__ __forceinline__ void xcd_barrier(const XcdBarrier& b) {
    asm volatile("s_waitcnt vmcnt(0)" ::: "memory");
    __syncthreads();
    if (threadIdx.x == 0) {
        unsigned* bar = b.bar;
        __builtin_amdgcn_s_waitcnt(0);
        unsigned nloc = b.st[0], nx = b.st[1];
        if (nloc == 0u) { xcd_barrier_complete(bar, b.x, nloc, nx); b.st[0] = nloc; b.st[1] = nx; }
        const unsigned old = xb_add(&bar[XB_XSUB(b.x)], 1u);
        const unsigned gen = old / nloc;
        if (old + 1u == (gen + 1u) * nloc) {
            __builtin_amdgcn_fence(__ATOMIC_RELEASE, "agent");
            asm volatile("s_waitcnt vmcnt(0)" ::: "memory");
            const unsigned og = xb_add(&bar[XB_TOP], 1u);
            const unsigned tg = og / nx;
            if (og + 1u == (tg + 1u) * nx) xb_add(&bar[XB_TOPGEN], 1u);
            else XB_SPIN(xb_ld(&bar[XB_TOPGEN]) == tg, bar);
            __builtin_amdgcn_fence(__ATOMIC_ACQUIRE, "agent");
            xb_add(&bar[XB_XGEN(b.x)], 1u);
            asm volatile("s_waitcnt vmcnt(0)" ::: "memory");
        } else {
            XB_SPIN(xb_ld(&bar[XB_XGEN(b.x)]) == gen, bar);
            __builtin_amdgcn_fence(__ATOMIC_ACQUIRE, "agent");
            asm volatile("s_waitcnt vmcnt(0)" ::: "memory");
        }
    }
    __syncthreads();
}
#define PHASE_BEGIN() do { int t_ = threadIdx.x; asm volatile("" : "+v"(t_)); C.tid = t_; C.lane = t_ & 63; C.wave = __builtin_amdgcn_readfirstlane(t_ >> 6); \
    int b_ = blockIdx.x; asm volatile("" : "+s"(b_)); C.bid = b_; unsigned char* w_ = args.ws; asm volatile("" : "+s"(w_)); C.ws = w_; ws = w_; \
    hb_c = (bf16_t*)(ws + (s ? B_HB1 : B_HB0)); hb_n = (bf16_t*)(ws + (s ? B_HB0 : B_HB1)); sq_c = (float*)(ws + (s ? B_SSQ1 : B_SSQ0)); sq_n = (float*)(ws + (s ? B_SSQ0 : B_SSQ1)); Ub = (bf16_t*)(ws + ARENA + A_U); MIXb = (bf16_t*)(ws + ARENA + A_MIX); \
    hch = args.out + (size_t)chunk * CH * DM; } while (0)
__global__ void __launch_bounds__(NT, 2) fwd_mega(Args args) {
    extern __shared__ __attribute__((aligned(16))) unsigned char lds_raw[];
    cg::grid_group grid = cg::this_grid();
    Ctx C; C.lds = (LAS unsigned char*)lds_raw; C.tid = threadIdx.x; C.lane = C.tid & 63; C.wave = __builtin_amdgcn_readfirstlane(C.tid >> 6);
    C.G = gridDim.x; C.bid = blockIdx.x; C.a = &args; C.ws = args.ws;
    unsigned char* ws = args.ws;
    bf16_t *hb_c, *hb_n; float *sq_c, *sq_n; bf16_t *Ub, *MIXb;
    if (blockIdx.x == 0) for (int i = threadIdx.x; i < XCD_BAR_WORDS; i += NT) ((unsigned*)args.ws)[i] = 0u;
    if (threadIdx.x < 2) ((volatile LAS unsigned*)(C.lds + LDS_BYTES - 256))[threadIdx.x] = 0u;
    weights_prologue(C);
    __syncthreads();
    grid.sync();
    XcdBarrier bar = xcd_barrier_post((unsigned*)args.ws, (volatile LAS unsigned*)(C.lds + LDS_BYTES - 256));
    float* hch;
#ifdef PROBE_A
    unsigned tacc[12];
#pragma unroll
    for (int i = 0; i < 12; ++i) tacc[i] = 0u;
    unsigned long long tprev = __builtin_amdgcn_s_memrealtime();
#define TICK(k) do { const unsigned long long now_ = __builtin_amdgcn_s_memrealtime(); tacc[k] += (unsigned)(now_ - tprev); tprev = now_; } while (0)
#else
#define TICK(k) do {} while (0)
#endif
#pragma nounroll
    for (int chunk = 0; chunk < NCHUNK; ++chunk) {
        const int T = chunk == 0 ? 4096 : 2048; int s = 0;
        PHASE_BEGIN();
        chunk_prologue(C, chunk, hb_c, sq_c);
        xcd_barrier(bar); TICK(10);
#pragma nounroll
        for (int l = 0; l < DEPTH; ++l) {
            const int even = (l & 1) == 0, li = l >> 1;
            Mix mx; mx.even = even; mx.li = li; mx.T = T; mx.DV = even ? 128 : 256; mx.ld = even ? EV_IN : OD_INP; mx.vcol = even ? 1536 : 1024; mx.gcol = 2048; mx.qscale = even ? 1.f : 0.08838834764831845f; mx.vf = nullptr;
            PHASE_BEGIN();
            {
                const int N = even ? EV_IN : OD_INP;
                const bf16_t* Wt = even ? (const bf16_t*)(ws + W_EVIN) + (size_t)li * EV_IN * DM : (const bf16_t*)(ws + W_ODIN) + (size_t)li * OD_INP * DM;
                pg8::Gemm g{hb_c, Wt, CH, N, DM, 256}; pg8::StaticOrder S; S.init(CH, N, C.G, C.bid);
                EpiScale E{Ub, N, sq_c};
                pg8::gemm_phase<EpiScale, pg8::StaticOrder, true, true>(C.lds, g, S, E);
            }
            xcd_barrier(bar); TICK(1);
            PHASE_BEGIN(); mx.vf = even ? (unsigned char*)hb_n : ws + ARENA + A_VFOD;
#ifndef NO_PREP
            prep_phase(C, mx);
#endif
            TICK(2);
            PHASE_BEGIN();
#ifndef NO_ATTN
            if (even) attn_phase(C, T);
#endif
            TICK(7);
            xcd_barrier(bar); TICK(0);
            PHASE_BEGIN(); mx.vf = even ? (unsigned char*)hb_n : ws + ARENA + A_VFOD;
#ifndef NO_SCAN
            scan_phase(C, mx);
#endif
            xcd_barrier(bar); TICK(3);
            PHASE_BEGIN();
#ifndef NO_FIN
            finalize_phase(C, mx);
#endif
            pb_convert(C, chunk, l);
            xcd_barrier(bar); TICK(4);
            PHASE_BEGIN();
            {
                const bf16_t* Wt = even ? (const bf16_t*)(ws + W_EVOUT) + (size_t)li * DM * DM : (const bf16_t*)(ws + W_ODOUT) + (size_t)li * DM * DM;
                pg8::Gemm g{MIXb, Wt, CH, DM, DM, 256}; pg8::StaticOrder S; S.init(CH, DM, C.G, C.bid);
                EpiResid<0> E{hch, hb_n, sq_n, nullptr, nullptr};
                pg8::gemm_phase<EpiResid<0>, pg8::StaticOrder, true, true>(C.lds, g, S, E);
                s ^= 1;
            }
            xcd_barrier(bar); TICK(5);
            PHASE_BEGIN();
            {
                pg8::Gemm g{hb_c - DM, (const bf16_t*)(ws + W_UP) + (size_t)l * 2 * DFF * DM, 65 * 256, 2 * DFF, DM, 254}; pg8::StaticOrder S; S.init(65 * 256, 2 * DFF, C.G, C.bid);
                EpiConv E{(bf16_t*)(ws + ARENA + A_ACT), sq_c, args.in[I_CW] + (size_t)l * 3 * 2 * DFF, args.in[I_CB] + (size_t)l * 2 * DFF, T, (LAS float*)(C.lds + 131072)};
                pg8::gemm_phase<EpiConv, pg8::StaticOrder, true, true>(C.lds, g, S, E);
            }
            {
                const int rem = (65 * 22) % C.G, c0 = rem, gs = rem ? C.G - rem : C.G;
                if (C.bid >= c0) {
                    PHASE_BEGIN();
                    pg8::Gemm g2{(const bf16_t*)(ws + B_PB), (const bf16_t*)(ws + W_PROJ) + (size_t)l * DM * PLE, CH, DM, PLE, 256}; pg8::StaticOrder S2; S2.init(CH, DM, gs, C.bid - c0);
                    EpiF32 E2{(bf16_t*)(ws + ARENA + A_PP), DM};
                    pg8::gemm_phase<EpiF32, pg8::StaticOrder, true, true>(C.lds, g2, S2, E2);
                }
            }
            xcd_barrier(bar); TICK(6);
            PHASE_BEGIN();
            {
                pg8::Gemm g{(const bf16_t*)(ws + ARENA + A_ACT), (const bf16_t*)(ws + W_DOWN) + (size_t)l * DM * DFF, CH, DM, DFF, 256}; pg8::StaticOrder S; S.init(CH, DM, C.G, C.bid);
                EpiResid<0> E{hch, hb_n, sq_n, nullptr, nullptr};
                pg8::gemm_phase<EpiResid<0>, pg8::StaticOrder, true, true>(C.lds, g, S, E);
                s ^= 1;
            }
            xcd_barrier(bar); TICK(8);
            PHASE_BEGIN();
            {
                pg8::Gemm g{hb_c, (const bf16_t*)(ws + W_GATE) + (size_t)l * DM * DM, CH, DM, DM, 256}; pg8::StaticOrder S; S.init(CH, DM, C.G, C.bid);
                EpiResid<1> E{hch, hb_n, sq_n, sq_c, (const bf16_t*)(ws + ARENA + A_PP)};
                pg8::gemm_phase<EpiResid<1>, pg8::StaticOrder, true, true>(C.lds, g, S, E);
                s ^= 1;
            }
            xcd_barrier(bar); TICK(9);
        }
        PHASE_BEGIN();
        final_norm(C, chunk);
        TICK(10);
    }
#ifdef PROBE_A
    xcd_barrier(bar); TICK(10);
    for (int i = 0; i < 100; ++i) xcd_barrier(bar);
    TICK(11);
    if (blockIdx.x == 0) {
        const float x1 = 8.f + (float)tacc[PROBE_A] * 1e-5f, t2 = 0.1f * (float)tacc[PROBE_B] * 1e-5f;
        float* o0 = args.out; float* o1 = args.out + (size_t)16384 * 1024;
        if (threadIdx.x == 0) { o0[0] += x1; o1[0] += x1; o1[1] += x1; }
        for (int i = threadIdx.x; i < 8192; i += NT) o0[1024 + i] += t2;
        for (int i = threadIdx.x; i < 16384; i += NT) o1[1024 + i] += t2;
    }
#endif
}
extern "C" void kernel_launch(void* const* d_in, const int* in_sizes, int n_in, void* d_out, int out_size, void* d_ws, size_t ws_size, hipStream_t stream) {
    static int grid = 0;
    if (grid == 0) {
        int dev = 0, cus = 0, per = 0;
        (void)hipGetDevice(&dev); (void)hipDeviceGetAttribute(&cus, hipDeviceAttributeMultiprocessorCount, dev);
        (void)hipFuncSetAttribute((const void*)fwd_mega, hipFuncAttributeMaxDynamicSharedMemorySize, LDS_BYTES);
        (void)hipOccupancyMaxActiveBlocksPerMultiprocessor(&per, (const void*)fwd_mega, NT, LDS_BYTES);
        if (per < 1) per = 1;
        grid = cus * per;
        fprintf(stderr, "kernel_launch: grid %d (cus %d x %d), ws %zu need %zu\n", grid, cus, per, ws_size, (size_t)WS_NEED);
        if (n_in != 23 || ws_size < WS_NEED) { fprintf(stderr, "kernel_launch: bad inputs / workspace too small\n"); grid = -1; }
    }
    if (grid < 0) return;
    Args a{};
    for (int i = 0; i < 23; ++i) a.in[i] = (const float*)d_in[i];
    a.out = (float*)d_out; a.ws = (unsigned char*)d_ws; a.ph_lo = 0; a.ph_hi = 0;
    void* kargs[] = {&a};
    hipError_t e = hipLaunchCooperativeKernel((const void*)fwd_mega, dim3(grid), dim3(NT), kargs, LDS_BYTES, stream);
    if (e != hipSuccess) fprintf(stderr, "kernel_launch: cooperative launch failed: %s\n", hipGetErrorString(e));
}
```
